# Optimizing an MI355X kernel written in HIP

```python
import jax, jax.numpy as jnp
from jax import lax
import numpy as np

D_MODEL = 1024
BATCH = 8
SEQ = 2048
DEPTH = 4
DEC_BATCH = 128
DEC_SEQ = 4
PAST_LEN = 16384
PAGE_SIZE = 128

N_AB_LAYERS = (DEPTH + 1) // 2
N_C_LAYERS = DEPTH // 2
H_A = 8
N_A = 64
C_A = H_A * N_A
W_LORA = 64
A_LORA = 64
G_LORA = 128
A_SHIFT_COLS = 3 * C_A + W_LORA + A_LORA + G_LORA
RWKV_GN_EPS = 64e-5
H_B = 4
DK_B = 128
DV_B = 128
C_B = H_B * DV_B
RET_CHUNK = 128
ROPE_THETA = 10000.0
RET_GN_EPS = 1e-5
AB_COLS = A_SHIFT_COLS + 2 * H_B * DK_B + 2 * C_B
H_C = 8
DK_C = 128
DV_C = 128
C_C = H_C * DV_C
CONV_W = 4
GDN_CHUNK = 64
N_QKV_C = 2 * H_C * DK_C + C_C
C_COLS = N_QKV_C + 2 * H_C + C_C
D_FF = 2816
LN_EPS = 1e-5
DEEPNORM_ALPHA = (2 * DEPTH) ** 0.25
DEEPNORM_BETA = (8 * DEPTH) ** -0.25

kernel_name = 'rwkv7_retnet_gdn_macaron_deepnorm_step'


def layer_norm(x, g, b):
    xf = x.astype(jnp.float32)
    xc = xf - jnp.mean(xf, -1, keepdims=True)
    var = jnp.mean(xc * xc, -1, keepdims=True)
    return xc * lax.rsqrt(var + LN_EPS) * g + b


def group_norm(x, g, b, eps):
    xf = x.astype(jnp.float32)
    xc = xf - jnp.mean(xf, -1, keepdims=True)
    var = jnp.mean(xc * xc, -1, keepdims=True)
    shp = x.shape[-2:]
    return xc * lax.rsqrt(var + eps) * g.reshape(shp) + b.reshape(shp)


def l2_normalize(x):
    xf = x.astype(jnp.float32)
    return xf * lax.rsqrt(jnp.maximum(jnp.sum(xf * xf, -1, keepdims=True), 1e-12))


def swiglu(x, wg, wu, wd):
    return (jax.nn.silu(x @ wg) * (x @ wu)) @ wd


def rotary(x, pos):
    half = x.shape[-1] // 2
    inv_freq = 1.0 / (ROPE_THETA ** jnp.linspace(0.0, 1.0, half, dtype=jnp.float32))
    ang = pos[:, None] * inv_freq[None, :]
    cos = jnp.cos(ang)[None, :, None, :]
    sin = jnp.sin(ang)[None, :, None, :]
    x1, x2 = x[..., :half], x[..., half:]
    return jnp.concatenate([x1 * cos - x2 * sin, x2 * cos + x1 * sin], -1)


def retention_log_gamma():
    return jnp.log(1.0 - jnp.exp2(-5.0 - jnp.arange(H_B, dtype=jnp.float32)))


def rwkv7_recurrence(r, decay, k, v, kk, a, S0):
    def step(S, inp):
        r_t, w_t, k_t, v_t, kk_t, a_t = inp
        sk = jnp.einsum('bhvk,bhk->bhv', S, kk_t)
        S = (S * w_t[:, :, None, :] - sk[..., None] * (kk_t * a_t)[:, :, None, :]
             + v_t[..., None] * k_t[:, :, None, :])
        return S, jnp.einsum('bhvk,bhk->bhv', S, r_t)
    xs = tuple(jnp.moveaxis(t.astype(jnp.float32), 1, 0) for t in (r, decay, k, v, kk, a))
    S, o = lax.scan(step, S0.astype(jnp.float32), xs)
    return jnp.moveaxis(o, 0, 1), S


def retention_chunked(q, k, v, S0):
    Bn, L, H, DK = q.shape
    DV = v.shape[-1]
    C = RET_CHUNK if L % RET_CHUNK == 0 else L
    n = L // C
    blk = lambda t: t.astype(jnp.float32).reshape(Bn, n, C, H, t.shape[-1]).transpose(1, 0, 3, 2, 4)
    q, k, v = blk(q), blk(k), blk(v)
    lg = retention_log_gamma()
    idx = jnp.arange(C, dtype=jnp.float32)
    rel = idx[:, None] - idx[None, :]
    causal = rel >= 0
    dmat = jnp.where(causal, jnp.exp(jnp.where(causal, rel, 0.0)[None] * lg[:, None, None]), 0.0)
    xi = jnp.exp((idx[None, :] + 1.0) * lg[:, None])[..., None]
    zeta = jnp.exp((C - 1.0 - idx[None, :]) * lg[:, None])[..., None]
    g_chunk = jnp.exp(C * lg)[:, None, None]
    inner = (jnp.einsum('nbhid,nbhjd->nbhij', q, k) * dmat) @ v
    kz = k * zeta

    def step(S, inp):
        q_c, kz_c, v_c = inp
        o = (q_c @ S) * xi
        S = g_chunk * S + jnp.swapaxes(kz_c, -1, -2) @ v_c
        return S, o
    S, cross = lax.scan(step, S0.astype(jnp.float32), (q, kz, v))
    o = (inner + cross).transpose(1, 0, 3, 2, 4).reshape(Bn, L, H, DV)
    return o, S


def gated_delta_chunked(q, k, v, g, beta, S0):
    Bn, L, H, DK = q.shape
    DV = v.shape[-1]
    C = GDN_CHUNK if L % GDN_CHUNK == 0 else L
    n = L // C
    blk4 = lambda t: t.astype(jnp.float32).reshape(Bn, n, C, H, t.shape[-1]).transpose(1, 0, 3, 2, 4)
    blk3 = lambda t: t.astype(jnp.float32).reshape(Bn, n, C, H).transpose(1, 0, 3, 2)
    q = blk4(q) * DK ** -0.5
    k, v = blk4(k), blk4(v)
    g, beta = blk3(g), blk3(beta)
    gc = jnp.cumsum(g, -1)
    idx = jnp.arange(C)
    incl = idx[:, None] >= idx[None, :]
    strict = idx[:, None] > idx[None, :]
    diff = gc[..., :, None] - gc[..., None, :]
    dmat = jnp.where(incl, jnp.exp(jnp.where(incl, diff, 0.0)), 0.0)
    kb = k * beta[..., None]
    A = jnp.where(strict, jnp.einsum('nbhid,nbhjd->nbhij', kb, k) * dmat, 0.0)
    eye = jnp.eye(C, dtype=jnp.float32)
    T = lax.linalg.triangular_solve(A + eye, jnp.broadcast_to(eye, A.shape),
                                    left_side=True, lower=True, unit_diagonal=True)
    u = T @ (v * beta[..., None])
    w = T @ (kb * jnp.exp(gc)[..., None])
    qk = jnp.einsum('nbhid,nbhjd->nbhij', q, k) * dmat
    qg = q * jnp.exp(gc)[..., None]
    kd = k * jnp.exp(gc[..., -1:] - gc)[..., None]
    g_last = jnp.exp(gc[..., -1])[..., None, None]

    def step(S, inp):
        u_c, w_c, qk_c, qg_c, kd_c, gl_c = inp
        v_new = u_c - w_c @ S
        o = qg_c @ S + qk_c @ v_new
        S = gl_c * S + jnp.swapaxes(kd_c, -1, -2) @ v_new
        return S, o
    S, o = lax.scan(step, S0.astype(jnp.float32), (u, w, qk, qg, kd, g_last))
    return o.transpose(1, 0, 3, 2, 4).reshape(Bn, L, H, DV), S


def ab_mixer(h, pos, shift_prev, S_rwkv0, S_ret0, p, i):
    Bn, L, _ = h.shape
    z = (h @ p['ab_w_in'][i]).astype(jnp.float32)
    za, zb = z[..., :A_SHIFT_COLS], z[..., A_SHIFT_COLS:]
    za_prev = jnp.concatenate([shift_prev.astype(jnp.float32)[:, None, :], za[:, :-1]], axis=1)
    zs = za + (za_prev - za) * p['rwkv_mu'][i]
    r, k, v, wd, ad, gd = jnp.split(
        zs, (C_A, 2 * C_A, 3 * C_A, 3 * C_A + W_LORA, 3 * C_A + W_LORA + A_LORA), axis=-1)
    w_log = -jax.nn.softplus(-(p['rwkv_w0'][i] + jnp.tanh(wd) @ p['rwkv_w2'][i])) - 0.5
    decay = jnp.exp(-jnp.exp(w_log))
    a = jax.nn.sigmoid(p['rwkv_a0'][i] + ad @ p['rwkv_a2'][i])
    gate = jax.nn.sigmoid(gd) @ p['rwkv_g2'][i]
    split_a = lambda t: t.reshape(Bn, L, H_A, N_A)
    kk = l2_normalize(split_a(k * p['rwkv_k_k'][i]))
    k = k * (1.0 + (a - 1.0) * p['rwkv_k_a'][i])
    r_h, k_h, v_h, a_h = split_a(r), split_a(k), split_a(v), split_a(a)
    o_a, S_rwkv = rwkv7_recurrence(r_h, split_a(decay), k_h, v_h, kk, a_h, S_rwkv0)
    o_a = (group_norm(o_a, p['rwkv_gn_g'][i], p['rwkv_gn_b'][i], RWKV_GN_EPS)
           + jnp.sum(r_h * k_h * p['rwkv_r_k'][i], -1, keepdims=True) * v_h)
    o_a = o_a.reshape(Bn, L, C_A) * gate
    qr, kr, vr, gr = jnp.split(zb, (H_B * DK_B, 2 * H_B * DK_B, 2 * H_B * DK_B + C_B), axis=-1)
    qr = rotary(qr.reshape(Bn, L, H_B, DK_B), pos)
    kr = rotary(kr.reshape(Bn, L, H_B, DK_B), pos) * DK_B ** -0.5
    o_b, S_ret = retention_chunked(qr, kr, vr.reshape(Bn, L, H_B, DV_B), S_ret0)
    o_b = group_norm(o_b, p['ret_gn_g'][i], p['ret_gn_b'][i], RET_GN_EPS).reshape(Bn, L, C_B) * jax.nn.silu(gr)
    out = jnp.concatenate([o_a, o_b], -1) @ p['ab_w_out'][i]
    return out, za[:, -1], S_rwkv, S_ret


def gdn_mixer(h, conv_prev, S0, p, i):
    Bn, L, _ = h.shape
    z = (h @ p['gdn_w_in'][i]).astype(jnp.float32)
    qkv, b_in, a_in, zg = jnp.split(z, (N_QKV_C, N_QKV_C + H_C, N_QKV_C + 2 * H_C), axis=-1)
    xp = jnp.concatenate([conv_prev.astype(jnp.float32), qkv], axis=1)
    cw = p['gdn_conv_w'][i]
    conv = xp[:, 0:L] * cw[0]
    for j in range(1, CONV_W):
        conv = conv + xp[:, j:j + L] * cw[j]
    qkv = jax.nn.silu(conv)
    q, k, v = jnp.split(qkv, (H_C * DK_C, 2 * H_C * DK_C), axis=-1)
    q = l2_normalize(q.reshape(Bn, L, H_C, DK_C))
    k = l2_normalize(k.reshape(Bn, L, H_C, DK_C))
    v = v.reshape(Bn, L, H_C, DV_C)
    beta = jax.nn.sigmoid(b_in)
    g = -jnp.exp(p['gdn_A_log'][i]) * jax.nn.softplus(a_in + p['gdn_dt_bias'][i])
    o, S = gated_delta_chunked(q, k, v, g, beta, S0)
    o = (o * lax.rsqrt(jnp.mean(o * o, -1, keepdims=True) + 1e-6) * p['gdn_norm_g'][i]
         * jax.nn.silu(zg.reshape(Bn, L, H_C, DV_C)))
    return o.reshape(Bn, L, C_C) @ p['gdn_w_out'][i], xp[:, L:], S


def trunk(x, pos0, states, p):
    st_shift, st_rwkv, st_ret, st_conv, st_gdn = states
    pos = pos0 + jnp.arange(x.shape[1], dtype=jnp.float32)
    new_shift, new_rwkv, new_ret, new_conv, new_gdn = [], [], [], [], []
    h = x
    for l in range(DEPTH):
        i = l // 2
        f = swiglu(h, p['ffn_w_gate'][l, 0], p['ffn_w_up'][l, 0], p['ffn_w_down'][l, 0])
        h = layer_norm(DEEPNORM_ALPHA * h + 0.5 * f, p['ln_g'][l, 0], p['ln_b'][l, 0])
        if l % 2 == 0:
            m, s_sh, s_rw, s_rt = ab_mixer(h, pos, st_shift[i], st_rwkv[i], st_ret[i], p, i)
            new_shift.append(s_sh)
            new_rwkv.append(s_rw)
            new_ret.append(s_rt)
        else:
            m, s_cv, s_gd = gdn_mixer(h, st_conv[i], st_gdn[i], p, i)
            new_conv.append(s_cv)
            new_gdn.append(s_gd)
        h = layer_norm(DEEPNORM_ALPHA * h + m, p['ln_g'][l, 1], p['ln_b'][l, 1])
        f = swiglu(h, p['ffn_w_gate'][l, 1], p['ffn_w_up'][l, 1], p['ffn_w_down'][l, 1])
        h = layer_norm(DEEPNORM_ALPHA * h + 0.5 * f, p['ln_g'][l, 2], p['ln_b'][l, 2])
    return h, (jnp.stack(new_shift), jnp.stack(new_rwkv), jnp.stack(new_ret),
               jnp.stack(new_conv), jnp.stack(new_gdn))


def setup_inputs(seed: int = 0) -> dict:
    key = jax.random.key(seed)
    ks = iter(jax.random.split(key, 40))
    f32 = jnp.float32
    nrm = lambda shape, scale: jax.random.normal(next(ks), shape, f32) * scale
    uni = lambda shape, lo, hi: jax.random.uniform(next(ks), shape, f32, lo, hi)
    d = {}
    d['x_prompt'] = nrm((BATCH, SEQ, D_MODEL), 1.0)
    d['x_sample'] = nrm((DEC_BATCH, DEC_SEQ, D_MODEL), 1.0)
    d['state_rwkv_shift'] = nrm((N_AB_LAYERS, DEC_BATCH, A_SHIFT_COLS), 1.0)
    d['state_rwkv'] = nrm((N_AB_LAYERS, DEC_BATCH, H_A, N_A, N_A), 0.3)
    d['state_ret'] = nrm((N_AB_LAYERS, DEC_BATCH, H_B, DK_B, DV_B), 0.3)
    d['state_gdn_conv'] = nrm((N_C_LAYERS, DEC_BATCH, CONV_W - 1, N_QKV_C), 1.0)
    d['state_gdn'] = nrm((N_C_LAYERS, DEC_BATCH, H_C, DK_C, DV_C), 0.3)
    d['ln_g'] = 1.0 + nrm((DEPTH, 3, D_MODEL), 0.02)
    d['ln_b'] = nrm((DEPTH, 3, D_MODEL), 0.02)
    d['ffn_w_gate'] = nrm((DEPTH, 2, D_MODEL, D_FF), D_MODEL ** -0.5)
    d['ffn_w_up'] = nrm((DEPTH, 2, D_MODEL, D_FF), D_MODEL ** -0.5)
    d['ffn_w_down'] = nrm((DEPTH, 2, D_FF, D_MODEL), D_FF ** -0.5 * DEEPNORM_BETA)
    d['ab_w_in'] = nrm((N_AB_LAYERS, D_MODEL, AB_COLS), D_MODEL ** -0.5)
    d['ab_w_out'] = nrm((N_AB_LAYERS, C_A + C_B, D_MODEL), (C_A + C_B) ** -0.5 * DEEPNORM_BETA)
    d['rwkv_mu'] = uni((N_AB_LAYERS, A_SHIFT_COLS), 0.0, 1.0)
    d['rwkv_w0'] = jnp.linspace(-5.0, 1.0, C_A, dtype=f32)[None, :] + nrm((N_AB_LAYERS, C_A), 0.1)
    d['rwkv_w2'] = nrm((N_AB_LAYERS, W_LORA, C_A), W_LORA ** -0.5 * 0.3)
    d['rwkv_a0'] = nrm((N_AB_LAYERS, C_A), 0.3)
    d['rwkv_a2'] = nrm((N_AB_LAYERS, A_LORA, C_A), A_LORA ** -0.5 * 0.3)
    d['rwkv_g2'] = nrm((N_AB_LAYERS, G_LORA, C_A), G_LORA ** -0.5)
    d['rwkv_k_k'] = 0.85 + nrm((N_AB_LAYERS, C_A), 0.05)
    d['rwkv_k_a'] = 1.0 + nrm((N_AB_LAYERS, C_A), 0.05)
    d['rwkv_r_k'] = nrm((N_AB_LAYERS, H_A, N_A), 0.1)
    d['rwkv_gn_g'] = 1.0 + nrm((N_AB_LAYERS, C_A), 0.02)
    d['rwkv_gn_b'] = nrm((N_AB_LAYERS, C_A), 0.02)
    d['ret_gn_g'] = 1.0 + nrm((N_AB_LAYERS, C_B), 0.02)
    d['ret_gn_b'] = nrm((N_AB_LAYERS, C_B), 0.02)
    d['gdn_w_in'] = nrm((N_C_LAYERS, D_MODEL, C_COLS), D_MODEL ** -0.5)
    d['gdn_conv_w'] = nrm((N_C_LAYERS, CONV_W, N_QKV_C), 0.5)
    d['gdn_A_log'] = jnp.log(uni((N_C_LAYERS, H_C), 1.0, 16.0))
    dt = jnp.exp(uni((N_C_LAYERS, H_C), float(np.log(1e-3)), float(np.log(1e-1))))
    d['gdn_dt_bias'] = dt + jnp.log(-jnp.expm1(-dt))
    d['gdn_norm_g'] = 1.0 + nrm((N_C_LAYERS, DV_C), 0.02)
    d['gdn_w_out'] = nrm((N_C_LAYERS, C_C, D_MODEL), C_C ** -0.5 * DEEPNORM_BETA)
    return d


def reference(x_prompt, x_sample, state_rwkv_shift, state_rwkv, state_ret, state_gdn_conv, state_gdn,
              ln_g, ln_b, ffn_w_gate, ffn_w_up, ffn_w_down, ab_w_in, ab_w_out, rwkv_mu, rwkv_w0,
              rwkv_w2, rwkv_a0, rwkv_a2, rwkv_g2, rwkv_k_k, rwkv_k_a, rwkv_r_k, rwkv_gn_g, rwkv_gn_b,
              ret_gn_g, ret_gn_b, gdn_w_in, gdn_conv_w, gdn_A_log, gdn_dt_bias, gdn_norm_g, gdn_w_out):
    p = dict(ln_g=ln_g, ln_b=ln_b, ffn_w_gate=ffn_w_gate, ffn_w_up=ffn_w_up, ffn_w_down=ffn_w_down,
             ab_w_in=ab_w_in, ab_w_out=ab_w_out, rwkv_mu=rwkv_mu, rwkv_w0=rwkv_w0, rwkv_w2=rwkv_w2,
             rwkv_a0=rwkv_a0, rwkv_a2=rwkv_a2, rwkv_g2=rwkv_g2, rwkv_k_k=rwkv_k_k, rwkv_k_a=rwkv_k_a,
             rwkv_r_k=rwkv_r_k, rwkv_gn_g=rwkv_gn_g, rwkv_gn_b=rwkv_gn_b, ret_gn_g=ret_gn_g,
             ret_gn_b=ret_gn_b, gdn_w_in=gdn_w_in, gdn_conv_w=gdn_conv_w, gdn_A_log=gdn_A_log,
             gdn_dt_bias=gdn_dt_bias, gdn_norm_g=gdn_norm_g, gdn_w_out=gdn_w_out)
    nb = x_prompt.shape[0]
    zeros = lambda shape: jnp.zeros(shape, jnp.float32)
    empty = (zeros((N_AB_LAYERS, nb, A_SHIFT_COLS)), zeros((N_AB_LAYERS, nb, H_A, N_A, N_A)),
             zeros((N_AB_LAYERS, nb, H_B, DK_B, DV_B)), zeros((N_C_LAYERS, nb, CONV_W - 1, N_QKV_C)),
             zeros((N_C_LAYERS, nb, H_C, DK_C, DV_C)))
    y_prompt, (p_shift, p_rwkv, p_ret, p_conv, p_gdn) = trunk(x_prompt, 0, empty, p)
    past = (state_rwkv_shift, state_rwkv, state_ret, state_gdn_conv, state_gdn)
    y_sample, (s_shift, s_rwkv, s_ret, s_conv, s_gdn) = trunk(x_sample, PAST_LEN, past, p)
    return (y_prompt, y_sample, p_shift, p_rwkv, p_ret, p_conv, p_gdn, s_shift, s_rwkv, s_ret, s_conv, s_gdn)
```

```cpp
#include <hip/hip_runtime.h>
#include <hip/hip_cooperative_groups.h>
#include <cstdio>
#include <cstdint>
namespace cg = cooperative_groups;
__device__ __forceinline__ int mk_ltid() { int t = threadIdx.x; asm volatile("" : "+v"(t)); return t; }
__device__ __forceinline__ int mk_lbid() { int t = blockIdx.x; asm volatile("" : "+s"(t)); return t; }
namespace pg8 {
#define PG8_LAS __attribute__((address_space(3)))
typedef unsigned short bf16_t;
typedef short bf16x8 __attribute__((ext_vector_type(8)));
typedef float f32x4 __attribute__((ext_vector_type(4)));
typedef unsigned u32x4 __attribute__((ext_vector_type(4)));
constexpr int BM = 256, BK = 64, HALF = 128, HTB = HALF * BK * 2  , STAGE_BYTES = 8 * HTB, NXCD = 8, WGM = 8;

__host__ __device__ __forceinline__ int lds_byte(int r, int c) { const int st = (r >> 4) * 2 + (c >> 5), rr = r & 15, cc = c & 31, ob = rr * 64 + cc * 2; return st * 1024 + (ob ^ (((ob >> 9) & 1) << 5)); }
__host__ __device__ __forceinline__ void stage_rc(int b, int& R, int& C) { const int st = b / 1024, sb = b % 1024, swz = sb ^ (((sb >> 9) & 1) << 5); R = (st >> 1) * 16 + swz / 64; C = (st & 1) * 32 + (swz % 64) / 2; }
__host__ __device__ __forceinline__ int perm32(int rho) { const int n = rho >> 4, i = rho & 15; return 8 * (i >> 2) + 4 * n + (i & 3); }

struct Unit { int pm, pn; };
struct Gemm { const bf16_t* A; const bf16_t* Bt; int M, N, K; };

struct StaticOrder {
    int nM, nN, nwg, G, c;
    __host__ __device__ void init(int M, int N, int G_, int c_) { nM = M / BM; nN = N / BM; nwg = nM * nN; G = G_; c = c_; }
    __host__ __device__ bool next(int i, Unit& u) const {
        const long L = (long)i * G + c; if (L >= nwg) return false;
        int wgid = (int)L; { const int q = nwg / NXCD, r = nwg % NXCD, xcd = wgid % NXCD, off = wgid / NXCD; wgid = (xcd < r ? xcd * (q + 1) : r * (q + 1) + (xcd - r) * q) + off; }
        const int nig = WGM * nN, gid = wgid / nig, fm = gid * WGM, gsz = (nM - fm) < WGM ? (nM - fm) : WGM;
        u.pm = fm + ((wgid % nig) % gsz); u.pn = (wgid % nig) / gsz; return true;
    }
    __device__ __forceinline__ void a_ready(const Unit&) const {}
    __device__ __forceinline__ void done(const Unit&) const {}
};

template <class Epi, class Sched, bool ALIGN_EPI = false, bool SP2 = false>
__device__ __forceinline__ void gemm_phase(PG8_LAS unsigned char* lds, const Gemm g, const Sched& S, const Epi& E) {
    const int tid = mk_ltid(), wid = __builtin_amdgcn_readfirstlane(tid >> 6), lane = tid & 63, wr = wid >> 2, wc = wid & 3, fr = lane & 15, fq = lane >> 4;
    const int K = g.K, nt = K / BK;
    unsigned voffA[2], voffB[2];
#pragma unroll
    for (int i = 0; i < 2; ++i) { int R, C; stage_rc(tid * 16 + i * 8192, R, C); const int Rb = Epi::PERM ? ((R & ~31) + perm32(R & 31)) : R;
        voffA[i] = (unsigned)(R * K + C) * 2u; voffB[i] = (unsigned)(Rb * K + C) * 2u; }
    const size_t kstep = (size_t)(BK * 2);
    const size_t hstep = (size_t)HALF * K * 2;
    const size_t tstep = 2 * hstep;
    const unsigned ldsw = (unsigned)wid * 1024u;
    const int aoff = lds_byte(wr * 64 + fr, fq * 8), boff = lds_byte(wc * 32 + fr, fq * 8);
#define PG8_SA(b, h) (((b) * 2 + (h)) * HTB)
#define PG8_SB(b, h) ((4 + (b) * 2 + (h)) * HTB)
#define PG8_STAGE(bufoff, gbase, voff) do { _Pragma("unroll") for (int _i = 0; _i < 2; ++_i) \
        __builtin_amdgcn_global_load_lds((const unsigned*)((const char*)(gbase) + (voff)[_i]), (PG8_LAS unsigned*)(lds + (bufoff) + ldsw + _i * 8192), 16, 0, 0); } while (0)
#define PG8_LDA(dst, b, h) do { _Pragma("unroll") for (int m = 0; m < 4; ++m) _Pragma("unroll") for (int k = 0; k < 2; ++k) dst[m][k] = *(const PG8_LAS bf16x8*)(lds + PG8_SA(b, h) + aoff + m * 2048 + k * 1024); } while (0)
#define PG8_LDB(dst, b, h) do { _Pragma("unroll") for (int n = 0; n < 2; ++n) _Pragma("unroll") for (int k = 0; k < 2; ++k) dst[n][k] = *(const PG8_LAS bf16x8*)(lds + PG8_SB(b, h) + boff + n * 2048 + k * 1024); } while (0)
#define PG8_MMA(ai, bj, At, Bt) do { __builtin_amdgcn_s_setprio(1); _Pragma("unroll") for (int m = 0; m < 4; ++m) _Pragma("unroll") for (int n = 0; n < 2; ++n) _Pragma("unroll") for (int k = 0; k < 2; ++k) \
        acc[ai][bj][m][n] = __builtin_amdgcn_mfma_f32_16x16x32_bf16(Bt[n][k], At[m][k], acc[ai][bj][m][n], 0, 0, 0); __builtin_amdgcn_s_setprio(0); } while (0)
#define PG8_WAIT_V(n) asm volatile("s_waitcnt vmcnt(" #n ")" ::: "memory")
#define PG8_WAIT_L(n) asm volatile("s_waitcnt lgkmcnt(" #n ")" ::: "memory")
#define PG8_BAR __builtin_amdgcn_s_barrier()
#define PG8_SCHED __builtin_amdgcn_sched_barrier(0)
    Unit cur, nxt; int ui = 0;
    if (!S.next(0, cur)) return;
    f32x4 acc[2][2][4][2];
#pragma unroll
    for (int a = 0; a < 2; ++a)
#pragma unroll
        for (int b = 0; b < 2; ++b)
#pragma unroll
            for (int m = 0; m < 4; ++m)
#pragma unroll
                for (int n = 0; n < 2; ++n) acc[a][b][m][n] = (f32x4){0.f, 0.f, 0.f, 0.f};
    bf16x8 At[4][2], B0[2][2], B1[2][2];
    const char* cA = (const char*)g.A + (size_t)cur.pm * tstep; const char* cB = (const char*)g.Bt + (size_t)cur.pn * tstep;
    S.a_ready(cur);
    if constexpr (SP2) {
        PG8_STAGE(PG8_SB(0, 0), cB, voffB); PG8_STAGE(PG8_SB(0, 1), cB + hstep, voffB); PG8_STAGE(PG8_SA(0, 0), cA, voffA); PG8_STAGE(PG8_SA(0, 1), cA + hstep, voffA);
        if (wr == 1) PG8_BAR;
        PG8_WAIT_V(2); PG8_BAR;
        PG8_STAGE(PG8_SB(1, 0), cB + kstep, voffB); PG8_STAGE(PG8_SA(1, 0), cA + kstep, voffA); PG8_STAGE(PG8_SB(1, 1), cB + hstep + kstep, voffB);
        PG8_WAIT_V(6); PG8_BAR;
    } else {
        PG8_STAGE(PG8_SB(0, 0), cB, voffB); PG8_STAGE(PG8_SA(0, 0), cA, voffA); PG8_STAGE(PG8_SB(0, 1), cB + hstep, voffB); PG8_STAGE(PG8_SA(0, 1), cA + hstep, voffA);
        if (wr == 1) PG8_BAR;
        PG8_WAIT_V(4); PG8_BAR;
        PG8_STAGE(PG8_SB(1, 0), cB + kstep, voffB); PG8_STAGE(PG8_SA(1, 0), cA + kstep, voffA); PG8_STAGE(PG8_SB(1, 1), cB + hstep + kstep, voffB);
        PG8_WAIT_V(6); PG8_BAR;
    }
    for (;;) {
        const bool has_next = S.next(ui + 1, nxt);
        const char* nA = has_next ? (const char*)g.A + (size_t)nxt.pm * tstep : cA; const char* nB = has_next ? (const char*)g.Bt + (size_t)nxt.pn * tstep : cB;
        for (int t = 0; t < nt; t += 2) {
            const bool last = (t == nt - 2);
            const char* a1 = cA + (size_t)(t + 1) * kstep;
            const char* a2 = last ? nA : cA + (size_t)(t + 2) * kstep; const char* b2 = last ? nB : cB + (size_t)(t + 2) * kstep;
            const char* a3 = a2 + kstep; const char* b3 = b2 + kstep;
            if (last && has_next) S.a_ready(nxt);
            if constexpr (SP2) {
            PG8_LDB(B0, 0, 0); PG8_LDB(B1, 0, 1); PG8_SCHED; PG8_LDA(At, 0, 0); PG8_STAGE(PG8_SA(1, 1), a1 + hstep, voffA);
            PG8_WAIT_V(8); PG8_WAIT_L(0); PG8_BAR; PG8_MMA(0, 0, At, B0); PG8_MMA(0, 1, At, B1); PG8_BAR; PG8_SCHED;
            PG8_LDA(At, 0, 1); PG8_STAGE(PG8_SB(0, 0), b2, voffB); PG8_STAGE(PG8_SB(0, 1), b2 + hstep, voffB); PG8_STAGE(PG8_SA(0, 0), a2, voffA);
            PG8_WAIT_V(8); PG8_WAIT_L(0); PG8_BAR; PG8_MMA(1, 0, At, B0); PG8_MMA(1, 1, At, B1); PG8_BAR; PG8_SCHED;
            PG8_LDB(B0, 1, 0); PG8_LDB(B1, 1, 1); PG8_SCHED; PG8_LDA(At, 1, 0); PG8_STAGE(PG8_SA(0, 1), a2 + hstep, voffA);
            PG8_WAIT_V(8); PG8_WAIT_L(0); PG8_BAR; PG8_MMA(0, 0, At, B0); PG8_MMA(0, 1, At, B1); PG8_BAR; PG8_SCHED;
            PG8_LDA(At, 1, 1); PG8_STAGE(PG8_SB(1, 0), b3, voffB); PG8_STAGE(PG8_SB(1, 1), b3 + hstep, voffB); PG8_STAGE(PG8_SA(1, 0), a3, voffA);
            PG8_WAIT_V(8); PG8_WAIT_L(0); PG8_BAR; PG8_MMA(1, 0, At, B0); PG8_MMA(1, 1, At, B1); PG8_BAR; PG8_SCHED;
            } else {
            PG8_LDB(B0, 0, 0); PG8_SCHED; PG8_LDA(At, 0, 0); PG8_STAGE(PG8_SA(1, 1), a1 + hstep, voffA);
            PG8_WAIT_L(8); PG8_BAR; PG8_WAIT_L(0); PG8_MMA(0, 0, At, B0); PG8_BAR; PG8_SCHED;
            PG8_LDB(B1, 0, 1); PG8_STAGE(PG8_SB(0, 0), b2, voffB);
            PG8_BAR; PG8_WAIT_L(0); PG8_MMA(0, 1, At, B1); PG8_BAR;
            PG8_LDA(At, 0, 1); PG8_STAGE(PG8_SA(0, 0), a2, voffA);
            PG8_BAR; PG8_WAIT_L(0); PG8_MMA(1, 0, At, B0); PG8_BAR; PG8_SCHED;
            PG8_STAGE(PG8_SB(0, 1), b2 + hstep, voffB);
            PG8_WAIT_V(6); PG8_BAR; PG8_MMA(1, 1, At, B1); PG8_BAR;
            PG8_LDB(B0, 1, 0); PG8_SCHED; PG8_LDA(At, 1, 0); PG8_STAGE(PG8_SA(0, 1), a2 + hstep, voffA);
            PG8_WAIT_L(8); PG8_BAR; PG8_WAIT_L(0); PG8_MMA(0, 0, At, B0); PG8_BAR; PG8_SCHED;
            PG8_LDB(B1, 1, 1); PG8_STAGE(PG8_SB(1, 0), b3, voffB);
            PG8_BAR; PG8_WAIT_L(0); PG8_MMA(0, 1, At, B1); PG8_BAR;
            PG8_LDA(At, 1, 1); PG8_STAGE(PG8_SA(1, 0), a3, voffA);
            PG8_BAR; PG8_WAIT_L(0); PG8_MMA(1, 0, At, B0); PG8_BAR; PG8_SCHED;
            PG8_STAGE(PG8_SB(1, 1), b3 + hstep, voffB);
            PG8_WAIT_V(6); PG8_BAR; PG8_MMA(1, 1, At, B1); PG8_BAR;
            }
        }
        if constexpr (ALIGN_EPI) { if (wr == 0) PG8_BAR; }
        if constexpr (!Epi::AFTER_DRAIN) { E(acc, cur, wr, wc, fr, fq); S.done(cur); }
        if (!has_next) break;
#pragma unroll
        for (int a = 0; a < 2; ++a)
#pragma unroll
            for (int b = 0; b < 2; ++b)
#pragma unroll
                for (int m = 0; m < 4; ++m)
#pragma unroll
                    for (int n = 0; n < 2; ++n) acc[a][b][m][n] = (f32x4){0.f, 0.f, 0.f, 0.f};
        cur = nxt; cA = nA; cB = nB; ++ui;
        if constexpr (ALIGN_EPI) { if (wr == 1) PG8_BAR; }
    }
    PG8_WAIT_V(0);
    if constexpr (!ALIGN_EPI) { if (wr == 0) PG8_BAR; }
    PG8_BAR;
    if constexpr (Epi::AFTER_DRAIN) { E.fused(acc, cur, wr, wc, fr, fq, lds, wid, lane); S.done(cur); }
#undef PG8_SA
#undef PG8_SB
#undef PG8_STAGE
#undef PG8_LDA
#undef PG8_LDB
#undef PG8_MMA
#undef PG8_WAIT_V
#undef PG8_WAIT_L
#undef PG8_BAR
#undef PG8_SCHED
}
}

namespace mk {
using pg8::bf16_t; using pg8::bf16x8; using pg8::f32x4; using pg8::Unit;
typedef unsigned u32x4 __attribute__((ext_vector_type(4)));
typedef unsigned u32x2 __attribute__((ext_vector_type(2)));

constexpr int M = 16896, MP = 16384, D = 1024, FF = 2816;
constexpr int AB_N = 3840, GD_N = 4352, GD_NREAL = 4112;
constexpr float ALPHA = 1.6817928305074290f;
constexpr int LDS_BYTES = 163840;

constexpr size_t O_PSHIFT = 17301504, O_PRWKV = 17330176, O_PRET = 17854464, O_PCONV = 18903040, O_PGDN = 19050496;
constexpr size_t O_SSHIFT = 21147648, O_SRWKV = 21606400, O_SRET = 29995008, O_SCONV = 46772224, O_SGDN = 49131520;

constexpr size_t WS_WGU = 0;
constexpr size_t WS_WD = WS_WGU + 2ull * 5632 * 1024 * 2;
constexpr size_t WS_WIN = WS_WD + 2ull * 1024 * 2816 * 2;
constexpr size_t WS_WOUT = WS_WIN + 4352ull * 1024 * 2;
constexpr size_t WS_W2T = WS_WOUT + 1024ull * 1024 * 2;
constexpr size_t WS_A2T = WS_W2T + 65536;
constexpr size_t WS_G2T = WS_A2T + 65536;
constexpr size_t WS_X = WS_G2T + 131072;
constexpr size_t WS_HB = WS_X + (size_t)M * 1024 * 4;
constexpr size_t WS_S = WS_HB + (size_t)M * 1024 * 2;
constexpr size_t WS_HID = WS_S;
constexpr size_t WS_OMIX = WS_S;
constexpr size_t WS_ZB = WS_OMIX + (size_t)M * 1024 * 2;
constexpr size_t WS_OPS = WS_ZB + (size_t)M * AB_N * 2;
constexpr size_t WS_GATE = WS_OPS + (size_t)M * 3072 * 4;
constexpr size_t WS_ORAW = WS_GATE + (size_t)M * 512 * 4;
constexpr size_t WS_BONUS = WS_ORAW + (size_t)M * 512 * 4;
constexpr size_t WS_RQ = WS_BONUS + (size_t)M * 8 * 4;
constexpr size_t WS_RK = WS_RQ + (size_t)M * 512 * 2;
constexpr size_t WS_AB_END = WS_RK + (size_t)M * 512 * 2;
constexpr size_t WS_CH = WS_ZB + (size_t)M * GD_N * 2;
constexpr size_t CH_U = 0, CH_W = 32768, CH_QG = 49152, CH_QK = 65536, CH_KDT = 73728, CH_BYTES = 90112;
constexpr int N_CH = 2048 + 1024;
constexpr size_t WS_GL = WS_CH + (size_t)N_CH * CH_BYTES;
constexpr size_t WS_GD_END = WS_GL + N_CH * 4;
constexpr size_t WS_BAR = ((WS_AB_END > WS_GD_END ? WS_AB_END : WS_GD_END) + 255) / 256 * 256;
constexpr size_t WS_NEED = WS_BAR + 16384;

struct Params { const float* in[33]; float* out; unsigned char* ws; };

__device__ __forceinline__ float bf2f(bf16_t h) { return __uint_as_float(((unsigned)h) << 16); }
__device__ __forceinline__ unsigned pk2(float lo, float hi) { unsigned r; asm volatile("v_cvt_pk_bf16_f32 %0, %1, %2" : "=v"(r) : "v"(lo), "v"(hi)); return r; }
__device__ __forceinline__ bf16_t f2bf(float x) { return (bf16_t)(pk2(x, 0.f) & 0xffffu); }
__device__ __forceinline__ float sigm(float x) { return __builtin_amdgcn_rcpf(1.f + __expf(-x)); }
__device__ __forceinline__ float silu(float x) { return x * __builtin_amdgcn_rcpf(1.f + __expf(-x)); }
__device__ __forceinline__ float dppf(float v, const int ctrl_sel) {
    int x = __builtin_bit_cast(int, v), y;
    if (ctrl_sel == 0) y = __builtin_amdgcn_update_dpp(0, x, 0xB1, 0xF, 0xF, true);
    else if (ctrl_sel == 1) y = __builtin_amdgcn_update_dpp(0, x, 0x4E, 0xF, 0xF, true);
    else if (ctrl_sel == 2) y = __builtin_amdgcn_update_dpp(0, x, 0x141, 0xF, 0xF, true);
    else y = __builtin_amdgcn_update_dpp(0, x, 0x140, 0xF, 0xF, true);
    return __builtin_bit_cast(float, y);
}
__device__ __forceinline__ float row16_sum(float v) { v += dppf(v, 0); v += dppf(v, 1); v += dppf(v, 2); v += dppf(v, 3); return v; }
__device__ __forceinline__ float wave_sum(float v) {
#pragma unroll
    for (int o = 1; o < 64; o <<= 1) v += __shfl_xor(v, o);
    return v;
}
#define XB_XCNT(j)  (256  + 64 * (j))
#define XB_XSUB(j)  (1280 + 64 * (j))
#define XB_XGEN(j)  (2304 + 64 * (j))
#define XB_TOP      3328
#define XB_TOPGEN   3392
#define XCD_BAR_WORDS 3456
__device__ __forceinline__ unsigned xb_ld(unsigned* p)              { return __hip_atomic_load(p, __ATOMIC_RELAXED, __HIP_MEMORY_SCOPE_AGENT); }
__device__ __forceinline__ unsigned xb_add(unsigned* p, unsigned v) { return __hip_atomic_fetch_add(p, v, __ATOMIC_RELAXED, __HIP_MEMORY_SCOPE_AGENT); }
__device__ __forceinline__ unsigned xb_xcc_id() { return (unsigned)__builtin_amdgcn_s_getreg((3 << 11) | 20) & 0xFu; }
__device__ __forceinline__ void gbar(unsigned* bar, volatile unsigned* st) {
    asm volatile("s_waitcnt vmcnt(0)" ::: "memory");
    __syncthreads();
    if (mk_ltid() == 0) {
        __builtin_amdgcn_s_waitcnt(0);
        const unsigned x = xb_xcc_id();
        unsigned nloc = st[0], nx = st[1];
        if (nloc == 0u) {
            const unsigned G = gridDim.x;
            unsigned sum, cnt, mine;
            for (;;) {
                sum = 0u; cnt = 0u; mine = 0u;
#pragma unroll
                for (unsigned j = 0; j < 16; ++j) { const unsigned c = xb_ld(&bar[XB_XCNT(j)]); sum += c; cnt += (c > 0u) ? 1u : 0u; mine = (j == x) ? c : mine; }
                if (sum == G) break;
                __builtin_amdgcn_s_sleep(1);
            }
            nloc = mine > 0u ? mine : 1u; nx = cnt > 0u ? cnt : 1u; st[0] = nloc; st[1] = nx;
        }
        const unsigned old = xb_add(&bar[XB_XSUB(x)], 1u);
        const unsigned gen = old / nloc;
        if (old + 1u == (gen + 1u) * nloc) {
            __builtin_amdgcn_fence(__ATOMIC_RELEASE, "agent");
            asm volatile("s_waitcnt vmcnt(0)" ::: "memory");
            const unsigned og = xb_add(&bar[XB_TOP], 1u);
            const unsigned tg = og / nx;
            if (og + 1u == (tg + 1u) * nx) xb_add(&bar[XB_TOPGEN], 1u);
            else while (xb_ld(&bar[XB_TOPGEN]) == tg) __builtin_amdgcn_s_sleep(1);
            __builtin_amdgcn_fence(__ATOMIC_ACQUIRE, "agent");
            xb_add(&bar[XB_XGEN(x)], 1u);
            asm volatile("s_waitcnt vmcnt(0)" ::: "memory");
        } else {
            while (xb_ld(&bar[XB_XGEN(x)]) == gen) __builtin_amdgcn_s_sleep(1);
            __builtin_amdgcn_fence(__ATOMIC_ACQUIRE, "agent");
            asm volatile("s_waitcnt vmcnt(0)" ::: "memory");
        }
    }
    __syncthreads();
}
__device__ __forceinline__ void seq_info(int s, int& row0, int& L) { if (s < 8) { row0 = s * 2048; L = 2048; } else { row0 = MP + (s - 8) * 4; L = 4; } }

struct EpiSwiglu { static constexpr bool PERM = true, AFTER_DRAIN = false; bf16_t* O;
    __device__ __forceinline__ void operator()(const f32x4 (&acc)[2][2][4][2], const Unit& u, int wr, int wc, int fr, int fq) const {
        const int row0 = u.pm * 256 + wr * 64 + fr, col0 = u.pn * 128 + wc * 32 + 8 * fq;
#pragma unroll
        for (int ai = 0; ai < 2; ++ai)
#pragma unroll
            for (int m = 0; m < 4; ++m) {
                bf16_t* rp = O + (size_t)(row0 + ai * 128 + m * 16) * FF + col0;
                const f32x4 g0 = acc[ai][0][m][0], g1 = acc[ai][0][m][1], u0 = acc[ai][1][m][0], u1 = acc[ai][1][m][1];
                u32x4 w;
                w.x = pk2(silu(g0[0]) * u0[0], silu(g0[1]) * u0[1]); w.y = pk2(silu(g0[2]) * u0[2], silu(g0[3]) * u0[3]);
                w.z = pk2(silu(g1[0]) * u1[0], silu(g1[1]) * u1[1]); w.w = pk2(silu(g1[2]) * u1[2], silu(g1[3]) * u1[3]);
                *(u32x4*)rp = w;
            }
    }
};
struct EpiResid { static constexpr bool PERM = true, AFTER_DRAIN = false; bf16_t* X; const bf16_t* H; float scale;
    __device__ __forceinline__ void operator()(const f32x4 (&acc)[2][2][4][2], const Unit& u, int wr, int wc, int fr, int fq) const {
        const int row0 = u.pm * 256 + wr * 64 + fr, col0 = u.pn * 256 + wc * 32 + 8 * fq;
#pragma unroll
        for (int ai = 0; ai < 2; ++ai)
#pragma unroll
            for (int m = 0; m < 4; ++m)
#pragma unroll
                for (int bj = 0; bj < 2; ++bj)
#pragma unroll
                    for (int n = 0; n < 2; ++n) {
                        const size_t off = (size_t)(row0 + ai * 128 + m * 16) * D + col0 + bj * 128 + 4 * n;
                        const u32x2 hu = *(const u32x2*)(H + off);
                        f32x4 x; x[0] = __uint_as_float(hu.x << 16); x[1] = __uint_as_float(hu.x & 0xffff0000u); x[2] = __uint_as_float(hu.y << 16); x[3] = __uint_as_float(hu.y & 0xffff0000u);
                        x = x * ALPHA + acc[ai][bj][m][n] * scale; u32x2 xo; xo.x = pk2(x[0], x[1]); xo.y = pk2(x[2], x[3]); *(u32x2*)(X + off) = xo;
                    }
    }
};
struct EpiZ { static constexpr bool PERM = true, AFTER_DRAIN = false; bf16_t* Z; int ld;
    __device__ __forceinline__ void operator()(const f32x4 (&acc)[2][2][4][2], const Unit& u, int wr, int wc, int fr, int fq) const {
        const int row0 = u.pm * 256 + wr * 64 + fr, col0 = u.pn * 256 + wc * 32 + 8 * fq;
#pragma unroll
        for (int ai = 0; ai < 2; ++ai)
#pragma unroll
            for (int m = 0; m < 4; ++m)
#pragma unroll
                for (int bj = 0; bj < 2; ++bj) {
                    const f32x4 a = acc[ai][bj][m][0], b = acc[ai][bj][m][1];
                    u32x4 w; w.x = pk2(a[0], a[1]); w.y = pk2(a[2], a[3]); w.z = pk2(b[0], b[1]); w.w = pk2(b[2], b[3]);
                    *(u32x4*)(Z + (size_t)(row0 + ai * 128 + m * 16) * ld + col0 + bj * 128) = w;
                }
    }
};

__device__ __forceinline__ void tr_item(const float* __restrict__ W, int K, int N, bf16_t* WT, int dst_row0, int k0, int n0, float* scr, int lane) {
#pragma unroll
    for (int i = 0; i < 32; ++i) { const int kk = 2 * i + (lane >> 5); const int col = n0 + (lane & 31);
        scr[kk * 33 + (lane & 31)] = (col < N) ? W[(size_t)(k0 + kk) * N + col] : 0.f; }
    asm volatile("s_waitcnt lgkmcnt(0)" ::: "memory");
    const int c = lane & 7;
#pragma unroll
    for (int j = 0; j < 4; ++j) { const int n = (lane >> 3) + 8 * j; const float* s = scr + (8 * c) * 33 + n;
        u32x4 o; o.x = pk2(s[0], s[33]); o.y = pk2(s[2 * 33], s[3 * 33]); o.z = pk2(s[4 * 33], s[5 * 33]); o.w = pk2(s[6 * 33], s[7 * 33]);
        *(u32x4*)(WT + (size_t)(dst_row0 + n) * K + k0 + 8 * c) = o; }
    asm volatile("s_waitcnt lgkmcnt(0)" ::: "memory");
}

__device__ __forceinline__ void convert_items(const Params& p, int l, int parts, int gw, int NGW, unsigned char* smem) {
    const int lane = mk_ltid() & 63, wave = mk_ltid() >> 6;
    float* scr = (float*)smem + wave * (64 * 33);
    unsigned char* ws = p.ws;
    const int i = l >> 1; const bool ab = (l & 1) == 0;
    constexpr int I_G = 16 * 88, I_O = 16 * 32;
    const int I_IN = ab ? 16 * 120 : 16 * 136;
    const int I_LORA = ab ? (16 + 16 + 32) : 0;
    const int n0 = (parts & 1) ? 3 * I_G : 0, n1 = (parts & 2) ? 3 * I_G : 0, n2 = (parts & 4) ? (I_IN + I_O + I_LORA) : 0;
    const int total = n0 + n1 + n2;
    for (int it = gw; it < total; it += NGW) {
        int r = it;
        if (r < n0 + n1) {
            const int j = (r < n0) ? 0 : 1; r -= (j ? n0 : 0);
            const int kind = r / I_G; r -= kind * I_G;
            const size_t lw = (size_t)(l * 2 + j);
            if (kind < 2) { const float* W = p.in[kind == 0 ? 9 : 10] + lw * (size_t)D * FF;
                const int kb = r / 88, nb = r % 88, nn0 = nb * 32;
                tr_item(W, D, FF, (bf16_t*)(ws + WS_WGU) + (size_t)j * 5632 * 1024, (nn0 >> 7) * 256 + (nn0 & 127) + kind * 128, kb * 64, nn0, scr, lane);
            } else { const float* W = p.in[11] + lw * (size_t)FF * D;
                const int kb = r / 32, nb = r % 32;
                tr_item(W, FF, D, (bf16_t*)(ws + WS_WD) + (size_t)j * 1024 * 2816, nb * 32, kb * 64, nb * 32, scr, lane);
            }
            continue;
        }
        r -= n0 + n1;
        if (r < I_IN) {
            if (ab) { const int kb = r / 120, nb = r % 120; tr_item(p.in[12] + (size_t)i * D * AB_N, D, AB_N, (bf16_t*)(ws + WS_WIN), nb * 32, kb * 64, nb * 32, scr, lane); }
            else { const int kb = r / 136, nb = r % 136; tr_item(p.in[27] + (size_t)i * D * GD_NREAL, D, GD_NREAL, (bf16_t*)(ws + WS_WIN), nb * 32, kb * 64, nb * 32, scr, lane); }
            continue;
        }
        r -= I_IN;
        if (r < I_O) { const int kb = r / 32, nb = r % 32;
            tr_item(p.in[ab ? 13 : 32] + (size_t)i * D * D, D, D, (bf16_t*)(ws + WS_WOUT), nb * 32, kb * 64, nb * 32, scr, lane); continue; }
        r -= I_O;
        if (r < 16) { tr_item(p.in[16] + (size_t)i * 64 * 512, 64, 512, (bf16_t*)(ws + WS_W2T), r * 32, 0, r * 32, scr, lane); continue; }
        r -= 16;
        if (r < 16) { tr_item(p.in[18] + (size_t)i * 64 * 512, 64, 512, (bf16_t*)(ws + WS_A2T), r * 32, 0, r * 32, scr, lane); continue; }
        r -= 16;
        { const int kb = r / 16, nb = r % 16; tr_item(p.in[19] + (size_t)i * 128 * 512, 128, 512, (bf16_t*)(ws + WS_G2T), nb * 32, kb * 64, nb * 32, scr, lane); }
    }
}
__device__ __forceinline__ void convert_ffn_ahead(const Params& p, int l, int gw, int NGW, unsigned char* smem) {
    __syncthreads();
    convert_items(p, l, 2, gw, NGW, smem);
    if (l < 3) convert_items(p, l + 1, 1, gw, NGW, smem);
    __syncthreads();
}

__device__ __forceinline__ void phase_start(const Params& p, unsigned char* smem) {
    const int tid = mk_ltid(), lane = tid & 63, wave = tid >> 6;
    const int gw = mk_lbid() * 8 + wave, NGW = gridDim.x * 8;
    convert_items(p, 0, 5, gw, NGW, smem);
    bf16_t* HB = (bf16_t*)(p.ws + WS_HB);
    for (int m = gw; m < M; m += NGW) {
        const float* src = (m < MP) ? p.in[0] + (size_t)m * D : p.in[1] + (size_t)(m - MP) * D;
#pragma unroll
        for (int j = 0; j < 4; ++j) { const int c = (lane + 64 * j) * 4; const f32x4 v = *(const f32x4*)(src + c);
            u32x2 o; o.x = pk2(v[0], v[1]); o.y = pk2(v[2], v[3]); *(u32x2*)(HB + (size_t)m * D + c) = o; }
    }
}

__device__ __forceinline__ void phase_ln(const Params& p, int l, int k, bool final_out) {
    const int tid = mk_ltid(), lane = tid & 63, wave = tid >> 6;
    const int gw = mk_lbid() * 8 + wave, NGW = gridDim.x * 8;
    const bf16_t* X = (const bf16_t*)(p.ws + WS_X); bf16_t* HB = (bf16_t*)(p.ws + WS_HB);
    const float* g = p.in[7] + (size_t)(l * 3 + k) * D; const float* b = p.in[8] + (size_t)(l * 3 + k) * D;
    float* dst = p.out;
    for (int mq = gw; mq < M / 4; mq += NGW) {
        f32x4 v[4][4]; float s[4];
#pragma unroll
        for (int rr = 0; rr < 4; ++rr) { s[rr] = 0.f;
#pragma unroll
            for (int j = 0; j < 4; ++j) { const u32x2 xu = *(const u32x2*)(X + (size_t)(mq * 4 + rr) * D + (lane + 64 * j) * 4);
                v[rr][j][0] = __uint_as_float(xu.x << 16); v[rr][j][1] = __uint_as_float(xu.x & 0xffff0000u); v[rr][j][2] = __uint_as_float(xu.y << 16); v[rr][j][3] = __uint_as_float(xu.y & 0xffff0000u); s[rr] += (v[rr][j][0] + v[rr][j][1]) + (v[rr][j][2] + v[rr][j][3]); } }
#pragma unroll
        for (int o = 1; o < 64; o <<= 1) {
#pragma unroll
            for (int rr = 0; rr < 4; ++rr) s[rr] += __shfl_xor(s[rr], o); }
        float s2[4];
#pragma unroll
        for (int rr = 0; rr < 4; ++rr) { const float mean = s[rr] * (1.f / D); s2[rr] = 0.f;
#pragma unroll
            for (int j = 0; j < 4; ++j) { v[rr][j] = v[rr][j] - mean; s2[rr] += (v[rr][j][0] * v[rr][j][0] + v[rr][j][1] * v[rr][j][1]) + (v[rr][j][2] * v[rr][j][2] + v[rr][j][3] * v[rr][j][3]); } }
#pragma unroll
        for (int o = 1; o < 64; o <<= 1) {
#pragma unroll
            for (int rr = 0; rr < 4; ++rr) s2[rr] += __shfl_xor(s2[rr], o); }
#pragma unroll
        for (int j = 0; j < 4; ++j) { const int c = (lane + 64 * j) * 4; const f32x4 gg = *(const f32x4*)(g + c), bb = *(const f32x4*)(b + c);
#pragma unroll
            for (int rr = 0; rr < 4; ++rr) { const int m = mq * 4 + rr; const float rstd = rsqrtf(s2[rr] * (1.f / D) + 1e-5f);
                const f32x4 y = v[rr][j] * rstd * gg + bb;
                if (final_out) *(f32x4*)(dst + (size_t)m * D + c) = y;
                else { u32x2 o; o.x = pk2(y[0], y[1]); o.y = pk2(y[2], y[3]); *(u32x2*)(HB + (size_t)m * D + c) = o; } } }
    }
}

__device__ __forceinline__ void small_resid_gemm(const bf16_t* __restrict__ A, const bf16_t* __restrict__ Bt, int K, bf16_t* X, const bf16_t* H, float scale, unsigned char* smem) {
    const int tid = mk_ltid(), lane = tid & 63, w = __builtin_amdgcn_readfirstlane(tid >> 6);
    const int r = lane & 15, q = lane >> 4;
    float* part = (float*)smem;
    for (int t = mk_lbid(); t < 256; t += gridDim.x) {
        const int R0 = MP + (t >> 4) * 32, C0 = (t & 15) * 64;
        f32x4 acc[2][4];
#pragma unroll
        for (int a = 0; a < 2; ++a)
#pragma unroll
            for (int b = 0; b < 4; ++b) acc[a][b] = (f32x4){0.f, 0.f, 0.f, 0.f};
        const int nks = K / 32;
#pragma unroll 2
        for (int ks = w; ks < nks; ks += 8) {
            bf16x8 fa[2], fb[4];
#pragma unroll
            for (int a = 0; a < 2; ++a) fa[a] = *(const bf16x8*)(A + (size_t)(R0 + a * 16 + r) * K + ks * 32 + q * 8);
#pragma unroll
            for (int b = 0; b < 4; ++b) fb[b] = *(const bf16x8*)(Bt + (size_t)(C0 + b * 16 + r) * K + ks * 32 + q * 8);
#pragma unroll
            for (int a = 0; a < 2; ++a)
#pragma unroll
                for (int b = 0; b < 4; ++b) acc[a][b] = __builtin_amdgcn_mfma_f32_16x16x32_bf16(fa[a], fb[b], acc[a][b], 0, 0, 0);
        }
        __syncthreads();
#pragma unroll
        for (int a = 0; a < 2; ++a)
#pragma unroll
            for (int b = 0; b < 4; ++b) *(f32x4*)(part + ((w * 8 + a * 4 + b) * 64 + lane) * 4) = acc[a][b];
        __syncthreads();
        {
            const int tile = tid >> 6, a = tile >> 2, b = tile & 3;
            f32x4 sum = (f32x4){0.f, 0.f, 0.f, 0.f};
#pragma unroll
            for (int ww = 0; ww < 8; ++ww) sum += *(const f32x4*)(part + ((ww * 8 + tile) * 64 + lane) * 4);
            const int col = C0 + b * 16 + r;
#pragma unroll
            for (int j = 0; j < 4; ++j) { const size_t off = (size_t)(R0 + a * 16 + q * 4 + j) * D + col;
                X[off] = f2bf(bf2f(H[off]) * ALPHA + sum[j] * scale); }
        }
    }
}

__device__ __forceinline__ void phase_ab_prep(const Params& p, int i, unsigned char* smem) {
    const int tid = mk_ltid(), lane = tid & 63, wave = __builtin_amdgcn_readfirstlane(tid >> 6);
    const int r = lane & 15, q = lane >> 4;
    unsigned char* ws = p.ws;
    const bf16_t* ZB = (const bf16_t*)(ws + WS_ZB);
    float* OPS = (float*)(ws + WS_OPS); float* GATE = (float*)(ws + WS_GATE); float* BONUS = (float*)(ws + WS_BONUS);
    bf16_t* RQ = (bf16_t*)(ws + WS_RQ); bf16_t* RK = (bf16_t*)(ws + WS_RK);
    const bf16_t* W2T = (const bf16_t*)(ws + WS_W2T); const bf16_t* A2T = (const bf16_t*)(ws + WS_A2T); const bf16_t* G2T = (const bf16_t*)(ws + WS_G2T);
    const float* mu = p.in[14] + (size_t)i * 1792; const float* w0 = p.in[15] + i * 512; const float* a0 = p.in[17] + i * 512;
    const float* k_k = p.in[20] + i * 512; const float* k_a = p.in[21] + i * 512; const float* r_k = p.in[22] + i * 512;
    const float* shift_in = p.in[2] + (size_t)i * 128 * 1792;
    constexpr int ZS_LD = 1796, ACT_LD = 264;
    float* zs = (float*)smem;
    bf16_t* act = (bf16_t*)(smem + 16 * ZS_LD * 4);
    for (int tile = mk_lbid(); tile < M / 16; tile += gridDim.x) {
        const int R0 = tile * 16;
        unsigned pfa = 0u, pfb = 0u;
        { const int ntile = tile + gridDim.x;
          if (ntile < M / 16) { const bf16_t* nz = ZB + (size_t)ntile * 16 * AB_N;
              pfa = *(const unsigned*)(nz + (size_t)tid * 64); pfb = *(const unsigned*)(((size_t)(tid + 512) * 64 < (size_t)16 * AB_N) ? nz + (size_t)(tid + 512) * 64 : nz); } }
#ifndef REP_A_ST
#define REP_A_ST 1
#endif
#ifndef REP_A_RO
#define REP_A_RO 1
#endif
#ifndef REP_A_EP
#define REP_A_EP 1
#endif
        __syncthreads();
#pragma unroll 1
        for (int rp_ = 0; rp_ < REP_A_ST; ++rp_)
#pragma unroll 7
        for (int idx = tid; idx < 16 * 448; idx += 512) {
            const int tok = idx / 448, c4 = (idx % 448) * 4; const int row = R0 + tok;
            const int t = (row < MP) ? (row & 2047) : ((row - MP) & 3);
            const int Lm1 = (row < MP) ? 2047 : 3;
            const u32x2 cu = *(const u32x2*)(ZB + (size_t)row * AB_N + c4);
            f32x4 cur; cur[0] = __uint_as_float(cu.x << 16); cur[1] = __uint_as_float(cu.x & 0xffff0000u); cur[2] = __uint_as_float(cu.y << 16); cur[3] = __uint_as_float(cu.y & 0xffff0000u);
            f32x4 prev;
            if (t == 0) { if (row < MP) prev = (f32x4){0.f, 0.f, 0.f, 0.f}; else prev = *(const f32x4*)(shift_in + (size_t)((row - MP) >> 2) * 1792 + c4); }
            else { const u32x2 pu = *(const u32x2*)(ZB + (size_t)(row - 1) * AB_N + c4);
                prev[0] = __uint_as_float(pu.x << 16); prev[1] = __uint_as_float(pu.x & 0xffff0000u); prev[2] = __uint_as_float(pu.y << 16); prev[3] = __uint_as_float(pu.y & 0xffff0000u); }
            if (t == Lm1) {
                float* o = (row < MP) ? p.out + O_PSHIFT + (size_t)(i * 8 + (row >> 11)) * 1792 : p.out + O_SSHIFT + (size_t)(i * 128 + ((row - MP) >> 2)) * 1792;
                *(f32x4*)(o + c4) = cur;
            }
            const f32x4 m4 = *(const f32x4*)(mu + c4);
            const f32x4 z = cur + (prev - cur) * m4;
            *(f32x4*)(zs + tok * ZS_LD + c4) = z;
            if (c4 >= 1536) {
                f32x4 a;
                if (c4 < 1600) { a[0] = tanhf(z[0]); a[1] = tanhf(z[1]); a[2] = tanhf(z[2]); a[3] = tanhf(z[3]); }
                else if (c4 < 1664) a = z;
                else { a[0] = sigm(z[0]); a[1] = sigm(z[1]); a[2] = sigm(z[2]); a[3] = sigm(z[3]); }
                u32x2 o; o.x = pk2(a[0], a[1]); o.y = pk2(a[2], a[3]); *(u32x2*)(act + tok * ACT_LD + (c4 - 1536)) = o;
            }
        }
#pragma unroll 1
        for (int rp_ = 0; rp_ < REP_A_RO; ++rp_)
#pragma unroll 8
        for (int idx = tid; idx < 16 * 256; idx += 512) {
            const int tok = idx >> 8, hh = (idx >> 6) & 3, ii = idx & 63; const int row = R0 + tok;
            const float pos = (row < MP) ? (float)(row & 2047) : (float)(16384 + ((row - MP) & 3));
            const float inv_freq = exp2f(-(float)ii * (13.287712379549449f / 63.0f));
            const float ang = pos * inv_freq;
            const float n = rintf(ang * 0.15915494309189535f);
            float rr = fmaf(-n, 6.2831854820251465f, ang); rr = fmaf(-n, -1.7484555e-7f, rr);
            const float rev = rr * 0.15915494309189535f;
            const float sn = __builtin_amdgcn_sinf(rev), cs = __builtin_amdgcn_cosf(rev);
            const bf16_t* zq = ZB + (size_t)row * AB_N + 1792 + hh * 128 + ii;
            const float q1 = bf2f(zq[0]), q2 = bf2f(zq[64]), k1 = bf2f(zq[512]), k2 = bf2f(zq[576]);
            const size_t o = (size_t)row * 512 + hh * 128 + ii;
            RQ[o] = f2bf(q1 * cs - q2 * sn); RQ[o + 64] = f2bf(q2 * cs + q1 * sn);
            const float ksc = 0.08838834764831845f;
            RK[o] = f2bf((k1 * cs - k2 * sn) * ksc); RK[o + 64] = f2bf((k2 * cs + k1 * sn) * ksc);
        }
        __syncthreads();
        const int cb = wave * 64;
#pragma unroll 1
        for (int rp_ = 0; rp_ < REP_A_EP; ++rp_) {
        f32x4 aw[4], aa[4], ag[4];
#pragma unroll
        for (int nt = 0; nt < 4; ++nt) { aw[nt] = (f32x4){0.f, 0.f, 0.f, 0.f}; aa[nt] = aw[nt]; ag[nt] = aw[nt]; }
#pragma unroll
        for (int ks = 0; ks < 2; ++ks) {
            const bf16x8 bw = *(const bf16x8*)(act + r * ACT_LD + ks * 32 + q * 8);
            const bf16x8 ba = *(const bf16x8*)(act + r * ACT_LD + 64 + ks * 32 + q * 8);
#pragma unroll
            for (int nt = 0; nt < 4; ++nt) {
                const bf16x8 fw = *(const bf16x8*)(W2T + (size_t)(cb + nt * 16 + r) * 64 + ks * 32 + q * 8);
                const bf16x8 fa = *(const bf16x8*)(A2T + (size_t)(cb + nt * 16 + r) * 64 + ks * 32 + q * 8);
                aw[nt] = __builtin_amdgcn_mfma_f32_16x16x32_bf16(fw, bw, aw[nt], 0, 0, 0);
                aa[nt] = __builtin_amdgcn_mfma_f32_16x16x32_bf16(fa, ba, aa[nt], 0, 0, 0);
            }
        }
#pragma unroll
        for (int ks = 0; ks < 4; ++ks) {
            const bf16x8 bg = *(const bf16x8*)(act + r * ACT_LD + 128 + ks * 32 + q * 8);
#pragma unroll
            for (int nt = 0; nt < 4; ++nt) {
                const bf16x8 fg = *(const bf16x8*)(G2T + (size_t)(cb + nt * 16 + r) * 128 + ks * 32 + q * 8);
                ag[nt] = __builtin_amdgcn_mfma_f32_16x16x32_bf16(fg, bg, ag[nt], 0, 0, 0);
            }
        }
        const int row = R0 + r;
        float ssq = 0.f, bon = 0.f;
        f32x4 kkraw[4], av[4];
#pragma unroll
        for (int nt = 0; nt < 4; ++nt) {
            const int c = cb + nt * 16 + q * 4;
            const f32x4 rr = *(const f32x4*)(zs + r * ZS_LD + c), kx = *(const f32x4*)(zs + r * ZS_LD + 512 + c), vv = *(const f32x4*)(zs + r * ZS_LD + 1024 + c);
            const f32x4 w04 = *(const f32x4*)(w0 + c), a04 = *(const f32x4*)(a0 + c), kk4 = *(const f32x4*)(k_k + c), ka4 = *(const f32x4*)(k_a + c), rk4 = *(const f32x4*)(r_k + c);
            f32x4 dec, a, kp;
#pragma unroll
            for (int j = 0; j < 4; ++j) {
                const float wl = w04[j] + aw[nt][j];
                const float sp = fmaxf(-wl, 0.f) + __logf(1.f + __expf(-fabsf(wl)));
                const float wlog = -sp - 0.5f;
                dec[j] = __expf(-__expf(wlog));
                a[j] = sigm(a04[j] + aa[nt][j]);
                kkraw[nt][j] = kx[j] * kk4[j];
                kp[j] = kx[j] * (1.f + (a[j] - 1.f) * ka4[j]);
                ssq += kkraw[nt][j] * kkraw[nt][j];
                bon += rr[j] * kp[j] * rk4[j];
            }
            av[nt] = a;
            float* ob = OPS + ((size_t)row * 8 + wave) * 384 + nt * 16 + q * 4;
            *(f32x4*)(ob) = rr; *(f32x4*)(ob + 64) = dec; *(f32x4*)(ob + 128) = kp; *(f32x4*)(ob + 192) = vv;
            *(f32x4*)(GATE + (size_t)row * 512 + c) = ag[nt];
        }
        ssq += __shfl_xor(ssq, 16); ssq += __shfl_xor(ssq, 32);
        bon += __shfl_xor(bon, 16); bon += __shfl_xor(bon, 32);
        const float rn = rsqrtf(fmaxf(ssq, 1e-12f));
#pragma unroll
        for (int nt = 0; nt < 4; ++nt) {
            float* ob = OPS + ((size_t)row * 8 + wave) * 384 + nt * 16 + q * 4;
            const f32x4 kk = kkraw[nt] * rn;
            *(f32x4*)(ob + 256) = kk; *(f32x4*)(ob + 320) = kk * av[nt];
        }
        if (q == 0) BONUS[(size_t)row * 8 + wave] = bon;
        }
        if (pfa == 0x7fc17fc1u && pfb == 0x7fc27fc2u) zs[0] = 1.f;
    }
}

__device__ __forceinline__ void rwkv_item(const Params& p, int i, int s, int h, int rg, unsigned char* smem) {
    const int tid = mk_ltid(), lane = tid & 63, wave = __builtin_amdgcn_readfirstlane(tid >> 6);
    int row0, L; seq_info(s, row0, L);
    const float* OPS = (const float*)(p.ws + WS_OPS); float* ORAW = (float*)(p.ws + WS_ORAW);
    float* buf = (float*)smem;
    const int rih = rg * 16 + (wave & 3) * 4 + (lane >> 4);
    const int c4 = (lane & 15) * 4;
    f32x4 S = (f32x4){0.f, 0.f, 0.f, 0.f};
    if (s >= 8 && wave < 4) S = *(const f32x4*)(p.in[3] + ((((size_t)i * 128 + (s - 8)) * 8 + h) * 64 + rih) * 64 + c4);
    f32x4 pre[6];
    const int nch = (L + 31) / 32;
#pragma unroll
    for (int k = 0; k < 6; ++k) { const int idx4 = tid + k * 512; const int tt = idx4 / 96, off = idx4 % 96;
        pre[k] = (tt < L) ? *(const f32x4*)(OPS + ((size_t)(row0 + tt) * 8 + h) * 384 + off * 4) : (f32x4){0.f, 0.f, 0.f, 0.f}; }
    for (int ch = 0; ch < nch; ++ch) {
        const int t0 = ch * 32;
        __syncthreads();
#pragma unroll
        for (int k = 0; k < 6; ++k) { const int idx4 = tid + k * 512; *(f32x4*)(buf + idx4 * 4) = pre[k]; }
        __syncthreads();
        if (ch + 1 < nch) {
#pragma unroll
            for (int k = 0; k < 6; ++k) { const int idx4 = tid + k * 512; const int tt = t0 + 32 + idx4 / 96, off = idx4 % 96;
                pre[k] = (tt < L) ? *(const f32x4*)(OPS + ((size_t)(row0 + tt) * 8 + h) * 384 + off * 4) : (f32x4){0.f, 0.f, 0.f, 0.f}; }
        }
        if (wave < 4) {
            const int ns = (L - t0) < 32 ? (L - t0) : 32;
            f32x4 r4 = *(const f32x4*)(buf + c4), w4 = *(const f32x4*)(buf + 64 + c4), k4 = *(const f32x4*)(buf + 128 + c4);
            f32x4 kk4 = *(const f32x4*)(buf + 256 + c4), ka4 = *(const f32x4*)(buf + 320 + c4);
            float vv = buf[192 + rih];
            float* op = ORAW + (size_t)(row0 + t0) * 512 + h * 64 + rih;
            f32x4 rprev = r4;
#pragma unroll 2
            for (int tt = 0; tt < ns; ++tt) {
                const float* nb = buf + ((tt + 1 < 32) ? (tt + 1) : 31) * 384;
                const f32x4 r4n = *(const f32x4*)(nb + c4), w4n = *(const f32x4*)(nb + 64 + c4), k4n = *(const f32x4*)(nb + 128 + c4);
                const f32x4 kk4n = *(const f32x4*)(nb + 256 + c4), ka4n = *(const f32x4*)(nb + 320 + c4);
                const float vvn = nb[192 + rih];
                float o = (S[0] * rprev[0] + S[1] * rprev[1]) + (S[2] * rprev[2] + S[3] * rprev[3]);
                const f32x4 kv = k4 * vv;
                float sk = (S[0] * kk4[0] + S[1] * kk4[1]) + (S[2] * kk4[2] + S[3] * kk4[3]);
                sk = row16_sum(sk);
                o = row16_sum(o);
                const f32x4 t1 = kv - ka4 * sk;
                S = S * w4 + t1;
                if ((lane & 15) == 0 && tt > 0) op[(size_t)(tt - 1) * 512] = o;
                rprev = r4;
                r4 = r4n; w4 = w4n; k4 = k4n; kk4 = kk4n; ka4 = ka4n; vv = vvn;
            }
            {
                float o = (S[0] * rprev[0] + S[1] * rprev[1]) + (S[2] * rprev[2] + S[3] * rprev[3]);
                o = row16_sum(o);
                if ((lane & 15) == 0) op[(size_t)(ns - 1) * 512] = o;
            }
        }
    }
    if (wave < 4) {
        float* so = (s < 8) ? p.out + O_PRWKV + ((((size_t)i * 8 + s) * 8 + h) * 64 + rih) * 64 + c4
                            : p.out + O_SRWKV + ((((size_t)i * 128 + (s - 8)) * 8 + h) * 64 + rih) * 64 + c4;
        *(f32x4*)so = S;
    }
}

__device__ __forceinline__ void rwkv_item2(const Params& p, int i, int s, int h, int rg, unsigned char* smem) {
    const int tid = mk_ltid(), lane = tid & 63, wave = __builtin_amdgcn_readfirstlane(tid >> 6);
    int row0, L; seq_info(s, row0, L);
    const float* OPS = (const float*)(p.ws + WS_OPS); float* ORAW = (float*)(p.ws + WS_ORAW);
    float* buf = (float*)smem;
    const int ra = rg * 32 + (wave & 3) * 4 + (lane >> 4), rb = ra + 16;
    const int c4 = (lane & 15) * 4;
    f32x4 Sa = (f32x4){0.f, 0.f, 0.f, 0.f}, Sb = Sa;
    if (s >= 8 && wave < 4) { const float* sp = p.in[3] + (((size_t)i * 128 + (s - 8)) * 8 + h) * 4096;
        Sa = *(const f32x4*)(sp + ra * 64 + c4); Sb = *(const f32x4*)(sp + rb * 64 + c4); }
    f32x4 pre[12];
    const int nch = (L + 63) / 64;
#pragma unroll
    for (int k = 0; k < 12; ++k) { const int idx4 = tid + k * 512; const int tt = idx4 / 96, off = idx4 % 96;
        pre[k] = (tt < L) ? *(const f32x4*)(OPS + ((size_t)(row0 + tt) * 8 + h) * 384 + off * 4) : (f32x4){0.f, 0.f, 0.f, 0.f}; }
    for (int ch = 0; ch < nch; ++ch) {
        const int t0 = ch * 64;
        __syncthreads();
#pragma unroll
        for (int k = 0; k < 12; ++k) { const int idx4 = tid + k * 512; *(f32x4*)(buf + idx4 * 4) = pre[k]; }
        __syncthreads();
        if (ch + 1 < nch) {
#pragma unroll
            for (int k = 0; k < 12; ++k) { const int idx4 = tid + k * 512; const int tt = t0 + 64 + idx4 / 96, off = idx4 % 96;
                pre[k] = (tt < L) ? *(const f32x4*)(OPS + ((size_t)(row0 + tt) * 8 + h) * 384 + off * 4) : (f32x4){0.f, 0.f, 0.f, 0.f}; }
        }
        if (wave < 4) {
            const int ns = (L - t0) < 64 ? (L - t0) : 64;
            f32x4 rA = *(const f32x4*)(buf + c4), wA = *(const f32x4*)(buf + 64 + c4), kA = *(const f32x4*)(buf + 128 + c4);
            f32x4 kkA = *(const f32x4*)(buf + 256 + c4), kaA = *(const f32x4*)(buf + 320 + c4);
            float vaA = buf[192 + ra], vbA = buf[192 + rb];
            f32x4 rB, wB, kB, kkB, kaB; float vaB, vbB;
            float* op = ORAW + (size_t)(row0 + t0) * 512 + h * 64 + ra;
            f32x4 rprev = rA;
#define RW_LOAD(R, W, K, KK, KA, VA, VB, nb_) do { const float* nb = (nb_); R = *(const f32x4*)(nb + c4); W = *(const f32x4*)(nb + 64 + c4); K = *(const f32x4*)(nb + 128 + c4); \
                KK = *(const f32x4*)(nb + 256 + c4); KA = *(const f32x4*)(nb + 320 + c4); VA = nb[192 + ra]; VB = nb[192 + rb]; } while (0)
#define RW_STEP(R, W, K, KK, KA, VA, VB, RP, tt_) do { \
                float oa = (Sa[0] * RP[0] + Sa[1] * RP[1]) + (Sa[2] * RP[2] + Sa[3] * RP[3]); \
                float ob = (Sb[0] * RP[0] + Sb[1] * RP[1]) + (Sb[2] * RP[2] + Sb[3] * RP[3]); \
                float ska = (Sa[0] * KK[0] + Sa[1] * KK[1]) + (Sa[2] * KK[2] + Sa[3] * KK[3]); \
                float skb = (Sb[0] * KK[0] + Sb[1] * KK[1]) + (Sb[2] * KK[2] + Sb[3] * KK[3]); \
                ska = row16_sum(ska); skb = row16_sum(skb); oa = row16_sum(oa); ob = row16_sum(ob); \
                Sa = Sa * W + (K * VA - KA * ska); Sb = Sb * W + (K * VB - KA * skb); \
                if ((lane & 15) == 0 && (tt_) > 0) { op[(size_t)((tt_) - 1) * 512] = oa; op[(size_t)((tt_) - 1) * 512 + 16] = ob; } } while (0)
            for (int tt = 0; tt < ns; tt += 2) {
                RW_LOAD(rB, wB, kB, kkB, kaB, vaB, vbB, buf + (tt + 1) * 384);
                RW_STEP(rA, wA, kA, kkA, kaA, vaA, vbA, rprev, tt);
                const f32x4 rEven = rA;
                RW_LOAD(rA, wA, kA, kkA, kaA, vaA, vbA, buf + ((tt + 2 < 64) ? (tt + 2) : 63) * 384);
                RW_STEP(rB, wB, kB, kkB, kaB, vaB, vbB, rEven, tt + 1);
                rprev = rB;
            }
            {
                float oa = (Sa[0] * rprev[0] + Sa[1] * rprev[1]) + (Sa[2] * rprev[2] + Sa[3] * rprev[3]);
                float ob = (Sb[0] * rprev[0] + Sb[1] * rprev[1]) + (Sb[2] * rprev[2] + Sb[3] * rprev[3]);
                oa = row16_sum(oa); ob = row16_sum(ob);
                if ((lane & 15) == 0) { op[(size_t)(ns - 1) * 512] = oa; op[(size_t)(ns - 1) * 512 + 16] = ob; }
            }
#undef RW_LOAD
#undef RW_STEP
        }
    }
    if (wave < 4) {
        float* so = (s < 8) ? p.out + O_PRWKV + (((size_t)i * 8 + s) * 8 + h) * 4096 : p.out + O_SRWKV + (((size_t)i * 128 + (s - 8)) * 8 + h) * 4096;
        *(f32x4*)(so + ra * 64 + c4) = Sa; *(f32x4*)(so + rb * 64 + c4) = Sb;
    }
}

__device__ __forceinline__ void ret_item(const Params& p, int i, int s, int hb, unsigned char* smem) {
    const int tid = mk_ltid(), lane = tid & 63, w = __builtin_amdgcn_readfirstlane(tid >> 6);
    const int r = lane & 15, q = lane >> 4;
    int row0, L; seq_info(s, row0, L);
    const int C = (s < 8) ? 128 : 4; const int nch = L / C;
    const float lg = log2f(1.0f - exp2f(-5.0f - (float)hb));
    const bf16_t* ZB = (const bf16_t*)(p.ws + WS_ZB); const bf16_t* RQ = (const bf16_t*)(p.ws + WS_RQ); const bf16_t* RK = (const bf16_t*)(p.ws + WS_RK);
    bf16_t* OMIX = (bf16_t*)(p.ws + WS_OMIX);
    const float* gn_g = p.in[25] + i * 512 + hb * 128; const float* gn_b = p.in[26] + i * 512 + hb * 128;
    constexpr int LD = 136;
    bf16_t* KC = (bf16_t*)smem; bf16_t* KZT = KC + 128 * LD; bf16_t* VT = KZT + 128 * LD; bf16_t* SB = VT + 128 * LD;
    f32x4 ST[8];
#pragma unroll
    for (int nt = 0; nt < 8; ++nt) ST[nt] = (f32x4){0.f, 0.f, 0.f, 0.f};
    if (s >= 8) {
        const float* S0 = p.in[4] + (((size_t)i * 128 + (s - 8)) * 4 + hb) * 16384;
#pragma unroll
        for (int nt = 0; nt < 8; ++nt) ST[nt] = *(const f32x4*)(S0 + (size_t)(nt * 16 + r) * 128 + 16 * w + q * 4);
    }
    const float gch = exp2f((float)C * lg);
    for (int ch = 0; ch < nch; ++ch) {
        const int rb = row0 + ch * C;
        __syncthreads();
        for (int idx = tid; idx < 128 * 16; idx += 512) {
            const int tok = idx & 127, c8 = (idx >> 7) * 8;
            u32x4 kv = (u32x4){0u, 0u, 0u, 0u}, vv = kv;
            if (tok < C) { kv = *(const u32x4*)(RK + (size_t)(rb + tok) * 512 + hb * 128 + c8);
                           vv = *(const u32x4*)(ZB + (size_t)(rb + tok) * AB_N + 1792 + 1024 + hb * 128 + c8); }
            *(u32x4*)(KC + tok * LD + c8) = kv;
            const float zeta = exp2f((float)(C - 1 - tok) * lg);
            const unsigned kw[4] = {kv.x, kv.y, kv.z, kv.w}; const unsigned vw[4] = {vv.x, vv.y, vv.z, vv.w};
#pragma unroll
            for (int e = 0; e < 4; ++e) {
                const float k0 = __uint_as_float(kw[e] << 16) * zeta, k1 = __uint_as_float(kw[e] & 0xffff0000u) * zeta;
                KZT[(c8 + 2 * e) * LD + tok] = f2bf(k0); KZT[(c8 + 2 * e + 1) * LD + tok] = f2bf(k1);
                VT[(c8 + 2 * e) * LD + tok] = (bf16_t)(vw[e] & 0xffffu); VT[(c8 + 2 * e + 1) * LD + tok] = (bf16_t)(vw[e] >> 16);
            }
        }
#pragma unroll
        for (int nt = 0; nt < 8; ++nt)
#pragma unroll
            for (int j = 0; j < 4; ++j) SB[(16 * w + q * 4 + j) * LD + nt * 16 + r] = f2bf(ST[nt][j]);
        __syncthreads();
        bf16x8 aq[4];
#pragma unroll
        for (int ks = 0; ks < 4; ++ks) {
            if (16 * w + r < C) aq[ks] = *(const bf16x8*)(RQ + (size_t)(rb + 16 * w + r) * 512 + hb * 128 + ks * 32 + q * 8);
            else aq[ks] = (bf16x8){0, 0, 0, 0, 0, 0, 0, 0};
        }
        u32x2 P[8]; f32x4 O[8];
#pragma unroll
        for (int nt = 0; nt < 8; ++nt) {
            f32x4 acc = (f32x4){0.f, 0.f, 0.f, 0.f}, oc = acc;
#pragma unroll
            for (int ks = 0; ks < 4; ++ks) {
                const bf16x8 bk = *(const bf16x8*)(KC + (nt * 16 + r) * LD + ks * 32 + q * 8);
                const bf16x8 bs = *(const bf16x8*)(SB + (nt * 16 + r) * LD + ks * 32 + q * 8);
                acc = __builtin_amdgcn_mfma_f32_16x16x32_bf16(aq[ks], bk, acc, 0, 0, 0);
                oc = __builtin_amdgcn_mfma_f32_16x16x32_bf16(aq[ks], bs, oc, 0, 0, 0);
            }
#pragma unroll
            for (int j = 0; j < 4; ++j) {
                const int ii = 16 * w + q * 4 + j, jt = nt * 16 + r;
                acc[j] = (ii >= jt) ? acc[j] * exp2f((float)(ii - jt) * lg) : 0.f;
                oc[j] *= exp2f((float)(ii + 1) * lg);
            }
            P[nt].x = pk2(acc[0], acc[1]); P[nt].y = pk2(acc[2], acc[3]); O[nt] = oc;
        }
        __syncthreads();
#pragma unroll
        for (int nt = 0; nt < 8; ++nt)
#pragma unroll
            for (int j = 0; j < 4; ++j) KC[(16 * w + q * 4 + j) * LD + nt * 16 + r] = (bf16_t)(((j & 2) ? P[nt].y : P[nt].x) >> ((j & 1) * 16));
        __syncthreads();
#pragma unroll
        for (int nt = 0; nt < 8; ++nt) ST[nt] = ST[nt] * gch;
#pragma unroll
        for (int ks = 0; ks < 4; ++ks) {
            const bf16x8 ap = *(const bf16x8*)(KC + (16 * w + r) * LD + ks * 32 + q * 8);
            const bf16x8 av = *(const bf16x8*)(VT + (16 * w + r) * LD + ks * 32 + q * 8);
#pragma unroll
            for (int nt = 0; nt < 8; ++nt) {
                const bf16x8 bv = *(const bf16x8*)(VT + (nt * 16 + r) * LD + ks * 32 + q * 8);
                const bf16x8 bz = *(const bf16x8*)(KZT + (nt * 16 + r) * LD + ks * 32 + q * 8);
                O[nt] = __builtin_amdgcn_mfma_f32_16x16x32_bf16(ap, bv, O[nt], 0, 0, 0);
                ST[nt] = __builtin_amdgcn_mfma_f32_16x16x32_bf16(av, bz, ST[nt], 0, 0, 0);
            }
        }
#pragma unroll
        for (int j = 0; j < 4; ++j) {
            float s1 = 0.f;
#pragma unroll
            for (int nt = 0; nt < 8; ++nt) s1 += O[nt][j];
            s1 = row16_sum(s1); const float mean = s1 * (1.f / 128.f);
            float s2 = 0.f;
#pragma unroll
            for (int nt = 0; nt < 8; ++nt) { const float d = O[nt][j] - mean; s2 += d * d; }
            s2 = row16_sum(s2); const float rstd = rsqrtf(s2 * (1.f / 128.f) + 1e-5f);
            const int ii = 16 * w + q * 4 + j;
            if (ii < C) {
                const size_t row = (size_t)(rb + ii);
#pragma unroll
                for (int nt = 0; nt < 8; ++nt) { const int dv = nt * 16 + r;
                    const float val = (O[nt][j] - mean) * rstd * gn_g[dv] + gn_b[dv];
                    const float gr = bf2f(ZB[row * AB_N + 1792 + 1536 + hb * 128 + dv]);
                    OMIX[row * 1024 + 512 + hb * 128 + dv] = f2bf(val * silu(gr)); }
            }
        }
    }
    float* so = (s < 8) ? p.out + O_PRET + (((size_t)i * 8 + s) * 4 + hb) * 16384 : p.out + O_SRET + (((size_t)i * 128 + (s - 8)) * 4 + hb) * 16384;
#pragma unroll
    for (int nt = 0; nt < 8; ++nt) *(f32x4*)(so + (size_t)(nt * 16 + r) * 128 + 16 * w + q * 4) = ST[nt];
}

__device__ __forceinline__ void phase_ab_core(const Params& p, int i, int l, unsigned char* smem) {
    const int bid = mk_lbid(), G = gridDim.x; const int wv = mk_ltid() >> 6;
    if (G == 256) {
        if (bid < 128) rwkv_item2(p, i, bid >> 4, (bid >> 1) & 7, bid & 1, smem);
        else if (bid < 160) ret_item(p, i, (bid - 128) >> 2, (bid - 128) & 3, smem);
        else {
            for (int it = bid - 160; it < 128 * 16; it += 96) rwkv_item2(p, i, 8 + (it >> 4), (it >> 1) & 7, it & 1, smem);
            __syncthreads();
            for (int it = bid - 160; it < 128 * 4; it += 96) ret_item(p, i, 8 + (it >> 2), it & 3, smem);
        }
        if (bid >= 128) convert_ffn_ahead(p, l, (bid - 128) * 8 + wv, 128 * 8, smem);
    } else {
        for (int it = bid; it < 136 * 16; it += G) rwkv_item2(p, i, it >> 4, (it >> 1) & 7, it & 1, smem);
        __syncthreads();
        for (int it = bid; it < 136 * 4; it += G) ret_item(p, i, it >> 2, it & 3, smem);
        convert_ffn_ahead(p, l, bid * 8 + wv, G * 8, smem);
    }
}

__device__ __forceinline__ void phase_ab_post(const Params& p, int i) {
    const int tid = mk_ltid(), lane = tid & 63, wave = tid >> 6;
    const int gw = mk_lbid() * 8 + wave, NGW = gridDim.x * 8;
    const float* OPS = (const float*)(p.ws + WS_OPS); const float* ORAW = (const float*)(p.ws + WS_ORAW);
    const float* GATE = (const float*)(p.ws + WS_GATE); const float* BONUS = (const float*)(p.ws + WS_BONUS);
    bf16_t* OMIX = (bf16_t*)(p.ws + WS_OMIX);
    const float* gg = p.in[23] + i * 512; const float* gb = p.in[24] + i * 512;
    for (int m = gw; m < M; m += NGW) {
        const int c = lane * 8, h = lane >> 3, hc = c & 63;
        const f32x4 o0 = *(const f32x4*)(ORAW + (size_t)m * 512 + c), o1 = *(const f32x4*)(ORAW + (size_t)m * 512 + c + 4);
        float s1 = (o0[0] + o0[1]) + (o0[2] + o0[3]) + (o1[0] + o1[1]) + (o1[2] + o1[3]);
        s1 += __shfl_xor(s1, 1); s1 += __shfl_xor(s1, 2); s1 += __shfl_xor(s1, 4);
        const float mean = s1 * (1.f / 64.f);
        const f32x4 d0 = o0 - mean, d1 = o1 - mean;
        float s2 = (d0[0] * d0[0] + d0[1] * d0[1]) + (d0[2] * d0[2] + d0[3] * d0[3]) + (d1[0] * d1[0] + d1[1] * d1[1]) + (d1[2] * d1[2] + d1[3] * d1[3]);
        s2 += __shfl_xor(s2, 1); s2 += __shfl_xor(s2, 2); s2 += __shfl_xor(s2, 4);
        const float rstd = rsqrtf(s2 * (1.f / 64.f) + 64e-5f);
        const float bon = BONUS[(size_t)m * 8 + h];
        const float* vb = OPS + ((size_t)m * 8 + h) * 384 + 192 + hc;
        const f32x4 v0 = *(const f32x4*)vb, v1 = *(const f32x4*)(vb + 4);
        const f32x4 g0 = *(const f32x4*)(gg + c), g1 = *(const f32x4*)(gg + c + 4), b0 = *(const f32x4*)(gb + c), b1 = *(const f32x4*)(gb + c + 4);
        const f32x4 t0 = *(const f32x4*)(GATE + (size_t)m * 512 + c), t1 = *(const f32x4*)(GATE + (size_t)m * 512 + c + 4);
        const f32x4 y0 = (d0 * rstd * g0 + b0 + v0 * bon) * t0, y1 = (d1 * rstd * g1 + b1 + v1 * bon) * t1;
        u32x4 o; o.x = pk2(y0[0], y0[1]); o.y = pk2(y0[2], y0[3]); o.z = pk2(y1[0], y1[1]); o.w = pk2(y1[2], y1[3]);
        *(u32x4*)(OMIX + (size_t)m * 1024 + c) = o;
    }
}

__device__ __forceinline__ int gdn_item_index(int s, int h, int c) { return (s < 8) ? ((s * 8 + h) * 32 + c) : (2048 + (s - 8) * 8 + h); }

__device__ __forceinline__ void gdn_chunk_item(const Params& p, int i, int s, int h, int c, int pf_row, int pf_h, unsigned char* smem) {
    const int tid = mk_ltid(), lane = tid & 63, w = __builtin_amdgcn_readfirstlane(tid >> 6);
    const int r = lane & 15, q = lane >> 4;
    int row0, L; seq_info(s, row0, L);
    const int t0 = c * 64; const int nvalid = (L - t0) < 64 ? (L - t0) : 64;
    const bf16_t* ZB = (const bf16_t*)(p.ws + WS_ZB);
    unsigned char* rec = p.ws + WS_CH + (size_t)gdn_item_index(s, h, c) * CH_BYTES;
    float* U = (float*)(rec + CH_U); bf16_t* Wd = (bf16_t*)(rec + CH_W); bf16_t* QG = (bf16_t*)(rec + CH_QG); bf16_t* QK = (bf16_t*)(rec + CH_QK); bf16_t* KDT = (bf16_t*)(rec + CH_KDT);
    constexpr int LD = 132, ALD = 68;
    float* qs = (float*)smem; float* ks = qs + 64 * LD; float* vs = ks + 64 * LD; float* As = vs + 64 * LD;
    float* AT = As + 64 * ALD; float* gcs = AT + 64 * ALD; float* bes = gcs + 64;
    unsigned short pfv = 0;
    if (pf_row >= 0 && tid < 384) { const int rr_ = tid / 6, pp_ = (tid % 6) >> 1, hh_ = tid & 1;
        pfv = ((const bf16_t*)(p.ws + WS_ZB))[(size_t)(pf_row + rr_) * GD_N + pp_ * 1024 + pf_h * 128 + hh_ * 64]; }
#ifndef REP_G_CONV
#define REP_G_CONV 1
#endif
#ifndef REP_G_MFMA
#define REP_G_MFMA 1
#endif
#ifndef REP_G_QG
#define REP_G_QG 1
#endif
#ifndef REP_G_SUB
#define REP_G_SUB 1
#endif
#pragma unroll 1
    for (int rp_ = 0; rp_ < REP_G_CONV; ++rp_) {
    __syncthreads();
    if (tid < 384) {
        const int part = tid >> 7, ch = tid & 127; const int zc = part * 1024 + h * 128 + ch;
        const float* cw = p.in[28] + (size_t)i * 4 * 3072 + zc;
        const float cw0 = cw[0], cw1 = cw[3072], cw2 = cw[2 * 3072], cw3 = cw[3 * 3072];
        float* dst = (part == 0 ? qs : part == 1 ? ks : vs) + ch;
        if (nvalid == 64) {
            float xh[3], xn[64];
#pragma unroll
            for (int j = 0; j < 3; ++j) { const int t = t0 - 3 + j;
                xh[j] = (t >= 0) ? bf2f(ZB[(size_t)(row0 + (t >= 0 ? t : 0)) * GD_N + zc]) : 0.f; }
#pragma unroll
            for (int e = 0; e < 64; ++e) xn[e] = bf2f(ZB[(size_t)(row0 + t0 + e) * GD_N + zc]);
            float x3 = xh[0], x2 = xh[1], x1 = xh[2];
#pragma unroll
            for (int e = 0; e < 64; ++e) {
                const float y = cw0 * x3 + cw1 * x2 + cw2 * x1 + cw3 * xn[e];
                dst[e * LD] = silu(y);
                x3 = x2; x2 = x1; x1 = xn[e];
            }
        } else {
            float x3, x2, x1;
            { const float* cs = p.in[5] + (((size_t)i * 128 + (s - 8)) * 3) * 3072 + zc; x3 = cs[0]; x2 = cs[3072]; x1 = cs[2 * 3072]; }
#pragma unroll
            for (int e = 0; e < 64; ++e) {
                float v = 0.f;
                if (e < 4) { const float xe = (e < nvalid) ? bf2f(ZB[(size_t)(row0 + e) * GD_N + zc]) : 0.f;
                    const float y = cw0 * x3 + cw1 * x2 + cw2 * x1 + cw3 * xe; v = (e < nvalid) ? silu(y) : 0.f; x3 = x2; x2 = x1; x1 = xe; }
                dst[e * LD] = v;
            }
        }
    } else if (tid < 448) {
        const int t = tid - 384;
        float be = 0.f, g = 0.f;
        if (t < nvalid) { const size_t zr = (size_t)(row0 + t0 + t) * GD_N;
            be = sigm(bf2f(ZB[zr + 3072 + h]));
            const float a = bf2f(ZB[zr + 3080 + h]) + p.in[30][i * 8 + h];
            const float sp = fmaxf(a, 0.f) + __logf(1.f + __expf(-fabsf(a)));
            g = -__expf(p.in[29][i * 8 + h]) * sp; }
#pragma unroll
        for (int o = 1; o < 64; o <<= 1) { const float y = __shfl_up(g, o); if (t >= o) g += y; }
        gcs[t] = g; bes[t] = be;
    }
    }
    __syncthreads();
    for (int pass = 0; pass < 4; ++pass) {
        const int rowi = w * 16 + pass * 4 + q;
        const int t = rowi & 63;
        if ((w * 16 + pass * 4) % 64 < nvalid) {
            float* base = ((rowi < 64) ? qs : ks) + t * LD + r * 8;
            f32x4 a = *(f32x4*)base, b = *(f32x4*)(base + 4);
            float ss = (a[0] * a[0] + a[1] * a[1]) + (a[2] * a[2] + a[3] * a[3]) + (b[0] * b[0] + b[1] * b[1]) + (b[2] * b[2] + b[3] * b[3]);
            ss = row16_sum(ss);
            const float rn = rsqrtf(fmaxf(ss, 1e-12f));
            *(f32x4*)base = a * rn; *(f32x4*)(base + 4) = b * rn;
        }
    }
    __syncthreads();
#pragma unroll 1
    for (int rp_ = 0; rp_ < REP_G_MFMA; ++rp_)
#pragma unroll
    for (int tl = 0; tl < 2; ++tl) {
        const int tile = 2 * w + tl, mi = tile >> 2, ni = tile & 3;
        f32x4 akk = (f32x4){0.f, 0.f, 0.f, 0.f}, aqk = akk;
        if (mi * 16 < nvalid) {
#pragma unroll 8
            for (int k0 = 0; k0 < 128; k0 += 4) {
                const float ka = ks[(mi * 16 + r) * LD + k0 + q], kb = ks[(ni * 16 + r) * LD + k0 + q], qa = qs[(mi * 16 + r) * LD + k0 + q];
                akk = __builtin_amdgcn_mfma_f32_16x16x4f32(ka, kb, akk, 0, 0, 0);
                aqk = __builtin_amdgcn_mfma_f32_16x16x4f32(qa, kb, aqk, 0, 0, 0);
            }
        }
#pragma unroll
        for (int j = 0; j < 4; ++j) { const int ii = mi * 16 + q * 4 + j, jj = ni * 16 + r;
            const float dm = (ii >= jj) ? __expf(gcs[ii] - gcs[jj]) : 0.f;
            const float aij = (ii > jj) ? bes[ii] * akk[j] * dm : 0.f;
            As[ii * ALD + jj] = aij; AT[jj * ALD + ii] = aij;
            if (mi * 16 < nvalid) QK[ii * 64 + jj] = f2bf(aqk[j] * 0.08838834764831845f * dm); }
    }
    __syncthreads();
#pragma unroll 1
    for (int rp_ = 0; rp_ < REP_G_QG; ++rp_)
    {
        const float gl = gcs[63];
        const int nrow = (nvalid == 64) ? 64 : 16;
        for (int idx = tid; idx < nrow * 128; idx += 512) { const int t = idx >> 7, d = idx & 127;
            QG[idx] = f2bf(qs[t * LD + d] * 0.08838834764831845f * __expf(gcs[t])); }
        if (nvalid == 64) {
            for (int idx = tid; idx < 64 * 128; idx += 512) { const int d = idx >> 6, t = idx & 63;
                KDT[idx] = f2bf(ks[t * LD + d] * __expf(gl - gcs[t])); }
        } else {
            for (int idx = tid; idx < 16 * 128; idx += 512) { const int d = idx >> 4, t = idx & 15;
                KDT[d * 64 + t] = f2bf(ks[t * LD + d] * __expf(gl - gcs[t])); }
        }
        if (tid == 0) ((float*)(p.ws + WS_GL))[gdn_item_index(s, h, c)] = __expf(gl);
    }
    __syncthreads();
    for (int idx = tid; idx < 64 * 128; idx += 512) { const int t = idx >> 7, d = idx & 127; const float be = bes[t];
        vs[t * LD + d] *= be; ks[t * LD + d] *= be * __expf(gcs[t]); }
    __syncthreads();
    const int nblk = (nvalid + 15) >> 4;
#pragma unroll 1
    for (int blk = 0; blk < 4; ++blk) {
        if (blk >= nblk) continue;
        if (blk > 0) {
#pragma unroll
            for (int tl = 0; tl < 2; ++tl) {
                const int nt = 2 * w + tl; float* bb = (nt < 8 ? vs : ks) + (nt & 7) * 16 + r;
                f32x4 acc = (f32x4){0.f, 0.f, 0.f, 0.f};
                const float* ap = As + (blk * 16 + r) * ALD + q;
                for (int k0 = 0; k0 < blk * 16; k0 += 4)
                    acc = __builtin_amdgcn_mfma_f32_16x16x4f32(ap[k0], bb[(k0 + q) * LD], acc, 0, 0, 0);
#pragma unroll
                for (int j = 0; j < 4; ++j) bb[(blk * 16 + q * 4 + j) * LD] -= acc[j];
            }
            __syncthreads();
        }
        if (tid < 256) {
            const int col = tid & 127; const bool isu = tid < 128;
            float* buf = (isu ? vs : ks) + col;
            float acc[16];
#pragma unroll
            for (int e = 0; e < 16; ++e) acc[e] = buf[(blk * 16 + e) * LD];
#pragma unroll
            for (int e = 1; e < 16; ++e) {
#pragma unroll
                for (int f = 0; f < e; ++f) acc[e] -= As[(blk * 16 + e) * ALD + blk * 16 + f] * acc[f];
            }
#pragma unroll
            for (int e = 0; e < 16; ++e) { const int ii = blk * 16 + e; buf[ii * LD] = acc[e];
                if (isu) U[ii * 128 + col] = acc[e]; else Wd[ii * 128 + col] = f2bf(acc[e]); }
        }
        __syncthreads();
    }
    if (pfv == 0x7fc3u) gcs[0] = 1.f;
}

__device__ __forceinline__ void phase_gdn_chunk(const Params& p, int i, unsigned char* smem) {
    for (int it = mk_lbid(); it < N_CH; it += gridDim.x) {
        int s, h, c;
        if (it < 2048) { s = it >> 8; h = (it >> 5) & 7; c = it & 31; } else { const int k = it - 2048; s = 8 + (k >> 3); h = k & 7; c = 0; }
        const int nit = it + gridDim.x; int pf_row = -1, pf_h = 0;
        if (nit < 2048) { pf_row = (nit >> 8) * 2048 + (nit & 31) * 64; pf_h = (nit >> 5) & 7; }
        gdn_chunk_item(p, i, s, h, c, pf_row, pf_h, smem);
    }
    const bf16_t* ZB = (const bf16_t*)(p.ws + WS_ZB);
    const int gt = mk_lbid() * 512 + mk_ltid(), GT = gridDim.x * 512;
    for (int idx = gt; idx < 136 * 3 * 3072; idx += GT) {
        const int s = idx / (3 * 3072), rem = idx % (3 * 3072), j = rem / 3072, zc = rem % 3072;
        int row0, L; seq_info(s, row0, L);
        const float v = bf2f(ZB[(size_t)(row0 + L - 3 + j) * GD_N + zc]);
        if (s < 8) p.out[O_PCONV + (((size_t)i * 8 + s) * 3 + j) * 3072 + zc] = v;
        else p.out[O_SCONV + (((size_t)i * 128 + (s - 8)) * 3 + j) * 3072 + zc] = v;
    }
}

__device__ __forceinline__ void gdn_scan_item(const Params& p, int i, int s, int h, unsigned char* smem) {
    const int tid = mk_ltid(), lane = tid & 63, w = __builtin_amdgcn_readfirstlane(tid >> 6);
    const int r = lane & 15, q = lane >> 4;
    int row0, L; seq_info(s, row0, L);
    const int nch = (s < 8) ? 32 : 1;
    const bf16_t* ZB = (const bf16_t*)(p.ws + WS_ZB); bf16_t* OMIX = (bf16_t*)(p.ws + WS_OMIX);
    const float* GL = (const float*)(p.ws + WS_GL);
    const float* ng = p.in[31] + i * 128;
    constexpr int LD = 136, VLD = 72, ULD = 132;
    bf16_t* SB = (bf16_t*)smem;
    bf16_t* VN = (bf16_t*)(smem + 34816);
    float* red = (float*)(smem + 53248);
    bf16_t* WL = (bf16_t*)(smem + 53760);
    bf16_t* QGL = (bf16_t*)(smem + 71168);
    bf16_t* QKL = (bf16_t*)(smem + 88576);
    bf16_t* KDL = (bf16_t*)(smem + 97792);
    float* UL = (float*)(smem + 116224);
    f32x4 ST[8];
#pragma unroll
    for (int nt = 0; nt < 8; ++nt) ST[nt] = (f32x4){0.f, 0.f, 0.f, 0.f};
    if (s >= 8) {
        const float* S0 = p.in[6] + (((size_t)i * 128 + (s - 8)) * 8 + h) * 16384;
#pragma unroll
        for (int nt = 0; nt < 8; ++nt) ST[nt] = *(const f32x4*)(S0 + (size_t)(nt * 16 + r) * 128 + 16 * w + q * 4);
    }
    const int mt = w & 3, nh = w >> 2;
    u32x4 pw[2], pq[2], pk, pd[2]; f32x4 pu[4]; float pgl;
    const bool smp = (s >= 8);
#define GDN_PREFETCH(cc) do { const int item_ = gdn_item_index(s, h, (cc)); const unsigned char* rec_ = p.ws + WS_CH + (size_t)item_ * CH_BYTES; \
        const u32x4 z4_ = (u32x4){0u, 0u, 0u, 0u}; \
        _Pragma("unroll") for (int k_ = 0; k_ < 2; ++k_) { const int idx_ = tid + k_ * 512; \
            pw[k_] = (smp && (idx_ >> 4) >= 16) ? z4_ : *(const u32x4*)((const bf16_t*)(rec_ + CH_W) + (idx_ >> 4) * 128 + (idx_ & 15) * 8); \
            pq[k_] = (smp && (idx_ >> 4) >= 16) ? z4_ : *(const u32x4*)((const bf16_t*)(rec_ + CH_QG) + (idx_ >> 4) * 128 + (idx_ & 15) * 8); \
            pd[k_] = (smp && (idx_ & 7) >= 2) ? z4_ : *(const u32x4*)((const bf16_t*)(rec_ + CH_KDT) + (idx_ >> 3) * 64 + (idx_ & 7) * 8); } \
        pk = (smp && (tid >> 3) >= 16) ? z4_ : *(const u32x4*)((const bf16_t*)(rec_ + CH_QK) + (tid >> 3) * 64 + (tid & 7) * 8); \
        _Pragma("unroll") for (int k_ = 0; k_ < 4; ++k_) { const int idx_ = tid + k_ * 512; \
            pu[k_] = (smp && (idx_ >> 5) >= 16) ? (f32x4){0.f, 0.f, 0.f, 0.f} : *(const f32x4*)((const float*)(rec_ + CH_U) + (idx_ >> 5) * 128 + (idx_ & 31) * 4); } \
        pgl = GL[item_]; } while (0)
    GDN_PREFETCH(0);
    for (int c = 0; c < nch; ++c) {
        const float glast = pgl;
        const int rb = row0 + c * 64; const int nvalid = (L - c * 64) < 64 ? (L - c * 64) : 64;
#pragma unroll
        for (int k = 0; k < 2; ++k) { const int idx = tid + k * 512;
            *(u32x4*)(WL + (idx >> 4) * LD + (idx & 15) * 8) = pw[k]; *(u32x4*)(QGL + (idx >> 4) * LD + (idx & 15) * 8) = pq[k];
            *(u32x4*)(KDL + (idx >> 3) * VLD + (idx & 7) * 8) = pd[k]; }
        *(u32x4*)(QKL + (tid >> 3) * VLD + (tid & 7) * 8) = pk;
#pragma unroll
        for (int k = 0; k < 4; ++k) { const int idx = tid + k * 512; *(f32x4*)(UL + (idx >> 5) * ULD + (idx & 31) * 4) = pu[k]; }
#pragma unroll
        for (int nt = 0; nt < 8; ++nt)
#pragma unroll
            for (int j = 0; j < 4; ++j) SB[(16 * w + q * 4 + j) * LD + nt * 16 + r] = f2bf(ST[nt][j]);
        __syncthreads();
        if (c + 1 < nch) GDN_PREFETCH(c + 1);
        bf16_t zgr[4][4];
#pragma unroll
        for (int j = 0; j < 4; ++j) { const int tk = mt * 16 + q * 4 + j; const size_t row = (size_t)(rb + (tk < nvalid ? tk : 0));
#pragma unroll
            for (int n4 = 0; n4 < 4; ++n4) zgr[j][n4] = ZB[row * GD_N + 3088 + h * 128 + (nh * 4 + n4) * 16 + r]; }
        f32x4 aws[4], aqg[4];
#pragma unroll
        for (int n4 = 0; n4 < 4; ++n4) { aws[n4] = (f32x4){0.f, 0.f, 0.f, 0.f}; aqg[n4] = aws[n4]; }
#pragma unroll
        for (int ks = 0; ks < 4; ++ks) {
            const bf16x8 fw = *(const bf16x8*)(WL + (mt * 16 + r) * LD + ks * 32 + q * 8);
            const bf16x8 fq = *(const bf16x8*)(QGL + (mt * 16 + r) * LD + ks * 32 + q * 8);
#pragma unroll
            for (int n4 = 0; n4 < 4; ++n4) {
                const bf16x8 bs = *(const bf16x8*)(SB + ((nh * 4 + n4) * 16 + r) * LD + ks * 32 + q * 8);
                aws[n4] = __builtin_amdgcn_mfma_f32_16x16x32_bf16(fw, bs, aws[n4], 0, 0, 0);
                aqg[n4] = __builtin_amdgcn_mfma_f32_16x16x32_bf16(fq, bs, aqg[n4], 0, 0, 0);
            }
        }
#pragma unroll
        for (int n4 = 0; n4 < 4; ++n4) {
            const int dv = (nh * 4 + n4) * 16 + r;
            float vn[4];
#pragma unroll
            for (int j = 0; j < 4; ++j) vn[j] = UL[(mt * 16 + q * 4 + j) * ULD + dv] - aws[n4][j];
            u32x2 o; o.x = pk2(vn[0], vn[1]); o.y = pk2(vn[2], vn[3]);
            *(u32x2*)(VN + dv * VLD + mt * 16 + q * 4) = o;
        }
        __syncthreads();
#pragma unroll
        for (int ks = 0; ks < 2; ++ks) {
            const bf16x8 fk = *(const bf16x8*)(QKL + (mt * 16 + r) * VLD + ks * 32 + q * 8);
#pragma unroll
            for (int n4 = 0; n4 < 4; ++n4) {
                const bf16x8 bv = *(const bf16x8*)(VN + ((nh * 4 + n4) * 16 + r) * VLD + ks * 32 + q * 8);
                aqg[n4] = __builtin_amdgcn_mfma_f32_16x16x32_bf16(fk, bv, aqg[n4], 0, 0, 0);
            }
        }
        {
            float ssq[4];
#pragma unroll
            for (int j = 0; j < 4; ++j) { float a = 0.f;
#pragma unroll
                for (int n4 = 0; n4 < 4; ++n4) a += aqg[n4][j] * aqg[n4][j];
                ssq[j] = row16_sum(a); }
            if (r == 0) {
#pragma unroll
                for (int j = 0; j < 4; ++j) red[(mt * 16 + q * 4 + j) * 2 + nh] = ssq[j];
            }
        }
#pragma unroll
        for (int nt = 0; nt < 8; ++nt) ST[nt] = ST[nt] * glast;
#pragma unroll
        for (int ks = 0; ks < 2; ++ks) {
            const bf16x8 av = *(const bf16x8*)(VN + (16 * w + r) * VLD + ks * 32 + q * 8);
#pragma unroll
            for (int nt = 0; nt < 8; ++nt) {
                const bf16x8 bk = *(const bf16x8*)(KDL + (nt * 16 + r) * VLD + ks * 32 + q * 8);
                ST[nt] = __builtin_amdgcn_mfma_f32_16x16x32_bf16(av, bk, ST[nt], 0, 0, 0);
            }
        }
        __syncthreads();
#pragma unroll
        for (int j = 0; j < 4; ++j) {
            const int tk = mt * 16 + q * 4 + j;
            if (tk < nvalid) {
                const float rs = rsqrtf((red[tk * 2] + red[tk * 2 + 1]) * (1.f / 128.f) + 1e-6f);
                const size_t row = (size_t)(rb + tk);
#pragma unroll
                for (int n4 = 0; n4 < 4; ++n4) { const int dv = (nh * 4 + n4) * 16 + r;
                    OMIX[row * 1024 + h * 128 + dv] = f2bf(aqg[n4][j] * rs * ng[dv] * silu(bf2f(zgr[j][n4]))); }
            }
        }
    }
#undef GDN_PREFETCH
    float* so = (s < 8) ? p.out + O_PGDN + (((size_t)i * 8 + s) * 8 + h) * 16384 : p.out + O_SGDN + (((size_t)i * 128 + (s - 8)) * 8 + h) * 16384;
#pragma unroll
    for (int nt = 0; nt < 8; ++nt) *(f32x4*)(so + (size_t)(nt * 16 + r) * 128 + 16 * w + q * 4) = ST[nt];
    __syncthreads();
}

__device__ __forceinline__ void phase_gdn_scan(const Params& p, int i, int l, unsigned char* smem) {
    const int bid = mk_lbid(), G = gridDim.x; const int wv = mk_ltid() >> 6;
    if (G == 256) {
        if (bid < 64) gdn_scan_item(p, i, bid >> 3, bid & 7, smem);
        else {
            for (int it = bid - 64; it < 128 * 8; it += 192) gdn_scan_item(p, i, 8 + (it >> 3), it & 7, smem);
            convert_ffn_ahead(p, l, (bid - 64) * 8 + wv, 192 * 8, smem);
        }
    } else {
        for (int it = bid; it < 136 * 8; it += G) { const int s = it >> 3, h = it & 7; gdn_scan_item(p, i, s, h, smem); }
        convert_ffn_ahead(p, l, bid * 8 + wv, G * 8, smem);
    }
}

__global__ void __launch_bounds__(512, 2) mega(Params p) {
    extern __shared__ __attribute__((aligned(16))) unsigned char lds[];
    cg::grid_group grid = cg::this_grid();
    constexpr int NPH = 1 + 4 * 12;
    unsigned* bar = (unsigned*)(p.ws + WS_BAR);
    volatile unsigned* bst = (volatile unsigned*)(lds + LDS_BYTES - 16);
    if (mk_ltid() == 0) { bst[0] = 0u; bst[1] = 0u; }
    if (mk_lbid() == 0) for (int u = mk_ltid(); u < XCD_BAR_WORDS; u += 512) __hip_atomic_store(bar + u, 0u, __ATOMIC_RELAXED, __HIP_MEMORY_SCOPE_AGENT);
    __syncthreads();
#pragma unroll 1
    for (int ph = 0; ph < NPH; ++ph) {
        int l = (ph == 0) ? 0 : (ph - 1) / 12, k = (ph == 0) ? -1 : (ph - 1) % 12;
        asm volatile("" : "+s"(l), "+s"(k));
        const int i = l >> 1; const bool ab = (l & 1) == 0;
        if (k == 6 && !ab) continue;
        unsigned char* ws = p.ws; asm volatile("" : "+s"(ws));
        unsigned char* smem = (unsigned char*)lds;
        PG8_LAS unsigned char* ldsp = (PG8_LAS unsigned char*)lds;
        const int G = gridDim.x, cu = mk_lbid();
#ifndef REPMASK
#define REPMASK 0
#endif
#ifndef REPAB
#define REPAB 3
#endif
        const int nrep = (((REPMASK >> (k + 1)) & 1) && ((REPAB >> (l & 1)) & 1)) ? 2 : 1;
#pragma unroll 1
        for (int rep = 0; rep < nrep; ++rep) {
        if (rep) grid.sync();
        if (k == -1) phase_start(p, smem);
        else if (k == 0 || k == 9) {
            const int j = (k == 9);
            pg8::Gemm g{(const bf16_t*)(ws + WS_HB), (const bf16_t*)(ws + WS_WGU) + (size_t)j * 5632 * 1024, M, 5632, D};
            pg8::StaticOrder S; S.init(g.M, g.N, G, cu); EpiSwiglu E{(bf16_t*)(ws + WS_HID)};
            pg8::gemm_phase<EpiSwiglu, pg8::StaticOrder, true, true>(ldsp, g, S, E);
        } else if (k == 1 || k == 10 || k == 7) {
            const int j = (k == 10);
            pg8::Gemm g{(const bf16_t*)(ws + (k == 7 ? WS_OMIX : WS_HID)), k == 7 ? (const bf16_t*)(ws + WS_WOUT) : (const bf16_t*)(ws + WS_WD) + (size_t)j * 1024 * 2816, MP, D, k == 7 ? D : FF};
            pg8::StaticOrder S; S.init(g.M, g.N, G, cu); EpiResid E{(bf16_t*)(ws + WS_X), (const bf16_t*)(ws + WS_HB), k == 7 ? 1.0f : 0.5f};
            pg8::gemm_phase<EpiResid, pg8::StaticOrder, true, true>(ldsp, g, S, E);
            small_resid_gemm(g.A, g.Bt, g.K, E.X, E.H, E.scale, smem);
        } else if (k == 2 || k == 8 || k == 11) {
            phase_ln(p, l, k == 2 ? 0 : (k == 8 ? 1 : 2), (l == 3 && k == 11));
            if (k == 11 && l < 3) convert_items(p, l + 1, 4, mk_lbid() * 8 + (mk_ltid() >> 6), gridDim.x * 8, smem);
        } else if (k == 3) {
            pg8::Gemm g{(const bf16_t*)(ws + WS_HB), (const bf16_t*)(ws + WS_WIN), M, ab ? AB_N : GD_N, D};
            pg8::StaticOrder S; S.init(g.M, g.N, G, cu); EpiZ E{(bf16_t*)(ws + WS_ZB), g.N};
            pg8::gemm_phase<EpiZ, pg8::StaticOrder, true, true>(ldsp, g, S, E);
        } else if (k == 4) { if (ab) phase_ab_prep(p, i, smem); else phase_gdn_chunk(p, i, smem); }
        else if (k == 5) { if (ab) phase_ab_core(p, i, l, smem); else phase_gdn_scan(p, i, l, smem); }
        else if (k == 6) phase_ab_post(p, i);
        }
        if (ph + 1 < NPH) { if (ph == 0) { grid.sync(); if (mk_ltid() == 0) (void)xb_add(&bar[XB_XCNT(xb_xcc_id())], 1u); } else gbar(bar, bst); }
#ifdef REPSYNC
        if (ph > 0) { gbar(bar, bst); gbar(bar, bst); }
#endif
    }
}
}

extern "C" void kernel_launch(void* const* d_in, const int* in_sizes, int n_in, void* d_out, int out_size, void* d_ws, size_t ws_size, hipStream_t stream) {
    static int grid_blocks = 0;
    if (grid_blocks == 0) {
        if (n_in != 33 || ws_size < mk::WS_NEED) { fprintf(stderr, "kernel_launch: need 33 inputs and %zu bytes of workspace; got %d, %zu\n", (size_t)mk::WS_NEED, n_in, ws_size); grid_blocks = -1; return; }
        int dev = 0, cus = 0, per_cu = 0;
        hipGetDevice(&dev);
        hipDeviceGetAttribute(&cus, hipDeviceAttributeMultiprocessorCount, dev);
        if (hipFuncSetAttribute((const void*)mk::mega, hipFuncAttributeMaxDynamicSharedMemorySize, mk::LDS_BYTES) != hipSuccess) { fprintf(stderr, "kernel_launch: hipFuncSetAttribute failed\n"); grid_blocks = -1; return; }
        if (hipOccupancyMaxActiveBlocksPerMultiprocessor(&per_cu, (const void*)mk::mega, 512, mk::LDS_BYTES) != hipSuccess || per_cu < 1) { fprintf(stderr, "kernel_launch: occupancy query failed (%d)\n", per_cu); (void)hipGetLastError(); per_cu = 1; }
        grid_blocks = cus * 1;
        fprintf(stderr, "kernel_launch: grid %d (cus %d, per_cu %d)\n", grid_blocks, cus, per_cu);
    }
    if (grid_blocks < 0) return;
    mk::Params prm{};
    for (int k = 0; k < 33; ++k) prm.in[k] = (const float*)d_in[k];
    prm.out = (float*)d_out; prm.ws = (unsigned char*)d_ws;
    void* args[] = {&prm};
    hipError_t e = hipLaunchCooperativeKernel((const void*)mk::mega, dim3(grid_blocks), dim3(512), args, mk::LDS_BYTES, stream);
    if (e != hipSuccess) fprintf(stderr, "cooperative launch failed: %s (grid %d)\n", hipGetErrorString(e), grid_blocks);
}
```

```cpp
#include <hip/hip_runtime.h>
#include <hip/hip_cooperative_groups.h>
#include <cstdio>
#include <cstdint>
namespace cg = cooperative_groups;
__device__ __forceinline__ int mk_ltid() { int t = threadIdx.x; asm volatile("" : "+v"(t)); return t; }
__device__ __forceinline__ int mk_lbid() { int t = blockIdx.x; asm volatile("" : "+s"(t)); return t; }
namespace pg8 {
#define PG8_LAS __attribute__((address_space(3)))
typedef unsigned short bf16_t;
typedef short bf16x8 __attribute__((ext_vector_type(8)));
typedef float f32x4 __attribute__((ext_vector_type(4)));
typedef unsigned u32x4 __attribute__((ext_vector_type(4)));
constexpr int BM = 256, BK = 64, HALF = 128, HTB = HALF * BK * 2  , STAGE_BYTES = 8 * HTB, NXCD = 8, WGM = 8;

__host__ __device__ __forceinline__ int lds_byte(int r, int c) { const int st = (r >> 4) * 2 + (c >> 5), rr = r & 15, cc = c & 31, ob = rr * 64 + cc * 2; return st * 1024 + (ob ^ (((ob >> 9) & 1) << 5)); }
__host__ __device__ __forceinline__ void stage_rc(int b, int& R, int& C) { const int st = b / 1024, sb = b % 1024, swz = sb ^ (((sb >> 9) & 1) << 5); R = (st >> 1) * 16 + swz / 64; C = (st & 1) * 32 + (swz % 64) / 2; }
__host__ __device__ __forceinline__ int perm32(int rho) { const int n = rho >> 4, i = rho & 15; return 8 * (i >> 2) + 4 * n + (i & 3); }

struct Unit { int pm, pn; };
struct Gemm { const bf16_t* A; const bf16_t* Bt; int M, N, K; };

struct StaticOrder {
    int nM, nN, nwg, G, c;
    __host__ __device__ void init(int M, int N, int G_, int c_) { nM = M / BM; nN = N / BM; nwg = nM * nN; G = G_; c = c_; }
    __host__ __device__ bool next(int i, Unit& u) const {
        const long L = (long)i * G + c; if (L >= nwg) return false;
        int wgid = (int)L; { const int q = nwg / NXCD, r = nwg % NXCD, xcd = wgid % NXCD, off = wgid / NXCD; wgid = (xcd < r ? xcd * (q + 1) : r * (q + 1) + (xcd - r) * q) + off; }
        const int nig = WGM * nN, gid = wgid / nig, fm = gid * WGM, gsz = (nM - fm) < WGM ? (nM - fm) : WGM;
        u.pm = fm + ((wgid % nig) % gsz); u.pn = (wgid % nig) / gsz; return true;
    }
    __device__ __forceinline__ void a_ready(const Unit&) const {}
    __device__ __forceinline__ void done(const Unit&) const {}
};

template <class Epi, class Sched, bool ALIGN_EPI = false, bool SP2 = false>
__device__ __forceinline__ void gemm_phase(PG8_LAS unsigned char* lds, const Gemm g, const Sched& S, const Epi& E) {
    const int tid = mk_ltid(), wid = __builtin_amdgcn_readfirstlane(tid >> 6), lane = tid & 63, wr = wid >> 2, wc = wid & 3, fr = lane & 15, fq = lane >> 4;
    const int K = g.K, nt = K / BK;
    unsigned voffA[2], voffB[2];
#pragma unroll
    for (int i = 0; i < 2; ++i) { int R, C; stage_rc(tid * 16 + i * 8192, R, C); const int Rb = Epi::PERM ? ((R & ~31) + perm32(R & 31)) : R;
        voffA[i] = (unsigned)(R * K + C) * 2u; voffB[i] = (unsigned)(Rb * K + C) * 2u; }
    const size_t kstep = (size_t)(BK * 2);
    const size_t hstep = (size_t)HALF * K * 2;
    const size_t tstep = 2 * hstep;
    const unsigned ldsw = (unsigned)wid * 1024u;
    const int aoff = lds_byte(wr * 64 + fr, fq * 8), boff = lds_byte(wc * 32 + fr, fq * 8);
#define PG8_SA(b, h) (((b) * 2 + (h)) * HTB)
#define PG8_SB(b, h) ((4 + (b) * 2 + (h)) * HTB)
#define PG8_STAGE(bufoff, gbase, voff) do { _Pragma("unroll") for (int _i = 0; _i < 2; ++_i) \
        __builtin_amdgcn_global_load_lds((const unsigned*)((const char*)(gbase) + (voff)[_i]), (PG8_LAS unsigned*)(lds + (bufoff) + ldsw + _i * 8192), 16, 0, 0); } while (0)
#define PG8_LDA(dst, b, h) do { _Pragma("unroll") for (int m = 0; m < 4; ++m) _Pragma("unroll") for (int k = 0; k < 2; ++k) dst[m][k] = *(const PG8_LAS bf16x8*)(lds + PG8_SA(b, h) + aoff + m * 2048 + k * 1024); } while (0)
#define PG8_LDB(dst, b, h) do { _Pragma("unroll") for (int n = 0; n < 2; ++n) _Pragma("unroll") for (int k = 0; k < 2; ++k) dst[n][k] = *(const PG8_LAS bf16x8*)(lds + PG8_SB(b, h) + boff + n * 2048 + k * 1024); } while (0)
#define PG8_MMA(ai, bj, At, Bt) do { __builtin_amdgcn_s_setprio(1); _Pragma("unroll") for (int m = 0; m < 4; ++m) _Pragma("unroll") for (int n = 0; n < 2; ++n) _Pragma("unroll") for (int k = 0; k < 2; ++k) \
        acc[ai][bj][m][n] = __builtin_amdgcn_mfma_f32_16x16x32_bf16(Bt[n][k], At[m][k], acc[ai][bj][m][n], 0, 0, 0); __builtin_amdgcn_s_setprio(0); } while (0)
#define PG8_WAIT_V(n) asm volatile("s_waitcnt vmcnt(" #n ")" ::: "memory")
#define PG8_WAIT_L(n) asm volatile("s_waitcnt lgkmcnt(" #n ")" ::: "memory")
#define PG8_BAR __builtin_amdgcn_s_barrier()
#define PG8_SCHED __builtin_amdgcn_sched_barrier(0)
    Unit cur, nxt; int ui = 0;
    if (!S.next(0, cur)) return;
    f32x4 acc[2][2][4][2];
#pragma unroll
    for (int a = 0; a < 2; ++a)
#pragma unroll
        for (int b = 0; b < 2; ++b)
#pragma unroll
            for (int m = 0; m < 4; ++m)
#pragma unroll
                for (int n = 0; n < 2; ++n) acc[a][b][m][n] = (f32x4){0.f, 0.f, 0.f, 0.f};
    bf16x8 At[4][2], B0[2][2], B1[2][2];
    const char* cA = (const char*)g.A + (size_t)cur.pm * tstep; const char* cB = (const char*)g.Bt + (size_t)cur.pn * tstep;
    S.a_ready(cur);
    if constexpr (SP2) {
        PG8_STAGE(PG8_SB(0, 0), cB, voffB); PG8_STAGE(PG8_SB(0, 1), cB + hstep, voffB); PG8_STAGE(PG8_SA(0, 0), cA, voffA); PG8_STAGE(PG8_SA(0, 1), cA + hstep, voffA);
        if (wr == 1) PG8_BAR;
        PG8_WAIT_V(2); PG8_BAR;
        PG8_STAGE(PG8_SB(1, 0), cB + kstep, voffB); PG8_STAGE(PG8_SA(1, 0), cA + kstep, voffA); PG8_STAGE(PG8_SB(1, 1), cB + hstep + kstep, voffB);
        PG8_WAIT_V(6); PG8_BAR;
    } else {
        PG8_STAGE(PG8_SB(0, 0), cB, voffB); PG8_STAGE(PG8_SA(0, 0), cA, voffA); PG8_STAGE(PG8_SB(0, 1), cB + hstep, voffB); PG8_STAGE(PG8_SA(0, 1), cA + hstep, voffA);
        if (wr == 1) PG8_BAR;
        PG8_WAIT_V(4); PG8_BAR;
        PG8_STAGE(PG8_SB(1, 0), cB + kstep, voffB); PG8_STAGE(PG8_SA(1, 0), cA + kstep, voffA); PG8_STAGE(PG8_SB(1, 1), cB + hstep + kstep, voffB);
        PG8_WAIT_V(6); PG8_BAR;
    }
    for (;;) {
        const bool has_next = S.next(ui + 1, nxt);
        const char* nA = has_next ? (const char*)g.A + (size_t)nxt.pm * tstep : cA; const char* nB = has_next ? (const char*)g.Bt + (size_t)nxt.pn * tstep : cB;
        for (int t = 0; t < nt; t += 2) {
            const bool last = (t == nt - 2);
            const char* a1 = cA + (size_t)(t + 1) * kstep;
            const char* a2 = last ? nA : cA + (size_t)(t + 2) * kstep; const char* b2 = last ? nB : cB + (size_t)(t + 2) * kstep;
            const char* a3 = a2 + kstep; const char* b3 = b2 + kstep;
            if (last && has_next) S.a_ready(nxt);
            if constexpr (SP2) {
            PG8_LDB(B0, 0, 0); PG8_LDB(B1, 0, 1); PG8_SCHED; PG8_LDA(At, 0, 0); PG8_STAGE(PG8_SA(1, 1), a1 + hstep, voffA);
            PG8_WAIT_V(8); PG8_WAIT_L(0); PG8_BAR; PG8_MMA(0, 0, At, B0); PG8_MMA(0, 1, At, B1); PG8_BAR; PG8_SCHED;
            PG8_LDA(At, 0, 1); PG8_STAGE(PG8_SB(0, 0), b2, voffB); PG8_STAGE(PG8_SB(0, 1), b2 + hstep, voffB); PG8_STAGE(PG8_SA(0, 0), a2, voffA);
            PG8_WAIT_V(8); PG8_WAIT_L(0); PG8_BAR; PG8_MMA(1, 0, At, B0); PG8_MMA(1, 1, At, B1); PG8_BAR; PG8_SCHED;
            PG8_LDB(B0, 1, 0); PG8_LDB(B1, 1, 1); PG8_SCHED; PG8_LDA(At, 1, 0); PG8_STAGE(PG8_SA(0, 1), a2 + hstep, voffA);
            PG8_WAIT_V(8); PG8_WAIT_L(0); PG8_BAR; PG8_MMA(0, 0, At, B0); PG8_MMA(0, 1, At, B1); PG8_BAR; PG8_SCHED;
            PG8_LDA(At, 1, 1); PG8_STAGE(PG8_SB(1, 0), b3, voffB); PG8_STAGE(PG8_SB(1, 1), b3 + hstep, voffB); PG8_STAGE(PG8_SA(1, 0), a3, voffA);
            PG8_WAIT_V(8); PG8_WAIT_L(0); PG8_BAR; PG8_MMA(1, 0, At, B0); PG8_MMA(1, 1, At, B1); PG8_BAR; PG8_SCHED;
            } else {
            PG8_LDB(B0, 0, 0); PG8_SCHED; PG8_LDA(At, 0, 0); PG8_STAGE(PG8_SA(1, 1), a1 + hstep, voffA);
            PG8_WAIT_L(8); PG8_BAR; PG8_WAIT_L(0); PG8_MMA(0, 0, At, B0); PG8_BAR; PG8_SCHED;
            PG8_LDB(B1, 0, 1); PG8_STAGE(PG8_SB(0, 0), b2, voffB);
            PG8_BAR; PG8_WAIT_L(0); PG8_MMA(0, 1, At, B1); PG8_BAR;
            PG8_LDA(At, 0, 1); PG8_STAGE(PG8_SA(0, 0), a2, voffA);
            PG8_BAR; PG8_WAIT_L(0); PG8_MMA(1, 0, At, B0); PG8_BAR; PG8_SCHED;
            PG8_STAGE(PG8_SB(0, 1), b2 + hstep, voffB);
            PG8_WAIT_V(6); PG8_BAR; PG8_MMA(1, 1, At, B1); PG8_BAR;
            PG8_LDB(B0, 1, 0); PG8_SCHED; PG8_LDA(At, 1, 0); PG8_STAGE(PG8_SA(0, 1), a2 + hstep, voffA);
            PG8_WAIT_L(8); PG8_BAR; PG8_WAIT_L(0); PG8_MMA(0, 0, At, B0); PG8_BAR; PG8_SCHED;
            PG8_LDB(B1, 1, 1); PG8_STAGE(PG8_SB(1, 0), b3, voffB);
            PG8_BAR; PG8_WAIT_L(0); PG8_MMA(0, 1, At, B1); PG8_BAR;
            PG8_LDA(At, 1, 1); PG8_STAGE(PG8_SA(1, 0), a3, voffA);
            PG8_BAR; PG8_WAIT_L(0); PG8_MMA(1, 0, At, B0); PG8_BAR; PG8_SCHED;
            PG8_STAGE(PG8_SB(1, 1), b3 + hstep, voffB);
            PG8_WAIT_V(6); PG8_BAR; PG8_MMA(1, 1, At, B1); PG8_BAR;
            }
        }
        if constexpr (ALIGN_EPI) { if (wr == 0) PG8_BAR; }
        if constexpr (!Epi::AFTER_DRAIN) { E(acc, cur, wr, wc, fr, fq); S.done(cur); }
        if (!has_next) break;
#pragma unroll
        for (int a = 0; a < 2; ++a)
#pragma unroll
            for (int b = 0; b < 2; ++b)
#pragma unroll
                for (int m = 0; m < 4; ++m)
#pragma unroll
                    for (int n = 0; n < 2; ++n) acc[a][b][m][n] = (f32x4){0.f, 0.f, 0.f, 0.f};
        cur = nxt; cA = nA; cB = nB; ++ui;
        if constexpr (ALIGN_EPI) { if (wr == 1) PG8_BAR; }
    }
    PG8_WAIT_V(0);
    if constexpr (!ALIGN_EPI) { if (wr == 0) PG8_BAR; }
    PG8_BAR;
    if constexpr (Epi::AFTER_DRAIN) { E.fused(acc, cur, wr, wc, fr, fq, lds, wid, lane); S.done(cur); }
#undef PG8_SA
#undef PG8_SB
#undef PG8_STAGE
#undef PG8_LDA
#undef PG8_LDB
#undef PG8_MMA
#undef PG8_WAIT_V
#undef PG8_WAIT_L
#undef PG8_BAR
#undef PG8_SCHED
}
}

namespace mk {
using pg8::bf16_t; using pg8::bf16x8; using pg8::f32x4; using pg8::Unit;
typedef unsigned u32x4 __attribute__((ext_vector_type(4)));
typedef unsigned u32x2 __attribute__((ext_vector_type(2)));

constexpr int M = 16896, MP = 16384, D = 1024, FF = 2816;
constexpr int AB_N = 3840, GD_N = 4352, GD_NREAL = 4112;
constexpr float ALPHA = 1.6817928305074290f;
constexpr int LDS_BYTES = 163840;

constexpr size_t O_PSHIFT = 17301504, O_PRWKV = 17330176, O_PRET = 17854464, O_PCONV = 18903040, O_PGDN = 19050496;
constexpr size_t O_SSHIFT = 21147648, O_SRWKV = 21606400, O_SRET = 29995008, O_SCONV = 46772224, O_SGDN = 49131520;

constexpr size_t WS_WGU = 0;
constexpr size_t WS_WD = WS_WGU + 2ull * 5632 * 1024 * 2;
constexpr size_t WS_WIN = WS_WD + 2ull * 1024 * 2816 * 2;
constexpr size_t WS_WOUT = WS_WIN + 4352ull * 1024 * 2;
constexpr size_t WS_W2T = WS_WOUT + 1024ull * 1024 * 2;
constexpr size_t WS_A2T = WS_W2T + 65536;
constexpr size_t WS_G2T = WS_A2T + 65536;
constexpr size_t WS_X = WS_G2T + 131072;
constexpr size_t WS_HB = WS_X + (size_t)M * 1024 * 4;
constexpr size_t WS_S = WS_HB + (size_t)M * 1024 * 2;
constexpr size_t WS_HID = WS_S;
constexpr size_t WS_OMIX = WS_S;
constexpr size_t WS_ZB = WS_OMIX + (size_t)M * 1024 * 2;
constexpr size_t WS_OPS = WS_ZB + (size_t)M * AB_N * 2;
constexpr size_t WS_GATE = WS_OPS + (size_t)M * 3072 * 4;
constexpr size_t WS_ORAW = WS_GATE + (size_t)M * 512 * 4;
constexpr size_t WS_BONUS = WS_ORAW + (size_t)M * 512 * 4;
constexpr size_t WS_RQ = WS_BONUS + (size_t)M * 8 * 4;
constexpr size_t WS_RK = WS_RQ + (size_t)M * 512 * 2;
constexpr size_t WS_AB_END = WS_RK + (size_t)M * 512 * 2;
constexpr size_t WS_CH = WS_ZB + (size_t)M * GD_N * 2;
constexpr size_t CH_U = 0, CH_W = 32768, CH_QG = 49152, CH_QK = 65536, CH_KDT = 73728, CH_BYTES = 90112;
constexpr int N_CH = 2048 + 1024;
constexpr size_t WS_GL = WS_CH + (size_t)N_CH * CH_BYTES;
constexpr size_t WS_GD_END = WS_GL + N_CH * 4;
constexpr size_t WS_BAR = ((WS_AB_END > WS_GD_END ? WS_AB_END : WS_GD_END) + 255) / 256 * 256;
constexpr size_t WS_NEED = WS_BAR + 16384;

struct Params { const float* in[33]; float* out; unsigned char* ws; };

__device__ __forceinline__ float bf2f(bf16_t h) { return __uint_as_float(((unsigned)h) << 16); }
__device__ __forceinline__ unsigned pk2(float lo, float hi) { unsigned r; asm volatile("v_cvt_pk_bf16_f32 %0, %1, %2" : "=v"(r) : "v"(lo), "v"(hi)); return r; }
__device__ __forceinline__ bf16_t f2bf(float x) { return (bf16_t)(pk2(x, 0.f) & 0xffffu); }
__device__ __forceinline__ float sigm(float x) { return __builtin_amdgcn_rcpf(1.f + __expf(-x)); }
__device__ __forceinline__ float silu(float x) { return x * __builtin_amdgcn_rcpf(1.f + __expf(-x)); }
__device__ __forceinline__ float dppf(float v, const int ctrl_sel) {
    int x = __builtin_bit_cast(int, v), y;
    if (ctrl_sel == 0) y = __builtin_amdgcn_update_dpp(0, x, 0xB1, 0xF, 0xF, true);
    else if (ctrl_sel == 1) y = __builtin_amdgcn_update_dpp(0, x, 0x4E, 0xF, 0xF, true);
    else if (ctrl_sel == 2) y = __builtin_amdgcn_update_dpp(0, x, 0x141, 0xF, 0xF, true);
    else y = __builtin_amdgcn_update_dpp(0, x, 0x140, 0xF, 0xF, true);
    return __builtin_bit_cast(float, y);
}
__device__ __forceinline__ float row16_sum(float v) { v += dppf(v, 0); v += dppf(v, 1); v += dppf(v, 2); v += dppf(v, 3); return v; }
__device__ __forceinline__ float wave_sum(float v) {
#pragma unroll
    for (int o = 1; o < 64; o <<= 1) v += __shfl_xor(v, o);
    return v;
}
#define XB_XCNT(j)  (256  + 64 * (j))
#define XB_XSUB(j)  (1280 + 64 * (j))
#define XB_XGEN(j)  (2304 + 64 * (j))
#define XB_TOP      3328
#define XB_TOPGEN   3392
#define XCD_BAR_WORDS 3456
__device__ __forceinline__ unsigned xb_ld(unsigned* p)              { return __hip_atomic_load(p, __ATOMIC_RELAXED, __HIP_MEMORY_SCOPE_AGENT); }
__device__ __forceinline__ unsigned xb_add(unsigned* p, unsigned v) { return __hip_atomic_fetch_add(p, v, __ATOMIC_RELAXED, __HIP_MEMORY_SCOPE_AGENT); }
__device__ __forceinline__ unsigned xb_xcc_id() { return (unsigned)__builtin_amdgcn_s_getreg((3 << 11) | 20) & 0xFu; }
__device__ __forceinline__ void gbar(unsigned* bar, volatile unsigned* st) {
    asm volatile("s_waitcnt vmcnt(0)" ::: "memory");
    __syncthreads();
    if (mk_ltid() == 0) {
        __builtin_amdgcn_s_waitcnt(0);
        const unsigned x = xb_xcc_id();
        unsigned nloc = st[0], nx = st[1];
        if (nloc == 0u) {
            const unsigned G = gridDim.x;
            unsigned sum, cnt, mine;
            for (;;) {
                sum = 0u; cnt = 0u; mine = 0u;
#pragma unroll
                for (unsigned j = 0; j < 16; ++j) { const unsigned c = xb_ld(&bar[XB_XCNT(j)]); sum += c; cnt += (c > 0u) ? 1u : 0u; mine = (j == x) ? c : mine; }
                if (sum == G) break;
                __builtin_amdgcn_s_sleep(1);
            }
            nloc = mine > 0u ? mine : 1u; nx = cnt > 0u ? cnt : 1u; st[0] = nloc; st[1] = nx;
        }
        const unsigned old = xb_add(&bar[XB_XSUB(x)], 1u);
        const unsigned gen = old / nloc;
        if (old + 1u == (gen + 1u) * nloc) {
            __builtin_amdgcn_fence(__ATOMIC_RELEASE, "agent");
            asm volatile("s_waitcnt vmcnt(0)" ::: "memory");
            const unsigned og = xb_add(&bar[XB_TOP], 1u);
            const unsigned tg = og / nx;
            if (og + 1u == (tg + 1u) * nx) xb_add(&bar[XB_TOPGEN], 1u);
            else while (xb_ld(&bar[XB_TOPGEN]) == tg) __builtin_amdgcn_s_sleep(1);
            __builtin_amdgcn_fence(__ATOMIC_ACQUIRE, "agent");
            xb_add(&bar[XB_XGEN(x)], 1u);
            asm volatile("s_waitcnt vmcnt(0)" ::: "memory");
        } else {
            while (xb_ld(&bar[XB_XGEN(x)]) == gen) __builtin_amdgcn_s_sleep(1);
            __builtin_amdgcn_fence(__ATOMIC_ACQUIRE, "agent");
            asm volatile("s_waitcnt vmcnt(0)" ::: "memory");
        }
    }
    __syncthreads();
}
__device__ __forceinline__ void seq_info(int s, int& row0, int& L) { if (s < 8) { row0 = s * 2048; L = 2048; } else { row0 = MP + (s - 8) * 4; L = 4; } }

struct EpiSwiglu { static constexpr bool PERM = true, AFTER_DRAIN = false; bf16_t* O;
    __device__ __forceinline__ void operator()(const f32x4 (&acc)[2][2][4][2], const Unit& u, int wr, int wc, int fr, int fq) const {
        const int row0 = u.pm * 256 + wr * 64 + fr, col0 = u.pn * 128 + wc * 32 + 8 * fq;
#pragma unroll
        for (int ai = 0; ai < 2; ++ai)
#pragma unroll
            for (int m = 0; m < 4; ++m) {
                bf16_t* rp = O + (size_t)(row0 + ai * 128 + m * 16) * FF + col0;
                const f32x4 g0 = acc[ai][0][m][0], g1 = acc[ai][0][m][1], u0 = acc[ai][1][m][0], u1 = acc[ai][1][m][1];
                u32x4 w;
                w.x = pk2(silu(g0[0]) * u0[0], silu(g0[1]) * u0[1]); w.y = pk2(silu(g0[2]) * u0[2], silu(g0[3]) * u0[3]);
                w.z = pk2(silu(g1[0]) * u1[0], silu(g1[1]) * u1[1]); w.w = pk2(silu(g1[2]) * u1[2], silu(g1[3]) * u1[3]);
                *(u32x4*)rp = w;
            }
    }
};
struct EpiResid { static constexpr bool PERM = true, AFTER_DRAIN = false; bf16_t* X; const bf16_t* H; float scale;
    __device__ __forceinline__ void operator()(const f32x4 (&acc)[2][2][4][2], const Unit& u, int wr, int wc, int fr, int fq) const {
        const int row0 = u.pm * 256 + wr * 64 + fr, col0 = u.pn * 256 + wc * 32 + 8 * fq;
#pragma unroll
        for (int ai = 0; ai < 2; ++ai)
#pragma unroll
            for (int m = 0; m < 4; ++m)
#pragma unroll
                for (int bj = 0; bj < 2; ++bj)
#pragma unroll
                    for (int n = 0; n < 2; ++n) {
                        const size_t off = (size_t)(row0 + ai * 128 + m * 16) * D + col0 + bj * 128 + 4 * n;
                        const u32x2 hu = *(const u32x2*)(H + off);
                        f32x4 x; x[0] = __uint_as_float(hu.x << 16); x[1] = __uint_as_float(hu.x & 0xffff0000u); x[2] = __uint_as_float(hu.y << 16); x[3] = __uint_as_float(hu.y & 0xffff0000u);
                        x = x * ALPHA + acc[ai][bj][m][n] * scale; u32x2 xo; xo.x = pk2(x[0], x[1]); xo.y = pk2(x[2], x[3]); *(u32x2*)(X + off) = xo;
                    }
    }
};
struct EpiZ { static constexpr bool PERM = true, AFTER_DRAIN = false; bf16_t* Z; int ld;
    __device__ __forceinline__ void operator()(const f32x4 (&acc)[2][2][4][2], const Unit& u, int wr, int wc, int fr, int fq) const {
        const int row0 = u.pm * 256 + wr * 64 + fr, col0 = u.pn * 256 + wc * 32 + 8 * fq;
#pragma unroll
        for (int ai = 0; ai < 2; ++ai)
#pragma unroll
            for (int m = 0; m < 4; ++m)
#pragma unroll
                for (int bj = 0; bj < 2; ++bj) {
                    const f32x4 a = acc[ai][bj][m][0], b = acc[ai][bj][m][1];
                    u32x4 w; w.x = pk2(a[0], a[1]); w.y = pk2(a[2], a[3]); w.z = pk2(b[0], b[1]); w.w = pk2(b[2], b[3]);
                    *(u32x4*)(Z + (size_t)(row0 + ai * 128 + m * 16) * ld + col0 + bj * 128) = w;
                }
    }
};

__device__ __forceinline__ void tr_item(const float* __restrict__ W, int K, int N, bf16_t* WT, int dst_row0, int k0, int n0, float* scr, int lane) {
#pragma unroll
    for (int i = 0; i < 32; ++i) { const int kk = 2 * i + (lane >> 5); const int col = n0 + (lane & 31);
        scr[kk * 33 + (lane & 31)] = (col < N) ? W[(size_t)(k0 + kk) * N + col] : 0.f; }
    asm volatile("s_waitcnt lgkmcnt(0)" ::: "memory");
    const int c = lane & 7;
#pragma unroll
    for (int j = 0; j < 4; ++j) { const int n = (lane >> 3) + 8 * j; const float* s = scr + (8 * c) * 33 + n;
        u32x4 o; o.x = pk2(s[0], s[33]); o.y = pk2(s[2 * 33], s[3 * 33]); o.z = pk2(s[4 * 33], s[5 * 33]); o.w = pk2(s[6 * 33], s[7 * 33]);
        *(u32x4*)(WT + (size_t)(dst_row0 + n) * K + k0 + 8 * c) = o; }
    asm volatile("s_waitcnt lgkmcnt(0)" ::: "memory");
}

__device__ __forceinline__ void convert_items(const Params& p, int l, int parts, int gw, int NGW, unsigned char* smem) {
    const int lane = mk_ltid() & 63, wave = mk_ltid() >> 6;
    float* scr = (float*)smem + wave * (64 * 33);
    unsigned char* ws = p.ws;
    const int i = l >> 1; const bool ab = (l & 1) == 0;
    constexpr int I_G = 16 * 88, I_O = 16 * 32;
    const int I_IN = ab ? 16 * 120 : 16 * 136;
    const int I_LORA = ab ? (16 + 16 + 32) : 0;
    const int n0 = (parts & 1) ? 3 * I_G : 0, n1 = (parts & 2) ? 3 * I_G : 0, n2 = (parts & 4) ? (I_IN + I_O + I_LORA) : 0;
    const int total = n0 + n1 + n2;
    for (int it = gw; it < total; it += NGW) {
        int r = it;
        if (r < n0 + n1) {
            const int j = (r < n0) ? 0 : 1; r -= (j ? n0 : 0);
            const int kind = r / I_G; r -= kind * I_G;
            const size_t lw = (size_t)(l * 2 + j);
            if (kind < 2) { const float* W = p.in[kind == 0 ? 9 : 10] + lw * (size_t)D * FF;
                const int kb = r / 88, nb = r % 88, nn0 = nb * 32;
                tr_item(W, D, FF, (bf16_t*)(ws + WS_WGU) + (size_t)j * 5632 * 1024, (nn0 >> 7) * 256 + (nn0 & 127) + kind * 128, kb * 64, nn0, scr, lane);
            } else { const float* W = p.in[11] + lw * (size_t)FF * D;
                const int kb = r / 32, nb = r % 32;
                tr_item(W, FF, D, (bf16_t*)(ws + WS_WD) + (size_t)j * 1024 * 2816, nb * 32, kb * 64, nb * 32, scr, lane);
            }
            continue;
        }
        r -= n0 + n1;
        if (r < I_IN) {
            if (ab) { const int kb = r / 120, nb = r % 120; tr_item(p.in[12] + (size_t)i * D * AB_N, D, AB_N, (bf16_t*)(ws + WS_WIN), nb * 32, kb * 64, nb * 32, scr, lane); }
            else { const int kb = r / 136, nb = r % 136; tr_item(p.in[27] + (size_t)i * D * GD_NREAL, D, GD_NREAL, (bf16_t*)(ws + WS_WIN), nb * 32, kb * 64, nb * 32, scr, lane); }
            continue;
        }
        r -= I_IN;
        if (r < I_O) { const int kb = r / 32, nb = r % 32;
            tr_item(p.in[ab ? 13 : 32] + (size_t)i * D * D, D, D, (bf16_t*)(ws + WS_WOUT), nb * 32, kb * 64, nb * 32, scr, lane); continue; }
        r -= I_O;
        if (r < 16) { tr_item(p.in[16] + (size_t)i * 64 * 512, 64, 512, (bf16_t*)(ws + WS_W2T), r * 32, 0, r * 32, scr, lane); continue; }
        r -= 16;
        if (r < 16) { tr_item(p.in[18] + (size_t)i * 64 * 512, 64, 512, (bf16_t*)(ws + WS_A2T), r * 32, 0, r * 32, scr, lane); continue; }
        r -= 16;
        { const int kb = r / 16, nb = r % 16; tr_item(p.in[19] + (size_t)i * 128 * 512, 128, 512, (bf16_t*)(ws + WS_G2T), nb * 32, kb * 64, nb * 32, scr, lane); }
    }
}
__device__ __forceinline__ void convert_ffn_ahead(const Params& p, int l, int gw, int NGW, unsigned char* smem) {
    __syncthreads();
    convert_items(p, l, 2, gw, NGW, smem);
    if (l < 3) convert_items(p, l + 1, 1, gw, NGW, smem);
    __syncthreads();
}

__device__ __forceinline__ void phase_start(const Params& p, unsigned char* smem) {
    const int tid = mk_ltid(), lane = tid & 63, wave = tid >> 6;
    const int gw = mk_lbid() * 8 + wave, NGW = gridDim.x * 8;
    convert_items(p, 0, 5, gw, NGW, smem);
    bf16_t* HB = (bf16_t*)(p.ws + WS_HB);
    for (int m = gw; m < M; m += NGW) {
        const float* src = (m < MP) ? p.in[0] + (size_t)m * D : p.in[1] + (size_t)(m - MP) * D;
#pragma unroll
        for (int j = 0; j < 4; ++j) { const int c = (lane + 64 * j) * 4; const f32x4 v = *(const f32x4*)(src + c);
            u32x2 o; o.x = pk2(v[0], v[1]); o.y = pk2(v[2], v[3]); *(u32x2*)(HB + (size_t)m * D + c) = o; }
    }
}

__device__ __forceinline__ void phase_ln(const Params& p, int l, int k, bool final_out) {
    const int tid = mk_ltid(), lane = tid & 63, wave = tid >> 6;
    const int gw = mk_lbid() * 8 + wave, NGW = gridDim.x * 8;
    const bf16_t* X = (const bf16_t*)(p.ws + WS_X); bf16_t* HB = (bf16_t*)(p.ws + WS_HB);
    const float* g = p.in[7] + (size_t)(l * 3 + k) * D; const float* b = p.in[8] + (size_t)(l * 3 + k) * D;
    float* dst = p.out;
    for (int mq = gw; mq < M / 4; mq += NGW) {
        f32x4 v[4][4]; float s[4];
#pragma unroll
        for (int rr = 0; rr < 4; ++rr) { s[rr] = 0.f;
#pragma unroll
            for (int j = 0; j < 4; ++j) { const u32x2 xu = *(const u32x2*)(X + (size_t)(mq * 4 + rr) * D + (lane + 64 * j) * 4);
                v[rr][j][0] = __uint_as_float(xu.x << 16); v[rr][j][1] = __uint_as_float(xu.x & 0xffff0000u); v[rr][j][2] = __uint_as_float(xu.y << 16); v[rr][j][3] = __uint_as_float(xu.y & 0xffff0000u); s[rr] += (v[rr][j][0] + v[rr][j][1]) + (v[rr][j][2] + v[rr][j][3]); } }
#pragma unroll
        for (int o = 1; o < 64; o <<= 1) {
#pragma unroll
            for (int rr = 0; rr < 4; ++rr) s[rr] += __shfl_xor(s[rr], o); }
        float s2[4];
#pragma unroll
        for (int rr = 0; rr < 4; ++rr) { const float mean = s[rr] * (1.f / D); s2[rr] = 0.f;
#pragma unroll
            for (int j = 0; j < 4; ++j) { v[rr][j] = v[rr][j] - mean; s2[rr] += (v[rr][j][0] * v[rr][j][0] + v[rr][j][1] * v[rr][j][1]) + (v[rr][j][2] * v[rr][j][2] + v[rr][j][3] * v[rr][j][3]); } }
#pragma unroll
        for (int o = 1; o < 64; o <<= 1) {
#pragma unroll
            for (int rr = 0; rr < 4; ++rr) s2[rr] += __shfl_xor(s2[rr], o); }
#pragma unroll
        for (int j = 0; j < 4; ++j) { const int c = (lane + 64 * j) * 4; const f32x4 gg = *(const f32x4*)(g + c), bb = *(const f32x4*)(b + c);
#pragma unroll
            for (int rr = 0; rr < 4; ++rr) { const int m = mq * 4 + rr; const float rstd = rsqrtf(s2[rr] * (1.f / D) + 1e-5f);
                const f32x4 y = v[rr][j] * rstd * gg + bb;
                if (final_out) *(f32x4*)(dst + (size_t)m * D + c) = y;
                else { u32x2 o; o.x = pk2(y[0], y[1]); o.y = pk2(y[2], y[3]); *(u32x2*)(HB + (size_t)m * D + c) = o; } } }
    }
}

__device__ __forceinline__ void small_resid_gemm(const bf16_t* __restrict__ A, const bf16_t* __restrict__ Bt, int K, bf16_t* X, const bf16_t* H, float scale, unsigned char* smem) {
    const int tid = mk_ltid(), lane = tid & 63, w = __builtin_amdgcn_readfirstlane(tid >> 6);
    const int r = lane & 15, q = lane >> 4;
    float* part = (float*)smem;
    for (int t = mk_lbid(); t < 256; t += gridDim.x) {
        const int R0 = MP + (t >> 4) * 32, C0 = (t & 15) * 64;
        f32x4 acc[2][4];
#pragma unroll
        for (int a = 0; a < 2; ++a)
#pragma unroll
            for (int b = 0; b < 4; ++b) acc[a][b] = (f32x4){0.f, 0.f, 0.f, 0.f};
        const int nks = K / 32;
#pragma unroll 2
        for (int ks = w; ks < nks; ks += 8) {
            bf16x8 fa[2], fb[4];
#pragma unroll
            for (int a = 0; a < 2; ++a) fa[a] = *(const bf16x8*)(A + (size_t)(R0 + a * 16 + r) * K + ks * 32 + q * 8);
#pragma unroll
            for (int b = 0; b < 4; ++b) fb[b] = *(const bf16x8*)(Bt + (size_t)(C0 + b * 16 + r) * K + ks * 32 + q * 8);
#pragma unroll
            for (int a = 0; a < 2; ++a)
#pragma unroll
                for (int b = 0; b < 4; ++b) acc[a][b] = __builtin_amdgcn_mfma_f32_16x16x32_bf16(fa[a], fb[b], acc[a][b], 0, 0, 0);
        }
        __syncthreads();
#pragma unroll
        for (int a = 0; a < 2; ++a)
#pragma unroll
            for (int b = 0; b < 4; ++b) *(f32x4*)(part + ((w * 8 + a * 4 + b) * 64 + lane) * 4) = acc[a][b];
        __syncthreads();
        {
            const int tile = tid >> 6, a = tile >> 2, b = tile & 3;
            f32x4 sum = (f32x4){0.f, 0.f, 0.f, 0.f};
#pragma unroll
            for (int ww = 0; ww < 8; ++ww) sum += *(const f32x4*)(part + ((ww * 8 + tile) * 64 + lane) * 4);
            const int col = C0 + b * 16 + r;
#pragma unroll
            for (int j = 0; j < 4; ++j) { const size_t off = (size_t)(R0 + a * 16 + q * 4 + j) * D + col;
                X[off] = f2bf(bf2f(H[off]) * ALPHA + sum[j] * scale); }
        }
    }
}

__device__ __forceinline__ void phase_ab_prep(const Params& p, int i, unsigned char* smem) {
    const int tid = mk_ltid(), lane = tid & 63, wave = __builtin_amdgcn_readfirstlane(tid >> 6);
    const int r = lane & 15, q = lane >> 4;
    unsigned char* ws = p.ws;
    const bf16_t* ZB = (const bf16_t*)(ws + WS_ZB);
    float* OPS = (float*)(ws + WS_OPS); float* GATE = (float*)(ws + WS_GATE); float* BONUS = (float*)(ws + WS_BONUS);
    bf16_t* RQ = (bf16_t*)(ws + WS_RQ); bf16_t* RK = (bf16_t*)(ws + WS_RK);
    const bf16_t* W2T = (const bf16_t*)(ws + WS_W2T); const bf16_t* A2T = (const bf16_t*)(ws + WS_A2T); const bf16_t* G2T = (const bf16_t*)(ws + WS_G2T);
    const float* mu = p.in[14] + (size_t)i * 1792; const float* w0 = p.in[15] + i * 512; const float* a0 = p.in[17] + i * 512;
    const float* k_k = p.in[20] + i * 512; const float* k_a = p.in[21] + i * 512; const float* r_k = p.in[22] + i * 512;
    const float* shift_in = p.in[2] + (size_t)i * 128 * 1792;
    constexpr int ZS_LD = 1796, ACT_LD = 264;
    float* zs = (float*)smem;
    bf16_t* act = (bf16_t*)(smem + 16 * ZS_LD * 4);
    for (int tile = mk_lbid(); tile < M / 16; tile += gridDim.x) {
        const int R0 = tile * 16;
        unsigned pfa = 0u, pfb = 0u;
        { const int ntile = tile + gridDim.x;
          if (ntile < M / 16) { const bf16_t* nz = ZB + (size_t)ntile * 16 * AB_N;
              pfa = *(const unsigned*)(nz + (size_t)tid * 64); pfb = *(const unsigned*)(((size_t)(tid + 512) * 64 < (size_t)16 * AB_N) ? nz + (size_t)(tid + 512) * 64 : nz); } }
#ifndef REP_A_ST
#define REP_A_ST 1
#endif
#ifndef REP_A_RO
#define REP_A_RO 1
#endif
#ifndef REP_A_EP
#define REP_A_EP 1
#endif
        __syncthreads();
#pragma unroll 1
        for (int rp_ = 0; rp_ < REP_A_ST; ++rp_)
#pragma unroll 7
        for (int idx = tid; idx < 16 * 448; idx += 512) {
            const int tok = idx / 448, c4 = (idx % 448) * 4; const int row = R0 + tok;
            const int t = (row < MP) ? (row & 2047) : ((row - MP) & 3);
            const int Lm1 = (row < MP) ? 2047 : 3;
            const u32x2 cu = *(const u32x2*)(ZB + (size_t)row * AB_N + c4);
            f32x4 cur; cur[0] = __uint_as_float(cu.x << 16); cur[1] = __uint_as_float(cu.x & 0xffff0000u); cur[2] = __uint_as_float(cu.y << 16); cur[3] = __uint_as_float(cu.y & 0xffff0000u);
            f32x4 prev;
            if (t == 0) { if (row < MP) prev = (f32x4){0.f, 0.f, 0.f, 0.f}; else prev = *(const f32x4*)(shift_in + (size_t)((row - MP) >> 2) * 1792 + c4); }
            else { const u32x2 pu = *(const u32x2*)(ZB + (size_t)(row - 1) * AB_N + c4);
                prev[0] = __uint_as_float(pu.x << 16); prev[1] = __uint_as_float(pu.x & 0xffff0000u); prev[2] = __uint_as_float(pu.y << 16); prev[3] = __uint_as_float(pu.y & 0xffff0000u); }
            if (t == Lm1) {
                float* o = (row < MP) ? p.out + O_PSHIFT + (size_t)(i * 8 + (row >> 11)) * 1792 : p.out + O_SSHIFT + (size_t)(i * 128 + ((row - MP) >> 2)) * 1792;
                *(f32x4*)(o + c4) = cur;
            }
            const f32x4 m4 = *(const f32x4*)(mu + c4);
            const f32x4 z = cur + (prev - cur) * m4;
            *(f32x4*)(zs + tok * ZS_LD + c4) = z;
            if (c4 >= 1536) {
                f32x4 a;
                if (c4 < 1600) { a[0] = tanhf(z[0]); a[1] = tanhf(z[1]); a[2] = tanhf(z[2]); a[3] = tanhf(z[3]); }
                else if (c4 < 1664) a = z;
                else { a[0] = sigm(z[0]); a[1] = sigm(z[1]); a[2] = sigm(z[2]); a[3] = sigm(z[3]); }
                u32x2 o; o.x = pk2(a[0], a[1]); o.y = pk2(a[2], a[3]); *(u32x2*)(act + tok * ACT_LD + (c4 - 1536)) = o;
            }
        }
#pragma unroll 1
        for (int rp_ = 0; rp_ < REP_A_RO; ++rp_)
#pragma unroll 8
        for (int idx = tid; idx < 16 * 256; idx += 512) {
            const int tok = idx >> 8, hh = (idx >> 6) & 3, ii = idx & 63; const int row = R0 + tok;
            const float pos = (row < MP) ? (float)(row & 2047) : (float)(16384 + ((row - MP) & 3));
            const float inv_freq = exp2f(-(float)ii * (13.287712379549449f / 63.0f));
            const float ang = pos * inv_freq;
            const float n = rintf(ang * 0.15915494309189535f);
            float rr = fmaf(-n, 6.2831854820251465f, ang); rr = fmaf(-n, -1.7484555e-7f, rr);
            const float rev = rr * 0.15915494309189535f;
            const float sn = __builtin_amdgcn_sinf(rev), cs = __builtin_amdgcn_cosf(rev);
            const bf16_t* zq = ZB + (size_t)row * AB_N + 1792 + hh * 128 + ii;
            const float q1 = bf2f(zq[0]), q2 = bf2f(zq[64]), k1 = bf2f(zq[512]), k2 = bf2f(zq[576]);
            const size_t o = (size_t)row * 512 + hh * 128 + ii;
            RQ[o] = f2bf(q1 * cs - q2 * sn); RQ[o + 64] = f2bf(q2 * cs + q1 * sn);
            const float ksc = 0.08838834764831845f;
            RK[o] = f2bf((k1 * cs - k2 * sn) * ksc); RK[o + 64] = f2bf((k2 * cs + k1 * sn) * ksc);
        }
        __syncthreads();
        const int cb = wave * 64;
#pragma unroll 1
        for (int rp_ = 0; rp_ < REP_A_EP; ++rp_) {
        f32x4 aw[4], aa[4], ag[4];
#pragma unroll
        for (int nt = 0; nt < 4; ++nt) { aw[nt] = (f32x4){0.f, 0.f, 0.f, 0.f}; aa[nt] = aw[nt]; ag[nt] = aw[nt]; }
#pragma unroll
        for (int ks = 0; ks < 2; ++ks) {
            const bf16x8 bw = *(const bf16x8*)(act + r * ACT_LD + ks * 32 + q * 8);
            const bf16x8 ba = *(const bf16x8*)(act + r * ACT_LD + 64 + ks * 32 + q * 8);
#pragma unroll
            for (int nt = 0; nt < 4; ++nt) {
                const bf16x8 fw = *(const bf16x8*)(W2T + (size_t)(cb + nt * 16 + r) * 64 + ks * 32 + q * 8);
                const bf16x8 fa = *(const bf16x8*)(A2T + (size_t)(cb + nt * 16 + r) * 64 + ks * 32 + q * 8);
                aw[nt] = __builtin_amdgcn_mfma_f32_16x16x32_bf16(fw, bw, aw[nt], 0, 0, 0);
                aa[nt] = __builtin_amdgcn_mfma_f32_16x16x32_bf16(fa, ba, aa[nt], 0, 0, 0);
            }
        }
#pragma unroll
        for (int ks = 0; ks < 4; ++ks) {
            const bf16x8 bg = *(const bf16x8*)(act + r * ACT_LD + 128 + ks * 32 + q * 8);
#pragma unroll
            for (int nt = 0; nt < 4; ++nt) {
                const bf16x8 fg = *(const bf16x8*)(G2T + (size_t)(cb + nt * 16 + r) * 128 + ks * 32 + q * 8);
                ag[nt] = __builtin_amdgcn_mfma_f32_16x16x32_bf16(fg, bg, ag[nt], 0, 0, 0);
            }
        }
        const int row = R0 + r;
        float ssq = 0.f, bon = 0.f;
        f32x4 kkraw[4], av[4];
#pragma unroll
        for (int nt = 0; nt < 4; ++nt) {
            const int c = cb + nt * 16 + q * 4;
            const f32x4 rr = *(const f32x4*)(zs + r * ZS_LD + c), kx = *(const f32x4*)(zs + r * ZS_LD + 512 + c), vv = *(const f32x4*)(zs + r * ZS_LD + 1024 + c);
            const f32x4 w04 = *(const f32x4*)(w0 + c), a04 = *(const f32x4*)(a0 + c), kk4 = *(const f32x4*)(k_k + c), ka4 = *(const f32x4*)(k_a + c), rk4 = *(const f32x4*)(r_k + c);
            f32x4 dec, a, kp;
#pragma unroll
            for (int j = 0; j < 4; ++j) {
                const float wl = w04[j] + aw[nt][j];
                const float sp = fmaxf(-wl, 0.f) + __logf(1.f + __expf(-fabsf(wl)));
                const float wlog = -sp - 0.5f;
                dec[j] = __expf(-__expf(wlog));
                a[j] = sigm(a04[j] + aa[nt][j]);
                kkraw[nt][j] = kx[j] * kk4[j];
                kp[j] = kx[j] * (1.f + (a[j] - 1.f) * ka4[j]);
                ssq += kkraw[nt][j] * kkraw[nt][j];
                bon += rr[j] * kp[j] * rk4[j];
            }
            av[nt] = a;
            float* ob = OPS + ((size_t)row * 8 + wave) * 384 + nt * 16 + q * 4;
            *(f32x4*)(ob) = rr; *(f32x4*)(ob + 64) = dec; *(f32x4*)(ob + 128) = kp; *(f32x4*)(ob + 192) = vv;
            *(f32x4*)(GATE + (size_t)row * 512 + c) = ag[nt];
        }
        ssq += __shfl_xor(ssq, 16); ssq += __shfl_xor(ssq, 32);
        bon += __shfl_xor(bon, 16); bon += __shfl_xor(bon, 32);
        const float rn = rsqrtf(fmaxf(ssq, 1e-12f));
#pragma unroll
        for (int nt = 0; nt < 4; ++nt) {
            float* ob = OPS + ((size_t)row * 8 + wave) * 384 + nt * 16 + q * 4;
            const f32x4 kk = kkraw[nt] * rn;
            *(f32x4*)(ob + 256) = kk; *(f32x4*)(ob + 320) = kk * av[nt];
        }
        if (q == 0) BONUS[(size_t)row * 8 + wave] = bon;
        }
        if (pfa == 0x7fc17fc1u && pfb == 0x7fc27fc2u) zs[0] = 1.f;
    }
}

__device__ __forceinline__ void rwkv_item(const Params& p, int i, int s, int h, int rg, unsigned char* smem) {
    const int tid = mk_ltid(), lane = tid & 63, wave = __builtin_amdgcn_readfirstlane(tid >> 6);
    int row0, L; seq_info(s, row0, L);
    const float* OPS = (const float*)(p.ws + WS_OPS); float* ORAW = (float*)(p.ws + WS_ORAW);
    float* buf = (float*)smem;
    const int rih = rg * 16 + (wave & 3) * 4 + (lane >> 4);
    const int c4 = (lane & 15) * 4;
    f32x4 S = (f32x4){0.f, 0.f, 0.f, 0.f};
    if (s >= 8 && wave < 4) S = *(const f32x4*)(p.in[3] + ((((size_t)i * 128 + (s - 8)) * 8 + h) * 64 + rih) * 64 + c4);
    f32x4 pre[6];
    const int nch = (L + 31) / 32;
#pragma unroll
    for (int k = 0; k < 6; ++k) { const int idx4 = tid + k * 512; const int tt = idx4 / 96, off = idx4 % 96;
        pre[k] = (tt < L) ? *(const f32x4*)(OPS + ((size_t)(row0 + tt) * 8 + h) * 384 + off * 4) : (f32x4){0.f, 0.f, 0.f, 0.f}; }
    for (int ch = 0; ch < nch; ++ch) {
        const int t0 = ch * 32;
        __syncthreads();
#pragma unroll
        for (int k = 0; k < 6; ++k) { const int idx4 = tid + k * 512; *(f32x4*)(buf + idx4 * 4) = pre[k]; }
        __syncthreads();
        if (ch + 1 < nch) {
#pragma unroll
            for (int k = 0; k < 6; ++k) { const int idx4 = tid + k * 512; const int tt = t0 + 32 + idx4 / 96, off = idx4 % 96;
                pre[k] = (tt < L) ? *(const f32x4*)(OPS + ((size_t)(row0 + tt) * 8 + h) * 384 + off * 4) : (f32x4){0.f, 0.f, 0.f, 0.f}; }
        }
        if (wave < 4) {
            const int ns = (L - t0) < 32 ? (L - t0) : 32;
            f32x4 r4 = *(const f32x4*)(buf + c4), w4 = *(const f32x4*)(buf + 64 + c4), k4 = *(const f32x4*)(buf + 128 + c4);
            f32x4 kk4 = *(const f32x4*)(buf + 256 + c4), ka4 = *(const f32x4*)(buf + 320 + c4);
            float vv = buf[192 + rih];
            float* op = ORAW + (size_t)(row0 + t0) * 512 + h * 64 + rih;
            f32x4 rprev = r4;
#pragma unroll 2
            for (int tt = 0; tt < ns; ++tt) {
                const float* nb = buf + ((tt + 1 < 32) ? (tt + 1) : 31) * 384;
                const f32x4 r4n = *(const f32x4*)(nb + c4), w4n = *(const f32x4*)(nb + 64 + c4), k4n = *(const f32x4*)(nb + 128 + c4);
                const f32x4 kk4n = *(const f32x4*)(nb + 256 + c4), ka4n = *(const f32x4*)(nb + 320 + c4);
                const float vvn = nb[192 + rih];
                float o = (S[0] * rprev[0] + S[1] * rprev[1]) + (S[2] * rprev[2] + S[3] * rprev[3]);
                const f32x4 kv = k4 * vv;
                float sk = (S[0] * kk4[0] + S[1] * kk4[1]) + (S[2] * kk4[2] + S[3] * kk4[3]);
                sk = row16_sum(sk);
                o = row16_sum(o);
                const f32x4 t1 = kv - ka4 * sk;
                S = S * w4 + t1;
                if ((lane & 15) == 0 && tt > 0) op[(size_t)(tt - 1) * 512] = o;
                rprev = r4;
                r4 = r4n; w4 = w4n; k4 = k4n; kk4 = kk4n; ka4 = ka4n; vv = vvn;
            }
            {
                float o = (S[0] * rprev[0] + S[1] * rprev[1]) + (S[2] * rprev[2] + S[3] * rprev[3]);
                o = row16_sum(o);
                if ((lane & 15) == 0) op[(size_t)(ns - 1) * 512] = o;
            }
        }
    }
    if (wave < 4) {
        float* so = (s < 8) ? p.out + O_PRWKV + ((((size_t)i * 8 + s) * 8 + h) * 64 + rih) * 64 + c4
                            : p.out + O_SRWKV + ((((size_t)i * 128 + (s - 8)) * 8 + h) * 64 + rih) * 64 + c4;
        *(f32x4*)so = S;
    }
}

__device__ __forceinline__ void rwkv_item2(const Params& p, int i, int s, int h, int rg, unsigned char* smem) {
    const int tid = mk_ltid(), lane = tid & 63, wave = __builtin_amdgcn_readfirstlane(tid >> 6);
    int row0, L; seq_info(s, row0, L);
    const float* OPS = (const float*)(p.ws + WS_OPS); float* ORAW = (float*)(p.ws + WS_ORAW);
    float* buf = (float*)smem;
    const int ra = rg * 32 + (wave & 3) * 4 + (lane >> 4), rb = ra + 16;
    const int c4 = (lane & 15) * 4;
    f32x4 Sa = (f32x4){0.f, 0.f, 0.f, 0.f}, Sb = Sa;
    if (s >= 8 && wave < 4) { const float* sp = p.in[3] + (((size_t)i * 128 + (s - 8)) * 8 + h) * 4096;
        Sa = *(const f32x4*)(sp + ra * 64 + c4); Sb = *(const f32x4*)(sp + rb * 64 + c4); }
    f32x4 pre[12];
    const int nch = (L + 63) / 64;
#pragma unroll
    for (int k = 0; k < 12; ++k) { const int idx4 = tid + k * 512; const int tt = idx4 / 96, off = idx4 % 96;
        pre[k] = (tt < L) ? *(const f32x4*)(OPS + ((size_t)(row0 + tt) * 8 + h) * 384 + off * 4) : (f32x4){0.f, 0.f, 0.f, 0.f}; }
    for (int ch = 0; ch < nch; ++ch) {
        const int t0 = ch * 64;
        __syncthreads();
#pragma unroll
        for (int k = 0; k < 12; ++k) { const int idx4 = tid + k * 512; *(f32x4*)(buf + idx4 * 4) = pre[k]; }
        __syncthreads();
        if (ch + 1 < nch) {
#pragma unroll
            for (int k = 0; k < 12; ++k) { const int idx4 = tid + k * 512; const int tt = t0 + 64 + idx4 / 96, off = idx4 % 96;
                pre[k] = (tt < L) ? *(const f32x4*)(OPS + ((size_t)(row0 + tt) * 8 + h) * 384 + off * 4) : (f32x4){0.f, 0.f, 0.f, 0.f}; }
        }
        if (wave < 4) {
            const int ns = (L - t0) < 64 ? (L - t0) : 64;
            f32x4 rA = *(const f32x4*)(buf + c4), wA = *(const f32x4*)(buf + 64 + c4), kA = *(const f32x4*)(buf + 128 + c4);
            f32x4 kkA = *(const f32x4*)(buf + 256 + c4), kaA = *(const f32x4*)(buf + 320 + c4);
            float vaA = buf[192 + ra], vbA = buf[192 + rb];
            f32x4 rB, wB, kB, kkB, kaB; float vaB, vbB;
            float* op = ORAW + (size_t)(row0 + t0) * 512 + h * 64 + ra;
            f32x4 rprev = rA;
#define RW_LOAD(R, W, K, KK, KA, VA, VB, nb_) do { const float* nb = (nb_); R = *(const f32x4*)(nb + c4); W = *(const f32x4*)(nb + 64 + c4); K = *(const f32x4*)(nb + 128 + c4); \
                KK = *(const f32x4*)(nb + 256 + c4); KA = *(const f32x4*)(nb + 320 + c4); VA = nb[192 + ra]; VB = nb[192 + rb]; } while (0)
#define RW_STEP(R, W, K, KK, KA, VA, VB, RP, tt_) do { \
                float oa = (Sa[0] * RP[0] + Sa[1] * RP[1]) + (Sa[2] * RP[2] + Sa[3] * RP[3]); \
                float ob = (Sb[0] * RP[0] + Sb[1] * RP[1]) + (Sb[2] * RP[2] + Sb[3] * RP[3]); \
                float ska = (Sa[0] * KK[0] + Sa[1] * KK[1]) + (Sa[2] * KK[2] + Sa[3] * KK[3]); \
                float skb = (Sb[0] * KK[0] + Sb[1] * KK[1]) + (Sb[2] * KK[2] + Sb[3] * KK[3]); \
                ska = row16_sum(ska); skb = row16_sum(skb); oa = row16_sum(oa); ob = row16_sum(ob); \
                Sa = Sa * W + (K * VA - KA * ska); Sb = Sb * W + (K * VB - KA * skb); \
                if ((lane & 15) == 0 && (tt_) > 0) { op[(size_t)((tt_) - 1) * 512] = oa; op[(size_t)((tt_) - 1) * 512 + 16] = ob; } } while (0)
            for (int tt = 0; tt < ns; tt += 2) {
                RW_LOAD(rB, wB, kB, kkB, kaB, vaB, vbB, buf + (tt + 1) * 384);
                RW_STEP(rA, wA, kA, kkA, kaA, vaA, vbA, rprev, tt);
                const f32x4 rEven = rA;
                RW_LOAD(rA, wA, kA, kkA, kaA, vaA, vbA, buf + ((tt + 2 < 64) ? (tt + 2) : 63) * 384);
                RW_STEP(rB, wB, kB, kkB, kaB, vaB, vbB, rEven, tt + 1);
                rprev = rB;
            }
            {
                float oa = (Sa[0] * rprev[0] + Sa[1] * rprev[1]) + (Sa[2] * rprev[2] + Sa[3] * rprev[3]);
                float ob = (Sb[0] * rprev[0] + Sb[1] * rprev[1]) + (Sb[2] * rprev[2] + Sb[3] * rprev[3]);
                oa = row16_sum(oa); ob = row16_sum(ob);
                if ((lane & 15) == 0) { op[(size_t)(ns - 1) * 512] = oa; op[(size_t)(ns - 1) * 512 + 16] = ob; }
            }
#undef RW_LOAD
#undef RW_STEP
        }
    }
    if (wave < 4) {
        float* so = (s < 8) ? p.out + O_PRWKV + (((size_t)i * 8 + s) * 8 + h) * 4096 : p.out + O_SRWKV + (((size_t)i * 128 + (s - 8)) * 8 + h) * 4096;
        *(f32x4*)(so + ra * 64 + c4) = Sa; *(f32x4*)(so + rb * 64 + c4) = Sb;
    }
}

__device__ __forceinline__ void ret_item(const Params& p, int i, int s, int hb, unsigned char* smem) {
    const int tid = mk_ltid(), lane = tid & 63, w = __builtin_amdgcn_readfirstlane(tid >> 6);
    const int r = lane & 15, q = lane >> 4;
    int row0, L; seq_info(s, row0, L);
    const int C = (s < 8) ? 128 : 4; const int nch = L / C;
    const float lg = log2f(1.0f - exp2f(-5.0f - (float)hb));
    const bf16_t* ZB = (const bf16_t*)(p.ws + WS_ZB); const bf16_t* RQ = (const bf16_t*)(p.ws + WS_RQ); const bf16_t* RK = (const bf16_t*)(p.ws + WS_RK);
    bf16_t* OMIX = (bf16_t*)(p.ws + WS_OMIX);
    const float* gn_g = p.in[25] + i * 512 + hb * 128; const float* gn_b = p.in[26] + i * 512 + hb * 128;
    constexpr int LD = 136;
    bf16_t* KC = (bf16_t*)smem; bf16_t* KZT = KC + 128 * LD; bf16_t* VT = KZT + 128 * LD; bf16_t* SB = VT + 128 * LD;
    f32x4 ST[8];
#pragma unroll
    for (int nt = 0; nt < 8; ++nt) ST[nt] = (f32x4){0.f, 0.f, 0.f, 0.f};
    if (s >= 8) {
        const float* S0 = p.in[4] + (((size_t)i * 128 + (s - 8)) * 4 + hb) * 16384;
#pragma unroll
        for (int nt = 0; nt < 8; ++nt) ST[nt] = *(const f32x4*)(S0 + (size_t)(nt * 16 + r) * 128 + 16 * w + q * 4);
    }
    const float gch = exp2f((float)C * lg);
    for (int ch = 0; ch < nch; ++ch) {
        const int rb = row0 + ch * C;
        __syncthreads();
        for (int idx = tid; idx < 128 * 16; idx += 512) {
            const int tok = idx & 127, c8 = (idx >> 7) * 8;
            u32x4 kv = (u32x4){0u, 0u, 0u, 0u}, vv = kv;
            if (tok < C) { kv = *(const u32x4*)(RK + (size_t)(rb + tok) * 512 + hb * 128 + c8);
                           vv = *(const u32x4*)(ZB + (size_t)(rb + tok) * AB_N + 1792 + 1024 + hb * 128 + c8); }
            *(u32x4*)(KC + tok * LD + c8) = kv;
            const float zeta = __builtin_amdgcn_exp2f((float)(C - 1 - tok) * lg);
            const unsigned kw[4] = {kv.x, kv.y, kv.z, kv.w}; const unsigned vw[4] = {vv.x, vv.y, vv.z, vv.w};
#pragma unroll
            for (int e = 0; e < 4; ++e) {
                const float k0 = __uint_as_float(kw[e] << 16) * zeta, k1 = __uint_as_float(kw[e] & 0xffff0000u) * zeta;
                KZT[(c8 + 2 * e) * LD + tok] = f2bf(k0); KZT[(c8 + 2 * e + 1) * LD + tok] = f2bf(k1);
                VT[(c8 + 2 * e) * LD + tok] = (bf16_t)(vw[e] & 0xffffu); VT[(c8 + 2 * e + 1) * LD + tok] = (bf16_t)(vw[e] >> 16);
            }
        }
#pragma unroll
        for (int nt = 0; nt < 8; ++nt)
#pragma unroll
            for (int j = 0; j < 4; ++j) SB[(16 * w + q * 4 + j) * LD + nt * 16 + r] = f2bf(ST[nt][j]);
        __syncthreads();
        bf16x8 aq[4];
#pragma unroll
        for (int ks = 0; ks < 4; ++ks) {
            if (16 * w + r < C) aq[ks] = *(const bf16x8*)(RQ + (size_t)(rb + 16 * w + r) * 512 + hb * 128 + ks * 32 + q * 8);
            else aq[ks] = (bf16x8){0, 0, 0, 0, 0, 0, 0, 0};
        }
        u32x2 P[8]; f32x4 O[8];
#pragma unroll
        for (int nt = 0; nt < 8; ++nt) {
            f32x4 acc = (f32x4){0.f, 0.f, 0.f, 0.f}, oc = acc;
#pragma unroll
            for (int ks = 0; ks < 4; ++ks) {
                const bf16x8 bk = *(const bf16x8*)(KC + (nt * 16 + r) * LD + ks * 32 + q * 8);
                const bf16x8 bs = *(const bf16x8*)(SB + (nt * 16 + r) * LD + ks * 32 + q * 8);
                acc = __builtin_amdgcn_mfma_f32_16x16x32_bf16(aq[ks], bk, acc, 0, 0, 0);
                oc = __builtin_amdgcn_mfma_f32_16x16x32_bf16(aq[ks], bs, oc, 0, 0, 0);
            }
#pragma unroll
            for (int j = 0; j < 4; ++j) {
                const int ii = 16 * w + q * 4 + j, jt = nt * 16 + r;
                acc[j] = (ii >= jt) ? acc[j] * __builtin_amdgcn_exp2f((float)(ii - jt) * lg) : 0.f;
                oc[j] *= __builtin_amdgcn_exp2f((float)(ii + 1) * lg);
            }
            P[nt].x = pk2(acc[0], acc[1]); P[nt].y = pk2(acc[2], acc[3]); O[nt] = oc;
        }
        __syncthreads();
#pragma unroll
        for (int nt = 0; nt < 8; ++nt)
#pragma unroll
            for (int j = 0; j < 4; ++j) KC[(16 * w + q * 4 + j) * LD + nt * 16 + r] = (bf16_t)(((j & 2) ? P[nt].y : P[nt].x) >> ((j & 1) * 16));
        __syncthreads();
#pragma unroll
        for (int nt = 0; nt < 8; ++nt) ST[nt] = ST[nt] * gch;
#pragma unroll
        for (int ks = 0; ks < 4; ++ks) {
            const bf16x8 ap = *(const bf16x8*)(KC + (16 * w + r) * LD + ks * 32 + q * 8);
            const bf16x8 av = *(const bf16x8*)(VT + (16 * w + r) * LD + ks * 32 + q * 8);
#pragma unroll
            for (int nt = 0; nt < 8; ++nt) {
                const bf16x8 bv = *(const bf16x8*)(VT + (nt * 16 + r) * LD + ks * 32 + q * 8);
                const bf16x8 bz = *(const bf16x8*)(KZT + (nt * 16 + r) * LD + ks * 32 + q * 8);
                O[nt] = __builtin_amdgcn_mfma_f32_16x16x32_bf16(ap, bv, O[nt], 0, 0, 0);
                ST[nt] = __builtin_amdgcn_mfma_f32_16x16x32_bf16(av, bz, ST[nt], 0, 0, 0);
            }
        }
#pragma unroll
        for (int j = 0; j < 4; ++j) {
            float s1 = 0.f;
#pragma unroll
            for (int nt = 0; nt < 8; ++nt) s1 += O[nt][j];
            s1 = row16_sum(s1); const float mean = s1 * (1.f / 128.f);
            float s2 = 0.f;
#pragma unroll
            for (int nt = 0; nt < 8; ++nt) { const float d = O[nt][j] - mean; s2 += d * d; }
            s2 = row16_sum(s2); const float rstd = rsqrtf(s2 * (1.f / 128.f) + 1e-5f);
            const int ii = 16 * w + q * 4 + j;
            if (ii < C) {
                const size_t row = (size_t)(rb + ii);
#pragma unroll
                for (int nt = 0; nt < 8; ++nt) { const int dv = nt * 16 + r;
                    const float val = (O[nt][j] - mean) * rstd * gn_g[dv] + gn_b[dv];
                    const float gr = bf2f(ZB[row * AB_N + 1792 + 1536 + hb * 128 + dv]);
                    OMIX[row * 1024 + 512 + hb * 128 + dv] = f2bf(val * silu(gr)); }
            }
        }
    }
    float* so = (s < 8) ? p.out + O_PRET + (((size_t)i * 8 + s) * 4 + hb) * 16384 : p.out + O_SRET + (((size_t)i * 128 + (s - 8)) * 4 + hb) * 16384;
#pragma unroll
    for (int nt = 0; nt < 8; ++nt) *(f32x4*)(so + (size_t)(nt * 16 + r) * 128 + 16 * w + q * 4) = ST[nt];
}

__device__ __forceinline__ void phase_ab_core(const Params& p, int i, int l, unsigned char* smem) {
    const int bid = mk_lbid(), G = gridDim.x; const int wv = mk_ltid() >> 6;
    if (G == 256) {
        if (bid < 128) rwkv_item2(p, i, bid >> 4, (bid >> 1) & 7, bid & 1, smem);
        else if (bid < 160) ret_item(p, i, (bid - 128) >> 2, (bid - 128) & 3, smem);
        else {
            for (int it = bid - 160; it < 128 * 16; it += 96) rwkv_item2(p, i, 8 + (it >> 4), (it >> 1) & 7, it & 1, smem);
            __syncthreads();
            for (int it = bid - 160; it < 128 * 4; it += 96) ret_item(p, i, 8 + (it >> 2), it & 3, smem);
        }
        if (bid >= 160) convert_ffn_ahead(p, l, (bid - 160) * 8 + wv, 96 * 8, smem);
    } else {
        for (int it = bid; it < 136 * 16; it += G) rwkv_item2(p, i, it >> 4, (it >> 1) & 7, it & 1, smem);
        __syncthreads();
        for (int it = bid; it < 136 * 4; it += G) ret_item(p, i, it >> 2, it & 3, smem);
        convert_ffn_ahead(p, l, bid * 8 + wv, G * 8, smem);
    }
}

__device__ __forceinline__ void phase_ab_post(const Params& p, int i) {
    const int tid = mk_ltid(), lane = tid & 63, wave = tid >> 6;
    const int gw = mk_lbid() * 8 + wave, NGW = gridDim.x * 8;
    const float* OPS = (const float*)(p.ws + WS_OPS); const float* ORAW = (const float*)(p.ws + WS_ORAW);
    const float* GATE = (const float*)(p.ws + WS_GATE); const float* BONUS = (const float*)(p.ws + WS_BONUS);
    bf16_t* OMIX = (bf16_t*)(p.ws + WS_OMIX);
    const float* gg = p.in[23] + i * 512; const float* gb = p.in[24] + i * 512;
    for (int m = gw; m < M; m += NGW) {
        const int c = lane * 8, h = lane >> 3, hc = c & 63;
        const f32x4 o0 = *(const f32x4*)(ORAW + (size_t)m * 512 + c), o1 = *(const f32x4*)(ORAW + (size_t)m * 512 + c + 4);
        float s1 = (o0[0] + o0[1]) + (o0[2] + o0[3]) + (o1[0] + o1[1]) + (o1[2] + o1[3]);
        s1 += __shfl_xor(s1, 1); s1 += __shfl_xor(s1, 2); s1 += __shfl_xor(s1, 4);
        const float mean = s1 * (1.f / 64.f);
        const f32x4 d0 = o0 - mean, d1 = o1 - mean;
        float s2 = (d0[0] * d0[0] + d0[1] * d0[1]) + (d0[2] * d0[2] + d0[3] * d0[3]) + (d1[0] * d1[0] + d1[1] * d1[1]) + (d1[2] * d1[2] + d1[3] * d1[3]);
        s2 += __shfl_xor(s2, 1); s2 += __shfl_xor(s2, 2); s2 += __shfl_xor(s2, 4);
        const float rstd = rsqrtf(s2 * (1.f / 64.f) + 64e-5f);
        const float bon = BONUS[(size_t)m * 8 + h];
        const float* vb = OPS + ((size_t)m * 8 + h) * 384 + 192 + hc;
        const f32x4 v0 = *(const f32x4*)vb, v1 = *(const f32x4*)(vb + 4);
        const f32x4 g0 = *(const f32x4*)(gg + c), g1 = *(const f32x4*)(gg + c + 4), b0 = *(const f32x4*)(gb + c), b1 = *(const f32x4*)(gb + c + 4);
        const f32x4 t0 = *(const f32x4*)(GATE + (size_t)m * 512 + c), t1 = *(const f32x4*)(GATE + (size_t)m * 512 + c + 4);
        const f32x4 y0 = (d0 * rstd * g0 + b0 + v0 * bon) * t0, y1 = (d1 * rstd * g1 + b1 + v1 * bon) * t1;
        u32x4 o; o.x = pk2(y0[0], y0[1]); o.y = pk2(y0[2], y0[3]); o.z = pk2(y1[0], y1[1]); o.w = pk2(y1[2], y1[3]);
        *(u32x4*)(OMIX + (size_t)m * 1024 + c) = o;
    }
}

__device__ __forceinline__ int gdn_item_index(int s, int h, int c) { return (s < 8) ? ((s * 8 + h) * 32 + c) : (2048 + (s - 8) * 8 + h); }

__device__ __forceinline__ void gdn_chunk_item(const Params& p, int i, int s, int h, int c, int pf_row, int pf_h, unsigned char* smem) {
    const int tid = mk_ltid(), lane = tid & 63, w = __builtin_amdgcn_readfirstlane(tid >> 6);
    const int r = lane & 15, q = lane >> 4;
    int row0, L; seq_info(s, row0, L);
    const int t0 = c * 64; const int nvalid = (L - t0) < 64 ? (L - t0) : 64;
    const bf16_t* ZB = (const bf16_t*)(p.ws + WS_ZB);
    unsigned char* rec = p.ws + WS_CH + (size_t)gdn_item_index(s, h, c) * CH_BYTES;
    float* U = (float*)(rec + CH_U); bf16_t* Wd = (bf16_t*)(rec + CH_W); bf16_t* QG = (bf16_t*)(rec + CH_QG); bf16_t* QK = (bf16_t*)(rec + CH_QK); bf16_t* KDT = (bf16_t*)(rec + CH_KDT);
    constexpr int LD = 132, ALD = 68;
    float* qs = (float*)smem; float* ks = qs + 64 * LD; float* vs = ks + 64 * LD; float* As = vs + 64 * LD;
    float* AT = As + 64 * ALD; float* gcs = AT + 64 * ALD; float* bes = gcs + 64;
    unsigned short pfv = 0;
    if (pf_row >= 0 && tid < 384) { const int rr_ = tid / 6, pp_ = (tid % 6) >> 1, hh_ = tid & 1;
        pfv = ((const bf16_t*)(p.ws + WS_ZB))[(size_t)(pf_row + rr_) * GD_N + pp_ * 1024 + pf_h * 128 + hh_ * 64]; }
#ifndef REP_G_CONV
#define REP_G_CONV 1
#endif
#ifndef REP_G_MFMA
#define REP_G_MFMA 1
#endif
#ifndef REP_G_QG
#define REP_G_QG 1
#endif
#ifndef REP_G_SUB
#define REP_G_SUB 1
#endif
#pragma unroll 1
    for (int rp_ = 0; rp_ < REP_G_CONV; ++rp_) {
    __syncthreads();
    if (tid < 384) {
        const int part = tid >> 7, ch = tid & 127; const int zc = part * 1024 + h * 128 + ch;
        const float* cw = p.in[28] + (size_t)i * 4 * 3072 + zc;
        const float cw0 = cw[0], cw1 = cw[3072], cw2 = cw[2 * 3072], cw3 = cw[3 * 3072];
        float* dst = (part == 0 ? qs : part == 1 ? ks : vs) + ch;
        if (nvalid == 64) {
            float xh[3], xn[64];
#pragma unroll
            for (int j = 0; j < 3; ++j) { const int t = t0 - 3 + j;
                xh[j] = (t >= 0) ? bf2f(ZB[(size_t)(row0 + (t >= 0 ? t : 0)) * GD_N + zc]) : 0.f; }
#pragma unroll
            for (int e = 0; e < 64; ++e) xn[e] = bf2f(ZB[(size_t)(row0 + t0 + e) * GD_N + zc]);
            float x3 = xh[0], x2 = xh[1], x1 = xh[2];
#pragma unroll
            for (int e = 0; e < 64; ++e) {
                const float y = cw0 * x3 + cw1 * x2 + cw2 * x1 + cw3 * xn[e];
                dst[e * LD] = silu(y);
                x3 = x2; x2 = x1; x1 = xn[e];
            }
        } else {
            float x3, x2, x1;
            { const float* cs = p.in[5] + (((size_t)i * 128 + (s - 8)) * 3) * 3072 + zc; x3 = cs[0]; x2 = cs[3072]; x1 = cs[2 * 3072]; }
#pragma unroll
            for (int e = 0; e < 64; ++e) {
                float v = 0.f;
                if (e < 4) { const float xe = (e < nvalid) ? bf2f(ZB[(size_t)(row0 + e) * GD_N + zc]) : 0.f;
                    const float y = cw0 * x3 + cw1 * x2 + cw2 * x1 + cw3 * xe; v = (e < nvalid) ? silu(y) : 0.f; x3 = x2; x2 = x1; x1 = xe; }
                dst[e * LD] = v;
            }
        }
    } else if (tid < 448) {
        const int t = tid - 384;
        float be = 0.f, g = 0.f;
        if (t < nvalid) { const size_t zr = (size_t)(row0 + t0 + t) * GD_N;
            be = sigm(bf2f(ZB[zr + 3072 + h]));
            const float a = bf2f(ZB[zr + 3080 + h]) + p.in[30][i * 8 + h];
            const float sp = fmaxf(a, 0.f) + __logf(1.f + __expf(-fabsf(a)));
            g = -__expf(p.in[29][i * 8 + h]) * sp; }
#pragma unroll
        for (int o = 1; o < 64; o <<= 1) { const float y = __shfl_up(g, o); if (t >= o) g += y; }
        gcs[t] = g; bes[t] = be;
    }
    }
    __syncthreads();
    for (int pass = 0; pass < 4; ++pass) {
        const int rowi = w * 16 + pass * 4 + q;
        const int t = rowi & 63;
        if ((w * 16 + pass * 4) % 64 < nvalid) {
            float* base = ((rowi < 64) ? qs : ks) + t * LD + r * 8;
            f32x4 a = *(f32x4*)base, b = *(f32x4*)(base + 4);
            float ss = (a[0] * a[0] + a[1] * a[1]) + (a[2] * a[2] + a[3] * a[3]) + (b[0] * b[0] + b[1] * b[1]) + (b[2] * b[2] + b[3] * b[3]);
            ss = row16_sum(ss);
            const float rn = rsqrtf(fmaxf(ss, 1e-12f));
            *(f32x4*)base = a * rn; *(f32x4*)(base + 4) = b * rn;
        }
    }
    __syncthreads();
#pragma unroll 1
    for (int rp_ = 0; rp_ < REP_G_MFMA; ++rp_)
#pragma unroll
    for (int tl = 0; tl < 2; ++tl) {
        const int tile = 2 * w + tl, mi = tile >> 2, ni = tile & 3;
        f32x4 akk = (f32x4){0.f, 0.f, 0.f, 0.f}, aqk = akk;
        if (mi * 16 < nvalid) {
#pragma unroll 8
            for (int k0 = 0; k0 < 128; k0 += 4) {
                const float ka = ks[(mi * 16 + r) * LD + k0 + q], kb = ks[(ni * 16 + r) * LD + k0 + q], qa = qs[(mi * 16 + r) * LD + k0 + q];
                akk = __builtin_amdgcn_mfma_f32_16x16x4f32(ka, kb, akk, 0, 0, 0);
                aqk = __builtin_amdgcn_mfma_f32_16x16x4f32(qa, kb, aqk, 0, 0, 0);
            }
        }
#pragma unroll
        for (int j = 0; j < 4; ++j) { const int ii = mi * 16 + q * 4 + j, jj = ni * 16 + r;
            const float dm = (ii >= jj) ? __expf(gcs[ii] - gcs[jj]) : 0.f;
            const float aij = (ii > jj) ? bes[ii] * akk[j] * dm : 0.f;
            As[ii * ALD + jj] = aij; AT[jj * ALD + ii] = aij;
            if (mi * 16 < nvalid) QK[ii * 64 + jj] = f2bf(aqk[j] * 0.08838834764831845f * dm); }
    }
    __syncthreads();
#pragma unroll 1
    for (int rp_ = 0; rp_ < REP_G_QG; ++rp_)
    {
        const float gl = gcs[63];
        const int nrow = (nvalid == 64) ? 64 : 16;
        for (int idx = tid; idx < nrow * 128; idx += 512) { const int t = idx >> 7, d = idx & 127;
            QG[idx] = f2bf(qs[t * LD + d] * 0.08838834764831845f * __expf(gcs[t])); }
        if (nvalid == 64) {
            for (int idx = tid; idx < 64 * 128; idx += 512) { const int d = idx >> 6, t = idx & 63;
                KDT[idx] = f2bf(ks[t * LD + d] * __expf(gl - gcs[t])); }
        } else {
            for (int idx = tid; idx < 16 * 128; idx += 512) { const int d = idx >> 4, t = idx & 15;
                KDT[d * 64 + t] = f2bf(ks[t * LD + d] * __expf(gl - gcs[t])); }
        }
        if (tid == 0) ((float*)(p.ws + WS_GL))[gdn_item_index(s, h, c)] = __expf(gl);
    }
    __syncthreads();
    for (int idx = tid; idx < 64 * 128; idx += 512) { const int t = idx >> 7, d = idx & 127; const float be = bes[t];
        vs[t * LD + d] *= be; ks[t * LD + d] *= be * __expf(gcs[t]); }
    __syncthreads();
    const int nblk = (nvalid + 15) >> 4;
#pragma unroll 1
    for (int blk = 0; blk < 4; ++blk) {
        if (blk >= nblk) continue;
        if (blk > 0) {
#pragma unroll
            for (int tl = 0; tl < 2; ++tl) {
                const int nt = 2 * w + tl; float* bb = (nt < 8 ? vs : ks) + (nt & 7) * 16 + r;
                f32x4 acc = (f32x4){0.f, 0.f, 0.f, 0.f};
                const float* ap = As + (blk * 16 + r) * ALD + q;
                for (int k0 = 0; k0 < blk * 16; k0 += 4)
                    acc = __builtin_amdgcn_mfma_f32_16x16x4f32(ap[k0], bb[(k0 + q) * LD], acc, 0, 0, 0);
#pragma unroll
                for (int j = 0; j < 4; ++j) bb[(blk * 16 + q * 4 + j) * LD] -= acc[j];
            }
            __syncthreads();
        }
        if (tid < 256) {
            const int col = tid & 127; const bool isu = tid < 128;
            float* buf = (isu ? vs : ks) + col;
            float acc[16];
#pragma unroll
            for (int e = 0; e < 16; ++e) acc[e] = buf[(blk * 16 + e) * LD];
#pragma unroll
            for (int e = 1; e < 16; ++e) {
#pragma unroll
                for (int f = 0; f < e; ++f) acc[e] -= As[(blk * 16 + e) * ALD + blk * 16 + f] * acc[f];
            }
#pragma unroll
            for (int e = 0; e < 16; ++e) { const int ii = blk * 16 + e; buf[ii * LD] = acc[e];
                if (isu) U[ii * 128 + col] = acc[e]; else Wd[ii * 128 + col] = f2bf(acc[e]); }
        }
        __syncthreads();
    }
    if (pfv == 0x7fc3u) gcs[0] = 1.f;
}

__device__ __forceinline__ void phase_gdn_chunk(const Params& p, int i, unsigned char* smem) {
    for (int it = mk_lbid(); it < N_CH; it += gridDim.x) {
        int s, h, c;
        if (it < 2048) { s = it >> 8; h = (it >> 5) & 7; c = it & 31; } else { const int k = it - 2048; s = 8 + (k >> 3); h = k & 7; c = 0; }
        const int nit = it + gridDim.x; int pf_row = -1, pf_h = 0;
        if (nit < 2048) { pf_row = (nit >> 8) * 2048 + (nit & 31) * 64; pf_h = (nit >> 5) & 7; }
        gdn_chunk_item(p, i, s, h, c, pf_row, pf_h, smem);
    }
    const bf16_t* ZB = (const bf16_t*)(p.ws + WS_ZB);
    const int gt = mk_lbid() * 512 + mk_ltid(), GT = gridDim.x * 512;
    for (int idx = gt; idx < 136 * 3 * 3072; idx += GT) {
        const int s = idx / (3 * 3072), rem = idx % (3 * 3072), j = rem / 3072, zc = rem % 3072;
        int row0, L; seq_info(s, row0, L);
        const float v = bf2f(ZB[(size_t)(row0 + L - 3 + j) * GD_N + zc]);
        if (s < 8) p.out[O_PCONV + (((size_t)i * 8 + s) * 3 + j) * 3072 + zc] = v;
        else p.out[O_SCONV + (((size_t)i * 128 + (s - 8)) * 3 + j) * 3072 + zc] = v;
    }
}

__device__ __forceinline__ void gdn_scan_item(const Params& p, int i, int s, int h, unsigned char* smem) {
    const int tid = mk_ltid(), lane = tid & 63, w = __builtin_amdgcn_readfirstlane(tid >> 6);
    const int r = lane & 15, q = lane >> 4;
    int row0, L; seq_info(s, row0, L);
    const int nch = (s < 8) ? 32 : 1;
    const bf16_t* ZB = (const bf16_t*)(p.ws + WS_ZB); bf16_t* OMIX = (bf16_t*)(p.ws + WS_OMIX);
    const float* GL = (const float*)(p.ws + WS_GL);
    const float* ng = p.in[31] + i * 128;
    constexpr int LD = 136, VLD = 72, ULD = 132;
    bf16_t* SB = (bf16_t*)smem;
    bf16_t* VN = (bf16_t*)(smem + 34816);
    float* red = (float*)(smem + 53248);
    bf16_t* WL = (bf16_t*)(smem + 53760);
    bf16_t* QGL = (bf16_t*)(smem + 71168);
    bf16_t* QKL = (bf16_t*)(smem + 88576);
    bf16_t* KDL = (bf16_t*)(smem + 97792);
    float* UL = (float*)(smem + 116224);
    f32x4 ST[8];
#pragma unroll
    for (int nt = 0; nt < 8; ++nt) ST[nt] = (f32x4){0.f, 0.f, 0.f, 0.f};
    if (s >= 8) {
        const float* S0 = p.in[6] + (((size_t)i * 128 + (s - 8)) * 8 + h) * 16384;
#pragma unroll
        for (int nt = 0; nt < 8; ++nt) ST[nt] = *(const f32x4*)(S0 + (size_t)(nt * 16 + r) * 128 + 16 * w + q * 4);
    }
    const int mt = w & 3, nh = w >> 2;
    u32x4 pw[2], pq[2], pk, pd[2]; f32x4 pu[4]; float pgl;
    const bool smp = (s >= 8);
#define GDN_PREFETCH(cc) do { const int item_ = gdn_item_index(s, h, (cc)); const unsigned char* rec_ = p.ws + WS_CH + (size_t)item_ * CH_BYTES; \
        const u32x4 z4_ = (u32x4){0u, 0u, 0u, 0u}; \
        _Pragma("unroll") for (int k_ = 0; k_ < 2; ++k_) { const int idx_ = tid + k_ * 512; \
            pw[k_] = (smp && (idx_ >> 4) >= 16) ? z4_ : *(const u32x4*)((const bf16_t*)(rec_ + CH_W) + (idx_ >> 4) * 128 + (idx_ & 15) * 8); \
            pq[k_] = (smp && (idx_ >> 4) >= 16) ? z4_ : *(const u32x4*)((const bf16_t*)(rec_ + CH_QG) + (idx_ >> 4) * 128 + (idx_ & 15) * 8); \
            pd[k_] = (smp && (idx_ & 7) >= 2) ? z4_ : *(const u32x4*)((const bf16_t*)(rec_ + CH_KDT) + (idx_ >> 3) * 64 + (idx_ & 7) * 8); } \
        pk = (smp && (tid >> 3) >= 16) ? z4_ : *(const u32x4*)((const bf16_t*)(rec_ + CH_QK) + (tid >> 3) * 64 + (tid & 7) * 8); \
        _Pragma("unroll") for (int k_ = 0; k_ < 4; ++k_) { const int idx_ = tid + k_ * 512; \
            pu[k_] = (smp && (idx_ >> 5) >= 16) ? (f32x4){0.f, 0.f, 0.f, 0.f} : *(const f32x4*)((const float*)(rec_ + CH_U) + (idx_ >> 5) * 128 + (idx_ & 31) * 4); } \
        pgl = GL[item_]; } while (0)
    GDN_PREFETCH(0);
    for (int c = 0; c < nch; ++c) {
        const float glast = pgl;
        const int rb = row0 + c * 64; const int nvalid = (L - c * 64) < 64 ? (L - c * 64) : 64;
#pragma unroll
        for (int k = 0; k < 2; ++k) { const int idx = tid + k * 512;
            *(u32x4*)(WL + (idx >> 4) * LD + (idx & 15) * 8) = pw[k]; *(u32x4*)(QGL + (idx >> 4) * LD + (idx & 15) * 8) = pq[k];
            *(u32x4*)(KDL + (idx >> 3) * VLD + (idx & 7) * 8) = pd[k]; }
        *(u32x4*)(QKL + (tid >> 3) * VLD + (tid & 7) * 8) = pk;
#pragma unroll
        for (int k = 0; k < 4; ++k) { const int idx = tid + k * 512; *(f32x4*)(UL + (idx >> 5) * ULD + (idx & 31) * 4) = pu[k]; }
#pragma unroll
        for (int nt = 0; nt < 8; ++nt)
#pragma unroll
            for (int j = 0; j < 4; ++j) SB[(16 * w + q * 4 + j) * LD + nt * 16 + r] = f2bf(ST[nt][j]);
        __syncthreads();
        if (c + 1 < nch) GDN_PREFETCH(c + 1);
        bf16_t zgr[4][4];
#pragma unroll
        for (int j = 0; j < 4; ++j) { const int tk = mt * 16 + q * 4 + j; const size_t row = (size_t)(rb + (tk < nvalid ? tk : 0));
#pragma unroll
            for (int n4 = 0; n4 < 4; ++n4) zgr[j][n4] = ZB[row * GD_N + 3088 + h * 128 + (nh * 4 + n4) * 16 + r]; }
        f32x4 aws[4], aqg[4];
#pragma unroll
        for (int n4 = 0; n4 < 4; ++n4) { aws[n4] = (f32x4){0.f, 0.f, 0.f, 0.f}; aqg[n4] = aws[n4]; }
#pragma unroll
        for (int ks = 0; ks < 4; ++ks) {
            const bf16x8 fw = *(const bf16x8*)(WL + (mt * 16 + r) * LD + ks * 32 + q * 8);
            const bf16x8 fq = *(const bf16x8*)(QGL + (mt * 16 + r) * LD + ks * 32 + q * 8);
#pragma unroll
            for (int n4 = 0; n4 < 4; ++n4) {
                const bf16x8 bs = *(const bf16x8*)(SB + ((nh * 4 + n4) * 16 + r) * LD + ks * 32 + q * 8);
                aws[n4] = __builtin_amdgcn_mfma_f32_16x16x32_bf16(fw, bs, aws[n4], 0, 0, 0);
                aqg[n4] = __builtin_amdgcn_mfma_f32_16x16x32_bf16(fq, bs, aqg[n4], 0, 0, 0);
            }
        }
#pragma unroll
        for (int n4 = 0; n4 < 4; ++n4) {
            const int dv = (nh * 4 + n4) * 16 + r;
            float vn[4];
#pragma unroll
            for (int j = 0; j < 4; ++j) vn[j] = UL[(mt * 16 + q * 4 + j) * ULD + dv] - aws[n4][j];
            u32x2 o; o.x = pk2(vn[0], vn[1]); o.y = pk2(vn[2], vn[3]);
            *(u32x2*)(VN + dv * VLD + mt * 16 + q * 4) = o;
        }
        __syncthreads();
#pragma unroll
        for (int ks = 0; ks < 2; ++ks) {
            const bf16x8 fk = *(const bf16x8*)(QKL + (mt * 16 + r) * VLD + ks * 32 + q * 8);
#pragma unroll
            for (int n4 = 0; n4 < 4; ++n4) {
                const bf16x8 bv = *(const bf16x8*)(VN + ((nh * 4 + n4) * 16 + r) * VLD + ks * 32 + q * 8);
                aqg[n4] = __builtin_amdgcn_mfma_f32_16x16x32_bf16(fk, bv, aqg[n4], 0, 0, 0);
            }
        }
        {
            float ssq[4];
#pragma unroll
            for (int j = 0; j < 4; ++j) { float a = 0.f;
#pragma unroll
                for (int n4 = 0; n4 < 4; ++n4) a += aqg[n4][j] * aqg[n4][j];
                ssq[j] = row16_sum(a); }
            if (r == 0) {
#pragma unroll
                for (int j = 0; j < 4; ++j) red[(mt * 16 + q * 4 + j) * 2 + nh] = ssq[j];
            }
        }
#pragma unroll
        for (int nt = 0; nt < 8; ++nt) ST[nt] = ST[nt] * glast;
#pragma unroll
        for (int ks = 0; ks < 2; ++ks) {
            const bf16x8 av = *(const bf16x8*)(VN + (16 * w + r) * VLD + ks * 32 + q * 8);
#pragma unroll
            for (int nt = 0; nt < 8; ++nt) {
                const bf16x8 bk = *(const bf16x8*)(KDL + (nt * 16 + r) * VLD + ks * 32 + q * 8);
                ST[nt] = __builtin_amdgcn_mfma_f32_16x16x32_bf16(av, bk, ST[nt], 0, 0, 0);
            }
        }
        __syncthreads();
#pragma unroll
        for (int j = 0; j < 4; ++j) {
            const int tk = mt * 16 + q * 4 + j;
            if (tk < nvalid) {
                const float rs = rsqrtf((red[tk * 2] + red[tk * 2 + 1]) * (1.f / 128.f) + 1e-6f);
                const size_t row = (size_t)(rb + tk);
#pragma unroll
                for (int n4 = 0; n4 < 4; ++n4) { const int dv = (nh * 4 + n4) * 16 + r;
                    OMIX[row * 1024 + h * 128 + dv] = f2bf(aqg[n4][j] * rs * ng[dv] * silu(bf2f(zgr[j][n4]))); }
            }
        }
    }
#undef GDN_PREFETCH
    float* so = (s < 8) ? p.out + O_PGDN + (((size_t)i * 8 + s) * 8 + h) * 16384 : p.out + O_SGDN + (((size_t)i * 128 + (s - 8)) * 8 + h) * 16384;
#pragma unroll
    for (int nt = 0; nt < 8; ++nt) *(f32x4*)(so + (size_t)(nt * 16 + r) * 128 + 16 * w + q * 4) = ST[nt];
    __syncthreads();
}

__device__ __forceinline__ void phase_gdn_scan(const Params& p, int i, int l, unsigned char* smem) {
    const int bid = mk_lbid(), G = gridDim.x; const int wv = mk_ltid() >> 6;
    if (G == 256) {
        if (bid < 64) gdn_scan_item(p, i, bid >> 3, bid & 7, smem);
        else {
            for (int it = bid - 64; it < 128 * 8; it += 192) gdn_scan_item(p, i, 8 + (it >> 3), it & 7, smem);
            convert_ffn_ahead(p, l, (bid - 64) * 8 + wv, 192 * 8, smem);
        }
    } else {
        for (int it = bid; it < 136 * 8; it += G) { const int s = it >> 3, h = it & 7; gdn_scan_item(p, i, s, h, smem); }
        convert_ffn_ahead(p, l, bid * 8 + wv, G * 8, smem);
    }
}

__global__ void __launch_bounds__(512, 2) mega(Params p) {
    extern __shared__ __attribute__((aligned(16))) unsigned char lds[];
    cg::grid_group grid = cg::this_grid();
    constexpr int NPH = 1 + 4 * 12;
    unsigned* bar = (unsigned*)(p.ws + WS_BAR);
    volatile unsigned* bst = (volatile unsigned*)(lds + LDS_BYTES - 16);
    if (mk_ltid() == 0) { bst[0] = 0u; bst[1] = 0u; }
    if (mk_lbid() == 0) for (int u = mk_ltid(); u < XCD_BAR_WORDS; u += 512) __hip_atomic_store(bar + u, 0u, __ATOMIC_RELAXED, __HIP_MEMORY_SCOPE_AGENT);
    __syncthreads();
#pragma unroll 1
    for (int ph = 0; ph < NPH; ++ph) {
        int l = (ph == 0) ? 0 : (ph - 1) / 12, k = (ph == 0) ? -1 : (ph - 1) % 12;
        asm volatile("" : "+s"(l), "+s"(k));
        const int i = l >> 1; const bool ab = (l & 1) == 0;
        if (k == 6 && !ab) continue;
        unsigned char* ws = p.ws; asm volatile("" : "+s"(ws));
        unsigned char* smem = (unsigned char*)lds;
        PG8_LAS unsigned char* ldsp = (PG8_LAS unsigned char*)lds;
        const int G = gridDim.x, cu = mk_lbid();
#ifndef REPMASK
#define REPMASK 0
#endif
#ifndef REPAB
#define REPAB 3
#endif
        const int nrep = (((REPMASK >> (k + 1)) & 1) && ((REPAB >> (l & 1)) & 1)) ? 2 : 1;
#pragma unroll 1
        for (int rep = 0; rep < nrep; ++rep) {
        if (rep) grid.sync();
        if (k == -1) phase_start(p, smem);
        else if (k == 0 || k == 9) {
            const int j = (k == 9);
            pg8::Gemm g{(const bf16_t*)(ws + WS_HB), (const bf16_t*)(ws + WS_WGU) + (size_t)j * 5632 * 1024, M, 5632, D};
            pg8::StaticOrder S; S.init(g.M, g.N, G, cu); EpiSwiglu E{(bf16_t*)(ws + WS_HID)};
            pg8::gemm_phase<EpiSwiglu, pg8::StaticOrder, true, true>(ldsp, g, S, E);
        } else if (k == 1 || k == 10 || k == 7) {
            const int j = (k == 10);
            pg8::Gemm g{(const bf16_t*)(ws + (k == 7 ? WS_OMIX : WS_HID)), k == 7 ? (const bf16_t*)(ws + WS_WOUT) : (const bf16_t*)(ws + WS_WD) + (size_t)j * 1024 * 2816, MP, D, k == 7 ? D : FF};
            pg8::StaticOrder S; S.init(g.M, g.N, G, cu); EpiResid E{(bf16_t*)(ws + WS_X), (const bf16_t*)(ws + WS_HB), k == 7 ? 1.0f : 0.5f};
            pg8::gemm_phase<EpiResid, pg8::StaticOrder, true, true>(ldsp, g, S, E);
            small_resid_gemm(g.A, g.Bt, g.K, E.X, E.H, E.scale, smem);
        } else if (k == 2 || k == 8 || k == 11) {
            phase_ln(p, l, k == 2 ? 0 : (k == 8 ? 1 : 2), (l == 3 && k == 11));
            if (k == 11 && l < 3) convert_items(p, l + 1, 4, mk_lbid() * 8 + (mk_ltid() >> 6), gridDim.x * 8, smem);
        } else if (k == 3) {
            pg8::Gemm g{(const bf16_t*)(ws + WS_HB), (const bf16_t*)(ws + WS_WIN), M, ab ? AB_N : GD_N, D};
            pg8::StaticOrder S; S.init(g.M, g.N, G, cu); EpiZ E{(bf16_t*)(ws + WS_ZB), g.N};
            pg8::gemm_phase<EpiZ, pg8::StaticOrder, true, true>(ldsp, g, S, E);
        } else if (k == 4) { if (ab) phase_ab_prep(p, i, smem); else phase_gdn_chunk(p, i, smem); }
        else if (k == 5) { if (ab) phase_ab_core(p, i, l, smem); else phase_gdn_scan(p, i, l, smem); }
        else if (k == 6) phase_ab_post(p, i);
        }
        if (ph + 1 < NPH) { if (ph == 0) { grid.sync(); if (mk_ltid() == 0) (void)xb_add(&bar[XB_XCNT(xb_xcc_id())], 1u); } else gbar(bar, bst); }
#ifdef REPSYNC
        if (ph > 0) { gbar(bar, bst); gbar(bar, bst); }
#endif
    }
}
}

extern "C" void kernel_launch(void* const* d_in, const int* in_sizes, int n_in, void* d_out, int out_size, void* d_ws, size_t ws_size, hipStream_t stream) {
    static int grid_blocks = 0;
    if (grid_blocks == 0) {
        if (n_in != 33 || ws_size < mk::WS_NEED) { fprintf(stderr, "kernel_launch: need 33 inputs and %zu bytes of workspace; got %d, %zu\n", (size_t)mk::WS_NEED, n_in, ws_size); grid_blocks = -1; return; }
        int dev = 0, cus = 0, per_cu = 0;
        hipGetDevice(&dev);
        hipDeviceGetAttribute(&cus, hipDeviceAttributeMultiprocessorCount, dev);
        if (hipFuncSetAttribute((const void*)mk::mega, hipFuncAttributeMaxDynamicSharedMemorySize, mk::LDS_BYTES) != hipSuccess) { fprintf(stderr, "kernel_launch: hipFuncSetAttribute failed\n"); grid_blocks = -1; return; }
        if (hipOccupancyMaxActiveBlocksPerMultiprocessor(&per_cu, (const void*)mk::mega, 512, mk::LDS_BYTES) != hipSuccess || per_cu < 1) { fprintf(stderr, "kernel_launch: occupancy query failed (%d)\n", per_cu); (void)hipGetLastError(); per_cu = 1; }
        grid_blocks = cus * 1;
        fprintf(stderr, "kernel_launch: grid %d (cus %d, per_cu %d)\n", grid_blocks, cus, per_cu);
    }
    if (grid_blocks < 0) return;
    mk::Params prm{};
    for (int k = 0; k < 33; ++k) prm.in[k] = (const float*)d_in[k];
    prm.out = (float*)d_out; prm.ws = (unsigned char*)d_ws;
    void* args[] = {&prm};
    hipError_t e = hipLaunchCooperativeKernel((const void*)mk::mega, dim3(grid_blocks), dim3(512), args, mk::LDS_BYTES, stream);
    if (e != hipSuccess) fprintf(stderr, "cooperative launch failed: %s (grid %d)\n", hipGetErrorString(e), grid_blocks);
}
```

```cpp
#include <hip/hip_runtime.h>
#include <hip/hip_cooperative_groups.h>
#include <cstdio>
#include <cstdint>
namespace cg = cooperative_groups;
__device__ __forceinline__ int mk_ltid() { int t = threadIdx.x; asm volatile("" : "+v"(t)); return t; }
__device__ __forceinline__ int mk_lbid() { int t = blockIdx.x; asm volatile("" : "+s"(t)); return t; }
namespace pg8 {
#define PG8_LAS __attribute__((address_space(3)))
typedef unsigned short bf16_t;
typedef short bf16x8 __attribute__((ext_vector_type(8)));
typedef float f32x4 __attribute__((ext_vector_type(4)));
typedef unsigned u32x4 __attribute__((ext_vector_type(4)));
constexpr int BM = 256, BK = 64, HALF = 128, HTB = HALF * BK * 2  , STAGE_BYTES = 8 * HTB, NXCD = 8, WGM = 8;

__host__ __device__ __forceinline__ int lds_byte(int r, int c) { const int st = (r >> 4) * 2 + (c >> 5), rr = r & 15, cc = c & 31, ob = rr * 64 + cc * 2; return st * 1024 + (ob ^ (((ob >> 9) & 1) << 5)); }
__host__ __device__ __forceinline__ void stage_rc(int b, int& R, int& C) { const int st = b / 1024, sb = b % 1024, swz = sb ^ (((sb >> 9) & 1) << 5); R = (st >> 1) * 16 + swz / 64; C = (st & 1) * 32 + (swz % 64) / 2; }
__host__ __device__ __forceinline__ int perm32(int rho) { const int n = rho >> 4, i = rho & 15; return 8 * (i >> 2) + 4 * n + (i & 3); }

struct Unit { int pm, pn; };
struct Gemm { const bf16_t* A; const bf16_t* Bt; int M, N, K; };

struct StaticOrder {
    int nM, nN, nwg, G, c;
    __host__ __device__ void init(int M, int N, int G_, int c_) { nM = M / BM; nN = N / BM; nwg = nM * nN; G = G_; c = c_; }
    __host__ __device__ bool next(int i, Unit& u) const {
        const long L = (long)i * G + c; if (L >= nwg) return false;
        int wgid = (int)L; { const int q = nwg / NXCD, r = nwg % NXCD, xcd = wgid % NXCD, off = wgid / NXCD; wgid = (xcd < r ? xcd * (q + 1) : r * (q + 1) + (xcd - r) * q) + off; }
        const int nig = WGM * nN, gid = wgid / nig, fm = gid * WGM, gsz = (nM - fm) < WGM ? (nM - fm) : WGM;
        u.pm = fm + ((wgid % nig) % gsz); u.pn = (wgid % nig) / gsz; return true;
    }
    __device__ __forceinline__ void a_ready(const Unit&) const {}
    __device__ __forceinline__ void done(const Unit&) const {}
};

template <class Epi, class Sched, bool ALIGN_EPI = false, bool SP2 = false>
__device__ __forceinline__ void gemm_phase(PG8_LAS unsigned char* lds, const Gemm g, const Sched& S, const Epi& E) {
    const int tid = mk_ltid(), wid = __builtin_amdgcn_readfirstlane(tid >> 6), lane = tid & 63, wr = wid >> 2, wc = wid & 3, fr = lane & 15, fq = lane >> 4;
    const int K = g.K, nt = K / BK;
    unsigned voffA[2], voffB[2];
#pragma unroll
    for (int i = 0; i < 2; ++i) { int R, C; stage_rc(tid * 16 + i * 8192, R, C); const int Rb = Epi::PERM ? ((R & ~31) + perm32(R & 31)) : R;
        voffA[i] = (unsigned)(R * K + C) * 2u; voffB[i] = (unsigned)(Rb * K + C) * 2u; }
    const size_t kstep = (size_t)(BK * 2);
    const size_t hstep = (size_t)HALF * K * 2;
    const size_t tstep = 2 * hstep;
    const unsigned ldsw = (unsigned)wid * 1024u;
    const int aoff = lds_byte(wr * 64 + fr, fq * 8), boff = lds_byte(wc * 32 + fr, fq * 8);
#define PG8_SA(b, h) (((b) * 2 + (h)) * HTB)
#define PG8_SB(b, h) ((4 + (b) * 2 + (h)) * HTB)
#define PG8_STAGE(bufoff, gbase, voff) do { _Pragma("unroll") for (int _i = 0; _i < 2; ++_i) \
        __builtin_amdgcn_global_load_lds((const unsigned*)((const char*)(gbase) + (voff)[_i]), (PG8_LAS unsigned*)(lds + (bufoff) + ldsw + _i * 8192), 16, 0, 0); } while (0)
#define PG8_LDA(dst, b, h) do { _Pragma("unroll") for (int m = 0; m < 4; ++m) _Pragma("unroll") for (int k = 0; k < 2; ++k) dst[m][k] = *(const PG8_LAS bf16x8*)(lds + PG8_SA(b, h) + aoff + m * 2048 + k * 1024); } while (0)
#define PG8_LDB(dst, b, h) do { _Pragma("unroll") for (int n = 0; n < 2; ++n) _Pragma("unroll") for (int k = 0; k < 2; ++k) dst[n][k] = *(const PG8_LAS bf16x8*)(lds + PG8_SB(b, h) + boff + n * 2048 + k * 1024); } while (0)
#define PG8_MMA(ai, bj, At, Bt) do { __builtin_amdgcn_s_setprio(1); _Pragma("unroll") for (int m = 0; m < 4; ++m) _Pragma("unroll") for (int n = 0; n < 2; ++n) _Pragma("unroll") for (int k = 0; k < 2; ++k) \
        acc[ai][bj][m][n] = __builtin_amdgcn_mfma_f32_16x16x32_bf16(Bt[n][k], At[m][k], acc[ai][bj][m][n], 0, 0, 0); __builtin_amdgcn_s_setprio(0); } while (0)
#define PG8_WAIT_V(n) asm volatile("s_waitcnt vmcnt(" #n ")" ::: "memory")
#define PG8_WAIT_L(n) asm volatile("s_waitcnt lgkmcnt(" #n ")" ::: "memory")
#define PG8_BAR __builtin_amdgcn_s_barrier()
#define PG8_SCHED __builtin_amdgcn_sched_barrier(0)
    Unit cur, nxt; int ui = 0;
    if (!S.next(0, cur)) return;
    f32x4 acc[2][2][4][2];
#pragma unroll
    for (int a = 0; a < 2; ++a)
#pragma unroll
        for (int b = 0; b < 2; ++b)
#pragma unroll
            for (int m = 0; m < 4; ++m)
#pragma unroll
                for (int n = 0; n < 2; ++n) acc[a][b][m][n] = (f32x4){0.f, 0.f, 0.f, 0.f};
    bf16x8 At[4][2], B0[2][2], B1[2][2];
    const char* cA = (const char*)g.A + (size_t)cur.pm * tstep; const char* cB = (const char*)g.Bt + (size_t)cur.pn * tstep;
    S.a_ready(cur);
    if constexpr (SP2) {
        PG8_STAGE(PG8_SB(0, 0), cB, voffB); PG8_STAGE(PG8_SB(0, 1), cB + hstep, voffB); PG8_STAGE(PG8_SA(0, 0), cA, voffA); PG8_STAGE(PG8_SA(0, 1), cA + hstep, voffA);
        if (wr == 1) PG8_BAR;
        PG8_WAIT_V(2); PG8_BAR;
        PG8_STAGE(PG8_SB(1, 0), cB + kstep, voffB); PG8_STAGE(PG8_SA(1, 0), cA + kstep, voffA); PG8_STAGE(PG8_SB(1, 1), cB + hstep + kstep, voffB);
        PG8_WAIT_V(6); PG8_BAR;
    } else {
        PG8_STAGE(PG8_SB(0, 0), cB, voffB); PG8_STAGE(PG8_SA(0, 0), cA, voffA); PG8_STAGE(PG8_SB(0, 1), cB + hstep, voffB); PG8_STAGE(PG8_SA(0, 1), cA + hstep, voffA);
        if (wr == 1) PG8_BAR;
        PG8_WAIT_V(4); PG8_BAR;
        PG8_STAGE(PG8_SB(1, 0), cB + kstep, voffB); PG8_STAGE(PG8_SA(1, 0), cA + kstep, voffA); PG8_STAGE(PG8_SB(1, 1), cB + hstep + kstep, voffB);
        PG8_WAIT_V(6); PG8_BAR;
    }
    for (;;) {
        const bool has_next = S.next(ui + 1, nxt);
        const char* nA = has_next ? (const char*)g.A + (size_t)nxt.pm * tstep : cA; const char* nB = has_next ? (const char*)g.Bt + (size_t)nxt.pn * tstep : cB;
        for (int t = 0; t < nt; t += 2) {
            const bool last = (t == nt - 2);
            const char* a1 = cA + (size_t)(t + 1) * kstep;
            const char* a2 = last ? nA : cA + (size_t)(t + 2) * kstep; const char* b2 = last ? nB : cB + (size_t)(t + 2) * kstep;
            const char* a3 = a2 + kstep; const char* b3 = b2 + kstep;
            if (last && has_next) S.a_ready(nxt);
            if constexpr (SP2) {
            PG8_LDB(B0, 0, 0); PG8_LDB(B1, 0, 1); PG8_SCHED; PG8_LDA(At, 0, 0); PG8_STAGE(PG8_SA(1, 1), a1 + hstep, voffA);
            PG8_WAIT_V(8); PG8_WAIT_L(0); PG8_BAR; PG8_MMA(0, 0, At, B0); PG8_MMA(0, 1, At, B1); PG8_BAR; PG8_SCHED;
            PG8_LDA(At, 0, 1); PG8_STAGE(PG8_SB(0, 0), b2, voffB); PG8_STAGE(PG8_SB(0, 1), b2 + hstep, voffB); PG8_STAGE(PG8_SA(0, 0), a2, voffA);
            PG8_WAIT_V(8); PG8_WAIT_L(0); PG8_BAR; PG8_MMA(1, 0, At, B0); PG8_MMA(1, 1, At, B1); PG8_BAR; PG8_SCHED;
            PG8_LDB(B0, 1, 0); PG8_LDB(B1, 1, 1); PG8_SCHED; PG8_LDA(At, 1, 0); PG8_STAGE(PG8_SA(0, 1), a2 + hstep, voffA);
            PG8_WAIT_V(8); PG8_WAIT_L(0); PG8_BAR; PG8_MMA(0, 0, At, B0); PG8_MMA(0, 1, At, B1); PG8_BAR; PG8_SCHED;
            PG8_LDA(At, 1, 1); PG8_STAGE(PG8_SB(1, 0), b3, voffB); PG8_STAGE(PG8_SB(1, 1), b3 + hstep, voffB); PG8_STAGE(PG8_SA(1, 0), a3, voffA);
            PG8_WAIT_V(8); PG8_WAIT_L(0); PG8_BAR; PG8_MMA(1, 0, At, B0); PG8_MMA(1, 1, At, B1); PG8_BAR; PG8_SCHED;
            } else {
            PG8_LDB(B0, 0, 0); PG8_SCHED; PG8_LDA(At, 0, 0); PG8_STAGE(PG8_SA(1, 1), a1 + hstep, voffA);
            PG8_WAIT_L(8); PG8_BAR; PG8_WAIT_L(0); PG8_MMA(0, 0, At, B0); PG8_BAR; PG8_SCHED;
            PG8_LDB(B1, 0, 1); PG8_STAGE(PG8_SB(0, 0), b2, voffB);
            PG8_BAR; PG8_WAIT_L(0); PG8_MMA(0, 1, At, B1); PG8_BAR;
            PG8_LDA(At, 0, 1); PG8_STAGE(PG8_SA(0, 0), a2, voffA);
            PG8_BAR; PG8_WAIT_L(0); PG8_MMA(1, 0, At, B0); PG8_BAR; PG8_SCHED;
            PG8_STAGE(PG8_SB(0, 1), b2 + hstep, voffB);
            PG8_WAIT_V(6); PG8_BAR; PG8_MMA(1, 1, At, B1); PG8_BAR;
            PG8_LDB(B0, 1, 0); PG8_SCHED; PG8_LDA(At, 1, 0); PG8_STAGE(PG8_SA(0, 1), a2 + hstep, voffA);
            PG8_WAIT_L(8); PG8_BAR; PG8_WAIT_L(0); PG8_MMA(0, 0, At, B0); PG8_BAR; PG8_SCHED;
            PG8_LDB(B1, 1, 1); PG8_STAGE(PG8_SB(1, 0), b3, voffB);
            PG8_BAR; PG8_WAIT_L(0); PG8_MMA(0, 1, At, B1); PG8_BAR;
            PG8_LDA(At, 1, 1); PG8_STAGE(PG8_SA(1, 0), a3, voffA);
            PG8_BAR; PG8_WAIT_L(0); PG8_MMA(1, 0, At, B0); PG8_BAR; PG8_SCHED;
            PG8_STAGE(PG8_SB(1, 1), b3 + hstep, voffB);
            PG8_WAIT_V(6); PG8_BAR; PG8_MMA(1, 1, At, B1); PG8_BAR;
            }
        }
        if constexpr (ALIGN_EPI) { if (wr == 0) PG8_BAR; }
        if constexpr (!Epi::AFTER_DRAIN) { E(acc, cur, wr, wc, fr, fq); S.done(cur); }
        if (!has_next) break;
#pragma unroll
        for (int a = 0; a < 2; ++a)
#pragma unroll
            for (int b = 0; b < 2; ++b)
#pragma unroll
                for (int m = 0; m < 4; ++m)
#pragma unroll
                    for (int n = 0; n < 2; ++n) acc[a][b][m][n] = (f32x4){0.f, 0.f, 0.f, 0.f};
        cur = nxt; cA = nA; cB = nB; ++ui;
        if constexpr (ALIGN_EPI) { if (wr == 1) PG8_BAR; }
    }
    PG8_WAIT_V(0);
    if constexpr (!ALIGN_EPI) { if (wr == 0) PG8_BAR; }
    PG8_BAR;
    if constexpr (Epi::AFTER_DRAIN) { E.fused(acc, cur, wr, wc, fr, fq, lds, wid, lane); S.done(cur); }
#undef PG8_SA
#undef PG8_SB
#undef PG8_STAGE
#undef PG8_LDA
#undef PG8_LDB
#undef PG8_MMA
#undef PG8_WAIT_V
#undef PG8_WAIT_L
#undef PG8_BAR
#undef PG8_SCHED
}
}

namespace mk {
using pg8::bf16_t; using pg8::bf16x8; using pg8::f32x4; using pg8::Unit;
typedef unsigned u32x4 __attribute__((ext_vector_type(4)));
typedef unsigned u32x2 __attribute__((ext_vector_type(2)));

constexpr int M = 16896, MP = 16384, D = 1024, FF = 2816;
constexpr int AB_N = 3840, GD_N = 4352, GD_NREAL = 4112;
constexpr float ALPHA = 1.6817928305074290f;
constexpr int LDS_BYTES = 163840;

constexpr size_t O_PSHIFT = 17301504, O_PRWKV = 17330176, O_PRET = 17854464, O_PCONV = 18903040, O_PGDN = 19050496;
constexpr size_t O_SSHIFT = 21147648, O_SRWKV = 21606400, O_SRET = 29995008, O_SCONV = 46772224, O_SGDN = 49131520;

constexpr size_t WS_WGU = 0;
constexpr size_t WS_WD = WS_WGU + 2ull * 5632 * 1024 * 2;
constexpr size_t WS_WIN = WS_WD + 2ull * 1024 * 2816 * 2;
constexpr size_t WS_WOUT = WS_WIN + 4352ull * 1024 * 2;
constexpr size_t WS_W2T = WS_WOUT + 1024ull * 1024 * 2;
constexpr size_t WS_A2T = WS_W2T + 65536;
constexpr size_t WS_G2T = WS_A2T + 65536;
constexpr size_t WS_X = WS_G2T + 131072;
constexpr size_t WS_HB = WS_X + (size_t)M * 1024 * 4;
constexpr size_t WS_S = WS_HB + (size_t)M * 1024 * 2;
constexpr size_t WS_HID = WS_S;
constexpr size_t WS_OMIX = WS_S;
constexpr size_t WS_ZB = WS_OMIX + (size_t)M * 1024 * 2;
constexpr size_t WS_OPS = WS_ZB + (size_t)M * AB_N * 2;
constexpr size_t WS_GATE = WS_OPS + (size_t)M * 3072 * 4;
constexpr size_t WS_ORAW = WS_GATE + (size_t)M * 512 * 4;
constexpr size_t WS_BONUS = WS_ORAW + (size_t)M * 512 * 4;
constexpr size_t WS_RQ = WS_BONUS + (size_t)M * 8 * 4;
constexpr size_t WS_RK = WS_RQ + (size_t)M * 512 * 2;
constexpr size_t WS_AB_END = WS_RK + (size_t)M * 512 * 2;
constexpr size_t WS_CH = WS_ZB + (size_t)M * GD_N * 2;
constexpr size_t CH_U = 0, CH_W = 32768, CH_QG = 49152, CH_QK = 65536, CH_KDT = 73728, CH_BYTES = 90112;
constexpr int N_CH = 2048 + 1024;
constexpr size_t WS_GL = WS_CH + (size_t)N_CH * CH_BYTES;
constexpr size_t WS_GD_END = WS_GL + N_CH * 4;
constexpr size_t WS_BAR = ((WS_AB_END > WS_GD_END ? WS_AB_END : WS_GD_END) + 255) / 256 * 256;
constexpr size_t WS_NEED = WS_BAR + 16384;

struct Params { const float* in[33]; float* out; unsigned char* ws; };

__device__ __forceinline__ float bf2f(bf16_t h) { return __uint_as_float(((unsigned)h) << 16); }
__device__ __forceinline__ unsigned pk2(float lo, float hi) { unsigned r; asm volatile("v_cvt_pk_bf16_f32 %0, %1, %2" : "=v"(r) : "v"(lo), "v"(hi)); return r; }
__device__ __forceinline__ bf16_t f2bf(float x) { return (bf16_t)(pk2(x, 0.f) & 0xffffu); }
__device__ __forceinline__ float sigm(float x) { return __builtin_amdgcn_rcpf(1.f + __expf(-x)); }
__device__ __forceinline__ float silu(float x) { return x * __builtin_amdgcn_rcpf(1.f + __expf(-x)); }
__device__ __forceinline__ float dppf(float v, const int ctrl_sel) {
    int x = __builtin_bit_cast(int, v), y;
    if (ctrl_sel == 0) y = __builtin_amdgcn_update_dpp(0, x, 0xB1, 0xF, 0xF, true);
    else if (ctrl_sel == 1) y = __builtin_amdgcn_update_dpp(0, x, 0x4E, 0xF, 0xF, true);
    else if (ctrl_sel == 2) y = __builtin_amdgcn_update_dpp(0, x, 0x141, 0xF, 0xF, true);
    else y = __builtin_amdgcn_update_dpp(0, x, 0x140, 0xF, 0xF, true);
    return __builtin_bit_cast(float, y);
}
__device__ __forceinline__ float row16_sum(float v) { v += dppf(v, 0); v += dppf(v, 1); v += dppf(v, 2); v += dppf(v, 3); return v; }
__device__ __forceinline__ float wave_sum(float v) {
#pragma unroll
    for (int o = 1; o < 64; o <<= 1) v += __shfl_xor(v, o);
    return v;
}
#define XB_XCNT(j)  (256  + 64 * (j))
#define XB_XSUB(j)  (1280 + 64 * (j))
#define XB_XGEN(j)  (2304 + 64 * (j))
#define XB_TOP      3328
#define XB_TOPGEN   3392
#define XCD_BAR_WORDS 3456
__device__ __forceinline__ unsigned xb_ld(unsigned* p)              { return __hip_atomic_load(p, __ATOMIC_RELAXED, __HIP_MEMORY_SCOPE_AGENT); }
__device__ __forceinline__ unsigned xb_add(unsigned* p, unsigned v) { return __hip_atomic_fetch_add(p, v, __ATOMIC_RELAXED, __HIP_MEMORY_SCOPE_AGENT); }
__device__ __forceinline__ unsigned xb_xcc_id() { return (unsigned)__builtin_amdgcn_s_getreg((3 << 11) | 20) & 0xFu; }
__device__ __forceinline__ void gbar(unsigned* bar, volatile unsigned* st) {
    asm volatile("s_waitcnt vmcnt(0)" ::: "memory");
    __syncthreads();
    if (mk_ltid() == 0) {
        __builtin_amdgcn_s_waitcnt(0);
        const unsigned x = xb_xcc_id();
        unsigned nloc = st[0], nx = st[1];
        if (nloc == 0u) {
            const unsigned G = gridDim.x;
            unsigned sum, cnt, mine;
            for (;;) {
                sum = 0u; cnt = 0u; mine = 0u;
#pragma unroll
                for (unsigned j = 0; j < 16; ++j) { const unsigned c = xb_ld(&bar[XB_XCNT(j)]); sum += c; cnt += (c > 0u) ? 1u : 0u; mine = (j == x) ? c : mine; }
                if (sum == G) break;
                __builtin_amdgcn_s_sleep(1);
            }
            nloc = mine > 0u ? mine : 1u; nx = cnt > 0u ? cnt : 1u; st[0] = nloc; st[1] = nx;
        }
        const unsigned old = xb_add(&bar[XB_XSUB(x)], 1u);
        const unsigned gen = old / nloc;
        if (old + 1u == (gen + 1u) * nloc) {
            __builtin_amdgcn_fence(__ATOMIC_RELEASE, "agent");
            asm volatile("s_waitcnt vmcnt(0)" ::: "memory");
            const unsigned og = xb_add(&bar[XB_TOP], 1u);
            const unsigned tg = og / nx;
            if (og + 1u == (tg + 1u) * nx) xb_add(&bar[XB_TOPGEN], 1u);
            else while (xb_ld(&bar[XB_TOPGEN]) == tg) __builtin_amdgcn_s_sleep(1);
            __builtin_amdgcn_fence(__ATOMIC_ACQUIRE, "agent");
            xb_add(&bar[XB_XGEN(x)], 1u);
            asm volatile("s_waitcnt vmcnt(0)" ::: "memory");
        } else {
            while (xb_ld(&bar[XB_XGEN(x)]) == gen) __builtin_amdgcn_s_sleep(1);
            __builtin_amdgcn_fence(__ATOMIC_ACQUIRE, "agent");
            asm volatile("s_waitcnt vmcnt(0)" ::: "memory");
        }
    }
    __syncthreads();
}
__device__ __forceinline__ void seq_info(int s, int& row0, int& L) { if (s < 8) { row0 = s * 2048; L = 2048; } else { row0 = MP + (s - 8) * 4; L = 4; } }

struct EpiSwiglu { static constexpr bool PERM = true, AFTER_DRAIN = false; bf16_t* O;
    __device__ __forceinline__ void operator()(const f32x4 (&acc)[2][2][4][2], const Unit& u, int wr, int wc, int fr, int fq) const {
        const int row0 = u.pm * 256 + wr * 64 + fr, col0 = u.pn * 128 + wc * 32 + 8 * fq;
#pragma unroll
        for (int ai = 0; ai < 2; ++ai)
#pragma unroll
            for (int m = 0; m < 4; ++m) {
                bf16_t* rp = O + (size_t)(row0 + ai * 128 + m * 16) * FF + col0;
                const f32x4 g0 = acc[ai][0][m][0], g1 = acc[ai][0][m][1], u0 = acc[ai][1][m][0], u1 = acc[ai][1][m][1];
                u32x4 w;
                w.x = pk2(silu(g0[0]) * u0[0], silu(g0[1]) * u0[1]); w.y = pk2(silu(g0[2]) * u0[2], silu(g0[3]) * u0[3]);
                w.z = pk2(silu(g1[0]) * u1[0], silu(g1[1]) * u1[1]); w.w = pk2(silu(g1[2]) * u1[2], silu(g1[3]) * u1[3]);
                *(u32x4*)rp = w;
            }
    }
};
struct EpiResid { static constexpr bool PERM = true, AFTER_DRAIN = false; bf16_t* X; const bf16_t* H; float scale;
    __device__ __forceinline__ void operator()(const f32x4 (&acc)[2][2][4][2], const Unit& u, int wr, int wc, int fr, int fq) const {
        const int row0 = u.pm * 256 + wr * 64 + fr, col0 = u.pn * 256 + wc * 32 + 8 * fq;
#pragma unroll
        for (int ai = 0; ai < 2; ++ai)
#pragma unroll
            for (int m = 0; m < 4; ++m)
#pragma unroll
                for (int bj = 0; bj < 2; ++bj)
#pragma unroll
                    for (int n = 0; n < 2; ++n) {
                        const size_t off = (size_t)(row0 + ai * 128 + m * 16) * D + col0 + bj * 128 + 4 * n;
                        const u32x2 hu = *(const u32x2*)(H + off);
                        f32x4 x; x[0] = __uint_as_float(hu.x << 16); x[1] = __uint_as_float(hu.x & 0xffff0000u); x[2] = __uint_as_float(hu.y << 16); x[3] = __uint_as_float(hu.y & 0xffff0000u);
                        x = x * ALPHA + acc[ai][bj][m][n] * scale; u32x2 xo; xo.x = pk2(x[0], x[1]); xo.y = pk2(x[2], x[3]); *(u32x2*)(X + off) = xo;
                    }
    }
};
struct EpiZ { static constexpr bool PERM = true, AFTER_DRAIN = false; bf16_t* Z; int ld;
    __device__ __forceinline__ void operator()(const f32x4 (&acc)[2][2][4][2], const Unit& u, int wr, int wc, int fr, int fq) const {
        const int row0 = u.pm * 256 + wr * 64 + fr, col0 = u.pn * 256 + wc * 32 + 8 * fq;
#pragma unroll
        for (int ai = 0; ai < 2; ++ai)
#pragma unroll
            for (int m = 0; m < 4; ++m)
#pragma unroll
                for (int bj = 0; bj < 2; ++bj) {
                    const f32x4 a = acc[ai][bj][m][0], b = acc[ai][bj][m][1];
                    u32x4 w; w.x = pk2(a[0], a[1]); w.y = pk2(a[2], a[3]); w.z = pk2(b[0], b[1]); w.w = pk2(b[2], b[3]);
                    *(u32x4*)(Z + (size_t)(row0 + ai * 128 + m * 16) * ld + col0 + bj * 128) = w;
                }
    }
};

__device__ __forceinline__ void tr_item(const float* __restrict__ W, int K, int N, bf16_t* WT, int dst_row0, int k0, int n0, float* scr, int lane) {
#pragma unroll
    for (int i = 0; i < 32; ++i) { const int kk = 2 * i + (lane >> 5); const int col = n0 + (lane & 31);
        scr[kk * 33 + (lane & 31)] = (col < N) ? W[(size_t)(k0 + kk) * N + col] : 0.f; }
    asm volatile("s_waitcnt lgkmcnt(0)" ::: "memory");
    const int c = lane & 7;
#pragma unroll
    for (int j = 0; j < 4; ++j) { const int n = (lane >> 3) + 8 * j; const float* s = scr + (8 * c) * 33 + n;
        u32x4 o; o.x = pk2(s[0], s[33]); o.y = pk2(s[2 * 33], s[3 * 33]); o.z = pk2(s[4 * 33], s[5 * 33]); o.w = pk2(s[6 * 33], s[7 * 33]);
        *(u32x4*)(WT + (size_t)(dst_row0 + n) * K + k0 + 8 * c) = o; }
    asm volatile("s_waitcnt lgkmcnt(0)" ::: "memory");
}

__device__ __forceinline__ void convert_items(const Params& p, int l, int parts, int gw, int NGW, unsigned char* smem) {
    const int lane = mk_ltid() & 63, wave = mk_ltid() >> 6;
    float* scr = (float*)smem + wave * (64 * 33);
    unsigned char* ws = p.ws;
    const int i = l >> 1; const bool ab = (l & 1) == 0;
    constexpr int I_G = 16 * 88, I_O = 16 * 32;
    const int I_IN = ab ? 16 * 120 : 16 * 136;
    const int I_LORA = ab ? (16 + 16 + 32) : 0;
    const int n0 = (parts & 1) ? 3 * I_G : 0, n1 = (parts & 2) ? 3 * I_G : 0, n2 = (parts & 4) ? (I_IN + I_O + I_LORA) : 0;
    const int total = n0 + n1 + n2;
    for (int it = gw; it < total; it += NGW) {
        int r = it;
        if (r < n0 + n1) {
            const int j = (r < n0) ? 0 : 1; r -= (j ? n0 : 0);
            const int kind = r / I_G; r -= kind * I_G;
            const size_t lw = (size_t)(l * 2 + j);
            if (kind < 2) { const float* W = p.in[kind == 0 ? 9 : 10] + lw * (size_t)D * FF;
                const int kb = r / 88, nb = r % 88, nn0 = nb * 32;
                tr_item(W, D, FF, (bf16_t*)(ws + WS_WGU) + (size_t)j * 5632 * 1024, (nn0 >> 7) * 256 + (nn0 & 127) + kind * 128, kb * 64, nn0, scr, lane);
            } else { const float* W = p.in[11] + lw * (size_t)FF * D;
                const int kb = r / 32, nb = r % 32;
                tr_item(W, FF, D, (bf16_t*)(ws + WS_WD) + (size_t)j * 1024 * 2816, nb * 32, kb * 64, nb * 32, scr, lane);
            }
            continue;
        }
        r -= n0 + n1;
        if (r < I_IN) {
            if (ab) { const int kb = r / 120, nb = r % 120; tr_item(p.in[12] + (size_t)i * D * AB_N, D, AB_N, (bf16_t*)(ws + WS_WIN), nb * 32, kb * 64, nb * 32, scr, lane); }
            else { const int kb = r / 136, nb = r % 136; tr_item(p.in[27] + (size_t)i * D * GD_NREAL, D, GD_NREAL, (bf16_t*)(ws + WS_WIN), nb * 32, kb * 64, nb * 32, scr, lane); }
            continue;
        }
        r -= I_IN;
        if (r < I_O) { const int kb = r / 32, nb = r % 32;
            tr_item(p.in[ab ? 13 : 32] + (size_t)i * D * D, D, D, (bf16_t*)(ws + WS_WOUT), nb * 32, kb * 64, nb * 32, scr, lane); continue; }
        r -= I_O;
        if (r < 16) { tr_item(p.in[16] + (size_t)i * 64 * 512, 64, 512, (bf16_t*)(ws + WS_W2T), r * 32, 0, r * 32, scr, lane); continue; }
        r -= 16;
        if (r < 16) { tr_item(p.in[18] + (size_t)i * 64 * 512, 64, 512, (bf16_t*)(ws + WS_A2T), r * 32, 0, r * 32, scr, lane); continue; }
        r -= 16;
        { const int kb = r / 16, nb = r % 16; tr_item(p.in[19] + (size_t)i * 128 * 512, 128, 512, (bf16_t*)(ws + WS_G2T), nb * 32, kb * 64, nb * 32, scr, lane); }
    }
}
__device__ __forceinline__ void convert_ffn_ahead(const Params& p, int l, int gw, int NGW, unsigned char* smem) {
    __syncthreads();
    convert_items(p, l, 2, gw, NGW, smem);
    if (l < 3) convert_items(p, l + 1, 1, gw, NGW, smem);
    __syncthreads();
}

__device__ __forceinline__ void phase_start(const Params& p, unsigned char* smem) {
    const int tid = mk_ltid(), lane = tid & 63, wave = tid >> 6;
    const int gw = mk_lbid() * 8 + wave, NGW = gridDim.x * 8;
    convert_items(p, 0, 5, gw, NGW, smem);
    bf16_t* HB = (bf16_t*)(p.ws + WS_HB);
    for (int m = gw; m < M; m += NGW) {
        const float* src = (m < MP) ? p.in[0] + (size_t)m * D : p.in[1] + (size_t)(m - MP) * D;
#pragma unroll
        for (int j = 0; j < 4; ++j) { const int c = (lane + 64 * j) * 4; const f32x4 v = *(const f32x4*)(src + c);
            u32x2 o; o.x = pk2(v[0], v[1]); o.y = pk2(v[2], v[3]); *(u32x2*)(HB + (size_t)m * D + c) = o; }
    }
}

__device__ __forceinline__ void phase_ln(const Params& p, int l, int k, bool final_out) {
    const int tid = mk_ltid(), lane = tid & 63, wave = tid >> 6;
    const int gw = mk_lbid() * 8 + wave, NGW = gridDim.x * 8;
    const bf16_t* X = (const bf16_t*)(p.ws + WS_X); bf16_t* HB = (bf16_t*)(p.ws + WS_HB);
    const float* g = p.in[7] + (size_t)(l * 3 + k) * D; const float* b = p.in[8] + (size_t)(l * 3 + k) * D;
    float* dst = p.out;
    for (int mq = gw; mq < M / 4; mq += NGW) {
        f32x4 v[4][4]; float s[4];
#pragma unroll
        for (int rr = 0; rr < 4; ++rr) { s[rr] = 0.f;
#pragma unroll
            for (int j = 0; j < 4; ++j) { const u32x2 xu = *(const u32x2*)(X + (size_t)(mq * 4 + rr) * D + (lane + 64 * j) * 4);
                v[rr][j][0] = __uint_as_float(xu.x << 16); v[rr][j][1] = __uint_as_float(xu.x & 0xffff0000u); v[rr][j][2] = __uint_as_float(xu.y << 16); v[rr][j][3] = __uint_as_float(xu.y & 0xffff0000u); s[rr] += (v[rr][j][0] + v[rr][j][1]) + (v[rr][j][2] + v[rr][j][3]); } }
#pragma unroll
        for (int o = 1; o < 64; o <<= 1) {
#pragma unroll
            for (int rr = 0; rr < 4; ++rr) s[rr] += __shfl_xor(s[rr], o); }
        float s2[4];
#pragma unroll
        for (int rr = 0; rr < 4; ++rr) { const float mean = s[rr] * (1.f / D); s2[rr] = 0.f;
#pragma unroll
            for (int j = 0; j < 4; ++j) { v[rr][j] = v[rr][j] - mean; s2[rr] += (v[rr][j][0] * v[rr][j][0] + v[rr][j][1] * v[rr][j][1]) + (v[rr][j][2] * v[rr][j][2] + v[rr][j][3] * v[rr][j][3]); } }
#pragma unroll
        for (int o = 1; o < 64; o <<= 1) {
#pragma unroll
            for (int rr = 0; rr < 4; ++rr) s2[rr] += __shfl_xor(s2[rr], o); }
#pragma unroll
        for (int j = 0; j < 4; ++j) { const int c = (lane + 64 * j) * 4; const f32x4 gg = *(const f32x4*)(g + c), bb = *(const f32x4*)(b + c);
#pragma unroll
            for (int rr = 0; rr < 4; ++rr) { const int m = mq * 4 + rr; const float rstd = rsqrtf(s2[rr] * (1.f / D) + 1e-5f);
                const f32x4 y = v[rr][j] * rstd * gg + bb;
                if (final_out) *(f32x4*)(dst + (size_t)m * D + c) = y;
                else { u32x2 o; o.x = pk2(y[0], y[1]); o.y = pk2(y[2], y[3]); *(u32x2*)(HB + (size_t)m * D + c) = o; } } }
    }
}

__device__ __forceinline__ void small_resid_gemm(const bf16_t* __restrict__ A, const bf16_t* __restrict__ Bt, int K, bf16_t* X, const bf16_t* H, float scale, unsigned char* smem) {
    const int tid = mk_ltid(), lane = tid & 63, w = __builtin_amdgcn_readfirstlane(tid >> 6);
    const int r = lane & 15, q = lane >> 4;
    float* part = (float*)smem;
    for (int t = mk_lbid(); t < 256; t += gridDim.x) {
        const int R0 = MP + (t >> 4) * 32, C0 = (t & 15) * 64;
        f32x4 acc[2][4];
#pragma unroll
        for (int a = 0; a < 2; ++a)
#pragma unroll
            for (int b = 0; b < 4; ++b) acc[a][b] = (f32x4){0.f, 0.f, 0.f, 0.f};
        const int nks = K / 32;
#pragma unroll 2
        for (int ks = w; ks < nks; ks += 8) {
            bf16x8 fa[2], fb[4];
#pragma unroll
            for (int a = 0; a < 2; ++a) fa[a] = *(const bf16x8*)(A + (size_t)(R0 + a * 16 + r) * K + ks * 32 + q * 8);
#pragma unroll
            for (int b = 0; b < 4; ++b) fb[b] = *(const bf16x8*)(Bt + (size_t)(C0 + b * 16 + r) * K + ks * 32 + q * 8);
#pragma unroll
            for (int a = 0; a < 2; ++a)
#pragma unroll
                for (int b = 0; b < 4; ++b) acc[a][b] = __builtin_amdgcn_mfma_f32_16x16x32_bf16(fa[a], fb[b], acc[a][b], 0, 0, 0);
        }
        __syncthreads();
#pragma unroll
        for (int a = 0; a < 2; ++a)
#pragma unroll
            for (int b = 0; b < 4; ++b) *(f32x4*)(part + ((w * 8 + a * 4 + b) * 64 + lane) * 4) = acc[a][b];
        __syncthreads();
        {
            const int tile = tid >> 6, a = tile >> 2, b = tile & 3;
            f32x4 sum = (f32x4){0.f, 0.f, 0.f, 0.f};
#pragma unroll
            for (int ww = 0; ww < 8; ++ww) sum += *(const f32x4*)(part + ((ww * 8 + tile) * 64 + lane) * 4);
            const int col = C0 + b * 16 + r;
#pragma unroll
            for (int j = 0; j < 4; ++j) { const size_t off = (size_t)(R0 + a * 16 + q * 4 + j) * D + col;
                X[off] = f2bf(bf2f(H[off]) * ALPHA + sum[j] * scale); }
        }
    }
}

__device__ __forceinline__ void phase_ab_prep(const Params& p, int i, unsigned char* smem) {
    const int tid = mk_ltid(), lane = tid & 63, wave = __builtin_amdgcn_readfirstlane(tid >> 6);
    const int r = lane & 15, q = lane >> 4;
    unsigned char* ws = p.ws;
    const bf16_t* ZB = (const bf16_t*)(ws + WS_ZB);
    float* OPS = (float*)(ws + WS_OPS); float* GATE = (float*)(ws + WS_GATE); float* BONUS = (float*)(ws + WS_BONUS);
    bf16_t* RQ = (bf16_t*)(ws + WS_RQ); bf16_t* RK = (bf16_t*)(ws + WS_RK);
    const bf16_t* W2T = (const bf16_t*)(ws + WS_W2T); const bf16_t* A2T = (const bf16_t*)(ws + WS_A2T); const bf16_t* G2T = (const bf16_t*)(ws + WS_G2T);
    const float* mu = p.in[14] + (size_t)i * 1792; const float* w0 = p.in[15] + i * 512; const float* a0 = p.in[17] + i * 512;
    const float* k_k = p.in[20] + i * 512; const float* k_a = p.in[21] + i * 512; const float* r_k = p.in[22] + i * 512;
    const float* shift_in = p.in[2] + (size_t)i * 128 * 1792;
    constexpr int ZS_LD = 1796, ACT_LD = 264;
    float* zs = (float*)smem;
    bf16_t* act = (bf16_t*)(smem + 16 * ZS_LD * 4);
    for (int tile = mk_lbid(); tile < M / 16; tile += gridDim.x) {
        const int R0 = tile * 16;
        unsigned pfa = 0u, pfb = 0u;
        { const int ntile = tile + gridDim.x;
          if (ntile < M / 16) { const bf16_t* nz = ZB + (size_t)ntile * 16 * AB_N;
              pfa = *(const unsigned*)(nz + (size_t)tid * 64); pfb = *(const unsigned*)(((size_t)(tid + 512) * 64 < (size_t)16 * AB_N) ? nz + (size_t)(tid + 512) * 64 : nz); } }
#ifndef REP_A_ST
#define REP_A_ST 1
#endif
#ifndef REP_A_RO
#define REP_A_RO 1
#endif
#ifndef REP_A_EP
#define REP_A_EP 1
#endif
        __syncthreads();
#pragma unroll 1
        for (int rp_ = 0; rp_ < REP_A_ST; ++rp_)
#pragma unroll 7
        for (int idx = tid; idx < 16 * 448; idx += 512) {
            const int tok = idx / 448, c4 = (idx % 448) * 4; const int row = R0 + tok;
            const int t = (row < MP) ? (row & 2047) : ((row - MP) & 3);
            const int Lm1 = (row < MP) ? 2047 : 3;
            const u32x2 cu = *(const u32x2*)(ZB + (size_t)row * AB_N + c4);
            f32x4 cur; cur[0] = __uint_as_float(cu.x << 16); cur[1] = __uint_as_float(cu.x & 0xffff0000u); cur[2] = __uint_as_float(cu.y << 16); cur[3] = __uint_as_float(cu.y & 0xffff0000u);
            f32x4 prev;
            if (t == 0) { if (row < MP) prev = (f32x4){0.f, 0.f, 0.f, 0.f}; else prev = *(const f32x4*)(shift_in + (size_t)((row - MP) >> 2) * 1792 + c4); }
            else { const u32x2 pu = *(const u32x2*)(ZB + (size_t)(row - 1) * AB_N + c4);
                prev[0] = __uint_as_float(pu.x << 16); prev[1] = __uint_as_float(pu.x & 0xffff0000u); prev[2] = __uint_as_float(pu.y << 16); prev[3] = __uint_as_float(pu.y & 0xffff0000u); }
            if (t == Lm1) {
                float* o = (row < MP) ? p.out + O_PSHIFT + (size_t)(i * 8 + (row >> 11)) * 1792 : p.out + O_SSHIFT + (size_t)(i * 128 + ((row - MP) >> 2)) * 1792;
                *(f32x4*)(o + c4) = cur;
            }
            const f32x4 m4 = *(const f32x4*)(mu + c4);
            const f32x4 z = cur + (prev - cur) * m4;
            *(f32x4*)(zs + tok * ZS_LD + c4) = z;
            if (c4 >= 1536) {
                f32x4 a;
                if (c4 < 1600) { a[0] = tanhf(z[0]); a[1] = tanhf(z[1]); a[2] = tanhf(z[2]); a[3] = tanhf(z[3]); }
                else if (c4 < 1664) a = z;
                else { a[0] = sigm(z[0]); a[1] = sigm(z[1]); a[2] = sigm(z[2]); a[3] = sigm(z[3]); }
                u32x2 o; o.x = pk2(a[0], a[1]); o.y = pk2(a[2], a[3]); *(u32x2*)(act + tok * ACT_LD + (c4 - 1536)) = o;
            }
        }
#pragma unroll 1
        for (int rp_ = 0; rp_ < REP_A_RO; ++rp_)
#pragma unroll 8
        for (int idx = tid; idx < 16 * 256; idx += 512) {
            const int tok = idx >> 8, hh = (idx >> 6) & 3, ii = idx & 63; const int row = R0 + tok;
            const float pos = (row < MP) ? (float)(row & 2047) : (float)(16384 + ((row - MP) & 3));
            const float inv_freq = exp2f(-(float)ii * (13.287712379549449f / 63.0f));
            const float ang = pos * inv_freq;
            const float n = rintf(ang * 0.15915494309189535f);
            float rr = fmaf(-n, 6.2831854820251465f, ang); rr = fmaf(-n, -1.7484555e-7f, rr);
            const float rev = rr * 0.15915494309189535f;
            const float sn = __builtin_amdgcn_sinf(rev), cs = __builtin_amdgcn_cosf(rev);
            const bf16_t* zq = ZB + (size_t)row * AB_N + 1792 + hh * 128 + ii;
            const float q1 = bf2f(zq[0]), q2 = bf2f(zq[64]), k1 = bf2f(zq[512]), k2 = bf2f(zq[576]);
            const size_t o = (size_t)row * 512 + hh * 128 + ii;
            RQ[o] = f2bf(q1 * cs - q2 * sn); RQ[o + 64] = f2bf(q2 * cs + q1 * sn);
            const float ksc = 0.08838834764831845f;
            RK[o] = f2bf((k1 * cs - k2 * sn) * ksc); RK[o + 64] = f2bf((k2 * cs + k1 * sn) * ksc);
        }
        __syncthreads();
        const int cb = wave * 64;
#pragma unroll 1
        for (int rp_ = 0; rp_ < REP_A_EP; ++rp_) {
        f32x4 aw[4], aa[4], ag[4];
#pragma unroll
        for (int nt = 0; nt < 4; ++nt) { aw[nt] = (f32x4){0.f, 0.f, 0.f, 0.f}; aa[nt] = aw[nt]; ag[nt] = aw[nt]; }
#pragma unroll
        for (int ks = 0; ks < 2; ++ks) {
            const bf16x8 bw = *(const bf16x8*)(act + r * ACT_LD + ks * 32 + q * 8);
            const bf16x8 ba = *(const bf16x8*)(act + r * ACT_LD + 64 + ks * 32 + q * 8);
#pragma unroll
            for (int nt = 0; nt < 4; ++nt) {
                const bf16x8 fw = *(const bf16x8*)(W2T + (size_t)(cb + nt * 16 + r) * 64 + ks * 32 + q * 8);
                const bf16x8 fa = *(const bf16x8*)(A2T + (size_t)(cb + nt * 16 + r) * 64 + ks * 32 + q * 8);
                aw[nt] = __builtin_amdgcn_mfma_f32_16x16x32_bf16(fw, bw, aw[nt], 0, 0, 0);
                aa[nt] = __builtin_amdgcn_mfma_f32_16x16x32_bf16(fa, ba, aa[nt], 0, 0, 0);
            }
        }
#pragma unroll
        for (int ks = 0; ks < 4; ++ks) {
            const bf16x8 bg = *(const bf16x8*)(act + r * ACT_LD + 128 + ks * 32 + q * 8);
#pragma unroll
            for (int nt = 0; nt < 4; ++nt) {
                const bf16x8 fg = *(const bf16x8*)(G2T + (size_t)(cb + nt * 16 + r) * 128 + ks * 32 + q * 8);
                ag[nt] = __builtin_amdgcn_mfma_f32_16x16x32_bf16(fg, bg, ag[nt], 0, 0, 0);
            }
        }
        const int row = R0 + r;
        float ssq = 0.f, bon = 0.f;
        f32x4 kkraw[4], av[4];
#pragma unroll
        for (int nt = 0; nt < 4; ++nt) {
            const int c = cb + nt * 16 + q * 4;
            const f32x4 rr = *(const f32x4*)(zs + r * ZS_LD + c), kx = *(const f32x4*)(zs + r * ZS_LD + 512 + c), vv = *(const f32x4*)(zs + r * ZS_LD + 1024 + c);
            const f32x4 w04 = *(const f32x4*)(w0 + c), a04 = *(const f32x4*)(a0 + c), kk4 = *(const f32x4*)(k_k + c), ka4 = *(const f32x4*)(k_a + c), rk4 = *(const f32x4*)(r_k + c);
            f32x4 dec, a, kp;
#pragma unroll
            for (int j = 0; j < 4; ++j) {
                const float wl = w04[j] + aw[nt][j];
                const float sp = fmaxf(-wl, 0.f) + __logf(1.f + __expf(-fabsf(wl)));
                const float wlog = -sp - 0.5f;
                dec[j] = __expf(-__expf(wlog));
                a[j] = sigm(a04[j] + aa[nt][j]);
                kkraw[nt][j] = kx[j] * kk4[j];
                kp[j] = kx[j] * (1.f + (a[j] - 1.f) * ka4[j]);
                ssq += kkraw[nt][j] * kkraw[nt][j];
                bon += rr[j] * kp[j] * rk4[j];
            }
            av[nt] = a;
            float* ob = OPS + ((size_t)row * 8 + wave) * 384 + nt * 16 + q * 4;
            *(f32x4*)(ob) = rr; *(f32x4*)(ob + 64) = dec; *(f32x4*)(ob + 128) = kp; *(f32x4*)(ob + 192) = vv;
            *(f32x4*)(GATE + (size_t)row * 512 + c) = ag[nt];
        }
        ssq += __shfl_xor(ssq, 16); ssq += __shfl_xor(ssq, 32);
        bon += __shfl_xor(bon, 16); bon += __shfl_xor(bon, 32);
        const float rn = rsqrtf(fmaxf(ssq, 1e-12f));
#pragma unroll
        for (int nt = 0; nt < 4; ++nt) {
            float* ob = OPS + ((size_t)row * 8 + wave) * 384 + nt * 16 + q * 4;
            const f32x4 kk = kkraw[nt] * rn;
            *(f32x4*)(ob + 256) = kk; *(f32x4*)(ob + 320) = kk * av[nt];
        }
        if (q == 0) BONUS[(size_t)row * 8 + wave] = bon;
        }
        if (pfa == 0x7fc17fc1u && pfb == 0x7fc27fc2u) zs[0] = 1.f;
    }
}

__device__ __forceinline__ void rwkv_item(const Params& p, int i, int s, int h, int rg, unsigned char* smem) {
    const int tid = mk_ltid(), lane = tid & 63, wave = __builtin_amdgcn_readfirstlane(tid >> 6);
    int row0, L; seq_info(s, row0, L);
    const float* OPS = (const float*)(p.ws + WS_OPS); float* ORAW = (float*)(p.ws + WS_ORAW);
    float* buf = (float*)smem;
    const int rih = rg * 16 + (wave & 3) * 4 + (lane >> 4);
    const int c4 = (lane & 15) * 4;
    f32x4 S = (f32x4){0.f, 0.f, 0.f, 0.f};
    if (s >= 8 && wave < 4) S = *(const f32x4*)(p.in[3] + ((((size_t)i * 128 + (s - 8)) * 8 + h) * 64 + rih) * 64 + c4);
    f32x4 pre[6];
    const int nch = (L + 31) / 32;
#pragma unroll
    for (int k = 0; k < 6; ++k) { const int idx4 = tid + k * 512; const int tt = idx4 / 96, off = idx4 % 96;
        pre[k] = (tt < L) ? *(const f32x4*)(OPS + ((size_t)(row0 + tt) * 8 + h) * 384 + off * 4) : (f32x4){0.f, 0.f, 0.f, 0.f}; }
    for (int ch = 0; ch < nch; ++ch) {
        const int t0 = ch * 32;
        __syncthreads();
#pragma unroll
        for (int k = 0; k < 6; ++k) { const int idx4 = tid + k * 512; *(f32x4*)(buf + idx4 * 4) = pre[k]; }
        __syncthreads();
        if (ch + 1 < nch) {
#pragma unroll
            for (int k = 0; k < 6; ++k) { const int idx4 = tid + k * 512; const int tt = t0 + 32 + idx4 / 96, off = idx4 % 96;
                pre[k] = (tt < L) ? *(const f32x4*)(OPS + ((size_t)(row0 + tt) * 8 + h) * 384 + off * 4) : (f32x4){0.f, 0.f, 0.f, 0.f}; }
        }
        if (wave < 4) {
            const int ns = (L - t0) < 32 ? (L - t0) : 32;
            f32x4 r4 = *(const f32x4*)(buf + c4), w4 = *(const f32x4*)(buf + 64 + c4), k4 = *(const f32x4*)(buf + 128 + c4);
            f32x4 kk4 = *(const f32x4*)(buf + 256 + c4), ka4 = *(const f32x4*)(buf + 320 + c4);
            float vv = buf[192 + rih];
            float* op = ORAW + (size_t)(row0 + t0) * 512 + h * 64 + rih;
            f32x4 rprev = r4;
#pragma unroll 2
            for (int tt = 0; tt < ns; ++tt) {
                const float* nb = buf + ((tt + 1 < 32) ? (tt + 1) : 31) * 384;
                const f32x4 r4n = *(const f32x4*)(nb + c4), w4n = *(const f32x4*)(nb + 64 + c4), k4n = *(const f32x4*)(nb + 128 + c4);
                const f32x4 kk4n = *(const f32x4*)(nb + 256 + c4), ka4n = *(const f32x4*)(nb + 320 + c4);
                const float vvn = nb[192 + rih];
                float o = (S[0] * rprev[0] + S[1] * rprev[1]) + (S[2] * rprev[2] + S[3] * rprev[3]);
                const f32x4 kv = k4 * vv;
                float sk = (S[0] * kk4[0] + S[1] * kk4[1]) + (S[2] * kk4[2] + S[3] * kk4[3]);
                sk = row16_sum(sk);
                o = row16_sum(o);
                const f32x4 t1 = kv - ka4 * sk;
                S = S * w4 + t1;
                if ((lane & 15) == 0 && tt > 0) op[(size_t)(tt - 1) * 512] = o;
                rprev = r4;
                r4 = r4n; w4 = w4n; k4 = k4n; kk4 = kk4n; ka4 = ka4n; vv = vvn;
            }
            {
                float o = (S[0] * rprev[0] + S[1] * rprev[1]) + (S[2] * rprev[2] + S[3] * rprev[3]);
                o = row16_sum(o);
                if ((lane & 15) == 0) op[(size_t)(ns - 1) * 512] = o;
            }
        }
    }
    if (wave < 4) {
        float* so = (s < 8) ? p.out + O_PRWKV + ((((size_t)i * 8 + s) * 8 + h) * 64 + rih) * 64 + c4
                            : p.out + O_SRWKV + ((((size_t)i * 128 + (s - 8)) * 8 + h) * 64 + rih) * 64 + c4;
        *(f32x4*)so = S;
    }
}

__device__ __forceinline__ void rwkv_item2(const Params& p, int i, int s, int h, int rg, unsigned char* smem) {
    const int tid = mk_ltid(), lane = tid & 63, wave = __builtin_amdgcn_readfirstlane(tid >> 6);
    int row0, L; seq_info(s, row0, L);
    const float* OPS = (const float*)(p.ws + WS_OPS); float* ORAW = (float*)(p.ws + WS_ORAW);
    float* buf = (float*)smem;
    const int ra = rg * 32 + (wave & 3) * 4 + (lane >> 4), rb = ra + 16;
    const int c4 = (lane & 15) * 4;
    f32x4 Sa = (f32x4){0.f, 0.f, 0.f, 0.f}, Sb = Sa;
    if (s >= 8 && wave < 4) { const float* sp = p.in[3] + (((size_t)i * 128 + (s - 8)) * 8 + h) * 4096;
        Sa = *(const f32x4*)(sp + ra * 64 + c4); Sb = *(const f32x4*)(sp + rb * 64 + c4); }
    f32x4 pre[12];
    const int nch = (L + 63) / 64;
#pragma unroll
    for (int k = 0; k < 12; ++k) { const int idx4 = tid + k * 512; const int tt = idx4 / 96, off = idx4 % 96;
        pre[k] = (tt < L) ? *(const f32x4*)(OPS + ((size_t)(row0 + tt) * 8 + h) * 384 + off * 4) : (f32x4){0.f, 0.f, 0.f, 0.f}; }
    for (int ch = 0; ch < nch; ++ch) {
        const int t0 = ch * 64;
        __syncthreads();
#pragma unroll
        for (int k = 0; k < 12; ++k) { const int idx4 = tid + k * 512; *(f32x4*)(buf + idx4 * 4) = pre[k]; }
        __syncthreads();
        if (ch + 1 < nch) {
#pragma unroll
            for (int k = 0; k < 12; ++k) { const int idx4 = tid + k * 512; const int tt = t0 + 64 + idx4 / 96, off = idx4 % 96;
                pre[k] = (tt < L) ? *(const f32x4*)(OPS + ((size_t)(row0 + tt) * 8 + h) * 384 + off * 4) : (f32x4){0.f, 0.f, 0.f, 0.f}; }
        }
        if (wave < 4) {
            const int ns = (L - t0) < 64 ? (L - t0) : 64;
            f32x4 rA = *(const f32x4*)(buf + c4), wA = *(const f32x4*)(buf + 64 + c4), kA = *(const f32x4*)(buf + 128 + c4);
            f32x4 kkA = *(const f32x4*)(buf + 256 + c4), kaA = *(const f32x4*)(buf + 320 + c4);
            float vaA = buf[192 + ra], vbA = buf[192 + rb];
            f32x4 rB, wB, kB, kkB, kaB; float vaB, vbB;
            float* op = ORAW + (size_t)(row0 + t0) * 512 + h * 64 + ra;
            f32x4 rprev = rA;
#define RW_LOAD(R, W, K, KK, KA, VA, VB, nb_) do { const float* nb = (nb_); R = *(const f32x4*)(nb + c4); W = *(const f32x4*)(nb + 64 + c4); K = *(const f32x4*)(nb + 128 + c4); \
                KK = *(const f32x4*)(nb + 256 + c4); KA = *(const f32x4*)(nb + 320 + c4); VA = nb[192 + ra]; VB = nb[192 + rb]; } while (0)
#define RW_STEP(R, W, K, KK, KA, VA, VB, RP, tt_) do { \
                float oa = (Sa[0] * RP[0] + Sa[1] * RP[1]) + (Sa[2] * RP[2] + Sa[3] * RP[3]); \
                float ob = (Sb[0] * RP[0] + Sb[1] * RP[1]) + (Sb[2] * RP[2] + Sb[3] * RP[3]); \
                float ska = (Sa[0] * KK[0] + Sa[1] * KK[1]) + (Sa[2] * KK[2] + Sa[3] * KK[3]); \
                float skb = (Sb[0] * KK[0] + Sb[1] * KK[1]) + (Sb[2] * KK[2] + Sb[3] * KK[3]); \
                ska = row16_sum(ska); skb = row16_sum(skb); oa = row16_sum(oa); ob = row16_sum(ob); \
                Sa = Sa * W + (K * VA - KA * ska); Sb = Sb * W + (K * VB - KA * skb); \
                if ((lane & 15) == 0 && (tt_) > 0) { op[(size_t)((tt_) - 1) * 512] = oa; op[(size_t)((tt_) - 1) * 512 + 16] = ob; } } while (0)
            for (int tt = 0; tt < ns; tt += 2) {
                RW_LOAD(rB, wB, kB, kkB, kaB, vaB, vbB, buf + (tt + 1) * 384);
                RW_STEP(rA, wA, kA, kkA, kaA, vaA, vbA, rprev, tt);
                const f32x4 rEven = rA;
                RW_LOAD(rA, wA, kA, kkA, kaA, vaA, vbA, buf + ((tt + 2 < 64) ? (tt + 2) : 63) * 384);
                RW_STEP(rB, wB, kB, kkB, kaB, vaB, vbB, rEven, tt + 1);
                rprev = rB;
            }
            {
                float oa = (Sa[0] * rprev[0] + Sa[1] * rprev[1]) + (Sa[2] * rprev[2] + Sa[3] * rprev[3]);
                float ob = (Sb[0] * rprev[0] + Sb[1] * rprev[1]) + (Sb[2] * rprev[2] + Sb[3] * rprev[3]);
                oa = row16_sum(oa); ob = row16_sum(ob);
                if ((lane & 15) == 0) { op[(size_t)(ns - 1) * 512] = oa; op[(size_t)(ns - 1) * 512 + 16] = ob; }
            }
#undef RW_LOAD
#undef RW_STEP
        }
    }
    if (wave < 4) {
        float* so = (s < 8) ? p.out + O_PRWKV + (((size_t)i * 8 + s) * 8 + h) * 4096 : p.out + O_SRWKV + (((size_t)i * 128 + (s - 8)) * 8 + h) * 4096;
        *(f32x4*)(so + ra * 64 + c4) = Sa; *(f32x4*)(so + rb * 64 + c4) = Sb;
    }
}

__device__ __forceinline__ void ret_item(const Params& p, int i, int s, int hb, unsigned char* smem) {
    const int tid = mk_ltid(), lane = tid & 63, w = __builtin_amdgcn_readfirstlane(tid >> 6);
    const int r = lane & 15, q = lane >> 4;
    int row0, L; seq_info(s, row0, L);
    const int C = (s < 8) ? 128 : 4; const int nch = L / C;
    const float lg = log2f(1.0f - exp2f(-5.0f - (float)hb));
    const bf16_t* ZB = (const bf16_t*)(p.ws + WS_ZB); const bf16_t* RQ = (const bf16_t*)(p.ws + WS_RQ); const bf16_t* RK = (const bf16_t*)(p.ws + WS_RK);
    bf16_t* OMIX = (bf16_t*)(p.ws + WS_OMIX);
    const float* gn_g = p.in[25] + i * 512 + hb * 128; const float* gn_b = p.in[26] + i * 512 + hb * 128;
    constexpr int LD = 136;
    bf16_t* KC = (bf16_t*)smem; bf16_t* KZT = KC + 128 * LD; bf16_t* VT = KZT + 128 * LD; bf16_t* SB = VT + 128 * LD;
    f32x4 ST[8];
#pragma unroll
    for (int nt = 0; nt < 8; ++nt) ST[nt] = (f32x4){0.f, 0.f, 0.f, 0.f};
    if (s >= 8) {
        const float* S0 = p.in[4] + (((size_t)i * 128 + (s - 8)) * 4 + hb) * 16384;
#pragma unroll
        for (int nt = 0; nt < 8; ++nt) ST[nt] = *(const f32x4*)(S0 + (size_t)(nt * 16 + r) * 128 + 16 * w + q * 4);
    }
    const float gch = exp2f((float)C * lg);
    for (int ch = 0; ch < nch; ++ch) {
        const int rb = row0 + ch * C;
        __syncthreads();
        for (int idx = tid; idx < 128 * 16; idx += 512) {
            const int tok = idx & 127, c8 = (idx >> 7) * 8;
            u32x4 kv = (u32x4){0u, 0u, 0u, 0u}, vv = kv;
            if (tok < C) { kv = *(const u32x4*)(RK + (size_t)(rb + tok) * 512 + hb * 128 + c8);
                           vv = *(const u32x4*)(ZB + (size_t)(rb + tok) * AB_N + 1792 + 1024 + hb * 128 + c8); }
            *(u32x4*)(KC + tok * LD + c8) = kv;
            const float zeta = __builtin_amdgcn_exp2f((float)(C - 1 - tok) * lg);
            const unsigned kw[4] = {kv.x, kv.y, kv.z, kv.w}; const unsigned vw[4] = {vv.x, vv.y, vv.z, vv.w};
#pragma unroll
            for (int e = 0; e < 4; ++e) {
                const float k0 = __uint_as_float(kw[e] << 16) * zeta, k1 = __uint_as_float(kw[e] & 0xffff0000u) * zeta;
                KZT[(c8 + 2 * e) * LD + tok] = f2bf(k0); KZT[(c8 + 2 * e + 1) * LD + tok] = f2bf(k1);
                VT[(c8 + 2 * e) * LD + tok] = (bf16_t)(vw[e] & 0xffffu); VT[(c8 + 2 * e + 1) * LD + tok] = (bf16_t)(vw[e] >> 16);
            }
        }
#pragma unroll
        for (int nt = 0; nt < 8; ++nt)
#pragma unroll
            for (int j = 0; j < 4; ++j) SB[(16 * w + q * 4 + j) * LD + nt * 16 + r] = f2bf(ST[nt][j]);
        __syncthreads();
        bf16x8 aq[4];
#pragma unroll
        for (int ks = 0; ks < 4; ++ks) {
            if (16 * w + r < C) aq[ks] = *(const bf16x8*)(RQ + (size_t)(rb + 16 * w + r) * 512 + hb * 128 + ks * 32 + q * 8);
            else aq[ks] = (bf16x8){0, 0, 0, 0, 0, 0, 0, 0};
        }
        u32x2 P[8]; f32x4 O[8];
#pragma unroll
        for (int nt = 0; nt < 8; ++nt) {
            f32x4 acc = (f32x4){0.f, 0.f, 0.f, 0.f}, oc = acc;
#pragma unroll
            for (int ks = 0; ks < 4; ++ks) {
                const bf16x8 bk = *(const bf16x8*)(KC + (nt * 16 + r) * LD + ks * 32 + q * 8);
                const bf16x8 bs = *(const bf16x8*)(SB + (nt * 16 + r) * LD + ks * 32 + q * 8);
                acc = __builtin_amdgcn_mfma_f32_16x16x32_bf16(aq[ks], bk, acc, 0, 0, 0);
                oc = __builtin_amdgcn_mfma_f32_16x16x32_bf16(aq[ks], bs, oc, 0, 0, 0);
            }
#pragma unroll
            for (int j = 0; j < 4; ++j) {
                const int ii = 16 * w + q * 4 + j, jt = nt * 16 + r;
                acc[j] = (ii >= jt) ? acc[j] * __builtin_amdgcn_exp2f((float)(ii - jt) * lg) : 0.f;
                oc[j] *= __builtin_amdgcn_exp2f((float)(ii + 1) * lg);
            }
            P[nt].x = pk2(acc[0], acc[1]); P[nt].y = pk2(acc[2], acc[3]); O[nt] = oc;
        }
        __syncthreads();
#pragma unroll
        for (int nt = 0; nt < 8; ++nt)
#pragma unroll
            for (int j = 0; j < 4; ++j) KC[(16 * w + q * 4 + j) * LD + nt * 16 + r] = (bf16_t)(((j & 2) ? P[nt].y : P[nt].x) >> ((j & 1) * 16));
        __syncthreads();
#pragma unroll
        for (int nt = 0; nt < 8; ++nt) ST[nt] = ST[nt] * gch;
#pragma unroll
        for (int ks = 0; ks < 4; ++ks) {
            const bf16x8 ap = *(const bf16x8*)(KC + (16 * w + r) * LD + ks * 32 + q * 8);
            const bf16x8 av = *(const bf16x8*)(VT + (16 * w + r) * LD + ks * 32 + q * 8);
#pragma unroll
            for (int nt = 0; nt < 8; ++nt) {
                const bf16x8 bv = *(const bf16x8*)(VT + (nt * 16 + r) * LD + ks * 32 + q * 8);
                const bf16x8 bz = *(const bf16x8*)(KZT + (nt * 16 + r) * LD + ks * 32 + q * 8);
                O[nt] = __builtin_amdgcn_mfma_f32_16x16x32_bf16(ap, bv, O[nt], 0, 0, 0);
                ST[nt] = __builtin_amdgcn_mfma_f32_16x16x32_bf16(av, bz, ST[nt], 0, 0, 0);
            }
        }
#pragma unroll
        for (int j = 0; j < 4; ++j) {
            float s1 = 0.f;
#pragma unroll
            for (int nt = 0; nt < 8; ++nt) s1 += O[nt][j];
            s1 = row16_sum(s1); const float mean = s1 * (1.f / 128.f);
            float s2 = 0.f;
#pragma unroll
            for (int nt = 0; nt < 8; ++nt) { const float d = O[nt][j] - mean; s2 += d * d; }
            s2 = row16_sum(s2); const float rstd = rsqrtf(s2 * (1.f / 128.f) + 1e-5f);
            const int ii = 16 * w + q * 4 + j;
            if (ii < C) {
                const size_t row = (size_t)(rb + ii);
#pragma unroll
                for (int nt = 0; nt < 8; ++nt) { const int dv = nt * 16 + r;
                    const float val = (O[nt][j] - mean) * rstd * gn_g[dv] + gn_b[dv];
                    const float gr = bf2f(ZB[row * AB_N + 1792 + 1536 + hb * 128 + dv]);
                    OMIX[row * 1024 + 512 + hb * 128 + dv] = f2bf(val * silu(gr)); }
            }
        }
    }
    float* so = (s < 8) ? p.out + O_PRET + (((size_t)i * 8 + s) * 4 + hb) * 16384 : p.out + O_SRET + (((size_t)i * 128 + (s - 8)) * 4 + hb) * 16384;
#pragma unroll
    for (int nt = 0; nt < 8; ++nt) *(f32x4*)(so + (size_t)(nt * 16 + r) * 128 + 16 * w + q * 4) = ST[nt];
}

__device__ __forceinline__ void phase_ab_core(const Params& p, int i, int l, unsigned char* smem) {
    const int bid = mk_lbid(), G = gridDim.x; const int wv = mk_ltid() >> 6;
    if (G == 256) {
        if (bid < 128) rwkv_item2(p, i, bid >> 4, (bid >> 1) & 7, bid & 1, smem);
        else if (bid < 160) ret_item(p, i, (bid - 128) >> 2, (bid - 128) & 3, smem);
        else {
            for (int it = bid - 160; it < 128 * 16; it += 96) rwkv_item2(p, i, 8 + (it >> 4), (it >> 1) & 7, it & 1, smem);
            __syncthreads();
            for (int it = bid - 160; it < 128 * 4; it += 96) ret_item(p, i, 8 + (it >> 2), it & 3, smem);
        }
        if (bid >= 160) convert_ffn_ahead(p, l, (bid - 160) * 8 + wv, 96 * 8, smem);
    } else {
        for (int it = bid; it < 136 * 16; it += G) rwkv_item2(p, i, it >> 4, (it >> 1) & 7, it & 1, smem);
        __syncthreads();
        for (int it = bid; it < 136 * 4; it += G) ret_item(p, i, it >> 2, it & 3, smem);
        convert_ffn_ahead(p, l, bid * 8 + wv, G * 8, smem);
    }
}

__device__ __forceinline__ void phase_ab_post(const Params& p, int i) {
    const int tid = mk_ltid(), lane = tid & 63, wave = tid >> 6;
    const int gw = mk_lbid() * 8 + wave, NGW = gridDim.x * 8;
    const float* OPS = (const float*)(p.ws + WS_OPS); const float* ORAW = (const float*)(p.ws + WS_ORAW);
    const float* GATE = (const float*)(p.ws + WS_GATE); const float* BONUS = (const float*)(p.ws + WS_BONUS);
    bf16_t* OMIX = (bf16_t*)(p.ws + WS_OMIX);
    const float* gg = p.in[23] + i * 512; const float* gb = p.in[24] + i * 512;
    for (int m = gw; m < M; m += NGW) {
        const int c = lane * 8, h = lane >> 3, hc = c & 63;
        const f32x4 o0 = *(const f32x4*)(ORAW + (size_t)m * 512 + c), o1 = *(const f32x4*)(ORAW + (size_t)m * 512 + c + 4);
        float s1 = (o0[0] + o0[1]) + (o0[2] + o0[3]) + (o1[0] + o1[1]) + (o1[2] + o1[3]);
        s1 += __shfl_xor(s1, 1); s1 += __shfl_xor(s1, 2); s1 += __shfl_xor(s1, 4);
        const float mean = s1 * (1.f / 64.f);
        const f32x4 d0 = o0 - mean, d1 = o1 - mean;
        float s2 = (d0[0] * d0[0] + d0[1] * d0[1]) + (d0[2] * d0[2] + d0[3] * d0[3]) + (d1[0] * d1[0] + d1[1] * d1[1]) + (d1[2] * d1[2] + d1[3] * d1[3]);
        s2 += __shfl_xor(s2, 1); s2 += __shfl_xor(s2, 2); s2 += __shfl_xor(s2, 4);
        const float rstd = rsqrtf(s2 * (1.f / 64.f) + 64e-5f);
        const float bon = BONUS[(size_t)m * 8 + h];
        const float* vb = OPS + ((size_t)m * 8 + h) * 384 + 192 + hc;
        const f32x4 v0 = *(const f32x4*)vb, v1 = *(const f32x4*)(vb + 4);
        const f32x4 g0 = *(const f32x4*)(gg + c), g1 = *(const f32x4*)(gg + c + 4), b0 = *(const f32x4*)(gb + c), b1 = *(const f32x4*)(gb + c + 4);
        const f32x4 t0 = *(const f32x4*)(GATE + (size_t)m * 512 + c), t1 = *(const f32x4*)(GATE + (size_t)m * 512 + c + 4);
        const f32x4 y0 = (d0 * rstd * g0 + b0 + v0 * bon) * t0, y1 = (d1 * rstd * g1 + b1 + v1 * bon) * t1;
        u32x4 o; o.x = pk2(y0[0], y0[1]); o.y = pk2(y0[2], y0[3]); o.z = pk2(y1[0], y1[1]); o.w = pk2(y1[2], y1[3]);
        *(u32x4*)(OMIX + (size_t)m * 1024 + c) = o;
    }
}

__device__ __forceinline__ int gdn_item_index(int s, int h, int c) { return (s < 8) ? ((s * 8 + h) * 32 + c) : (2048 + (s - 8) * 8 + h); }

__device__ __forceinline__ void gdn_chunk_item(const Params& p, int i, int s, int h, int c, int pf_row, int pf_h, unsigned char* smem) {
    const int tid = mk_ltid(), lane = tid & 63, w = __builtin_amdgcn_readfirstlane(tid >> 6);
    const int r = lane & 15, q = lane >> 4;
    int row0, L; seq_info(s, row0, L);
    const int t0 = c * 64; const int nvalid = (L - t0) < 64 ? (L - t0) : 64;
    const bf16_t* ZB = (const bf16_t*)(p.ws + WS_ZB);
    unsigned char* rec = p.ws + WS_CH + (size_t)gdn_item_index(s, h, c) * CH_BYTES;
    float* U = (float*)(rec + CH_U); bf16_t* Wd = (bf16_t*)(rec + CH_W); bf16_t* QG = (bf16_t*)(rec + CH_QG); bf16_t* QK = (bf16_t*)(rec + CH_QK); bf16_t* KDT = (bf16_t*)(rec + CH_KDT);
    constexpr int LD = 132, ALD = 68;
    float* qs = (float*)smem; float* ks = qs + 64 * LD; float* vs = ks + 64 * LD; float* As = vs + 64 * LD;
    float* AT = As + 64 * ALD; float* gcs = AT + 64 * ALD; float* bes = gcs + 64;
    unsigned short pfv = 0;
    if (pf_row >= 0 && tid < 384) { const int rr_ = tid / 6, pp_ = (tid % 6) >> 1, hh_ = tid & 1;
        pfv = ((const bf16_t*)(p.ws + WS_ZB))[(size_t)(pf_row + rr_) * GD_N + pp_ * 1024 + pf_h * 128 + hh_ * 64]; }
#ifndef REP_G_CONV
#define REP_G_CONV 1
#endif
#ifndef REP_G_MFMA
#define REP_G_MFMA 1
#endif
#ifndef REP_G_QG
#define REP_G_QG 1
#endif
#ifndef REP_G_SUB
#define REP_G_SUB 1
#endif
#pragma unroll 1
    for (int rp_ = 0; rp_ < REP_G_CONV; ++rp_) {
    __syncthreads();
    if (tid < 384) {
        const int part = tid >> 7, ch = tid & 127; const int zc = part * 1024 + h * 128 + ch;
        const float* cw = p.in[28] + (size_t)i * 4 * 3072 + zc;
        const float cw0 = cw[0], cw1 = cw[3072], cw2 = cw[2 * 3072], cw3 = cw[3 * 3072];
        float* dst = (part == 0 ? qs : part == 1 ? ks : vs) + ch;
        if (nvalid == 64) {
            float xh[3], xn[64];
#pragma unroll
            for (int j = 0; j < 3; ++j) { const int t = t0 - 3 + j;
                xh[j] = (t >= 0) ? bf2f(ZB[(size_t)(row0 + (t >= 0 ? t : 0)) * GD_N + zc]) : 0.f; }
#pragma unroll
            for (int e = 0; e < 64; ++e) xn[e] = bf2f(ZB[(size_t)(row0 + t0 + e) * GD_N + zc]);
            float x3 = xh[0], x2 = xh[1], x1 = xh[2];
#pragma unroll
            for (int e = 0; e < 64; ++e) {
                const float y = cw0 * x3 + cw1 * x2 + cw2 * x1 + cw3 * xn[e];
                dst[e * LD] = silu(y);
                x3 = x2; x2 = x1; x1 = xn[e];
            }
        } else {
            float x3, x2, x1;
            { const float* cs = p.in[5] + (((size_t)i * 128 + (s - 8)) * 3) * 3072 + zc; x3 = cs[0]; x2 = cs[3072]; x1 = cs[2 * 3072]; }
#pragma unroll
            for (int e = 0; e < 64; ++e) {
                float v = 0.f;
                if (e < 4) { const float xe = (e < nvalid) ? bf2f(ZB[(size_t)(row0 + e) * GD_N + zc]) : 0.f;
                    const float y = cw0 * x3 + cw1 * x2 + cw2 * x1 + cw3 * xe; v = (e < nvalid) ? silu(y) : 0.f; x3 = x2; x2 = x1; x1 = xe; }
                dst[e * LD] = v;
            }
        }
    } else if (tid < 448) {
        const int t = tid - 384;
        float be = 0.f, g = 0.f;
        if (t < nvalid) { const size_t zr = (size_t)(row0 + t0 + t) * GD_N;
            be = sigm(bf2f(ZB[zr + 3072 + h]));
            const float a = bf2f(ZB[zr + 3080 + h]) + p.in[30][i * 8 + h];
            const float sp = fmaxf(a, 0.f) + __logf(1.f + __expf(-fabsf(a)));
            g = -__expf(p.in[29][i * 8 + h]) * sp; }
#pragma unroll
        for (int o = 1; o < 64; o <<= 1) { const float y = __shfl_up(g, o); if (t >= o) g += y; }
        gcs[t] = g; bes[t] = be;
    }
    }
    __syncthreads();
    for (int pass = 0; pass < 4; ++pass) {
        const int rowi = w * 16 + pass * 4 + q;
        const int t = rowi & 63;
        if ((w * 16 + pass * 4) % 64 < nvalid) {
            float* base = ((rowi < 64) ? qs : ks) + t * LD + r * 8;
            f32x4 a = *(f32x4*)base, b = *(f32x4*)(base + 4);
            float ss = (a[0] * a[0] + a[1] * a[1]) + (a[2] * a[2] + a[3] * a[3]) + (b[0] * b[0] + b[1] * b[1]) + (b[2] * b[2] + b[3] * b[3]);
            ss = row16_sum(ss);
            const float rn = rsqrtf(fmaxf(ss, 1e-12f));
            *(f32x4*)base = a * rn; *(f32x4*)(base + 4) = b * rn;
        }
    }
    __syncthreads();
#pragma unroll 1
    for (int rp_ = 0; rp_ < REP_G_MFMA; ++rp_)
#pragma unroll
    for (int tl = 0; tl < 2; ++tl) {
        const int tile = 2 * w + tl, mi = tile >> 2, ni = tile & 3;
        f32x4 akk = (f32x4){0.f, 0.f, 0.f, 0.f}, aqk = akk;
        if (mi * 16 < nvalid) {
#pragma unroll 8
            for (int k0 = 0; k0 < 128; k0 += 4) {
                const float ka = ks[(mi * 16 + r) * LD + k0 + q], kb = ks[(ni * 16 + r) * LD + k0 + q], qa = qs[(mi * 16 + r) * LD + k0 + q];
                akk = __builtin_amdgcn_mfma_f32_16x16x4f32(ka, kb, akk, 0, 0, 0);
                aqk = __builtin_amdgcn_mfma_f32_16x16x4f32(qa, kb, aqk, 0, 0, 0);
            }
        }
#pragma unroll
        for (int j = 0; j < 4; ++j) { const int ii = mi * 16 + q * 4 + j, jj = ni * 16 + r;
            const float dm = (ii >= jj) ? __expf(gcs[ii] - gcs[jj]) : 0.f;
            const float aij = (ii > jj) ? bes[ii] * akk[j] * dm : 0.f;
            As[ii * ALD + jj] = aij; AT[jj * ALD + ii] = aij;
            if (mi * 16 < nvalid) QK[ii * 64 + jj] = f2bf(aqk[j] * 0.08838834764831845f * dm); }
    }
    __syncthreads();
#pragma unroll 1
    for (int rp_ = 0; rp_ < REP_G_QG; ++rp_)
    {
        const float gl = gcs[63];
        const int nrow = (nvalid == 64) ? 64 : 16;
        for (int idx = tid; idx < nrow * 128; idx += 512) { const int t = idx >> 7, d = idx & 127;
            QG[idx] = f2bf(qs[t * LD + d] * 0.08838834764831845f * __expf(gcs[t])); }
        if (nvalid == 64) {
            for (int idx = tid; idx < 64 * 128; idx += 512) { const int d = idx >> 6, t = idx & 63;
                KDT[idx] = f2bf(ks[t * LD + d] * __expf(gl - gcs[t])); }
        } else {
            for (int idx = tid; idx < 16 * 128; idx += 512) { const int d = idx >> 4, t = idx & 15;
                KDT[d * 64 + t] = f2bf(ks[t * LD + d] * __expf(gl - gcs[t])); }
        }
        if (tid == 0) ((float*)(p.ws + WS_GL))[gdn_item_index(s, h, c)] = __expf(gl);
    }
    __syncthreads();
    for (int idx = tid; idx < 64 * 128; idx += 512) { const int t = idx >> 7, d = idx & 127; const float be = bes[t];
        vs[t * LD + d] *= be; ks[t * LD + d] *= be * __expf(gcs[t]); }
    __syncthreads();
    const int nblk = (nvalid + 15) >> 4;
#pragma unroll 1
    for (int blk = 0; blk < 4; ++blk) {
        if (blk >= nblk) continue;
        if (blk > 0) {
#pragma unroll
            for (int tl = 0; tl < 2; ++tl) {
                const int nt = 2 * w + tl; float* bb = (nt < 8 ? vs : ks) + (nt & 7) * 16 + r;
                f32x4 acc = (f32x4){0.f, 0.f, 0.f, 0.f};
                const float* ap = As + (blk * 16 + r) * ALD + q;
                for (int k0 = 0; k0 < blk * 16; k0 += 4)
                    acc = __builtin_amdgcn_mfma_f32_16x16x4f32(ap[k0], bb[(k0 + q) * LD], acc, 0, 0, 0);
#pragma unroll
                for (int j = 0; j < 4; ++j) bb[(blk * 16 + q * 4 + j) * LD] -= acc[j];
            }
            __syncthreads();
        }
        if (tid < 256) {
            const int col = tid & 127; const bool isu = tid < 128;
            float* buf = (isu ? vs : ks) + col;
            float acc[16];
#pragma unroll
            for (int e = 0; e < 16; ++e) acc[e] = buf[(blk * 16 + e) * LD];
#pragma unroll
            for (int e = 1; e < 16; ++e) {
#pragma unroll
                for (int f = 0; f < e; ++f) acc[e] -= As[(blk * 16 + e) * ALD + blk * 16 + f] * acc[f];
            }
#pragma unroll
            for (int e = 0; e < 16; ++e) { const int ii = blk * 16 + e; buf[ii * LD] = acc[e];
                if (isu) U[ii * 128 + col] = acc[e]; else Wd[ii * 128 + col] = f2bf(acc[e]); }
        }
        __syncthreads();
    }
    if (pfv == 0x7fc3u) gcs[0] = 1.f;
    asm volatile("s_waitcnt vmcnt(0)" ::: "memory");
    __syncthreads();
}

__device__ __forceinline__ void phase_gdn_chunk(const Params& p, int i, unsigned char* smem) {
    const int n_items = (gridDim.x == 256) ? 2048 : N_CH;
    for (int it = mk_lbid(); it < n_items; it += gridDim.x) {
        int s, h, c;
        if (it < 2048) { s = it >> 8; h = (it >> 5) & 7; c = it & 31; } else { const int k = it - 2048; s = 8 + (k >> 3); h = k & 7; c = 0; }
        const int nit = it + gridDim.x; int pf_row = -1, pf_h = 0;
        if (nit < 2048) { pf_row = (nit >> 8) * 2048 + (nit & 31) * 64; pf_h = (nit >> 5) & 7; }
        gdn_chunk_item(p, i, s, h, c, pf_row, pf_h, smem);
    }
    const bf16_t* ZB = (const bf16_t*)(p.ws + WS_ZB);
    const int gt = mk_lbid() * 512 + mk_ltid(), GT = gridDim.x * 512;
    for (int idx = gt; idx < 136 * 3 * 3072; idx += GT) {
        const int s = idx / (3 * 3072), rem = idx % (3 * 3072), j = rem / 3072, zc = rem % 3072;
        int row0, L; seq_info(s, row0, L);
        const float v = bf2f(ZB[(size_t)(row0 + L - 3 + j) * GD_N + zc]);
        if (s < 8) p.out[O_PCONV + (((size_t)i * 8 + s) * 3 + j) * 3072 + zc] = v;
        else p.out[O_SCONV + (((size_t)i * 128 + (s - 8)) * 3 + j) * 3072 + zc] = v;
    }
}

__device__ __forceinline__ void gdn_scan_item(const Params& p, int i, int s, int h, unsigned char* smem) {
    const int tid = mk_ltid(), lane = tid & 63, w = __builtin_amdgcn_readfirstlane(tid >> 6);
    const int r = lane & 15, q = lane >> 4;
    int row0, L; seq_info(s, row0, L);
    const int nch = (s < 8) ? 32 : 1;
    const bf16_t* ZB = (const bf16_t*)(p.ws + WS_ZB); bf16_t* OMIX = (bf16_t*)(p.ws + WS_OMIX);
    const float* GL = (const float*)(p.ws + WS_GL);
    const float* ng = p.in[31] + i * 128;
    constexpr int LD = 136, VLD = 72, ULD = 132;
    bf16_t* SB = (bf16_t*)smem;
    bf16_t* VN = (bf16_t*)(smem + 34816);
    float* red = (float*)(smem + 53248);
    bf16_t* WL = (bf16_t*)(smem + 53760);
    bf16_t* QGL = (bf16_t*)(smem + 71168);
    bf16_t* QKL = (bf16_t*)(smem + 88576);
    bf16_t* KDL = (bf16_t*)(smem + 97792);
    float* UL = (float*)(smem + 116224);
    f32x4 ST[8];
#pragma unroll
    for (int nt = 0; nt < 8; ++nt) ST[nt] = (f32x4){0.f, 0.f, 0.f, 0.f};
    if (s >= 8) {
        const float* S0 = p.in[6] + (((size_t)i * 128 + (s - 8)) * 8 + h) * 16384;
#pragma unroll
        for (int nt = 0; nt < 8; ++nt) ST[nt] = *(const f32x4*)(S0 + (size_t)(nt * 16 + r) * 128 + 16 * w + q * 4);
    }
    const int mt = w & 3, nh = w >> 2;
    u32x4 pw[2], pq[2], pk, pd[2]; f32x4 pu[4]; float pgl;
    const bool smp = (s >= 8);
#define GDN_PREFETCH(cc) do { const int item_ = gdn_item_index(s, h, (cc)); const unsigned char* rec_ = p.ws + WS_CH + (size_t)item_ * CH_BYTES; \
        const u32x4 z4_ = (u32x4){0u, 0u, 0u, 0u}; \
        _Pragma("unroll") for (int k_ = 0; k_ < 2; ++k_) { const int idx_ = tid + k_ * 512; \
            pw[k_] = (smp && (idx_ >> 4) >= 16) ? z4_ : *(const u32x4*)((const bf16_t*)(rec_ + CH_W) + (idx_ >> 4) * 128 + (idx_ & 15) * 8); \
            pq[k_] = (smp && (idx_ >> 4) >= 16) ? z4_ : *(const u32x4*)((const bf16_t*)(rec_ + CH_QG) + (idx_ >> 4) * 128 + (idx_ & 15) * 8); \
            pd[k_] = (smp && (idx_ & 7) >= 2) ? z4_ : *(const u32x4*)((const bf16_t*)(rec_ + CH_KDT) + (idx_ >> 3) * 64 + (idx_ & 7) * 8); } \
        pk = (smp && (tid >> 3) >= 16) ? z4_ : *(const u32x4*)((const bf16_t*)(rec_ + CH_QK) + (tid >> 3) * 64 + (tid & 7) * 8); \
        _Pragma("unroll") for (int k_ = 0; k_ < 4; ++k_) { const int idx_ = tid + k_ * 512; \
            pu[k_] = (smp && (idx_ >> 5) >= 16) ? (f32x4){0.f, 0.f, 0.f, 0.f} : *(const f32x4*)((const float*)(rec_ + CH_U) + (idx_ >> 5) * 128 + (idx_ & 31) * 4); } \
        pgl = GL[item_]; } while (0)
    GDN_PREFETCH(0);
    for (int c = 0; c < nch; ++c) {
        const float glast = pgl;
        const int rb = row0 + c * 64; const int nvalid = (L - c * 64) < 64 ? (L - c * 64) : 64;
#pragma unroll
        for (int k = 0; k < 2; ++k) { const int idx = tid + k * 512;
            *(u32x4*)(WL + (idx >> 4) * LD + (idx & 15) * 8) = pw[k]; *(u32x4*)(QGL + (idx >> 4) * LD + (idx & 15) * 8) = pq[k];
            *(u32x4*)(KDL + (idx >> 3) * VLD + (idx & 7) * 8) = pd[k]; }
        *(u32x4*)(QKL + (tid >> 3) * VLD + (tid & 7) * 8) = pk;
#pragma unroll
        for (int k = 0; k < 4; ++k) { const int idx = tid + k * 512; *(f32x4*)(UL + (idx >> 5) * ULD + (idx & 31) * 4) = pu[k]; }
#pragma unroll
        for (int nt = 0; nt < 8; ++nt)
#pragma unroll
            for (int j = 0; j < 4; ++j) SB[(16 * w + q * 4 + j) * LD + nt * 16 + r] = f2bf(ST[nt][j]);
        __syncthreads();
        if (c + 1 < nch) GDN_PREFETCH(c + 1);
        bf16_t zgr[4][4];
#pragma unroll
        for (int j = 0; j < 4; ++j) { const int tk = mt * 16 + q * 4 + j; const size_t row = (size_t)(rb + (tk < nvalid ? tk : 0));
#pragma unroll
            for (int n4 = 0; n4 < 4; ++n4) zgr[j][n4] = ZB[row * GD_N + 3088 + h * 128 + (nh * 4 + n4) * 16 + r]; }
        f32x4 aws[4], aqg[4];
#pragma unroll
        for (int n4 = 0; n4 < 4; ++n4) { aws[n4] = (f32x4){0.f, 0.f, 0.f, 0.f}; aqg[n4] = aws[n4]; }
#pragma unroll
        for (int ks = 0; ks < 4; ++ks) {
            const bf16x8 fw = *(const bf16x8*)(WL + (mt * 16 + r) * LD + ks * 32 + q * 8);
            const bf16x8 fq = *(const bf16x8*)(QGL + (mt * 16 + r) * LD + ks * 32 + q * 8);
#pragma unroll
            for (int n4 = 0; n4 < 4; ++n4) {
                const bf16x8 bs = *(const bf16x8*)(SB + ((nh * 4 + n4) * 16 + r) * LD + ks * 32 + q * 8);
                aws[n4] = __builtin_amdgcn_mfma_f32_16x16x32_bf16(fw, bs, aws[n4], 0, 0, 0);
                aqg[n4] = __builtin_amdgcn_mfma_f32_16x16x32_bf16(fq, bs, aqg[n4], 0, 0, 0);
            }
        }
#pragma unroll
        for (int n4 = 0; n4 < 4; ++n4) {
            const int dv = (nh * 4 + n4) * 16 + r;
            float vn[4];
#pragma unroll
            for (int j = 0; j < 4; ++j) vn[j] = UL[(mt * 16 + q * 4 + j) * ULD + dv] - aws[n4][j];
            u32x2 o; o.x = pk2(vn[0], vn[1]); o.y = pk2(vn[2], vn[3]);
            *(u32x2*)(VN + dv * VLD + mt * 16 + q * 4) = o;
        }
        __syncthreads();
#pragma unroll
        for (int ks = 0; ks < 2; ++ks) {
            const bf16x8 fk = *(const bf16x8*)(QKL + (mt * 16 + r) * VLD + ks * 32 + q * 8);
#pragma unroll
            for (int n4 = 0; n4 < 4; ++n4) {
                const bf16x8 bv = *(const bf16x8*)(VN + ((nh * 4 + n4) * 16 + r) * VLD + ks * 32 + q * 8);
                aqg[n4] = __builtin_amdgcn_mfma_f32_16x16x32_bf16(fk, bv, aqg[n4], 0, 0, 0);
            }
        }
        {
            float ssq[4];
#pragma unroll
            for (int j = 0; j < 4; ++j) { float a = 0.f;
#pragma unroll
                for (int n4 = 0; n4 < 4; ++n4) a += aqg[n4][j] * aqg[n4][j];
                ssq[j] = row16_sum(a); }
            if (r == 0) {
#pragma unroll
                for (int j = 0; j < 4; ++j) red[(mt * 16 + q * 4 + j) * 2 + nh] = ssq[j];
            }
        }
#pragma unroll
        for (int nt = 0; nt < 8; ++nt) ST[nt] = ST[nt] * glast;
#pragma unroll
        for (int ks = 0; ks < 2; ++ks) {
            const bf16x8 av = *(const bf16x8*)(VN + (16 * w + r) * VLD + ks * 32 + q * 8);
#pragma unroll
            for (int nt = 0; nt < 8; ++nt) {
                const bf16x8 bk = *(const bf16x8*)(KDL + (nt * 16 + r) * VLD + ks * 32 + q * 8);
                ST[nt] = __builtin_amdgcn_mfma_f32_16x16x32_bf16(av, bk, ST[nt], 0, 0, 0);
            }
        }
        __syncthreads();
#pragma unroll
        for (int j = 0; j < 4; ++j) {
            const int tk = mt * 16 + q * 4 + j;
            if (tk < nvalid) {
                const float rs = rsqrtf((red[tk * 2] + red[tk * 2 + 1]) * (1.f / 128.f) + 1e-6f);
                const size_t row = (size_t)(rb + tk);
#pragma unroll
                for (int n4 = 0; n4 < 4; ++n4) { const int dv = (nh * 4 + n4) * 16 + r;
                    OMIX[row * 1024 + h * 128 + dv] = f2bf(aqg[n4][j] * rs * ng[dv] * silu(bf2f(zgr[j][n4]))); }
            }
        }
    }
#undef GDN_PREFETCH
    float* so = (s < 8) ? p.out + O_PGDN + (((size_t)i * 8 + s) * 8 + h) * 16384 : p.out + O_SGDN + (((size_t)i * 128 + (s - 8)) * 8 + h) * 16384;
#pragma unroll
    for (int nt = 0; nt < 8; ++nt) *(f32x4*)(so + (size_t)(nt * 16 + r) * 128 + 16 * w + q * 4) = ST[nt];
    __syncthreads();
}

__device__ __forceinline__ void phase_gdn_scan(const Params& p, int i, int l, unsigned char* smem) {
    const int bid = mk_lbid(), G = gridDim.x; const int wv = mk_ltid() >> 6;
    if (G == 256) {
        if (bid < 64) gdn_scan_item(p, i, bid >> 3, bid & 7, smem);
        else {
            for (int it = bid - 64; it < 128 * 8; it += 192) { gdn_chunk_item(p, i, 8 + (it >> 3), it & 7, 0, -1, 0, smem); gdn_scan_item(p, i, 8 + (it >> 3), it & 7, smem); }
            convert_ffn_ahead(p, l, (bid - 64) * 8 + wv, 192 * 8, smem);
        }
    } else {
        for (int it = bid; it < 136 * 8; it += G) { const int s = it >> 3, h = it & 7; gdn_scan_item(p, i, s, h, smem); }
        convert_ffn_ahead(p, l, bid * 8 + wv, G * 8, smem);
    }
}

__global__ void __launch_bounds__(512, 2) mega(Params p) {
    extern __shared__ __attribute__((aligned(16))) unsigned char lds[];
    cg::grid_group grid = cg::this_grid();
    constexpr int NPH = 1 + 4 * 12;
    unsigned* bar = (unsigned*)(p.ws + WS_BAR);
    volatile unsigned* bst = (volatile unsigned*)(lds + LDS_BYTES - 16);
    if (mk_ltid() == 0) { bst[0] = 0u; bst[1] = 0u; }
    if (mk_lbid() == 0) for (int u = mk_ltid(); u < XCD_BAR_WORDS; u += 512) __hip_atomic_store(bar + u, 0u, __ATOMIC_RELAXED, __HIP_MEMORY_SCOPE_AGENT);
    __syncthreads();
#pragma unroll 1
    for (int ph = 0; ph < NPH; ++ph) {
        int l = (ph == 0) ? 0 : (ph - 1) / 12, k = (ph == 0) ? -1 : (ph - 1) % 12;
        asm volatile("" : "+s"(l), "+s"(k));
        const int i = l >> 1; const bool ab = (l & 1) == 0;
        if (k == 6 && !ab) continue;
        unsigned char* ws = p.ws; asm volatile("" : "+s"(ws));
        unsigned char* smem = (unsigned char*)lds;
        PG8_LAS unsigned char* ldsp = (PG8_LAS unsigned char*)lds;
        const int G = gridDim.x, cu = mk_lbid();
#ifndef REPMASK
#define REPMASK 0
#endif
#ifndef REPAB
#define REPAB 3
#endif
        const int nrep = (((REPMASK >> (k + 1)) & 1) && ((REPAB >> (l & 1)) & 1)) ? 2 : 1;
#pragma unroll 1
        for (int rep = 0; rep < nrep; ++rep) {
        if (rep) grid.sync();
        if (k == -1) phase_start(p, smem);
        else if (k == 0 || k == 9) {
            const int j = (k == 9);
            pg8::Gemm g{(const bf16_t*)(ws + WS_HB), (const bf16_t*)(ws + WS_WGU) + (size_t)j * 5632 * 1024, M, 5632, D};
            pg8::StaticOrder S; S.init(g.M, g.N, G, cu); EpiSwiglu E{(bf16_t*)(ws + WS_HID)};
            pg8::gemm_phase<EpiSwiglu, pg8::StaticOrder, true, true>(ldsp, g, S, E);
        } else if (k == 1 || k == 10 || k == 7) {
            const int j = (k == 10);
            pg8::Gemm g{(const bf16_t*)(ws + (k == 7 ? WS_OMIX : WS_HID)), k == 7 ? (const bf16_t*)(ws + WS_WOUT) : (const bf16_t*)(ws + WS_WD) + (size_t)j * 1024 * 2816, MP, D, k == 7 ? D : FF};
            pg8::StaticOrder S; S.init(g.M, g.N, G, cu); EpiResid E{(bf16_t*)(ws + WS_X), (const bf16_t*)(ws + WS_HB), k == 7 ? 1.0f : 0.5f};
            pg8::gemm_phase<EpiResid, pg8::StaticOrder, true, true>(ldsp, g, S, E);
            small_resid_gemm(g.A, g.Bt, g.K, E.X, E.H, E.scale, smem);
        } else if (k == 2 || k == 8 || k == 11) {
            phase_ln(p, l, k == 2 ? 0 : (k == 8 ? 1 : 2), (l == 3 && k == 11));
            if (k == 11 && l < 3) convert_items(p, l + 1, 4, mk_lbid() * 8 + (mk_ltid() >> 6), gridDim.x * 8, smem);
        } else if (k == 3) {
            pg8::Gemm g{(const bf16_t*)(ws + WS_HB), (const bf16_t*)(ws + WS_WIN), M, ab ? AB_N : GD_N, D};
            pg8::StaticOrder S; S.init(g.M, g.N, G, cu); EpiZ E{(bf16_t*)(ws + WS_ZB), g.N};
            pg8::gemm_phase<EpiZ, pg8::StaticOrder, true, true>(ldsp, g, S, E);
        } else if (k == 4) { if (ab) phase_ab_prep(p, i, smem); else phase_gdn_chunk(p, i, smem); }
        else if (k == 5) { if (ab) phase_ab_core(p, i, l, smem); else phase_gdn_scan(p, i, l, smem); }
        else if (k == 6) phase_ab_post(p, i);
        }
        if (ph + 1 < NPH) { if (ph == 0) { grid.sync(); if (mk_ltid() == 0) (void)xb_add(&bar[XB_XCNT(xb_xcc_id())], 1u); } else gbar(bar, bst); }
#ifdef REPSYNC
        if (ph > 0) { gbar(bar, bst); gbar(bar, bst); }
#endif
    }
}
}

extern "C" void kernel_launch(void* const* d_in, const int* in_sizes, int n_in, void* d_out, int out_size, void* d_ws, size_t ws_size, hipStream_t stream) {
    static int grid_blocks = 0;
    if (grid_blocks == 0) {
        if (n_in != 33 || ws_size < mk::WS_NEED) { fprintf(stderr, "kernel_launch: need 33 inputs and %zu bytes of workspace; got %d, %zu\n", (size_t)mk::WS_NEED, n_in, ws_size); grid_blocks = -1; return; }
        int dev = 0, cus = 0, per_cu = 0;
        hipGetDevice(&dev);
        hipDeviceGetAttribute(&cus, hipDeviceAttributeMultiprocessorCount, dev);
        if (hipFuncSetAttribute((const void*)mk::mega, hipFuncAttributeMaxDynamicSharedMemorySize, mk::LDS_BYTES) != hipSuccess) { fprintf(stderr, "kernel_launch: hipFuncSetAttribute failed\n"); grid_blocks = -1; return; }
        if (hipOccupancyMaxActiveBlocksPerMultiprocessor(&per_cu, (const void*)mk::mega, 512, mk::LDS_BYTES) != hipSuccess || per_cu < 1) { fprintf(stderr, "kernel_launch: occupancy query failed (%d)\n", per_cu); (void)hipGetLastError(); per_cu = 1; }
        grid_blocks = cus * 1;
        fprintf(stderr, "kernel_launch: grid %d (cus %d, per_cu %d)\n", grid_blocks, cus, per_cu);
    }
    if (grid_blocks < 0) return;
    mk::Params prm{};
    for (int k = 0; k < 33; ++k) prm.in[k] = (const float*)d_in[k];
    prm.out = (float*)d_out; prm.ws = (unsigned char*)d_ws;
    void* args[] = {&prm};
    hipError_t e = hipLaunchCooperativeKernel((const void*)mk::mega, dim3(grid_blocks), dim3(512), args, mk::LDS_BYTES, stream);
    if (e != hipSuccess) fprintf(stderr, "cooperative launch failed: %s (grid %d)\n", hipGetErrorString(e), grid_blocks);
}
```

```cpp
#include <hip/hip_runtime.h>
#include <hip/hip_cooperative_groups.h>
#include <cstdio>
#include <cstdint>
namespace cg = cooperative_groups;
__device__ __forceinline__ int mk_ltid() { int t = threadIdx.x; asm volatile("" : "+v"(t)); return t; }
__device__ __forceinline__ int mk_lbid() { int t = blockIdx.x; asm volatile("" : "+s"(t)); return t; }
namespace pg8 {
#define PG8_LAS __attribute__((address_space(3)))
typedef unsigned short bf16_t;
typedef short bf16x8 __attribute__((ext_vector_type(8)));
typedef float f32x4 __attribute__((ext_vector_type(4)));
typedef unsigned u32x4 __attribute__((ext_vector_type(4)));
constexpr int BM = 256, BK = 64, HALF = 128, HTB = HALF * BK * 2  , STAGE_BYTES = 8 * HTB, NXCD = 8, WGM = 8;

__host__ __device__ __forceinline__ int lds_byte(int r, int c) { const int st = (r >> 4) * 2 + (c >> 5), rr = r & 15, cc = c & 31, ob = rr * 64 + cc * 2; return st * 1024 + (ob ^ (((ob >> 9) & 1) << 5)); }
__host__ __device__ __forceinline__ void stage_rc(int b, int& R, int& C) { const int st = b / 1024, sb = b % 1024, swz = sb ^ (((sb >> 9) & 1) << 5); R = (st >> 1) * 16 + swz / 64; C = (st & 1) * 32 + (swz % 64) / 2; }
__host__ __device__ __forceinline__ int perm32(int rho) { const int n = rho >> 4, i = rho & 15; return 8 * (i >> 2) + 4 * n + (i & 3); }

struct Unit { int pm, pn; };
struct Gemm { const bf16_t* A; const bf16_t* Bt; int M, N, K; };

struct StaticOrder {
    int nM, nN, nwg, G, c;
    __host__ __device__ void init(int M, int N, int G_, int c_) { nM = M / BM; nN = N / BM; nwg = nM * nN; G = G_; c = c_; }
    __host__ __device__ bool next(int i, Unit& u) const {
        const long L = (long)i * G + c; if (L >= nwg) return false;
        int wgid = (int)L; { const int q = nwg / NXCD, r = nwg % NXCD, xcd = wgid % NXCD, off = wgid / NXCD; wgid = (xcd < r ? xcd * (q + 1) : r * (q + 1) + (xcd - r) * q) + off; }
        const int nig = WGM * nN, gid = wgid / nig, fm = gid * WGM, gsz = (nM - fm) < WGM ? (nM - fm) : WGM;
        u.pm = fm + ((wgid % nig) % gsz); u.pn = (wgid % nig) / gsz; return true;
    }
    __device__ __forceinline__ void a_ready(const Unit&) const {}
    __device__ __forceinline__ void done(const Unit&) const {}
};

template <class Epi, class Sched, bool ALIGN_EPI = false, bool SP2 = false>
__device__ __forceinline__ void gemm_phase(PG8_LAS unsigned char* lds, const Gemm g, const Sched& S, const Epi& E) {
    const int tid = mk_ltid(), wid = __builtin_amdgcn_readfirstlane(tid >> 6), lane = tid & 63, wr = wid >> 2, wc = wid & 3, fr = lane & 15, fq = lane >> 4;
    const int K = g.K, nt = K / BK;
    unsigned voffA[2], voffB[2];
#pragma unroll
    for (int i = 0; i < 2; ++i) { int R, C; stage_rc(tid * 16 + i * 8192, R, C); const int Rb = Epi::PERM ? ((R & ~31) + perm32(R & 31)) : R;
        voffA[i] = (unsigned)(R * K + C) * 2u; voffB[i] = (unsigned)(Rb * K + C) * 2u; }
    const size_t kstep = (size_t)(BK * 2);
    const size_t hstep = (size_t)HALF * K * 2;
    const size_t tstep = 2 * hstep;
    const unsigned ldsw = (unsigned)wid * 1024u;
    const int aoff = lds_byte(wr * 64 + fr, fq * 8), boff = lds_byte(wc * 32 + fr, fq * 8);
#define PG8_SA(b, h) (((b) * 2 + (h)) * HTB)
#define PG8_SB(b, h) ((4 + (b) * 2 + (h)) * HTB)
#define PG8_STAGE(bufoff, gbase, voff) do { _Pragma("unroll") for (int _i = 0; _i < 2; ++_i) \
        __builtin_amdgcn_global_load_lds((const unsigned*)((const char*)(gbase) + (voff)[_i]), (PG8_LAS unsigned*)(lds + (bufoff) + ldsw + _i * 8192), 16, 0, 0); } while (0)
#define PG8_LDA(dst, b, h) do { _Pragma("unroll") for (int m = 0; m < 4; ++m) _Pragma("unroll") for (int k = 0; k < 2; ++k) dst[m][k] = *(const PG8_LAS bf16x8*)(lds + PG8_SA(b, h) + aoff + m * 2048 + k * 1024); } while (0)
#define PG8_LDB(dst, b, h) do { _Pragma("unroll") for (int n = 0; n < 2; ++n) _Pragma("unroll") for (int k = 0; k < 2; ++k) dst[n][k] = *(const PG8_LAS bf16x8*)(lds + PG8_SB(b, h) + boff + n * 2048 + k * 1024); } while (0)
#define PG8_MMA(ai, bj, At, Bt) do { __builtin_amdgcn_s_setprio(1); _Pragma("unroll") for (int m = 0; m < 4; ++m) _Pragma("unroll") for (int n = 0; n < 2; ++n) _Pragma("unroll") for (int k = 0; k < 2; ++k) \
        acc[ai][bj][m][n] = __builtin_amdgcn_mfma_f32_16x16x32_bf16(Bt[n][k], At[m][k], acc[ai][bj][m][n], 0, 0, 0); __builtin_amdgcn_s_setprio(0); } while (0)
#define PG8_WAIT_V(n) asm volatile("s_waitcnt vmcnt(" #n ")" ::: "memory")
#define PG8_WAIT_L(n) asm volatile("s_waitcnt lgkmcnt(" #n ")" ::: "memory")
#define PG8_BAR __builtin_amdgcn_s_barrier()
#define PG8_SCHED __builtin_amdgcn_sched_barrier(0)
    Unit cur, nxt; int ui = 0;
    if (!S.next(0, cur)) return;
    f32x4 acc[2][2][4][2];
#pragma unroll
    for (int a = 0; a < 2; ++a)
#pragma unroll
        for (int b = 0; b < 2; ++b)
#pragma unroll
            for (int m = 0; m < 4; ++m)
#pragma unroll
                for (int n = 0; n < 2; ++n) acc[a][b][m][n] = (f32x4){0.f, 0.f, 0.f, 0.f};
    bf16x8 At[4][2], B0[2][2], B1[2][2];
    const char* cA = (const char*)g.A + (size_t)cur.pm * tstep; const char* cB = (const char*)g.Bt + (size_t)cur.pn * tstep;
    S.a_ready(cur);
    if constexpr (SP2) {
        PG8_STAGE(PG8_SB(0, 0), cB, voffB); PG8_STAGE(PG8_SB(0, 1), cB + hstep, voffB); PG8_STAGE(PG8_SA(0, 0), cA, voffA); PG8_STAGE(PG8_SA(0, 1), cA + hstep, voffA);
        if (wr == 1) PG8_BAR;
        PG8_WAIT_V(2); PG8_BAR;
        PG8_STAGE(PG8_SB(1, 0), cB + kstep, voffB); PG8_STAGE(PG8_SA(1, 0), cA + kstep, voffA); PG8_STAGE(PG8_SB(1, 1), cB + hstep + kstep, voffB);
        PG8_WAIT_V(6); PG8_BAR;
    } else {
        PG8_STAGE(PG8_SB(0, 0), cB, voffB); PG8_STAGE(PG8_SA(0, 0), cA, voffA); PG8_STAGE(PG8_SB(0, 1), cB + hstep, voffB); PG8_STAGE(PG8_SA(0, 1), cA + hstep, voffA);
        if (wr == 1) PG8_BAR;
        PG8_WAIT_V(4); PG8_BAR;
        PG8_STAGE(PG8_SB(1, 0), cB + kstep, voffB); PG8_STAGE(PG8_SA(1, 0), cA + kstep, voffA); PG8_STAGE(PG8_SB(1, 1), cB + hstep + kstep, voffB);
        PG8_WAIT_V(6); PG8_BAR;
    }
    for (;;) {
        const bool has_next = S.next(ui + 1, nxt);
        const char* nA = has_next ? (const char*)g.A + (size_t)nxt.pm * tstep : cA; const char* nB = has_next ? (const char*)g.Bt + (size_t)nxt.pn * tstep : cB;
        for (int t = 0; t < nt; t += 2) {
            const bool last = (t == nt - 2);
            const char* a1 = cA + (size_t)(t + 1) * kstep;
            const char* a2 = last ? nA : cA + (size_t)(t + 2) * kstep; const char* b2 = last ? nB : cB + (size_t)(t + 2) * kstep;
            const char* a3 = a2 + kstep; const char* b3 = b2 + kstep;
            if (last && has_next) S.a_ready(nxt);
            if constexpr (SP2) {
            PG8_LDB(B0, 0, 0); PG8_LDB(B1, 0, 1); PG8_SCHED; PG8_LDA(At, 0, 0); PG8_STAGE(PG8_SA(1, 1), a1 + hstep, voffA);
            PG8_WAIT_V(8); PG8_WAIT_L(0); PG8_BAR; PG8_MMA(0, 0, At, B0); PG8_MMA(0, 1, At, B1); PG8_BAR; PG8_SCHED;
            PG8_LDA(At, 0, 1); PG8_STAGE(PG8_SB(0, 0), b2, voffB); PG8_STAGE(PG8_SB(0, 1), b2 + hstep, voffB); PG8_STAGE(PG8_SA(0, 0), a2, voffA);
            PG8_WAIT_V(8); PG8_WAIT_L(0); PG8_BAR; PG8_MMA(1, 0, At, B0); PG8_MMA(1, 1, At, B1); PG8_BAR; PG8_SCHED;
            PG8_LDB(B0, 1, 0); PG8_LDB(B1, 1, 1); PG8_SCHED; PG8_LDA(At, 1, 0); PG8_STAGE(PG8_SA(0, 1), a2 + hstep, voffA);
            PG8_WAIT_V(8); PG8_WAIT_L(0); PG8_BAR; PG8_MMA(0, 0, At, B0); PG8_MMA(0, 1, At, B1); PG8_BAR; PG8_SCHED;
            PG8_LDA(At, 1, 1); PG8_STAGE(PG8_SB(1, 0), b3, voffB); PG8_STAGE(PG8_SB(1, 1), b3 + hstep, voffB); PG8_STAGE(PG8_SA(1, 0), a3, voffA);
            PG8_WAIT_V(8); PG8_WAIT_L(0); PG8_BAR; PG8_MMA(1, 0, At, B0); PG8_MMA(1, 1, At, B1); PG8_BAR; PG8_SCHED;
            } else {
            PG8_LDB(B0, 0, 0); PG8_SCHED; PG8_LDA(At, 0, 0); PG8_STAGE(PG8_SA(1, 1), a1 + hstep, voffA);
            PG8_WAIT_L(8); PG8_BAR; PG8_WAIT_L(0); PG8_MMA(0, 0, At, B0); PG8_BAR; PG8_SCHED;
            PG8_LDB(B1, 0, 1); PG8_STAGE(PG8_SB(0, 0), b2, voffB);
            PG8_BAR; PG8_WAIT_L(0); PG8_MMA(0, 1, At, B1); PG8_BAR;
            PG8_LDA(At, 0, 1); PG8_STAGE(PG8_SA(0, 0), a2, voffA);
            PG8_BAR; PG8_WAIT_L(0); PG8_MMA(1, 0, At, B0); PG8_BAR; PG8_SCHED;
            PG8_STAGE(PG8_SB(0, 1), b2 + hstep, voffB);
            PG8_WAIT_V(6); PG8_BAR; PG8_MMA(1, 1, At, B1); PG8_BAR;
            PG8_LDB(B0, 1, 0); PG8_SCHED; PG8_LDA(At, 1, 0); PG8_STAGE(PG8_SA(0, 1), a2 + hstep, voffA);
            PG8_WAIT_L(8); PG8_BAR; PG8_WAIT_L(0); PG8_MMA(0, 0, At, B0); PG8_BAR; PG8_SCHED;
            PG8_LDB(B1, 1, 1); PG8_STAGE(PG8_SB(1, 0), b3, voffB);
            PG8_BAR; PG8_WAIT_L(0); PG8_MMA(0, 1, At, B1); PG8_BAR;
            PG8_LDA(At, 1, 1); PG8_STAGE(PG8_SA(1, 0), a3, voffA);
            PG8_BAR; PG8_WAIT_L(0); PG8_MMA(1, 0, At, B0); PG8_BAR; PG8_SCHED;
            PG8_STAGE(PG8_SB(1, 1), b3 + hstep, voffB);
            PG8_WAIT_V(6); PG8_BAR; PG8_MMA(1, 1, At, B1); PG8_BAR;
            }
        }
        if constexpr (ALIGN_EPI) { if (wr == 0) PG8_BAR; }
        if constexpr (!Epi::AFTER_DRAIN) { E(acc, cur, wr, wc, fr, fq); S.done(cur); }
        if (!has_next) break;
#pragma unroll
        for (int a = 0; a < 2; ++a)
#pragma unroll
            for (int b = 0; b < 2; ++b)
#pragma unroll
                for (int m = 0; m < 4; ++m)
#pragma unroll
                    for (int n = 0; n < 2; ++n) acc[a][b][m][n] = (f32x4){0.f, 0.f, 0.f, 0.f};
        cur = nxt; cA = nA; cB = nB; ++ui;
        if constexpr (ALIGN_EPI) { if (wr == 1) PG8_BAR; }
    }
    PG8_WAIT_V(0);
    if constexpr (!ALIGN_EPI) { if (wr == 0) PG8_BAR; }
    PG8_BAR;
    if constexpr (Epi::AFTER_DRAIN) { E.fused(acc, cur, wr, wc, fr, fq, lds, wid, lane); S.done(cur); }
#undef PG8_SA
#undef PG8_SB
#undef PG8_STAGE
#undef PG8_LDA
#undef PG8_LDB
#undef PG8_MMA
#undef PG8_WAIT_V
#undef PG8_WAIT_L
#undef PG8_BAR
#undef PG8_SCHED
}
}

namespace mk {
using pg8::bf16_t; using pg8::bf16x8; using pg8::f32x4; using pg8::Unit;
typedef unsigned u32x4 __attribute__((ext_vector_type(4)));
typedef unsigned u32x2 __attribute__((ext_vector_type(2)));

constexpr int M = 16896, MP = 16384, D = 1024, FF = 2816;
constexpr int AB_N = 3840, GD_N = 4352, GD_NREAL = 4112;
constexpr float ALPHA = 1.6817928305074290f;
constexpr int LDS_BYTES = 163840;

constexpr size_t O_PSHIFT = 17301504, O_PRWKV = 17330176, O_PRET = 17854464, O_PCONV = 18903040, O_PGDN = 19050496;
constexpr size_t O_SSHIFT = 21147648, O_SRWKV = 21606400, O_SRET = 29995008, O_SCONV = 46772224, O_SGDN = 49131520;

constexpr size_t WS_WGU = 0;
constexpr size_t WS_WD = WS_WGU + 2ull * 5632 * 1024 * 2;
constexpr size_t WS_WIN = WS_WD + 2ull * 1024 * 2816 * 2;
constexpr size_t WS_WOUT = WS_WIN + 4352ull * 1024 * 2;
constexpr size_t WS_W2T = WS_WOUT + 1024ull * 1024 * 2;
constexpr size_t WS_A2T = WS_W2T + 65536;
constexpr size_t WS_G2T = WS_A2T + 65536;
constexpr size_t WS_X = WS_G2T + 131072;
constexpr size_t WS_HB = WS_X + (size_t)M * 1024 * 4;
constexpr size_t WS_S = WS_HB + (size_t)M * 1024 * 2;
constexpr size_t WS_HID = WS_S;
constexpr size_t WS_OMIX = WS_S;
constexpr size_t WS_ZB = WS_OMIX + (size_t)M * 1024 * 2;
constexpr size_t WS_OPS = WS_ZB + (size_t)M * AB_N * 2;
constexpr size_t WS_GATE = WS_OPS + (size_t)M * 3072 * 4;
constexpr size_t WS_ORAW = WS_GATE + (size_t)M * 512 * 4;
constexpr size_t WS_BONUS = WS_ORAW + (size_t)M * 512 * 4;
constexpr size_t WS_RQ = WS_BONUS + (size_t)M * 8 * 4;
constexpr size_t WS_RK = WS_RQ + (size_t)M * 512 * 2;
constexpr size_t WS_AB_END = WS_RK + (size_t)M * 512 * 2;
constexpr size_t WS_CH = WS_ZB + (size_t)M * GD_N * 2;
constexpr size_t CH_U = 0, CH_W = 32768, CH_QG = 49152, CH_QK = 65536, CH_KDT = 73728, CH_BYTES = 90112;
constexpr int N_CH = 2048 + 1024;
constexpr size_t WS_GL = WS_CH + (size_t)N_CH * CH_BYTES;
constexpr size_t WS_GD_END = WS_GL + N_CH * 4;
constexpr size_t WS_BAR = ((WS_AB_END > WS_GD_END ? WS_AB_END : WS_GD_END) + 255) / 256 * 256;
constexpr size_t WS_FLAGS = WS_BAR + 16384;
constexpr int CTL_WORDS = (16384 + 8192) / 4;
constexpr size_t WS_NEED = WS_FLAGS + 8192;
constexpr int GDN_LATE = 28;

struct Params { const float* in[33]; float* out; unsigned char* ws; };

__device__ __forceinline__ float bf2f(bf16_t h) { return __uint_as_float(((unsigned)h) << 16); }
__device__ __forceinline__ unsigned pk2(float lo, float hi) { unsigned r; asm volatile("v_cvt_pk_bf16_f32 %0, %1, %2" : "=v"(r) : "v"(lo), "v"(hi)); return r; }
__device__ __forceinline__ bf16_t f2bf(float x) { return (bf16_t)(pk2(x, 0.f) & 0xffffu); }
__device__ __forceinline__ float sigm(float x) { return __builtin_amdgcn_rcpf(1.f + __expf(-x)); }
__device__ __forceinline__ float silu(float x) { return x * __builtin_amdgcn_rcpf(1.f + __expf(-x)); }
__device__ __forceinline__ float dppf(float v, const int ctrl_sel) {
    int x = __builtin_bit_cast(int, v), y;
    if (ctrl_sel == 0) y = __builtin_amdgcn_update_dpp(0, x, 0xB1, 0xF, 0xF, true);
    else if (ctrl_sel == 1) y = __builtin_amdgcn_update_dpp(0, x, 0x4E, 0xF, 0xF, true);
    else if (ctrl_sel == 2) y = __builtin_amdgcn_update_dpp(0, x, 0x141, 0xF, 0xF, true);
    else y = __builtin_amdgcn_update_dpp(0, x, 0x140, 0xF, 0xF, true);
    return __builtin_bit_cast(float, y);
}
__device__ __forceinline__ float row16_sum(float v) { v += dppf(v, 0); v += dppf(v, 1); v += dppf(v, 2); v += dppf(v, 3); return v; }
__device__ __forceinline__ float wave_sum(float v) {
#pragma unroll
    for (int o = 1; o < 64; o <<= 1) v += __shfl_xor(v, o);
    return v;
}
#define XB_XCNT(j)  (256  + 64 * (j))
#define XB_XSUB(j)  (1280 + 64 * (j))
#define XB_XGEN(j)  (2304 + 64 * (j))
#define XB_TOP      3328
#define XB_TOPGEN   3392
#define XCD_BAR_WORDS 3456
__device__ __forceinline__ unsigned xb_ld(unsigned* p)              { return __hip_atomic_load(p, __ATOMIC_RELAXED, __HIP_MEMORY_SCOPE_AGENT); }
__device__ __forceinline__ unsigned xb_add(unsigned* p, unsigned v) { return __hip_atomic_fetch_add(p, v, __ATOMIC_RELAXED, __HIP_MEMORY_SCOPE_AGENT); }
__device__ __forceinline__ unsigned xb_xcc_id() { return (unsigned)__builtin_amdgcn_s_getreg((3 << 11) | 20) & 0xFu; }
__device__ __forceinline__ void gbar(unsigned* bar, volatile unsigned* st) {
    asm volatile("s_waitcnt vmcnt(0)" ::: "memory");
    __syncthreads();
    if (mk_ltid() == 0) {
        __builtin_amdgcn_s_waitcnt(0);
        const unsigned x = xb_xcc_id();
        unsigned nloc = st[0], nx = st[1];
        if (nloc == 0u) {
            const unsigned G = gridDim.x;
            unsigned sum, cnt, mine;
            for (;;) {
                sum = 0u; cnt = 0u; mine = 0u;
#pragma unroll
                for (unsigned j = 0; j < 16; ++j) { const unsigned c = xb_ld(&bar[XB_XCNT(j)]); sum += c; cnt += (c > 0u) ? 1u : 0u; mine = (j == x) ? c : mine; }
                if (sum == G) break;
                __builtin_amdgcn_s_sleep(1);
            }
            nloc = mine > 0u ? mine : 1u; nx = cnt > 0u ? cnt : 1u; st[0] = nloc; st[1] = nx;
        }
        const unsigned old = xb_add(&bar[XB_XSUB(x)], 1u);
        const unsigned gen = old / nloc;
        if (old + 1u == (gen + 1u) * nloc) {
            __builtin_amdgcn_fence(__ATOMIC_RELEASE, "agent");
            asm volatile("s_waitcnt vmcnt(0)" ::: "memory");
            const unsigned og = xb_add(&bar[XB_TOP], 1u);
            const unsigned tg = og / nx;
            if (og + 1u == (tg + 1u) * nx) xb_add(&bar[XB_TOPGEN], 1u);
            else while (xb_ld(&bar[XB_TOPGEN]) == tg) __builtin_amdgcn_s_sleep(1);
            __builtin_amdgcn_fence(__ATOMIC_ACQUIRE, "agent");
            xb_add(&bar[XB_XGEN(x)], 1u);
            asm volatile("s_waitcnt vmcnt(0)" ::: "memory");
        } else {
            while (xb_ld(&bar[XB_XGEN(x)]) == gen) __builtin_amdgcn_s_sleep(1);
            __builtin_amdgcn_fence(__ATOMIC_ACQUIRE, "agent");
            asm volatile("s_waitcnt vmcnt(0)" ::: "memory");
        }
    }
    __syncthreads();
}
__device__ __forceinline__ void seq_info(int s, int& row0, int& L) { if (s < 8) { row0 = s * 2048; L = 2048; } else { row0 = MP + (s - 8) * 4; L = 4; } }

struct EpiSwiglu { static constexpr bool PERM = true, AFTER_DRAIN = false; bf16_t* O;
    __device__ __forceinline__ void operator()(const f32x4 (&acc)[2][2][4][2], const Unit& u, int wr, int wc, int fr, int fq) const {
        const int row0 = u.pm * 256 + wr * 64 + fr, col0 = u.pn * 128 + wc * 32 + 8 * fq;
#pragma unroll
        for (int ai = 0; ai < 2; ++ai)
#pragma unroll
            for (int m = 0; m < 4; ++m) {
                bf16_t* rp = O + (size_t)(row0 + ai * 128 + m * 16) * FF + col0;
                const f32x4 g0 = acc[ai][0][m][0], g1 = acc[ai][0][m][1], u0 = acc[ai][1][m][0], u1 = acc[ai][1][m][1];
                u32x4 w;
                w.x = pk2(silu(g0[0]) * u0[0], silu(g0[1]) * u0[1]); w.y = pk2(silu(g0[2]) * u0[2], silu(g0[3]) * u0[3]);
                w.z = pk2(silu(g1[0]) * u1[0], silu(g1[1]) * u1[1]); w.w = pk2(silu(g1[2]) * u1[2], silu(g1[3]) * u1[3]);
                *(u32x4*)rp = w;
            }
    }
};
struct EpiResid { static constexpr bool PERM = true, AFTER_DRAIN = false; bf16_t* X; const bf16_t* H; float scale;
    __device__ __forceinline__ void operator()(const f32x4 (&acc)[2][2][4][2], const Unit& u, int wr, int wc, int fr, int fq) const {
        const int row0 = u.pm * 256 + wr * 64 + fr, col0 = u.pn * 256 + wc * 32 + 8 * fq;
#pragma unroll
        for (int ai = 0; ai < 2; ++ai)
#pragma unroll
            for (int m = 0; m < 4; ++m)
#pragma unroll
                for (int bj = 0; bj < 2; ++bj)
#pragma unroll
                    for (int n = 0; n < 2; ++n) {
                        const size_t off = (size_t)(row0 + ai * 128 + m * 16) * D + col0 + bj * 128 + 4 * n;
                        const u32x2 hu = *(const u32x2*)(H + off);
                        f32x4 x; x[0] = __uint_as_float(hu.x << 16); x[1] = __uint_as_float(hu.x & 0xffff0000u); x[2] = __uint_as_float(hu.y << 16); x[3] = __uint_as_float(hu.y & 0xffff0000u);
                        x = x * ALPHA + acc[ai][bj][m][n] * scale; u32x2 xo; xo.x = pk2(x[0], x[1]); xo.y = pk2(x[2], x[3]); *(u32x2*)(X + off) = xo;
                    }
    }
};
struct EpiZ { static constexpr bool PERM = true, AFTER_DRAIN = false; bf16_t* Z; int ld;
    __device__ __forceinline__ void operator()(const f32x4 (&acc)[2][2][4][2], const Unit& u, int wr, int wc, int fr, int fq) const {
        const int row0 = u.pm * 256 + wr * 64 + fr, col0 = u.pn * 256 + wc * 32 + 8 * fq;
#pragma unroll
        for (int ai = 0; ai < 2; ++ai)
#pragma unroll
            for (int m = 0; m < 4; ++m)
#pragma unroll
                for (int bj = 0; bj < 2; ++bj) {
                    const f32x4 a = acc[ai][bj][m][0], b = acc[ai][bj][m][1];
                    u32x4 w; w.x = pk2(a[0], a[1]); w.y = pk2(a[2], a[3]); w.z = pk2(b[0], b[1]); w.w = pk2(b[2], b[3]);
                    *(u32x4*)(Z + (size_t)(row0 + ai * 128 + m * 16) * ld + col0 + bj * 128) = w;
                }
    }
};

__device__ __forceinline__ void tr_item(const float* __restrict__ W, int K, int N, bf16_t* WT, int dst_row0, int k0, int n0, float* scr, int lane) {
#pragma unroll
    for (int i = 0; i < 32; ++i) { const int kk = 2 * i + (lane >> 5); const int col = n0 + (lane & 31);
        scr[kk * 33 + (lane & 31)] = (col < N) ? W[(size_t)(k0 + kk) * N + col] : 0.f; }
    asm volatile("s_waitcnt lgkmcnt(0)" ::: "memory");
    const int c = lane & 7;
#pragma unroll
    for (int j = 0; j < 4; ++j) { const int n = (lane >> 3) + 8 * j; const float* s = scr + (8 * c) * 33 + n;
        u32x4 o; o.x = pk2(s[0], s[33]); o.y = pk2(s[2 * 33], s[3 * 33]); o.z = pk2(s[4 * 33], s[5 * 33]); o.w = pk2(s[6 * 33], s[7 * 33]);
        *(u32x4*)(WT + (size_t)(dst_row0 + n) * K + k0 + 8 * c) = o; }
    asm volatile("s_waitcnt lgkmcnt(0)" ::: "memory");
}

__device__ __forceinline__ void convert_items(const Params& p, int l, int parts, int gw, int NGW, unsigned char* smem) {
    const int lane = mk_ltid() & 63, wave = mk_ltid() >> 6;
    float* scr = (float*)smem + wave * (64 * 33);
    unsigned char* ws = p.ws;
    const int i = l >> 1; const bool ab = (l & 1) == 0;
    constexpr int I_G = 16 * 88, I_O = 16 * 32;
    const int I_IN = ab ? 16 * 120 : 16 * 136;
    const int I_LORA = ab ? (16 + 16 + 32) : 0;
    const int n0 = (parts & 1) ? 3 * I_G : 0, n1 = (parts & 2) ? 3 * I_G : 0, n2 = (parts & 4) ? (I_IN + I_O + I_LORA) : 0;
    const int total = n0 + n1 + n2;
    for (int it = gw; it < total; it += NGW) {
        int r = it;
        if (r < n0 + n1) {
            const int j = (r < n0) ? 0 : 1; r -= (j ? n0 : 0);
            const int kind = r / I_G; r -= kind * I_G;
            const size_t lw = (size_t)(l * 2 + j);
            if (kind < 2) { const float* W = p.in[kind == 0 ? 9 : 10] + lw * (size_t)D * FF;
                const int kb = r / 88, nb = r % 88, nn0 = nb * 32;
                tr_item(W, D, FF, (bf16_t*)(ws + WS_WGU) + (size_t)j * 5632 * 1024, (nn0 >> 7) * 256 + (nn0 & 127) + kind * 128, kb * 64, nn0, scr, lane);
            } else { const float* W = p.in[11] + lw * (size_t)FF * D;
                const int kb = r / 32, nb = r % 32;
                tr_item(W, FF, D, (bf16_t*)(ws + WS_WD) + (size_t)j * 1024 * 2816, nb * 32, kb * 64, nb * 32, scr, lane);
            }
            continue;
        }
        r -= n0 + n1;
        if (r < I_IN) {
            if (ab) { const int kb = r / 120, nb = r % 120; tr_item(p.in[12] + (size_t)i * D * AB_N, D, AB_N, (bf16_t*)(ws + WS_WIN), nb * 32, kb * 64, nb * 32, scr, lane); }
            else { const int kb = r / 136, nb = r % 136; tr_item(p.in[27] + (size_t)i * D * GD_NREAL, D, GD_NREAL, (bf16_t*)(ws + WS_WIN), nb * 32, kb * 64, nb * 32, scr, lane); }
            continue;
        }
        r -= I_IN;
        if (r < I_O) { const int kb = r / 32, nb = r % 32;
            tr_item(p.in[ab ? 13 : 32] + (size_t)i * D * D, D, D, (bf16_t*)(ws + WS_WOUT), nb * 32, kb * 64, nb * 32, scr, lane); continue; }
        r -= I_O;
        if (r < 16) { tr_item(p.in[16] + (size_t)i * 64 * 512, 64, 512, (bf16_t*)(ws + WS_W2T), r * 32, 0, r * 32, scr, lane); continue; }
        r -= 16;
        if (r < 16) { tr_item(p.in[18] + (size_t)i * 64 * 512, 64, 512, (bf16_t*)(ws + WS_A2T), r * 32, 0, r * 32, scr, lane); continue; }
        r -= 16;
        { const int kb = r / 16, nb = r % 16; tr_item(p.in[19] + (size_t)i * 128 * 512, 128, 512, (bf16_t*)(ws + WS_G2T), nb * 32, kb * 64, nb * 32, scr, lane); }
    }
}
__device__ __forceinline__ void convert_ffn_ahead(const Params& p, int l, int gw, int NGW, unsigned char* smem) {
    __syncthreads();
    convert_items(p, l, 2, gw, NGW, smem);
    if (l < 3) convert_items(p, l + 1, 1, gw, NGW, smem);
    __syncthreads();
}

__device__ __forceinline__ void phase_start(const Params& p, unsigned char* smem) {
    const int tid = mk_ltid(), lane = tid & 63, wave = tid >> 6;
    const int gw = mk_lbid() * 8 + wave, NGW = gridDim.x * 8;
    convert_items(p, 0, 5, gw, NGW, smem);
    bf16_t* HB = (bf16_t*)(p.ws + WS_HB);
    for (int m = gw; m < M; m += NGW) {
        const float* src = (m < MP) ? p.in[0] + (size_t)m * D : p.in[1] + (size_t)(m - MP) * D;
#pragma unroll
        for (int j = 0; j < 4; ++j) { const int c = (lane + 64 * j) * 4; const f32x4 v = *(const f32x4*)(src + c);
            u32x2 o; o.x = pk2(v[0], v[1]); o.y = pk2(v[2], v[3]); *(u32x2*)(HB + (size_t)m * D + c) = o; }
    }
}

__device__ __forceinline__ void phase_ln(const Params& p, int l, int k, bool final_out) {
    const int tid = mk_ltid(), lane = tid & 63, wave = tid >> 6;
    const int gw = mk_lbid() * 8 + wave, NGW = gridDim.x * 8;
    const bf16_t* X = (const bf16_t*)(p.ws + WS_X); bf16_t* HB = (bf16_t*)(p.ws + WS_HB);
    const float* g = p.in[7] + (size_t)(l * 3 + k) * D; const float* b = p.in[8] + (size_t)(l * 3 + k) * D;
    float* dst = p.out;
    for (int mq = gw; mq < M / 4; mq += NGW) {
        f32x4 v[4][4]; float s[4];
#pragma unroll
        for (int rr = 0; rr < 4; ++rr) { s[rr] = 0.f;
#pragma unroll
            for (int j = 0; j < 4; ++j) { const u32x2 xu = *(const u32x2*)(X + (size_t)(mq * 4 + rr) * D + (lane + 64 * j) * 4);
                v[rr][j][0] = __uint_as_float(xu.x << 16); v[rr][j][1] = __uint_as_float(xu.x & 0xffff0000u); v[rr][j][2] = __uint_as_float(xu.y << 16); v[rr][j][3] = __uint_as_float(xu.y & 0xffff0000u); s[rr] += (v[rr][j][0] + v[rr][j][1]) + (v[rr][j][2] + v[rr][j][3]); } }
#pragma unroll
        for (int o = 1; o < 64; o <<= 1) {
#pragma unroll
            for (int rr = 0; rr < 4; ++rr) s[rr] += __shfl_xor(s[rr], o); }
        float s2[4];
#pragma unroll
        for (int rr = 0; rr < 4; ++rr) { const float mean = s[rr] * (1.f / D); s2[rr] = 0.f;
#pragma unroll
            for (int j = 0; j < 4; ++j) { v[rr][j] = v[rr][j] - mean; s2[rr] += (v[rr][j][0] * v[rr][j][0] + v[rr][j][1] * v[rr][j][1]) + (v[rr][j][2] * v[rr][j][2] + v[rr][j][3] * v[rr][j][3]); } }
#pragma unroll
        for (int o = 1; o < 64; o <<= 1) {
#pragma unroll
            for (int rr = 0; rr < 4; ++rr) s2[rr] += __shfl_xor(s2[rr], o); }
#pragma unroll
        for (int j = 0; j < 4; ++j) { const int c = (lane + 64 * j) * 4; const f32x4 gg = *(const f32x4*)(g + c), bb = *(const f32x4*)(b + c);
#pragma unroll
            for (int rr = 0; rr < 4; ++rr) { const int m = mq * 4 + rr; const float rstd = rsqrtf(s2[rr] * (1.f / D) + 1e-5f);
                const f32x4 y = v[rr][j] * rstd * gg + bb;
                if (final_out) *(f32x4*)(dst + (size_t)m * D + c) = y;
                else { u32x2 o; o.x = pk2(y[0], y[1]); o.y = pk2(y[2], y[3]); *(u32x2*)(HB + (size_t)m * D + c) = o; } } }
    }
}

__device__ __forceinline__ void small_resid_gemm(const bf16_t* __restrict__ A, const bf16_t* __restrict__ Bt, int K, bf16_t* X, const bf16_t* H, float scale, unsigned char* smem) {
    const int tid = mk_ltid(), lane = tid & 63, w = __builtin_amdgcn_readfirstlane(tid >> 6);
    const int r = lane & 15, q = lane >> 4;
    float* part = (float*)smem;
    for (int t = mk_lbid(); t < 256; t += gridDim.x) {
        const int R0 = MP + (t >> 4) * 32, C0 = (t & 15) * 64;
        f32x4 acc[2][4];
#pragma unroll
        for (int a = 0; a < 2; ++a)
#pragma unroll
            for (int b = 0; b < 4; ++b) acc[a][b] = (f32x4){0.f, 0.f, 0.f, 0.f};
        const int nks = K / 32;
#pragma unroll 2
        for (int ks = w; ks < nks; ks += 8) {
            bf16x8 fa[2], fb[4];
#pragma unroll
            for (int a = 0; a < 2; ++a) fa[a] = *(const bf16x8*)(A + (size_t)(R0 + a * 16 + r) * K + ks * 32 + q * 8);
#pragma unroll
            for (int b = 0; b < 4; ++b) fb[b] = *(const bf16x8*)(Bt + (size_t)(C0 + b * 16 + r) * K + ks * 32 + q * 8);
#pragma unroll
            for (int a = 0; a < 2; ++a)
#pragma unroll
                for (int b = 0; b < 4; ++b) acc[a][b] = __builtin_amdgcn_mfma_f32_16x16x32_bf16(fa[a], fb[b], acc[a][b], 0, 0, 0);
        }
        __syncthreads();
#pragma unroll
        for (int a = 0; a < 2; ++a)
#pragma unroll
            for (int b = 0; b < 4; ++b) *(f32x4*)(part + ((w * 8 + a * 4 + b) * 64 + lane) * 4) = acc[a][b];
        __syncthreads();
        {
            const int tile = tid >> 6, a = tile >> 2, b = tile & 3;
            f32x4 sum = (f32x4){0.f, 0.f, 0.f, 0.f};
#pragma unroll
            for (int ww = 0; ww < 8; ++ww) sum += *(const f32x4*)(part + ((ww * 8 + tile) * 64 + lane) * 4);
            const int col = C0 + b * 16 + r;
#pragma unroll
            for (int j = 0; j < 4; ++j) { const size_t off = (size_t)(R0 + a * 16 + q * 4 + j) * D + col;
                X[off] = f2bf(bf2f(H[off]) * ALPHA + sum[j] * scale); }
        }
    }
}

__device__ __forceinline__ void phase_ab_prep(const Params& p, int i, unsigned char* smem) {
    const int tid = mk_ltid(), lane = tid & 63, wave = __builtin_amdgcn_readfirstlane(tid >> 6);
    const int r = lane & 15, q = lane >> 4;
    unsigned char* ws = p.ws;
    const bf16_t* ZB = (const bf16_t*)(ws + WS_ZB);
    float* OPS = (float*)(ws + WS_OPS); float* GATE = (float*)(ws + WS_GATE); float* BONUS = (float*)(ws + WS_BONUS);
    bf16_t* RQ = (bf16_t*)(ws + WS_RQ); bf16_t* RK = (bf16_t*)(ws + WS_RK);
    const bf16_t* W2T = (const bf16_t*)(ws + WS_W2T); const bf16_t* A2T = (const bf16_t*)(ws + WS_A2T); const bf16_t* G2T = (const bf16_t*)(ws + WS_G2T);
    const float* mu = p.in[14] + (size_t)i * 1792; const float* w0 = p.in[15] + i * 512; const float* a0 = p.in[17] + i * 512;
    const float* k_k = p.in[20] + i * 512; const float* k_a = p.in[21] + i * 512; const float* r_k = p.in[22] + i * 512;
    const float* shift_in = p.in[2] + (size_t)i * 128 * 1792;
    constexpr int ZS_LD = 1796, ACT_LD = 264;
    float* zs = (float*)smem;
    bf16_t* act = (bf16_t*)(smem + 16 * ZS_LD * 4);
    for (int tile = mk_lbid(); tile < M / 16; tile += gridDim.x) {
        const int R0 = tile * 16;
        unsigned pfa = 0u, pfb = 0u;
        { const int ntile = tile + gridDim.x;
          if (ntile < M / 16) { const bf16_t* nz = ZB + (size_t)ntile * 16 * AB_N;
              pfa = *(const unsigned*)(nz + (size_t)tid * 64); pfb = *(const unsigned*)(((size_t)(tid + 512) * 64 < (size_t)16 * AB_N) ? nz + (size_t)(tid + 512) * 64 : nz); } }
#ifndef REP_A_ST
#define REP_A_ST 1
#endif
#ifndef REP_A_RO
#define REP_A_RO 1
#endif
#ifndef REP_A_EP
#define REP_A_EP 1
#endif
        __syncthreads();
#pragma unroll 1
        for (int rp_ = 0; rp_ < REP_A_ST; ++rp_)
#pragma unroll 7
        for (int idx = tid; idx < 16 * 448; idx += 512) {
            const int tok = idx / 448, c4 = (idx % 448) * 4; const int row = R0 + tok;
            const int t = (row < MP) ? (row & 2047) : ((row - MP) & 3);
            const int Lm1 = (row < MP) ? 2047 : 3;
            const u32x2 cu = *(const u32x2*)(ZB + (size_t)row * AB_N + c4);
            f32x4 cur; cur[0] = __uint_as_float(cu.x << 16); cur[1] = __uint_as_float(cu.x & 0xffff0000u); cur[2] = __uint_as_float(cu.y << 16); cur[3] = __uint_as_float(cu.y & 0xffff0000u);
            f32x4 prev;
            if (t == 0) { if (row < MP) prev = (f32x4){0.f, 0.f, 0.f, 0.f}; else prev = *(const f32x4*)(shift_in + (size_t)((row - MP) >> 2) * 1792 + c4); }
            else { const u32x2 pu = *(const u32x2*)(ZB + (size_t)(row - 1) * AB_N + c4);
                prev[0] = __uint_as_float(pu.x << 16); prev[1] = __uint_as_float(pu.x & 0xffff0000u); prev[2] = __uint_as_float(pu.y << 16); prev[3] = __uint_as_float(pu.y & 0xffff0000u); }
            if (t == Lm1) {
                float* o = (row < MP) ? p.out + O_PSHIFT + (size_t)(i * 8 + (row >> 11)) * 1792 : p.out + O_SSHIFT + (size_t)(i * 128 + ((row - MP) >> 2)) * 1792;
                *(f32x4*)(o + c4) = cur;
            }
            const f32x4 m4 = *(const f32x4*)(mu + c4);
            const f32x4 z = cur + (prev - cur) * m4;
            *(f32x4*)(zs + tok * ZS_LD + c4) = z;
            if (c4 >= 1536) {
                f32x4 a;
                if (c4 < 1600) { a[0] = tanhf(z[0]); a[1] = tanhf(z[1]); a[2] = tanhf(z[2]); a[3] = tanhf(z[3]); }
                else if (c4 < 1664) a = z;
                else { a[0] = sigm(z[0]); a[1] = sigm(z[1]); a[2] = sigm(z[2]); a[3] = sigm(z[3]); }
                u32x2 o; o.x = pk2(a[0], a[1]); o.y = pk2(a[2], a[3]); *(u32x2*)(act + tok * ACT_LD + (c4 - 1536)) = o;
            }
        }
#pragma unroll 1
        for (int rp_ = 0; rp_ < REP_A_RO; ++rp_)
#pragma unroll 8
        for (int idx = tid; idx < 16 * 256; idx += 512) {
            const int tok = idx >> 8, hh = (idx >> 6) & 3, ii = idx & 63; const int row = R0 + tok;
            const float pos = (row < MP) ? (float)(row & 2047) : (float)(16384 + ((row - MP) & 3));
            const float inv_freq = exp2f(-(float)ii * (13.287712379549449f / 63.0f));
            const float ang = pos * inv_freq;
            const float n = rintf(ang * 0.15915494309189535f);
            float rr = fmaf(-n, 6.2831854820251465f, ang); rr = fmaf(-n, -1.7484555e-7f, rr);
            const float rev = rr * 0.15915494309189535f;
            const float sn = __builtin_amdgcn_sinf(rev), cs = __builtin_amdgcn_cosf(rev);
            const bf16_t* zq = ZB + (size_t)row * AB_N + 1792 + hh * 128 + ii;
            const float q1 = bf2f(zq[0]), q2 = bf2f(zq[64]), k1 = bf2f(zq[512]), k2 = bf2f(zq[576]);
            const size_t o = (size_t)row * 512 + hh * 128 + ii;
            RQ[o] = f2bf(q1 * cs - q2 * sn); RQ[o + 64] = f2bf(q2 * cs + q1 * sn);
            const float ksc = 0.08838834764831845f;
            RK[o] = f2bf((k1 * cs - k2 * sn) * ksc); RK[o + 64] = f2bf((k2 * cs + k1 * sn) * ksc);
        }
        __syncthreads();
        const int cb = wave * 64;
#pragma unroll 1
        for (int rp_ = 0; rp_ < REP_A_EP; ++rp_) {
        f32x4 aw[4], aa[4], ag[4];
#pragma unroll
        for (int nt = 0; nt < 4; ++nt) { aw[nt] = (f32x4){0.f, 0.f, 0.f, 0.f}; aa[nt] = aw[nt]; ag[nt] = aw[nt]; }
#pragma unroll
        for (int ks = 0; ks < 2; ++ks) {
            const bf16x8 bw = *(const bf16x8*)(act + r * ACT_LD + ks * 32 + q * 8);
            const bf16x8 ba = *(const bf16x8*)(act + r * ACT_LD + 64 + ks * 32 + q * 8);
#pragma unroll
            for (int nt = 0; nt < 4; ++nt) {
                const bf16x8 fw = *(const bf16x8*)(W2T + (size_t)(cb + nt * 16 + r) * 64 + ks * 32 + q * 8);
                const bf16x8 fa = *(const bf16x8*)(A2T + (size_t)(cb + nt * 16 + r) * 64 + ks * 32 + q * 8);
                aw[nt] = __builtin_amdgcn_mfma_f32_16x16x32_bf16(fw, bw, aw[nt], 0, 0, 0);
                aa[nt] = __builtin_amdgcn_mfma_f32_16x16x32_bf16(fa, ba, aa[nt], 0, 0, 0);
            }
        }
#pragma unroll
        for (int ks = 0; ks < 4; ++ks) {
            const bf16x8 bg = *(const bf16x8*)(act + r * ACT_LD + 128 + ks * 32 + q * 8);
#pragma unroll
            for (int nt = 0; nt < 4; ++nt) {
                const bf16x8 fg = *(const bf16x8*)(G2T + (size_t)(cb + nt * 16 + r) * 128 + ks * 32 + q * 8);
                ag[nt] = __builtin_amdgcn_mfma_f32_16x16x32_bf16(fg, bg, ag[nt], 0, 0, 0);
            }
        }
        const int row = R0 + r;
        float ssq = 0.f, bon = 0.f;
        f32x4 kkraw[4], av[4];
#pragma unroll
        for (int nt = 0; nt < 4; ++nt) {
            const int c = cb + nt * 16 + q * 4;
            const f32x4 rr = *(const f32x4*)(zs + r * ZS_LD + c), kx = *(const f32x4*)(zs + r * ZS_LD + 512 + c), vv = *(const f32x4*)(zs + r * ZS_LD + 1024 + c);
            const f32x4 w04 = *(const f32x4*)(w0 + c), a04 = *(const f32x4*)(a0 + c), kk4 = *(const f32x4*)(k_k + c), ka4 = *(const f32x4*)(k_a + c), rk4 = *(const f32x4*)(r_k + c);
            f32x4 dec, a, kp;
#pragma unroll
            for (int j = 0; j < 4; ++j) {
                const float wl = w04[j] + aw[nt][j];
                const float sp = fmaxf(-wl, 0.f) + __logf(1.f + __expf(-fabsf(wl)));
                const float wlog = -sp - 0.5f;
                dec[j] = __expf(-__expf(wlog));
                a[j] = sigm(a04[j] + aa[nt][j]);
                kkraw[nt][j] = kx[j] * kk4[j];
                kp[j] = kx[j] * (1.f + (a[j] - 1.f) * ka4[j]);
                ssq += kkraw[nt][j] * kkraw[nt][j];
                bon += rr[j] * kp[j] * rk4[j];
            }
            av[nt] = a;
            float* ob = OPS + ((size_t)row * 8 + wave) * 384 + nt * 16 + q * 4;
            *(f32x4*)(ob) = rr; *(f32x4*)(ob + 64) = dec; *(f32x4*)(ob + 128) = kp; *(f32x4*)(ob + 192) = vv;
            *(f32x4*)(GATE + (size_t)row * 512 + c) = ag[nt];
        }
        ssq += __shfl_xor(ssq, 16); ssq += __shfl_xor(ssq, 32);
        bon += __shfl_xor(bon, 16); bon += __shfl_xor(bon, 32);
        const float rn = rsqrtf(fmaxf(ssq, 1e-12f));
#pragma unroll
        for (int nt = 0; nt < 4; ++nt) {
            float* ob = OPS + ((size_t)row * 8 + wave) * 384 + nt * 16 + q * 4;
            const f32x4 kk = kkraw[nt] * rn;
            *(f32x4*)(ob + 256) = kk; *(f32x4*)(ob + 320) = kk * av[nt];
        }
        if (q == 0) BONUS[(size_t)row * 8 + wave] = bon;
        }
        if (pfa == 0x7fc17fc1u && pfb == 0x7fc27fc2u) zs[0] = 1.f;
    }
}

__device__ __forceinline__ void rwkv_item(const Params& p, int i, int s, int h, int rg, unsigned char* smem) {
    const int tid = mk_ltid(), lane = tid & 63, wave = __builtin_amdgcn_readfirstlane(tid >> 6);
    int row0, L; seq_info(s, row0, L);
    const float* OPS = (const float*)(p.ws + WS_OPS); float* ORAW = (float*)(p.ws + WS_ORAW);
    float* buf = (float*)smem;
    const int rih = rg * 16 + (wave & 3) * 4 + (lane >> 4);
    const int c4 = (lane & 15) * 4;
    f32x4 S = (f32x4){0.f, 0.f, 0.f, 0.f};
    if (s >= 8 && wave < 4) S = *(const f32x4*)(p.in[3] + ((((size_t)i * 128 + (s - 8)) * 8 + h) * 64 + rih) * 64 + c4);
    f32x4 pre[6];
    const int nch = (L + 31) / 32;
#pragma unroll
    for (int k = 0; k < 6; ++k) { const int idx4 = tid + k * 512; const int tt = idx4 / 96, off = idx4 % 96;
        pre[k] = (tt < L) ? *(const f32x4*)(OPS + ((size_t)(row0 + tt) * 8 + h) * 384 + off * 4) : (f32x4){0.f, 0.f, 0.f, 0.f}; }
    for (int ch = 0; ch < nch; ++ch) {
        const int t0 = ch * 32;
        __syncthreads();
#pragma unroll
        for (int k = 0; k < 6; ++k) { const int idx4 = tid + k * 512; *(f32x4*)(buf + idx4 * 4) = pre[k]; }
        __syncthreads();
        if (ch + 1 < nch) {
#pragma unroll
            for (int k = 0; k < 6; ++k) { const int idx4 = tid + k * 512; const int tt = t0 + 32 + idx4 / 96, off = idx4 % 96;
                pre[k] = (tt < L) ? *(const f32x4*)(OPS + ((size_t)(row0 + tt) * 8 + h) * 384 + off * 4) : (f32x4){0.f, 0.f, 0.f, 0.f}; }
        }
        if (wave < 4) {
            const int ns = (L - t0) < 32 ? (L - t0) : 32;
            f32x4 r4 = *(const f32x4*)(buf + c4), w4 = *(const f32x4*)(buf + 64 + c4), k4 = *(const f32x4*)(buf + 128 + c4);
            f32x4 kk4 = *(const f32x4*)(buf + 256 + c4), ka4 = *(const f32x4*)(buf + 320 + c4);
            float vv = buf[192 + rih];
            float* op = ORAW + (size_t)(row0 + t0) * 512 + h * 64 + rih;
            f32x4 rprev = r4;
#pragma unroll 2
            for (int tt = 0; tt < ns; ++tt) {
                const float* nb = buf + ((tt + 1 < 32) ? (tt + 1) : 31) * 384;
                const f32x4 r4n = *(const f32x4*)(nb + c4), w4n = *(const f32x4*)(nb + 64 + c4), k4n = *(const f32x4*)(nb + 128 + c4);
                const f32x4 kk4n = *(const f32x4*)(nb + 256 + c4), ka4n = *(const f32x4*)(nb + 320 + c4);
                const float vvn = nb[192 + rih];
                float o = (S[0] * rprev[0] + S[1] * rprev[1]) + (S[2] * rprev[2] + S[3] * rprev[3]);
                const f32x4 kv = k4 * vv;
                float sk = (S[0] * kk4[0] + S[1] * kk4[1]) + (S[2] * kk4[2] + S[3] * kk4[3]);
                sk = row16_sum(sk);
                o = row16_sum(o);
                const f32x4 t1 = kv - ka4 * sk;
                S = S * w4 + t1;
                if ((lane & 15) == 0 && tt > 0) op[(size_t)(tt - 1) * 512] = o;
                rprev = r4;
                r4 = r4n; w4 = w4n; k4 = k4n; kk4 = kk4n; ka4 = ka4n; vv = vvn;
            }
            {
                float o = (S[0] * rprev[0] + S[1] * rprev[1]) + (S[2] * rprev[2] + S[3] * rprev[3]);
                o = row16_sum(o);
                if ((lane & 15) == 0) op[(size_t)(ns - 1) * 512] = o;
            }
        }
    }
    if (wave < 4) {
        float* so = (s < 8) ? p.out + O_PRWKV + ((((size_t)i * 8 + s) * 8 + h) * 64 + rih) * 64 + c4
                            : p.out + O_SRWKV + ((((size_t)i * 128 + (s - 8)) * 8 + h) * 64 + rih) * 64 + c4;
        *(f32x4*)so = S;
    }
}

__device__ __forceinline__ void rwkv_item2(const Params& p, int i, int s, int h, int rg, unsigned char* smem) {
    const int tid = mk_ltid(), lane = tid & 63, wave = __builtin_amdgcn_readfirstlane(tid >> 6);
    int row0, L; seq_info(s, row0, L);
    const float* OPS = (const float*)(p.ws + WS_OPS); float* ORAW = (float*)(p.ws + WS_ORAW);
    float* buf = (float*)smem;
    const int ra = rg * 32 + (wave & 3) * 4 + (lane >> 4), rb = ra + 16;
    const int c4 = (lane & 15) * 4;
    f32x4 Sa = (f32x4){0.f, 0.f, 0.f, 0.f}, Sb = Sa;
    if (s >= 8 && wave < 4) { const float* sp = p.in[3] + (((size_t)i * 128 + (s - 8)) * 8 + h) * 4096;
        Sa = *(const f32x4*)(sp + ra * 64 + c4); Sb = *(const f32x4*)(sp + rb * 64 + c4); }
    f32x4 pre[12];
    const int nch = (L + 63) / 64;
#pragma unroll
    for (int k = 0; k < 12; ++k) { const int idx4 = tid + k * 512; const int tt = idx4 / 96, off = idx4 % 96;
        pre[k] = (tt < L) ? *(const f32x4*)(OPS + ((size_t)(row0 + tt) * 8 + h) * 384 + off * 4) : (f32x4){0.f, 0.f, 0.f, 0.f}; }
    for (int ch = 0; ch < nch; ++ch) {
        const int t0 = ch * 64;
        __syncthreads();
#pragma unroll
        for (int k = 0; k < 12; ++k) { const int idx4 = tid + k * 512; *(f32x4*)(buf + idx4 * 4) = pre[k]; }
        __syncthreads();
        if (ch + 1 < nch) {
#pragma unroll
            for (int k = 0; k < 12; ++k) { const int idx4 = tid + k * 512; const int tt = t0 + 64 + idx4 / 96, off = idx4 % 96;
                pre[k] = (tt < L) ? *(const f32x4*)(OPS + ((size_t)(row0 + tt) * 8 + h) * 384 + off * 4) : (f32x4){0.f, 0.f, 0.f, 0.f}; }
        }
        if (wave < 4) {
            const int ns = (L - t0) < 64 ? (L - t0) : 64;
            f32x4 rA = *(const f32x4*)(buf + c4), wA = *(const f32x4*)(buf + 64 + c4), kA = *(const f32x4*)(buf + 128 + c4);
            f32x4 kkA = *(const f32x4*)(buf + 256 + c4), kaA = *(const f32x4*)(buf + 320 + c4);
            float vaA = buf[192 + ra], vbA = buf[192 + rb];
            f32x4 rB, wB, kB, kkB, kaB; float vaB, vbB;
            float* op = ORAW + (size_t)(row0 + t0) * 512 + h * 64 + ra;
            f32x4 rprev = rA;
#define RW_LOAD(R, W, K, KK, KA, VA, VB, nb_) do { const float* nb = (nb_); R = *(const f32x4*)(nb + c4); W = *(const f32x4*)(nb + 64 + c4); K = *(const f32x4*)(nb + 128 + c4); \
                KK = *(const f32x4*)(nb + 256 + c4); KA = *(const f32x4*)(nb + 320 + c4); VA = nb[192 + ra]; VB = nb[192 + rb]; } while (0)
#define RW_STEP(R, W, K, KK, KA, VA, VB, RP, tt_) do { \
                float oa = (Sa[0] * RP[0] + Sa[1] * RP[1]) + (Sa[2] * RP[2] + Sa[3] * RP[3]); \
                float ob = (Sb[0] * RP[0] + Sb[1] * RP[1]) + (Sb[2] * RP[2] + Sb[3] * RP[3]); \
                float ska = (Sa[0] * KK[0] + Sa[1] * KK[1]) + (Sa[2] * KK[2] + Sa[3] * KK[3]); \
                float skb = (Sb[0] * KK[0] + Sb[1] * KK[1]) + (Sb[2] * KK[2] + Sb[3] * KK[3]); \
                ska = row16_sum(ska); skb = row16_sum(skb); oa = row16_sum(oa); ob = row16_sum(ob); \
                Sa = Sa * W + (K * VA - KA * ska); Sb = Sb * W + (K * VB - KA * skb); \
                if ((lane & 15) == 0 && (tt_) > 0) { op[(size_t)((tt_) - 1) * 512] = oa; op[(size_t)((tt_) - 1) * 512 + 16] = ob; } } while (0)
            for (int tt = 0; tt < ns; tt += 2) {
                RW_LOAD(rB, wB, kB, kkB, kaB, vaB, vbB, buf + (tt + 1) * 384);
                RW_STEP(rA, wA, kA, kkA, kaA, vaA, vbA, rprev, tt);
                const f32x4 rEven = rA;
                RW_LOAD(rA, wA, kA, kkA, kaA, vaA, vbA, buf + ((tt + 2 < 64) ? (tt + 2) : 63) * 384);
                RW_STEP(rB, wB, kB, kkB, kaB, vaB, vbB, rEven, tt + 1);
                rprev = rB;
            }
            {
                float oa = (Sa[0] * rprev[0] + Sa[1] * rprev[1]) + (Sa[2] * rprev[2] + Sa[3] * rprev[3]);
                float ob = (Sb[0] * rprev[0] + Sb[1] * rprev[1]) + (Sb[2] * rprev[2] + Sb[3] * rprev[3]);
                oa = row16_sum(oa); ob = row16_sum(ob);
                if ((lane & 15) == 0) { op[(size_t)(ns - 1) * 512] = oa; op[(size_t)(ns - 1) * 512 + 16] = ob; }
            }
#undef RW_LOAD
#undef RW_STEP
        }
    }
    if (wave < 4) {
        float* so = (s < 8) ? p.out + O_PRWKV + (((size_t)i * 8 + s) * 8 + h) * 4096 : p.out + O_SRWKV + (((size_t)i * 128 + (s - 8)) * 8 + h) * 4096;
        *(f32x4*)(so + ra * 64 + c4) = Sa; *(f32x4*)(so + rb * 64 + c4) = Sb;
    }
}

__device__ __forceinline__ void ret_item(const Params& p, int i, int s, int hb, unsigned char* smem) {
    const int tid = mk_ltid(), lane = tid & 63, w = __builtin_amdgcn_readfirstlane(tid >> 6);
    const int r = lane & 15, q = lane >> 4;
    int row0, L; seq_info(s, row0, L);
    const int C = (s < 8) ? 128 : 4; const int nch = L / C;
    const float lg = log2f(1.0f - exp2f(-5.0f - (float)hb));
    const bf16_t* ZB = (const bf16_t*)(p.ws + WS_ZB); const bf16_t* RQ = (const bf16_t*)(p.ws + WS_RQ); const bf16_t* RK = (const bf16_t*)(p.ws + WS_RK);
    bf16_t* OMIX = (bf16_t*)(p.ws + WS_OMIX);
    const float* gn_g = p.in[25] + i * 512 + hb * 128; const float* gn_b = p.in[26] + i * 512 + hb * 128;
    constexpr int LD = 136;
    bf16_t* KC = (bf16_t*)smem; bf16_t* KZT = KC + 128 * LD; bf16_t* VT = KZT + 128 * LD; bf16_t* SB = VT + 128 * LD;
    f32x4 ST[8];
#pragma unroll
    for (int nt = 0; nt < 8; ++nt) ST[nt] = (f32x4){0.f, 0.f, 0.f, 0.f};
    if (s >= 8) {
        const float* S0 = p.in[4] + (((size_t)i * 128 + (s - 8)) * 4 + hb) * 16384;
#pragma unroll
        for (int nt = 0; nt < 8; ++nt) ST[nt] = *(const f32x4*)(S0 + (size_t)(nt * 16 + r) * 128 + 16 * w + q * 4);
    }
    const float gch = exp2f((float)C * lg);
    for (int ch = 0; ch < nch; ++ch) {
        const int rb = row0 + ch * C;
        __syncthreads();
        for (int idx = tid; idx < 128 * 16; idx += 512) {
            const int tok = idx & 127, c8 = (idx >> 7) * 8;
            u32x4 kv = (u32x4){0u, 0u, 0u, 0u}, vv = kv;
            if (tok < C) { kv = *(const u32x4*)(RK + (size_t)(rb + tok) * 512 + hb * 128 + c8);
                           vv = *(const u32x4*)(ZB + (size_t)(rb + tok) * AB_N + 1792 + 1024 + hb * 128 + c8); }
            *(u32x4*)(KC + tok * LD + c8) = kv;
            const float zeta = __builtin_amdgcn_exp2f((float)(C - 1 - tok) * lg);
            const unsigned kw[4] = {kv.x, kv.y, kv.z, kv.w}; const unsigned vw[4] = {vv.x, vv.y, vv.z, vv.w};
#pragma unroll
            for (int e = 0; e < 4; ++e) {
                const float k0 = __uint_as_float(kw[e] << 16) * zeta, k1 = __uint_as_float(kw[e] & 0xffff0000u) * zeta;
                KZT[(c8 + 2 * e) * LD + tok] = f2bf(k0); KZT[(c8 + 2 * e + 1) * LD + tok] = f2bf(k1);
                VT[(c8 + 2 * e) * LD + tok] = (bf16_t)(vw[e] & 0xffffu); VT[(c8 + 2 * e + 1) * LD + tok] = (bf16_t)(vw[e] >> 16);
            }
        }
#pragma unroll
        for (int nt = 0; nt < 8; ++nt)
#pragma unroll
            for (int j = 0; j < 4; ++j) SB[(16 * w + q * 4 + j) * LD + nt * 16 + r] = f2bf(ST[nt][j]);
        __syncthreads();
        bf16x8 aq[4];
#pragma unroll
        for (int ks = 0; ks < 4; ++ks) {
            if (16 * w + r < C) aq[ks] = *(const bf16x8*)(RQ + (size_t)(rb + 16 * w + r) * 512 + hb * 128 + ks * 32 + q * 8);
            else aq[ks] = (bf16x8){0, 0, 0, 0, 0, 0, 0, 0};
        }
        u32x2 P[8]; f32x4 O[8];
#pragma unroll
        for (int nt = 0; nt < 8; ++nt) {
            f32x4 acc = (f32x4){0.f, 0.f, 0.f, 0.f}, oc = acc;
#pragma unroll
            for (int ks = 0; ks < 4; ++ks) {
                const bf16x8 bk = *(const bf16x8*)(KC + (nt * 16 + r) * LD + ks * 32 + q * 8);
                const bf16x8 bs = *(const bf16x8*)(SB + (nt * 16 + r) * LD + ks * 32 + q * 8);
                acc = __builtin_amdgcn_mfma_f32_16x16x32_bf16(aq[ks], bk, acc, 0, 0, 0);
                oc = __builtin_amdgcn_mfma_f32_16x16x32_bf16(aq[ks], bs, oc, 0, 0, 0);
            }
#pragma unroll
            for (int j = 0; j < 4; ++j) {
                const int ii = 16 * w + q * 4 + j, jt = nt * 16 + r;
                acc[j] = (ii >= jt) ? acc[j] * __builtin_amdgcn_exp2f((float)(ii - jt) * lg) : 0.f;
                oc[j] *= __builtin_amdgcn_exp2f((float)(ii + 1) * lg);
            }
            P[nt].x = pk2(acc[0], acc[1]); P[nt].y = pk2(acc[2], acc[3]); O[nt] = oc;
        }
        __syncthreads();
#pragma unroll
        for (int nt = 0; nt < 8; ++nt)
#pragma unroll
            for (int j = 0; j < 4; ++j) KC[(16 * w + q * 4 + j) * LD + nt * 16 + r] = (bf16_t)(((j & 2) ? P[nt].y : P[nt].x) >> ((j & 1) * 16));
        __syncthreads();
#pragma unroll
        for (int nt = 0; nt < 8; ++nt) ST[nt] = ST[nt] * gch;
#pragma unroll
        for (int ks = 0; ks < 4; ++ks) {
            const bf16x8 ap = *(const bf16x8*)(KC + (16 * w + r) * LD + ks * 32 + q * 8);
            const bf16x8 av = *(const bf16x8*)(VT + (16 * w + r) * LD + ks * 32 + q * 8);
#pragma unroll
            for (int nt = 0; nt < 8; ++nt) {
                const bf16x8 bv = *(const bf16x8*)(VT + (nt * 16 + r) * LD + ks * 32 + q * 8);
                const bf16x8 bz = *(const bf16x8*)(KZT + (nt * 16 + r) * LD + ks * 32 + q * 8);
                O[nt] = __builtin_amdgcn_mfma_f32_16x16x32_bf16(ap, bv, O[nt], 0, 0, 0);
                ST[nt] = __builtin_amdgcn_mfma_f32_16x16x32_bf16(av, bz, ST[nt], 0, 0, 0);
            }
        }
#pragma unroll
        for (int j = 0; j < 4; ++j) {
            float s1 = 0.f;
#pragma unroll
            for (int nt = 0; nt < 8; ++nt) s1 += O[nt][j];
            s1 = row16_sum(s1); const float mean = s1 * (1.f / 128.f);
            float s2 = 0.f;
#pragma unroll
            for (int nt = 0; nt < 8; ++nt) { const float d = O[nt][j] - mean; s2 += d * d; }
            s2 = row16_sum(s2); const float rstd = rsqrtf(s2 * (1.f / 128.f) + 1e-5f);
            const int ii = 16 * w + q * 4 + j;
            if (ii < C) {
                const size_t row = (size_t)(rb + ii);
#pragma unroll
                for (int nt = 0; nt < 8; ++nt) { const int dv = nt * 16 + r;
                    const float val = (O[nt][j] - mean) * rstd * gn_g[dv] + gn_b[dv];
                    const float gr = bf2f(ZB[row * AB_N + 1792 + 1536 + hb * 128 + dv]);
                    OMIX[row * 1024 + 512 + hb * 128 + dv] = f2bf(val * silu(gr)); }
            }
        }
    }
    float* so = (s < 8) ? p.out + O_PRET + (((size_t)i * 8 + s) * 4 + hb) * 16384 : p.out + O_SRET + (((size_t)i * 128 + (s - 8)) * 4 + hb) * 16384;
#pragma unroll
    for (int nt = 0; nt < 8; ++nt) *(f32x4*)(so + (size_t)(nt * 16 + r) * 128 + 16 * w + q * 4) = ST[nt];
}

__device__ __forceinline__ void phase_ab_core(const Params& p, int i, int l, unsigned char* smem) {
    const int bid = mk_lbid(), G = gridDim.x; const int wv = mk_ltid() >> 6;
    if (G == 256) {
        if (bid < 128) rwkv_item2(p, i, bid >> 4, (bid >> 1) & 7, bid & 1, smem);
        else if (bid < 160) ret_item(p, i, (bid - 128) >> 2, (bid - 128) & 3, smem);
        else {
            for (int it = bid - 160; it < 128 * 16; it += 96) rwkv_item2(p, i, 8 + (it >> 4), (it >> 1) & 7, it & 1, smem);
            __syncthreads();
            for (int it = bid - 160; it < 128 * 4; it += 96) ret_item(p, i, 8 + (it >> 2), it & 3, smem);
        }
        if (bid >= 160) convert_ffn_ahead(p, l, (bid - 160) * 8 + wv, 96 * 8, smem);
    } else {
        for (int it = bid; it < 136 * 16; it += G) rwkv_item2(p, i, it >> 4, (it >> 1) & 7, it & 1, smem);
        __syncthreads();
        for (int it = bid; it < 136 * 4; it += G) ret_item(p, i, it >> 2, it & 3, smem);
        convert_ffn_ahead(p, l, bid * 8 + wv, G * 8, smem);
    }
}

__device__ __forceinline__ void phase_ab_post(const Params& p, int i) {
    const int tid = mk_ltid(), lane = tid & 63, wave = tid >> 6;
    const int gw = mk_lbid() * 8 + wave, NGW = gridDim.x * 8;
    const float* OPS = (const float*)(p.ws + WS_OPS); const float* ORAW = (const float*)(p.ws + WS_ORAW);
    const float* GATE = (const float*)(p.ws + WS_GATE); const float* BONUS = (const float*)(p.ws + WS_BONUS);
    bf16_t* OMIX = (bf16_t*)(p.ws + WS_OMIX);
    const float* gg = p.in[23] + i * 512; const float* gb = p.in[24] + i * 512;
    for (int m = gw; m < M; m += NGW) {
        const int c = lane * 8, h = lane >> 3, hc = c & 63;
        const f32x4 o0 = *(const f32x4*)(ORAW + (size_t)m * 512 + c), o1 = *(const f32x4*)(ORAW + (size_t)m * 512 + c + 4);
        float s1 = (o0[0] + o0[1]) + (o0[2] + o0[3]) + (o1[0] + o1[1]) + (o1[2] + o1[3]);
        s1 += __shfl_xor(s1, 1); s1 += __shfl_xor(s1, 2); s1 += __shfl_xor(s1, 4);
        const float mean = s1 * (1.f / 64.f);
        const f32x4 d0 = o0 - mean, d1 = o1 - mean;
        float s2 = (d0[0] * d0[0] + d0[1] * d0[1]) + (d0[2] * d0[2] + d0[3] * d0[3]) + (d1[0] * d1[0] + d1[1] * d1[1]) + (d1[2] * d1[2] + d1[3] * d1[3]);
        s2 += __shfl_xor(s2, 1); s2 += __shfl_xor(s2, 2); s2 += __shfl_xor(s2, 4);
        const float rstd = rsqrtf(s2 * (1.f / 64.f) + 64e-5f);
        const float bon = BONUS[(size_t)m * 8 + h];
        const float* vb = OPS + ((size_t)m * 8 + h) * 384 + 192 + hc;
        const f32x4 v0 = *(const f32x4*)vb, v1 = *(const f32x4*)(vb + 4);
        const f32x4 g0 = *(const f32x4*)(gg + c), g1 = *(const f32x4*)(gg + c + 4), b0 = *(const f32x4*)(gb + c), b1 = *(const f32x4*)(gb + c + 4);
        const f32x4 t0 = *(const f32x4*)(GATE + (size_t)m * 512 + c), t1 = *(const f32x4*)(GATE + (size_t)m * 512 + c + 4);
        const f32x4 y0 = (d0 * rstd * g0 + b0 + v0 * bon) * t0, y1 = (d1 * rstd * g1 + b1 + v1 * bon) * t1;
        u32x4 o; o.x = pk2(y0[0], y0[1]); o.y = pk2(y0[2], y0[3]); o.z = pk2(y1[0], y1[1]); o.w = pk2(y1[2], y1[3]);
        *(u32x4*)(OMIX + (size_t)m * 1024 + c) = o;
    }
}

__device__ __forceinline__ int gdn_item_index(int s, int h, int c) { return (s < 8) ? ((s * 8 + h) * 32 + c) : (2048 + (s - 8) * 8 + h); }

__device__ __forceinline__ void gdn_chunk_item(const Params& p, int i, int s, int h, int c, int pf_row, int pf_h, unsigned char* smem) {
    const int tid = mk_ltid(), lane = tid & 63, w = __builtin_amdgcn_readfirstlane(tid >> 6);
    const int r = lane & 15, q = lane >> 4;
    int row0, L; seq_info(s, row0, L);
    const int t0 = c * 64; const int nvalid = (L - t0) < 64 ? (L - t0) : 64;
    const bf16_t* ZB = (const bf16_t*)(p.ws + WS_ZB);
    unsigned char* rec = p.ws + WS_CH + (size_t)gdn_item_index(s, h, c) * CH_BYTES;
    float* U = (float*)(rec + CH_U); bf16_t* Wd = (bf16_t*)(rec + CH_W); bf16_t* QG = (bf16_t*)(rec + CH_QG); bf16_t* QK = (bf16_t*)(rec + CH_QK); bf16_t* KDT = (bf16_t*)(rec + CH_KDT);
    constexpr int LD = 132, ALD = 68;
    float* qs = (float*)smem; float* ks = qs + 64 * LD; float* vs = ks + 64 * LD; float* As = vs + 64 * LD;
    float* AT = As + 64 * ALD; float* gcs = AT + 64 * ALD; float* bes = gcs + 64;
    unsigned short pfv = 0;
    if (pf_row >= 0 && tid < 384) { const int rr_ = tid / 6, pp_ = (tid % 6) >> 1, hh_ = tid & 1;
        pfv = ((const bf16_t*)(p.ws + WS_ZB))[(size_t)(pf_row + rr_) * GD_N + pp_ * 1024 + pf_h * 128 + hh_ * 64]; }
#ifndef REP_G_CONV
#define REP_G_CONV 1
#endif
#ifndef REP_G_MFMA
#define REP_G_MFMA 1
#endif
#ifndef REP_G_QG
#define REP_G_QG 1
#endif
#ifndef REP_G_SUB
#define REP_G_SUB 1
#endif
#pragma unroll 1
    for (int rp_ = 0; rp_ < REP_G_CONV; ++rp_) {
    __syncthreads();
    if (tid < 384) {
        const int part = tid >> 7, ch = tid & 127; const int zc = part * 1024 + h * 128 + ch;
        const float* cw = p.in[28] + (size_t)i * 4 * 3072 + zc;
        const float cw0 = cw[0], cw1 = cw[3072], cw2 = cw[2 * 3072], cw3 = cw[3 * 3072];
        float* dst = (part == 0 ? qs : part == 1 ? ks : vs) + ch;
        if (nvalid == 64) {
            float xh[3], xn[64];
#pragma unroll
            for (int j = 0; j < 3; ++j) { const int t = t0 - 3 + j;
                xh[j] = (t >= 0) ? bf2f(ZB[(size_t)(row0 + (t >= 0 ? t : 0)) * GD_N + zc]) : 0.f; }
#pragma unroll
            for (int e = 0; e < 64; ++e) xn[e] = bf2f(ZB[(size_t)(row0 + t0 + e) * GD_N + zc]);
            float x3 = xh[0], x2 = xh[1], x1 = xh[2];
#pragma unroll
            for (int e = 0; e < 64; ++e) {
                const float y = cw0 * x3 + cw1 * x2 + cw2 * x1 + cw3 * xn[e];
                dst[e * LD] = silu(y);
                x3 = x2; x2 = x1; x1 = xn[e];
            }
        } else {
            float x3, x2, x1;
            { const float* cs = p.in[5] + (((size_t)i * 128 + (s - 8)) * 3) * 3072 + zc; x3 = cs[0]; x2 = cs[3072]; x1 = cs[2 * 3072]; }
#pragma unroll
            for (int e = 0; e < 64; ++e) {
                float v = 0.f;
                if (e < 4) { const float xe = (e < nvalid) ? bf2f(ZB[(size_t)(row0 + e) * GD_N + zc]) : 0.f;
                    const float y = cw0 * x3 + cw1 * x2 + cw2 * x1 + cw3 * xe; v = (e < nvalid) ? silu(y) : 0.f; x3 = x2; x2 = x1; x1 = xe; }
                dst[e * LD] = v;
            }
        }
    } else if (tid < 448) {
        const int t = tid - 384;
        float be = 0.f, g = 0.f;
        if (t < nvalid) { const size_t zr = (size_t)(row0 + t0 + t) * GD_N;
            be = sigm(bf2f(ZB[zr + 3072 + h]));
            const float a = bf2f(ZB[zr + 3080 + h]) + p.in[30][i * 8 + h];
            const float sp = fmaxf(a, 0.f) + __logf(1.f + __expf(-fabsf(a)));
            g = -__expf(p.in[29][i * 8 + h]) * sp; }
#pragma unroll
        for (int o = 1; o < 64; o <<= 1) { const float y = __shfl_up(g, o); if (t >= o) g += y; }
        gcs[t] = g; bes[t] = be;
    }
    }
    __syncthreads();
    for (int pass = 0; pass < 4; ++pass) {
        const int rowi = w * 16 + pass * 4 + q;
        const int t = rowi & 63;
        if ((w * 16 + pass * 4) % 64 < nvalid) {
            float* base = ((rowi < 64) ? qs : ks) + t * LD + r * 8;
            f32x4 a = *(f32x4*)base, b = *(f32x4*)(base + 4);
            float ss = (a[0] * a[0] + a[1] * a[1]) + (a[2] * a[2] + a[3] * a[3]) + (b[0] * b[0] + b[1] * b[1]) + (b[2] * b[2] + b[3] * b[3]);
            ss = row16_sum(ss);
            const float rn = rsqrtf(fmaxf(ss, 1e-12f));
            *(f32x4*)base = a * rn; *(f32x4*)(base + 4) = b * rn;
        }
    }
    __syncthreads();
#pragma unroll 1
    for (int rp_ = 0; rp_ < REP_G_MFMA; ++rp_)
#pragma unroll
    for (int tl = 0; tl < 2; ++tl) {
        const int tile = 2 * w + tl, mi = tile >> 2, ni = tile & 3;
        f32x4 akk = (f32x4){0.f, 0.f, 0.f, 0.f}, aqk = akk;
        if (mi * 16 < nvalid) {
#pragma unroll 8
            for (int k0 = 0; k0 < 128; k0 += 4) {
                const float ka = ks[(mi * 16 + r) * LD + k0 + q], kb = ks[(ni * 16 + r) * LD + k0 + q], qa = qs[(mi * 16 + r) * LD + k0 + q];
                akk = __builtin_amdgcn_mfma_f32_16x16x4f32(ka, kb, akk, 0, 0, 0);
                aqk = __builtin_amdgcn_mfma_f32_16x16x4f32(qa, kb, aqk, 0, 0, 0);
            }
        }
#pragma unroll
        for (int j = 0; j < 4; ++j) { const int ii = mi * 16 + q * 4 + j, jj = ni * 16 + r;
            const float dm = (ii >= jj) ? __expf(gcs[ii] - gcs[jj]) : 0.f;
            const float aij = (ii > jj) ? bes[ii] * akk[j] * dm : 0.f;
            As[ii * ALD + jj] = aij; AT[jj * ALD + ii] = aij;
            if (mi * 16 < nvalid) QK[ii * 64 + jj] = f2bf(aqk[j] * 0.08838834764831845f * dm); }
    }
    __syncthreads();
#pragma unroll 1
    for (int rp_ = 0; rp_ < REP_G_QG; ++rp_)
    {
        const float gl = gcs[63];
        const int nrow = (nvalid == 64) ? 64 : 16;
        for (int idx = tid; idx < nrow * 128; idx += 512) { const int t = idx >> 7, d = idx & 127;
            QG[idx] = f2bf(qs[t * LD + d] * 0.08838834764831845f * __expf(gcs[t])); }
        if (nvalid == 64) {
            for (int idx = tid; idx < 64 * 128; idx += 512) { const int d = idx >> 6, t = idx & 63;
                KDT[idx] = f2bf(ks[t * LD + d] * __expf(gl - gcs[t])); }
        } else {
            for (int idx = tid; idx < 16 * 128; idx += 512) { const int d = idx >> 4, t = idx & 15;
                KDT[d * 64 + t] = f2bf(ks[t * LD + d] * __expf(gl - gcs[t])); }
        }
        if (tid == 0) ((float*)(p.ws + WS_GL))[gdn_item_index(s, h, c)] = __expf(gl);
    }
    __syncthreads();
    for (int idx = tid; idx < 64 * 128; idx += 512) { const int t = idx >> 7, d = idx & 127; const float be = bes[t];
        vs[t * LD + d] *= be; ks[t * LD + d] *= be * __expf(gcs[t]); }
    __syncthreads();
    const int nblk = (nvalid + 15) >> 4;
#pragma unroll 1
    for (int blk = 0; blk < 4; ++blk) {
        if (blk >= nblk) continue;
        if (blk > 0) {
#pragma unroll
            for (int tl = 0; tl < 2; ++tl) {
                const int nt = 2 * w + tl; float* bb = (nt < 8 ? vs : ks) + (nt & 7) * 16 + r;
                f32x4 acc = (f32x4){0.f, 0.f, 0.f, 0.f};
                const float* ap = As + (blk * 16 + r) * ALD + q;
                for (int k0 = 0; k0 < blk * 16; k0 += 4)
                    acc = __builtin_amdgcn_mfma_f32_16x16x4f32(ap[k0], bb[(k0 + q) * LD], acc, 0, 0, 0);
#pragma unroll
                for (int j = 0; j < 4; ++j) bb[(blk * 16 + q * 4 + j) * LD] -= acc[j];
            }
            __syncthreads();
        }
        if (tid < 256) {
            const int col = tid & 127; const bool isu = tid < 128;
            float* buf = (isu ? vs : ks) + col;
            float acc[16];
#pragma unroll
            for (int e = 0; e < 16; ++e) acc[e] = buf[(blk * 16 + e) * LD];
#pragma unroll
            for (int e = 1; e < 16; ++e) {
#pragma unroll
                for (int f = 0; f < e; ++f) acc[e] -= As[(blk * 16 + e) * ALD + blk * 16 + f] * acc[f];
            }
#pragma unroll
            for (int e = 0; e < 16; ++e) { const int ii = blk * 16 + e; buf[ii * LD] = acc[e];
                if (isu) U[ii * 128 + col] = acc[e]; else Wd[ii * 128 + col] = f2bf(acc[e]); }
        }
        __syncthreads();
    }
    if (pfv == 0x7fc3u) gcs[0] = 1.f;
    asm volatile("s_waitcnt vmcnt(0)" ::: "memory");
    __syncthreads();
}

__device__ __forceinline__ void phase_gdn_chunk(const Params& p, int i, unsigned char* smem) {
    if (gridDim.x == 256) {
        for (int it = mk_lbid(); it < 64 * GDN_LATE; it += 256) {
            const int s = it / (8 * GDN_LATE), rem = it % (8 * GDN_LATE), h = rem / GDN_LATE, c = rem % GDN_LATE;
            const int nit = it + 256; int pf_row = -1, pf_h = 0;
            if (nit < 64 * GDN_LATE) { const int rem2 = nit % (8 * GDN_LATE); pf_row = (nit / (8 * GDN_LATE)) * 2048 + (rem2 % GDN_LATE) * 64; pf_h = rem2 / GDN_LATE; }
            gdn_chunk_item(p, i, s, h, c, pf_row, pf_h, smem);
        }
    } else
    for (int it = mk_lbid(); it < N_CH; it += gridDim.x) {
        int s, h, c;
        if (it < 2048) { s = it >> 8; h = (it >> 5) & 7; c = it & 31; } else { const int k = it - 2048; s = 8 + (k >> 3); h = k & 7; c = 0; }
        const int nit = it + gridDim.x; int pf_row = -1, pf_h = 0;
        if (nit < 2048) { pf_row = (nit >> 8) * 2048 + (nit & 31) * 64; pf_h = (nit >> 5) & 7; }
        gdn_chunk_item(p, i, s, h, c, pf_row, pf_h, smem);
    }
    const bf16_t* ZB = (const bf16_t*)(p.ws + WS_ZB);
    const int gt = mk_lbid() * 512 + mk_ltid(), GT = gridDim.x * 512;
    for (int idx = gt; idx < 136 * 3 * 3072; idx += GT) {
        const int s = idx / (3 * 3072), rem = idx % (3 * 3072), j = rem / 3072, zc = rem % 3072;
        int row0, L; seq_info(s, row0, L);
        const float v = bf2f(ZB[(size_t)(row0 + L - 3 + j) * GD_N + zc]);
        if (s < 8) p.out[O_PCONV + (((size_t)i * 8 + s) * 3 + j) * 3072 + zc] = v;
        else p.out[O_SCONV + (((size_t)i * 128 + (s - 8)) * 3 + j) * 3072 + zc] = v;
    }
}

__device__ __forceinline__ void gdn_scan_item(const Params& p, int i, int s, int h, unsigned* flags, unsigned tag, unsigned char* smem) {
    const int tid = mk_ltid(), lane = tid & 63, w = __builtin_amdgcn_readfirstlane(tid >> 6);
    const int r = lane & 15, q = lane >> 4;
    int row0, L; seq_info(s, row0, L);
    const int nch = (s < 8) ? 32 : 1;
    const bf16_t* ZB = (const bf16_t*)(p.ws + WS_ZB); bf16_t* OMIX = (bf16_t*)(p.ws + WS_OMIX);
    const float* GL = (const float*)(p.ws + WS_GL);
    const float* ng = p.in[31] + i * 128;
    constexpr int LD = 136, VLD = 72, ULD = 132;
    bf16_t* SB = (bf16_t*)smem;
    bf16_t* VN = (bf16_t*)(smem + 34816);
    float* red = (float*)(smem + 53248);
    bf16_t* WL = (bf16_t*)(smem + 53760);
    bf16_t* QGL = (bf16_t*)(smem + 71168);
    bf16_t* QKL = (bf16_t*)(smem + 88576);
    bf16_t* KDL = (bf16_t*)(smem + 97792);
    float* UL = (float*)(smem + 116224);
    f32x4 ST[8];
#pragma unroll
    for (int nt = 0; nt < 8; ++nt) ST[nt] = (f32x4){0.f, 0.f, 0.f, 0.f};
    if (s >= 8) {
        const float* S0 = p.in[6] + (((size_t)i * 128 + (s - 8)) * 8 + h) * 16384;
#pragma unroll
        for (int nt = 0; nt < 8; ++nt) ST[nt] = *(const f32x4*)(S0 + (size_t)(nt * 16 + r) * 128 + 16 * w + q * 4);
    }
    const int mt = w & 3, nh = w >> 2;
    u32x4 pw[2], pq[2], pk, pd[2]; f32x4 pu[4]; float pgl;
    const bool smp = (s >= 8);
#define GDN_PREFETCH(cc) do { const int item_ = gdn_item_index(s, h, (cc)); const unsigned char* rec_ = p.ws + WS_CH + (size_t)item_ * CH_BYTES; \
        const u32x4 z4_ = (u32x4){0u, 0u, 0u, 0u}; \
        _Pragma("unroll") for (int k_ = 0; k_ < 2; ++k_) { const int idx_ = tid + k_ * 512; \
            pw[k_] = (smp && (idx_ >> 4) >= 16) ? z4_ : *(const u32x4*)((const bf16_t*)(rec_ + CH_W) + (idx_ >> 4) * 128 + (idx_ & 15) * 8); \
            pq[k_] = (smp && (idx_ >> 4) >= 16) ? z4_ : *(const u32x4*)((const bf16_t*)(rec_ + CH_QG) + (idx_ >> 4) * 128 + (idx_ & 15) * 8); \
            pd[k_] = (smp && (idx_ & 7) >= 2) ? z4_ : *(const u32x4*)((const bf16_t*)(rec_ + CH_KDT) + (idx_ >> 3) * 64 + (idx_ & 7) * 8); } \
        pk = (smp && (tid >> 3) >= 16) ? z4_ : *(const u32x4*)((const bf16_t*)(rec_ + CH_QK) + (tid >> 3) * 64 + (tid & 7) * 8); \
        _Pragma("unroll") for (int k_ = 0; k_ < 4; ++k_) { const int idx_ = tid + k_ * 512; \
            pu[k_] = (smp && (idx_ >> 5) >= 16) ? (f32x4){0.f, 0.f, 0.f, 0.f} : *(const f32x4*)((const float*)(rec_ + CH_U) + (idx_ >> 5) * 128 + (idx_ & 31) * 4); } \
        pgl = GL[item_]; } while (0)
#define GDN_WAIT(cc) do { if (flags && (cc) >= GDN_LATE) { if (tid == 0) { unsigned* f_ = flags + (s * 8 + h) * 32 + (cc); \
        while (__hip_atomic_load(f_, __ATOMIC_RELAXED, __HIP_MEMORY_SCOPE_AGENT) != tag) __builtin_amdgcn_s_sleep(2); \
        __builtin_amdgcn_fence(__ATOMIC_ACQUIRE, "agent"); asm volatile("s_waitcnt vmcnt(0)" ::: "memory"); } \
        __syncthreads(); } } while (0)
    GDN_PREFETCH(0);
    for (int c = 0; c < nch; ++c) {
        const float glast = pgl;
        const int rb = row0 + c * 64; const int nvalid = (L - c * 64) < 64 ? (L - c * 64) : 64;
#pragma unroll
        for (int k = 0; k < 2; ++k) { const int idx = tid + k * 512;
            *(u32x4*)(WL + (idx >> 4) * LD + (idx & 15) * 8) = pw[k]; *(u32x4*)(QGL + (idx >> 4) * LD + (idx & 15) * 8) = pq[k];
            *(u32x4*)(KDL + (idx >> 3) * VLD + (idx & 7) * 8) = pd[k]; }
        *(u32x4*)(QKL + (tid >> 3) * VLD + (tid & 7) * 8) = pk;
#pragma unroll
        for (int k = 0; k < 4; ++k) { const int idx = tid + k * 512; *(f32x4*)(UL + (idx >> 5) * ULD + (idx & 31) * 4) = pu[k]; }
#pragma unroll
        for (int nt = 0; nt < 8; ++nt)
#pragma unroll
            for (int j = 0; j < 4; ++j) SB[(16 * w + q * 4 + j) * LD + nt * 16 + r] = f2bf(ST[nt][j]);
        __syncthreads();
        if (c + 1 < nch) { GDN_WAIT(c + 1); GDN_PREFETCH(c + 1); }
        bf16_t zgr[4][4];
#pragma unroll
        for (int j = 0; j < 4; ++j) { const int tk = mt * 16 + q * 4 + j; const size_t row = (size_t)(rb + (tk < nvalid ? tk : 0));
#pragma unroll
            for (int n4 = 0; n4 < 4; ++n4) zgr[j][n4] = ZB[row * GD_N + 3088 + h * 128 + (nh * 4 + n4) * 16 + r]; }
        f32x4 aws[4], aqg[4];
#pragma unroll
        for (int n4 = 0; n4 < 4; ++n4) { aws[n4] = (f32x4){0.f, 0.f, 0.f, 0.f}; aqg[n4] = aws[n4]; }
#pragma unroll
        for (int ks = 0; ks < 4; ++ks) {
            const bf16x8 fw = *(const bf16x8*)(WL + (mt * 16 + r) * LD + ks * 32 + q * 8);
            const bf16x8 fq = *(const bf16x8*)(QGL + (mt * 16 + r) * LD + ks * 32 + q * 8);
#pragma unroll
            for (int n4 = 0; n4 < 4; ++n4) {
                const bf16x8 bs = *(const bf16x8*)(SB + ((nh * 4 + n4) * 16 + r) * LD + ks * 32 + q * 8);
                aws[n4] = __builtin_amdgcn_mfma_f32_16x16x32_bf16(fw, bs, aws[n4], 0, 0, 0);
                aqg[n4] = __builtin_amdgcn_mfma_f32_16x16x32_bf16(fq, bs, aqg[n4], 0, 0, 0);
            }
        }
#pragma unroll
        for (int n4 = 0; n4 < 4; ++n4) {
            const int dv = (nh * 4 + n4) * 16 + r;
            float vn[4];
#pragma unroll
            for (int j = 0; j < 4; ++j) vn[j] = UL[(mt * 16 + q * 4 + j) * ULD + dv] - aws[n4][j];
            u32x2 o; o.x = pk2(vn[0], vn[1]); o.y = pk2(vn[2], vn[3]);
            *(u32x2*)(VN + dv * VLD + mt * 16 + q * 4) = o;
        }
        __syncthreads();
#pragma unroll
        for (int ks = 0; ks < 2; ++ks) {
            const bf16x8 fk = *(const bf16x8*)(QKL + (mt * 16 + r) * VLD + ks * 32 + q * 8);
#pragma unroll
            for (int n4 = 0; n4 < 4; ++n4) {
                const bf16x8 bv = *(const bf16x8*)(VN + ((nh * 4 + n4) * 16 + r) * VLD + ks * 32 + q * 8);
                aqg[n4] = __builtin_amdgcn_mfma_f32_16x16x32_bf16(fk, bv, aqg[n4], 0, 0, 0);
            }
        }
        {
            float ssq[4];
#pragma unroll
            for (int j = 0; j < 4; ++j) { float a = 0.f;
#pragma unroll
                for (int n4 = 0; n4 < 4; ++n4) a += aqg[n4][j] * aqg[n4][j];
                ssq[j] = row16_sum(a); }
            if (r == 0) {
#pragma unroll
                for (int j = 0; j < 4; ++j) red[(mt * 16 + q * 4 + j) * 2 + nh] = ssq[j];
            }
        }
#pragma unroll
        for (int nt = 0; nt < 8; ++nt) ST[nt] = ST[nt] * glast;
#pragma unroll
        for (int ks = 0; ks < 2; ++ks) {
            const bf16x8 av = *(const bf16x8*)(VN + (16 * w + r) * VLD + ks * 32 + q * 8);
#pragma unroll
            for (int nt = 0; nt < 8; ++nt) {
                const bf16x8 bk = *(const bf16x8*)(KDL + (nt * 16 + r) * VLD + ks * 32 + q * 8);
                ST[nt] = __builtin_amdgcn_mfma_f32_16x16x32_bf16(av, bk, ST[nt], 0, 0, 0);
            }
        }
        __syncthreads();
#pragma unroll
        for (int j = 0; j < 4; ++j) {
            const int tk = mt * 16 + q * 4 + j;
            if (tk < nvalid) {
                const float rs = rsqrtf((red[tk * 2] + red[tk * 2 + 1]) * (1.f / 128.f) + 1e-6f);
                const size_t row = (size_t)(rb + tk);
#pragma unroll
                for (int n4 = 0; n4 < 4; ++n4) { const int dv = (nh * 4 + n4) * 16 + r;
                    OMIX[row * 1024 + h * 128 + dv] = f2bf(aqg[n4][j] * rs * ng[dv] * silu(bf2f(zgr[j][n4]))); }
            }
        }
    }
#undef GDN_PREFETCH
#undef GDN_WAIT
    float* so = (s < 8) ? p.out + O_PGDN + (((size_t)i * 8 + s) * 8 + h) * 16384 : p.out + O_SGDN + (((size_t)i * 128 + (s - 8)) * 8 + h) * 16384;
#pragma unroll
    for (int nt = 0; nt < 8; ++nt) *(f32x4*)(so + (size_t)(nt * 16 + r) * 128 + 16 * w + q * 4) = ST[nt];
    __syncthreads();
}

__device__ __forceinline__ void phase_gdn_scan(const Params& p, int i, int l, unsigned char* smem) {
    const int bid = mk_lbid(), G = gridDim.x; const int wv = mk_ltid() >> 6;
    if (G == 256) {
        unsigned* flags = (unsigned*)(p.ws + WS_FLAGS); const unsigned tag = (unsigned)(i + 1);
        if (bid < 64) gdn_scan_item(p, i, bid >> 3, bid & 7, flags, tag, smem);
        else {
            for (int j = bid - 64; j < 64 * (32 - GDN_LATE); j += 192) {
                const int c = GDN_LATE + (j >> 6), sh = j & 63;
                gdn_chunk_item(p, i, sh >> 3, sh & 7, c, -1, 0, smem);
                if (mk_ltid() == 0) { __builtin_amdgcn_fence(__ATOMIC_RELEASE, "agent"); asm volatile("s_waitcnt vmcnt(0)" ::: "memory");
                    __hip_atomic_store(&flags[sh * 32 + c], tag, __ATOMIC_RELAXED, __HIP_MEMORY_SCOPE_AGENT); }
            }
            for (int it = bid - 64; it < 128 * 8; it += 192) { gdn_chunk_item(p, i, 8 + (it >> 3), it & 7, 0, -1, 0, smem); gdn_scan_item(p, i, 8 + (it >> 3), it & 7, nullptr, 0u, smem); }
            convert_ffn_ahead(p, l, (bid - 64) * 8 + wv, 192 * 8, smem);
        }
    } else {
        for (int it = bid; it < 136 * 8; it += G) { const int s = it >> 3, h = it & 7; gdn_scan_item(p, i, s, h, nullptr, 0u, smem); }
        convert_ffn_ahead(p, l, bid * 8 + wv, G * 8, smem);
    }
}

__global__ void __launch_bounds__(512, 2) mega(Params p) {
    extern __shared__ __attribute__((aligned(16))) unsigned char lds[];
    cg::grid_group grid = cg::this_grid();
    constexpr int NPH = 1 + 4 * 12;
    unsigned* bar = (unsigned*)(p.ws + WS_BAR);
    volatile unsigned* bst = (volatile unsigned*)(lds + LDS_BYTES - 16);
    if (mk_ltid() == 0) { bst[0] = 0u; bst[1] = 0u; }
    if (mk_lbid() == 0) for (int u = mk_ltid(); u < CTL_WORDS; u += 512) __hip_atomic_store(bar + u, 0u, __ATOMIC_RELAXED, __HIP_MEMORY_SCOPE_AGENT);
    __syncthreads();
#pragma unroll 1
    for (int ph = 0; ph < NPH; ++ph) {
        int l = (ph == 0) ? 0 : (ph - 1) / 12, k = (ph == 0) ? -1 : (ph - 1) % 12;
        asm volatile("" : "+s"(l), "+s"(k));
        const int i = l >> 1; const bool ab = (l & 1) == 0;
        if (k == 6 && !ab) continue;
        unsigned char* ws = p.ws; asm volatile("" : "+s"(ws));
        unsigned char* smem = (unsigned char*)lds;
        PG8_LAS unsigned char* ldsp = (PG8_LAS unsigned char*)lds;
        const int G = gridDim.x, cu = mk_lbid();
#ifndef REPMASK
#define REPMASK 0
#endif
#ifndef REPAB
#define REPAB 3
#endif
        const int nrep = (((REPMASK >> (k + 1)) & 1) && ((REPAB >> (l & 1)) & 1)) ? 2 : 1;
#pragma unroll 1
        for (int rep = 0; rep < nrep; ++rep) {
        if (rep) grid.sync();
        if (k == -1) phase_start(p, smem);
        else if (k == 0 || k == 9) {
            const int j = (k == 9);
            pg8::Gemm g{(const bf16_t*)(ws + WS_HB), (const bf16_t*)(ws + WS_WGU) + (size_t)j * 5632 * 1024, M, 5632, D};
            pg8::StaticOrder S; S.init(g.M, g.N, G, cu); EpiSwiglu E{(bf16_t*)(ws + WS_HID)};
            pg8::gemm_phase<EpiSwiglu, pg8::StaticOrder, true, true>(ldsp, g, S, E);
        } else if (k == 1 || k == 10 || k == 7) {
            const int j = (k == 10);
            pg8::Gemm g{(const bf16_t*)(ws + (k == 7 ? WS_OMIX : WS_HID)), k == 7 ? (const bf16_t*)(ws + WS_WOUT) : (const bf16_t*)(ws + WS_WD) + (size_t)j * 1024 * 2816, MP, D, k == 7 ? D : FF};
            pg8::StaticOrder S; S.init(g.M, g.N, G, cu); EpiResid E{(bf16_t*)(ws + WS_X), (const bf16_t*)(ws + WS_HB), k == 7 ? 1.0f : 0.5f};
            pg8::gemm_phase<EpiResid, pg8::StaticOrder, true, true>(ldsp, g, S, E);
            small_resid_gemm(g.A, g.Bt, g.K, E.X, E.H, E.scale, smem);
        } else if (k == 2 || k == 8 || k == 11) {
            phase_ln(p, l, k == 2 ? 0 : (k == 8 ? 1 : 2), (l == 3 && k == 11));
            if (k == 11 && l < 3) convert_items(p, l + 1, 4, mk_lbid() * 8 + (mk_ltid() >> 6), gridDim.x * 8, smem);
        } else if (k == 3) {
            pg8::Gemm g{(const bf16_t*)(ws + WS_HB), (const bf16_t*)(ws + WS_WIN), M, ab ? AB_N : GD_N, D};
            pg8::StaticOrder S; S.init(g.M, g.N, G, cu); EpiZ E{(bf16_t*)(ws + WS_ZB), g.N};
            pg8::gemm_phase<EpiZ, pg8::StaticOrder, true, true>(ldsp, g, S, E);
        } else if (k == 4) { if (ab) phase_ab_prep(p, i, smem); else phase_gdn_chunk(p, i, smem); }
        else if (k == 5) { if (ab) phase_ab_core(p, i, l, smem); else phase_gdn_scan(p, i, l, smem); }
        else if (k == 6) phase_ab_post(p, i);
        }
        if (ph + 1 < NPH) { if (ph == 0) { grid.sync(); if (mk_ltid() == 0) (void)xb_add(&bar[XB_XCNT(xb_xcc_id())], 1u); } else gbar(bar, bst); }
#ifdef REPSYNC
        if (ph > 0) { gbar(bar, bst); gbar(bar, bst); }
#endif
    }
}
}

extern "C" void kernel_launch(void* const* d_in, const int* in_sizes, int n_in, void* d_out, int out_size, void* d_ws, size_t ws_size, hipStream_t stream) {
    static int grid_blocks = 0;
    if (grid_blocks == 0) {
        if (n_in != 33 || ws_size < mk::WS_NEED) { fprintf(stderr, "kernel_launch: need 33 inputs and %zu bytes of workspace; got %d, %zu\n", (size_t)mk::WS_NEED, n_in, ws_size); grid_blocks = -1; return; }
        int dev = 0, cus = 0, per_cu = 0;
        hipGetDevice(&dev);
        hipDeviceGetAttribute(&cus, hipDeviceAttributeMultiprocessorCount, dev);
        if (hipFuncSetAttribute((const void*)mk::mega, hipFuncAttributeMaxDynamicSharedMemorySize, mk::LDS_BYTES) != hipSuccess) { fprintf(stderr, "kernel_launch: hipFuncSetAttribute failed\n"); grid_blocks = -1; return; }
        if (hipOccupancyMaxActiveBlocksPerMultiprocessor(&per_cu, (const void*)mk::mega, 512, mk::LDS_BYTES) != hipSuccess || per_cu < 1) { fprintf(stderr, "kernel_launch: occupancy query failed (%d)\n", per_cu); (void)hipGetLastError(); per_cu = 1; }
        grid_blocks = cus * 1;
        fprintf(stderr, "kernel_launch: grid %d (cus %d, per_cu %d)\n", grid_blocks, cus, per_cu);
    }
    if (grid_blocks < 0) return;
    mk::Params prm{};
    for (int k = 0; k < 33; ++k) prm.in[k] = (const float*)d_in[k];
    prm.out = (float*)d_out; prm.ws = (unsigned char*)d_ws;
    void* args[] = {&prm};
    hipError_t e = hipLaunchCooperativeKernel((const void*)mk::mega, dim3(grid_blocks), dim3(512), args, mk::LDS_BYTES, stream);
    if (e != hipSuccess) fprintf(stderr, "cooperative launch failed: %s (grid %d)\n", hipGetErrorString(e), grid_blocks);
}
```

```cpp
#include <hip/hip_runtime.h>
#include <hip/hip_cooperative_groups.h>
#include <cstdio>
#include <cstdint>
namespace cg = cooperative_groups;
__device__ __forceinline__ int mk_ltid() { int t = threadIdx.x; asm volatile("" : "+v"(t)); return t; }
__device__ __forceinline__ int mk_lbid() { int t = blockIdx.x; asm volatile("" : "+s"(t)); return t; }
namespace pg8 {
#define PG8_LAS __attribute__((address_space(3)))
typedef unsigned short bf16_t;
typedef short bf16x8 __attribute__((ext_vector_type(8)));
typedef float f32x4 __attribute__((ext_vector_type(4)));
typedef unsigned u32x4 __attribute__((ext_vector_type(4)));
constexpr int BM = 256, BK = 64, HALF = 128, HTB = HALF * BK * 2  , STAGE_BYTES = 8 * HTB, NXCD = 8, WGM = 8;

__host__ __device__ __forceinline__ int lds_byte(int r, int c) { const int st = (r >> 4) * 2 + (c >> 5), rr = r & 15, cc = c & 31, ob = rr * 64 + cc * 2; return st * 1024 + (ob ^ (((ob >> 9) & 1) << 5)); }
__host__ __device__ __forceinline__ void stage_rc(int b, int& R, int& C) { const int st = b / 1024, sb = b % 1024, swz = sb ^ (((sb >> 9) & 1) << 5); R = (st >> 1) * 16 + swz / 64; C = (st & 1) * 32 + (swz % 64) / 2; }
__host__ __device__ __forceinline__ int perm32(int rho) { const int n = rho >> 4, i = rho & 15; return 8 * (i >> 2) + 4 * n + (i & 3); }

struct Unit { int pm, pn; };
struct Gemm { const bf16_t* A; const bf16_t* Bt; int M, N, K; };

struct StaticOrder {
    int nM, nN, nwg, G, c;
    __host__ __device__ void init(int M, int N, int G_, int c_) { nM = M / BM; nN = N / BM; nwg = nM * nN; G = G_; c = c_; }
    __host__ __device__ bool next(int i, Unit& u) const {
        const long L = (long)i * G + c; if (L >= nwg) return false;
        int wgid = (int)L; { const int q = nwg / NXCD, r = nwg % NXCD, xcd = wgid % NXCD, off = wgid / NXCD; wgid = (xcd < r ? xcd * (q + 1) : r * (q + 1) + (xcd - r) * q) + off; }
        const int nig = WGM * nN, gid = wgid / nig, fm = gid * WGM, gsz = (nM - fm) < WGM ? (nM - fm) : WGM;
        u.pm = fm + ((wgid % nig) % gsz); u.pn = (wgid % nig) / gsz; return true;
    }
    __device__ __forceinline__ void a_ready(const Unit&) const {}
    __device__ __forceinline__ void done(const Unit&) const {}
};

template <class Epi, class Sched, bool ALIGN_EPI = false, bool SP2 = false>
__device__ __forceinline__ void gemm_phase(PG8_LAS unsigned char* lds, const Gemm g, const Sched& S, const Epi& E) {
    const int tid = mk_ltid(), wid = __builtin_amdgcn_readfirstlane(tid >> 6), lane = tid & 63, wr = wid >> 2, wc = wid & 3, fr = lane & 15, fq = lane >> 4;
    const int K = g.K, nt = K / BK;
    unsigned voffA[2], voffB[2];
#pragma unroll
    for (int i = 0; i < 2; ++i) { int R, C; stage_rc(tid * 16 + i * 8192, R, C); const int Rb = Epi::PERM ? ((R & ~31) + perm32(R & 31)) : R;
        voffA[i] = (unsigned)(R * K + C) * 2u; voffB[i] = (unsigned)(Rb * K + C) * 2u; }
    const size_t kstep = (size_t)(BK * 2);
    const size_t hstep = (size_t)HALF * K * 2;
    const size_t tstep = 2 * hstep;
    const unsigned ldsw = (unsigned)wid * 1024u;
    const int aoff = lds_byte(wr * 64 + fr, fq * 8), boff = lds_byte(wc * 32 + fr, fq * 8);
#define PG8_SA(b, h) (((b) * 2 + (h)) * HTB)
#define PG8_SB(b, h) ((4 + (b) * 2 + (h)) * HTB)
#define PG8_STAGE(bufoff, gbase, voff) do { _Pragma("unroll") for (int _i = 0; _i < 2; ++_i) \
        __builtin_amdgcn_global_load_lds((const unsigned*)((const char*)(gbase) + (voff)[_i]), (PG8_LAS unsigned*)(lds + (bufoff) + ldsw + _i * 8192), 16, 0, 0); } while (0)
#define PG8_LDA(dst, b, h) do { _Pragma("unroll") for (int m = 0; m < 4; ++m) _Pragma("unroll") for (int k = 0; k < 2; ++k) dst[m][k] = *(const PG8_LAS bf16x8*)(lds + PG8_SA(b, h) + aoff + m * 2048 + k * 1024); } while (0)
#define PG8_LDB(dst, b, h) do { _Pragma("unroll") for (int n = 0; n < 2; ++n) _Pragma("unroll") for (int k = 0; k < 2; ++k) dst[n][k] = *(const PG8_LAS bf16x8*)(lds + PG8_SB(b, h) + boff + n * 2048 + k * 1024); } while (0)
#define PG8_MMA(ai, bj, At, Bt) do { __builtin_amdgcn_s_setprio(1); _Pragma("unroll") for (int m = 0; m < 4; ++m) _Pragma("unroll") for (int n = 0; n < 2; ++n) _Pragma("unroll") for (int k = 0; k < 2; ++k) \
        acc[ai][bj][m][n] = __builtin_amdgcn_mfma_f32_16x16x32_bf16(Bt[n][k], At[m][k], acc[ai][bj][m][n], 0, 0, 0); __builtin_amdgcn_s_setprio(0); } while (0)
#define PG8_WAIT_V(n) asm volatile("s_waitcnt vmcnt(" #n ")" ::: "memory")
#define PG8_WAIT_L(n) asm volatile("s_waitcnt lgkmcnt(" #n ")" ::: "memory")
#define PG8_BAR __builtin_amdgcn_s_barrier()
#define PG8_SCHED __builtin_amdgcn_sched_barrier(0)
    Unit cur, nxt; int ui = 0;
    if (!S.next(0, cur)) return;
    f32x4 acc[2][2][4][2];
#pragma unroll
    for (int a = 0; a < 2; ++a)
#pragma unroll
        for (int b = 0; b < 2; ++b)
#pragma unroll
            for (int m = 0; m < 4; ++m)
#pragma unroll
                for (int n = 0; n < 2; ++n) acc[a][b][m][n] = (f32x4){0.f, 0.f, 0.f, 0.f};
    bf16x8 At[4][2], B0[2][2], B1[2][2];
    const char* cA = (const char*)g.A + (size_t)cur.pm * tstep; const char* cB = (const char*)g.Bt + (size_t)cur.pn * tstep;
    S.a_ready(cur);
    if constexpr (SP2) {
        PG8_STAGE(PG8_SB(0, 0), cB, voffB); PG8_STAGE(PG8_SB(0, 1), cB + hstep, voffB); PG8_STAGE(PG8_SA(0, 0), cA, voffA); PG8_STAGE(PG8_SA(0, 1), cA + hstep, voffA);
        if (wr == 1) PG8_BAR;
        PG8_WAIT_V(2); PG8_BAR;
        PG8_STAGE(PG8_SB(1, 0), cB + kstep, voffB); PG8_STAGE(PG8_SA(1, 0), cA + kstep, voffA); PG8_STAGE(PG8_SB(1, 1), cB + hstep + kstep, voffB);
        PG8_WAIT_V(6); PG8_BAR;
    } else {
        PG8_STAGE(PG8_SB(0, 0), cB, voffB); PG8_STAGE(PG8_SA(0, 0), cA, voffA); PG8_STAGE(PG8_SB(0, 1), cB + hstep, voffB); PG8_STAGE(PG8_SA(0, 1), cA + hstep, voffA);
        if (wr == 1) PG8_BAR;
        PG8_WAIT_V(4); PG8_BAR;
        PG8_STAGE(PG8_SB(1, 0), cB + kstep, voffB); PG8_STAGE(PG8_SA(1, 0), cA + kstep, voffA); PG8_STAGE(PG8_SB(1, 1), cB + hstep + kstep, voffB);
        PG8_WAIT_V(6); PG8_BAR;
    }
    for (;;) {
        const bool has_next = S.next(ui + 1, nxt);
        const char* nA = has_next ? (const char*)g.A + (size_t)nxt.pm * tstep : cA; const char* nB = has_next ? (const char*)g.Bt + (size_t)nxt.pn * tstep : cB;
        for (int t = 0; t < nt; t += 2) {
            const bool last = (t == nt - 2);
            const char* a1 = cA + (size_t)(t + 1) * kstep;
            const char* a2 = last ? nA : cA + (size_t)(t + 2) * kstep; const char* b2 = last ? nB : cB + (size_t)(t + 2) * kstep;
            const char* a3 = a2 + kstep; const char* b3 = b2 + kstep;
            if (last && has_next) S.a_ready(nxt);
            if constexpr (SP2) {
            PG8_LDB(B0, 0, 0); PG8_LDB(B1, 0, 1); PG8_SCHED; PG8_LDA(At, 0, 0); PG8_STAGE(PG8_SA(1, 1), a1 + hstep, voffA);
            PG8_WAIT_V(8); PG8_WAIT_L(0); PG8_BAR; PG8_MMA(0, 0, At, B0); PG8_MMA(0, 1, At, B1); PG8_BAR; PG8_SCHED;
            PG8_LDA(At, 0, 1); PG8_STAGE(PG8_SB(0, 0), b2, voffB); PG8_STAGE(PG8_SB(0, 1), b2 + hstep, voffB); PG8_STAGE(PG8_SA(0, 0), a2, voffA);
            PG8_WAIT_V(8); PG8_WAIT_L(0); PG8_BAR; PG8_MMA(1, 0, At, B0); PG8_MMA(1, 1, At, B1); PG8_BAR; PG8_SCHED;
            PG8_LDB(B0, 1, 0); PG8_LDB(B1, 1, 1); PG8_SCHED; PG8_LDA(At, 1, 0); PG8_STAGE(PG8_SA(0, 1), a2 + hstep, voffA);
            PG8_WAIT_V(8); PG8_WAIT_L(0); PG8_BAR; PG8_MMA(0, 0, At, B0); PG8_MMA(0, 1, At, B1); PG8_BAR; PG8_SCHED;
            PG8_LDA(At, 1, 1); PG8_STAGE(PG8_SB(1, 0), b3, voffB); PG8_STAGE(PG8_SB(1, 1), b3 + hstep, voffB); PG8_STAGE(PG8_SA(1, 0), a3, voffA);
            PG8_WAIT_V(8); PG8_WAIT_L(0); PG8_BAR; PG8_MMA(1, 0, At, B0); PG8_MMA(1, 1, At, B1); PG8_BAR; PG8_SCHED;
            } else {
            PG8_LDB(B0, 0, 0); PG8_SCHED; PG8_LDA(At, 0, 0); PG8_STAGE(PG8_SA(1, 1), a1 + hstep, voffA);
            PG8_WAIT_L(8); PG8_BAR; PG8_WAIT_L(0); PG8_MMA(0, 0, At, B0); PG8_BAR; PG8_SCHED;
            PG8_LDB(B1, 0, 1); PG8_STAGE(PG8_SB(0, 0), b2, voffB);
            PG8_BAR; PG8_WAIT_L(0); PG8_MMA(0, 1, At, B1); PG8_BAR;
            PG8_LDA(At, 0, 1); PG8_STAGE(PG8_SA(0, 0), a2, voffA);
            PG8_BAR; PG8_WAIT_L(0); PG8_MMA(1, 0, At, B0); PG8_BAR; PG8_SCHED;
            PG8_STAGE(PG8_SB(0, 1), b2 + hstep, voffB);
            PG8_WAIT_V(6); PG8_BAR; PG8_MMA(1, 1, At, B1); PG8_BAR;
            PG8_LDB(B0, 1, 0); PG8_SCHED; PG8_LDA(At, 1, 0); PG8_STAGE(PG8_SA(0, 1), a2 + hstep, voffA);
            PG8_WAIT_L(8); PG8_BAR; PG8_WAIT_L(0); PG8_MMA(0, 0, At, B0); PG8_BAR; PG8_SCHED;
            PG8_LDB(B1, 1, 1); PG8_STAGE(PG8_SB(1, 0), b3, voffB);
            PG8_BAR; PG8_WAIT_L(0); PG8_MMA(0, 1, At, B1); PG8_BAR;
            PG8_LDA(At, 1, 1); PG8_STAGE(PG8_SA(1, 0), a3, voffA);
            PG8_BAR; PG8_WAIT_L(0); PG8_MMA(1, 0, At, B0); PG8_BAR; PG8_SCHED;
            PG8_STAGE(PG8_SB(1, 1), b3 + hstep, voffB);
            PG8_WAIT_V(6); PG8_BAR; PG8_MMA(1, 1, At, B1); PG8_BAR;
            }
        }
        if constexpr (ALIGN_EPI) { if (wr == 0) PG8_BAR; }
        if constexpr (!Epi::AFTER_DRAIN) { E(acc, cur, wr, wc, fr, fq); S.done(cur); }
        if (!has_next) break;
#pragma unroll
        for (int a = 0; a < 2; ++a)
#pragma unroll
            for (int b = 0; b < 2; ++b)
#pragma unroll
                for (int m = 0; m < 4; ++m)
#pragma unroll
                    for (int n = 0; n < 2; ++n) acc[a][b][m][n] = (f32x4){0.f, 0.f, 0.f, 0.f};
        cur = nxt; cA = nA; cB = nB; ++ui;
        if constexpr (ALIGN_EPI) { if (wr == 1) PG8_BAR; }
    }
    PG8_WAIT_V(0);
    if constexpr (!ALIGN_EPI) { if (wr == 0) PG8_BAR; }
    PG8_BAR;
    if constexpr (Epi::AFTER_DRAIN) { E.fused(acc, cur, wr, wc, fr, fq, lds, wid, lane); S.done(cur); }
#undef PG8_SA
#undef PG8_SB
#undef PG8_STAGE
#undef PG8_LDA
#undef PG8_LDB
#undef PG8_MMA
#undef PG8_WAIT_V
#undef PG8_WAIT_L
#undef PG8_BAR
#undef PG8_SCHED
}
}

namespace mk {
using pg8::bf16_t; using pg8::bf16x8; using pg8::f32x4; using pg8::Unit;
typedef unsigned u32x4 __attribute__((ext_vector_type(4)));
typedef unsigned u32x2 __attribute__((ext_vector_type(2)));

constexpr int M = 16896, MP = 16384, D = 1024, FF = 2816;
constexpr int AB_N = 3840, GD_N = 4352, GD_NREAL = 4112;
constexpr float ALPHA = 1.6817928305074290f;
constexpr int LDS_BYTES = 163840;

constexpr size_t O_PSHIFT = 17301504, O_PRWKV = 17330176, O_PRET = 17854464, O_PCONV = 18903040, O_PGDN = 19050496;
constexpr size_t O_SSHIFT = 21147648, O_SRWKV = 21606400, O_SRET = 29995008, O_SCONV = 46772224, O_SGDN = 49131520;

constexpr size_t WS_WGU = 0;
constexpr size_t WS_WD = WS_WGU + 2ull * 5632 * 1024 * 2;
constexpr size_t WS_WIN = WS_WD + 2ull * 1024 * 2816 * 2;
constexpr size_t WS_WOUT = WS_WIN + 4352ull * 1024 * 2;
constexpr size_t WS_W2T = WS_WOUT + 1024ull * 1024 * 2;
constexpr size_t WS_A2T = WS_W2T + 65536;
constexpr size_t WS_G2T = WS_A2T + 65536;
constexpr size_t WS_X = WS_G2T + 131072;
constexpr size_t WS_HB = WS_X + (size_t)M * 1024 * 4;
constexpr size_t WS_S = WS_HB + (size_t)M * 1024 * 2;
constexpr size_t WS_HID = WS_S;
constexpr size_t WS_OMIX = WS_S;
constexpr size_t WS_ZB = WS_OMIX + (size_t)M * 1024 * 2;
constexpr size_t WS_OPS = WS_ZB + (size_t)M * AB_N * 2;
constexpr size_t WS_GATE = WS_OPS + (size_t)M * 3072 * 4;
constexpr size_t WS_ORAW = WS_GATE + (size_t)M * 512 * 4;
constexpr size_t WS_BONUS = WS_ORAW + (size_t)M * 512 * 4;
constexpr size_t WS_RQ = WS_BONUS + (size_t)M * 8 * 4;
constexpr size_t WS_RK = WS_RQ + (size_t)M * 512 * 2;
constexpr size_t WS_AB_END = WS_RK + (size_t)M * 512 * 2;
constexpr size_t WS_CH = WS_ZB + (size_t)M * GD_N * 2;
constexpr size_t CH_U = 0, CH_W = 32768, CH_QG = 49152, CH_QK = 65536, CH_KDT = 73728, CH_BYTES = 90112;
constexpr int N_CH = 2048 + 1024;
constexpr size_t WS_GL = WS_CH + (size_t)N_CH * CH_BYTES;
constexpr size_t WS_GD_END = WS_GL + N_CH * 4;
constexpr size_t WS_BAR = ((WS_AB_END > WS_GD_END ? WS_AB_END : WS_GD_END) + 255) / 256 * 256;
constexpr size_t WS_FLAGS = WS_BAR + 16384;
constexpr int CTL_WORDS = (16384 + 8192) / 4;
constexpr size_t WS_NEED = WS_FLAGS + 8192;
constexpr int GDN_LATE = 28;

struct Params { const float* in[33]; float* out; unsigned char* ws; };

__device__ __forceinline__ float bf2f(bf16_t h) { return __uint_as_float(((unsigned)h) << 16); }
__device__ __forceinline__ unsigned pk2(float lo, float hi) { unsigned r; asm volatile("v_cvt_pk_bf16_f32 %0, %1, %2" : "=v"(r) : "v"(lo), "v"(hi)); return r; }
__device__ __forceinline__ bf16_t f2bf(float x) { return (bf16_t)(pk2(x, 0.f) & 0xffffu); }
__device__ __forceinline__ float sigm(float x) { return __builtin_amdgcn_rcpf(1.f + __expf(-x)); }
__device__ __forceinline__ float silu(float x) { return x * __builtin_amdgcn_rcpf(1.f + __expf(-x)); }
__device__ __forceinline__ float dppf(float v, const int ctrl_sel) {
    int x = __builtin_bit_cast(int, v), y;
    if (ctrl_sel == 0) y = __builtin_amdgcn_update_dpp(0, x, 0xB1, 0xF, 0xF, true);
    else if (ctrl_sel == 1) y = __builtin_amdgcn_update_dpp(0, x, 0x4E, 0xF, 0xF, true);
    else if (ctrl_sel == 2) y = __builtin_amdgcn_update_dpp(0, x, 0x141, 0xF, 0xF, true);
    else y = __builtin_amdgcn_update_dpp(0, x, 0x140, 0xF, 0xF, true);
    return __builtin_bit_cast(float, y);
}
__device__ __forceinline__ float row16_sum(float v) { v += dppf(v, 0); v += dppf(v, 1); v += dppf(v, 2); v += dppf(v, 3); return v; }
__device__ __forceinline__ float wave_sum(float v) {
#pragma unroll
    for (int o = 1; o < 64; o <<= 1) v += __shfl_xor(v, o);
    return v;
}
#define XB_XCNT(j)  (256  + 64 * (j))
#define XB_XSUB(j)  (1280 + 64 * (j))
#define XB_XGEN(j)  (2304 + 64 * (j))
#define XB_TOP      3328
#define XB_TOPGEN   3392
#define XCD_BAR_WORDS 3456
__device__ __forceinline__ unsigned xb_ld(unsigned* p)              { return __hip_atomic_load(p, __ATOMIC_RELAXED, __HIP_MEMORY_SCOPE_AGENT); }
__device__ __forceinline__ unsigned xb_add(unsigned* p, unsigned v) { return __hip_atomic_fetch_add(p, v, __ATOMIC_RELAXED, __HIP_MEMORY_SCOPE_AGENT); }
__device__ __forceinline__ unsigned xb_xcc_id() { return (unsigned)__builtin_amdgcn_s_getreg((3 << 11) | 20) & 0xFu; }
__device__ __forceinline__ void gbar(unsigned* bar, volatile unsigned* st) {
    asm volatile("s_waitcnt vmcnt(0)" ::: "memory");
    __syncthreads();
    if (mk_ltid() == 0) {
        __builtin_amdgcn_s_waitcnt(0);
        const unsigned x = xb_xcc_id();
        unsigned nloc = st[0], nx = st[1];
        if (nloc == 0u) {
            const unsigned G = gridDim.x;
            unsigned sum, cnt, mine;
            for (;;) {
                sum = 0u; cnt = 0u; mine = 0u;
#pragma unroll
                for (unsigned j = 0; j < 16; ++j) { const unsigned c = xb_ld(&bar[XB_XCNT(j)]); sum += c; cnt += (c > 0u) ? 1u : 0u; mine = (j == x) ? c : mine; }
                if (sum == G) break;
                __builtin_amdgcn_s_sleep(1);
            }
            nloc = mine > 0u ? mine : 1u; nx = cnt > 0u ? cnt : 1u; st[0] = nloc; st[1] = nx;
        }
        const unsigned old = xb_add(&bar[XB_XSUB(x)], 1u);
        const unsigned gen = old / nloc;
        if (old + 1u == (gen + 1u) * nloc) {
            __builtin_amdgcn_fence(__ATOMIC_RELEASE, "agent");
            asm volatile("s_waitcnt vmcnt(0)" ::: "memory");
            const unsigned og = xb_add(&bar[XB_TOP], 1u);
            const unsigned tg = og / nx;
            if (og + 1u == (tg + 1u) * nx) xb_add(&bar[XB_TOPGEN], 1u);
            else while (xb_ld(&bar[XB_TOPGEN]) == tg) __builtin_amdgcn_s_sleep(1);
            __builtin_amdgcn_fence(__ATOMIC_ACQUIRE, "agent");
            xb_add(&bar[XB_XGEN(x)], 1u);
            asm volatile("s_waitcnt vmcnt(0)" ::: "memory");
        } else {
            while (xb_ld(&bar[XB_XGEN(x)]) == gen) __builtin_amdgcn_s_sleep(1);
            __builtin_amdgcn_fence(__ATOMIC_ACQUIRE, "agent");
            asm volatile("s_waitcnt vmcnt(0)" ::: "memory");
        }
    }
    __syncthreads();
}
__device__ __forceinline__ void seq_info(int s, int& row0, int& L) { if (s < 8) { row0 = s * 2048; L = 2048; } else { row0 = MP + (s - 8) * 4; L = 4; } }

struct EpiSwiglu { static constexpr bool PERM = true, AFTER_DRAIN = false; bf16_t* O;
    __device__ __forceinline__ void operator()(const f32x4 (&acc)[2][2][4][2], const Unit& u, int wr, int wc, int fr, int fq) const {
        const int row0 = u.pm * 256 + wr * 64 + fr, col0 = u.pn * 128 + wc * 32 + 8 * fq;
#pragma unroll
        for (int ai = 0; ai < 2; ++ai)
#pragma unroll
            for (int m = 0; m < 4; ++m) {
                bf16_t* rp = O + (size_t)(row0 + ai * 128 + m * 16) * FF + col0;
                const f32x4 g0 = acc[ai][0][m][0], g1 = acc[ai][0][m][1], u0 = acc[ai][1][m][0], u1 = acc[ai][1][m][1];
                u32x4 w;
                w.x = pk2(silu(g0[0]) * u0[0], silu(g0[1]) * u0[1]); w.y = pk2(silu(g0[2]) * u0[2], silu(g0[3]) * u0[3]);
                w.z = pk2(silu(g1[0]) * u1[0], silu(g1[1]) * u1[1]); w.w = pk2(silu(g1[2]) * u1[2], silu(g1[3]) * u1[3]);
                *(u32x4*)rp = w;
            }
    }
};
struct EpiResid { static constexpr bool PERM = true, AFTER_DRAIN = false; bf16_t* X; const bf16_t* H; float scale;
    __device__ __forceinline__ void operator()(const f32x4 (&acc)[2][2][4][2], const Unit& u, int wr, int wc, int fr, int fq) const {
        const int row0 = u.pm * 256 + wr * 64 + fr, col0 = u.pn * 256 + wc * 32 + 8 * fq;
#pragma unroll
        for (int ai = 0; ai < 2; ++ai)
#pragma unroll
            for (int m = 0; m < 4; ++m)
#pragma unroll
                for (int bj = 0; bj < 2; ++bj)
#pragma unroll
                    for (int n = 0; n < 2; ++n) {
                        const size_t off = (size_t)(row0 + ai * 128 + m * 16) * D + col0 + bj * 128 + 4 * n;
                        const u32x2 hu = *(const u32x2*)(H + off);
                        f32x4 x; x[0] = __uint_as_float(hu.x << 16); x[1] = __uint_as_float(hu.x & 0xffff0000u); x[2] = __uint_as_float(hu.y << 16); x[3] = __uint_as_float(hu.y & 0xffff0000u);
                        x = x * ALPHA + acc[ai][bj][m][n] * scale; u32x2 xo; xo.x = pk2(x[0], x[1]); xo.y = pk2(x[2], x[3]); *(u32x2*)(X + off) = xo;
                    }
    }
};
struct EpiZ { static constexpr bool PERM = true, AFTER_DRAIN = false; bf16_t* Z; int ld;
    __device__ __forceinline__ void operator()(const f32x4 (&acc)[2][2][4][2], const Unit& u, int wr, int wc, int fr, int fq) const {
        const int row0 = u.pm * 256 + wr * 64 + fr, col0 = u.pn * 256 + wc * 32 + 8 * fq;
#pragma unroll
        for (int ai = 0; ai < 2; ++ai)
#pragma unroll
            for (int m = 0; m < 4; ++m)
#pragma unroll
                for (int bj = 0; bj < 2; ++bj) {
                    const f32x4 a = acc[ai][bj][m][0], b = acc[ai][bj][m][1];
                    u32x4 w; w.x = pk2(a[0], a[1]); w.y = pk2(a[2], a[3]); w.z = pk2(b[0], b[1]); w.w = pk2(b[2], b[3]);
                    *(u32x4*)(Z + (size_t)(row0 + ai * 128 + m * 16) * ld + col0 + bj * 128) = w;
                }
    }
};

__device__ __forceinline__ void tr_item(const float* __restrict__ W, int K, int N, bf16_t* WT, int dst_row0, int k0, int n0, float* scr, int lane) {
#pragma unroll
    for (int i = 0; i < 32; ++i) { const int kk = 2 * i + (lane >> 5); const int col = n0 + (lane & 31);
        scr[kk * 33 + (lane & 31)] = (col < N) ? W[(size_t)(k0 + kk) * N + col] : 0.f; }
    asm volatile("s_waitcnt lgkmcnt(0)" ::: "memory");
    const int c = lane & 7;
#pragma unroll
    for (int j = 0; j < 4; ++j) { const int n = (lane >> 3) + 8 * j; const float* s = scr + (8 * c) * 33 + n;
        u32x4 o; o.x = pk2(s[0], s[33]); o.y = pk2(s[2 * 33], s[3 * 33]); o.z = pk2(s[4 * 33], s[5 * 33]); o.w = pk2(s[6 * 33], s[7 * 33]);
        *(u32x4*)(WT + (size_t)(dst_row0 + n) * K + k0 + 8 * c) = o; }
    asm volatile("s_waitcnt lgkmcnt(0)" ::: "memory");
}

__device__ __forceinline__ void convert_items(const Params& p, int l, int parts, int gw, int NGW, unsigned char* smem) {
    const int lane = mk_ltid() & 63, wave = mk_ltid() >> 6;
    float* scr = (float*)smem + wave * (64 * 33);
    unsigned char* ws = p.ws;
    const int i = l >> 1; const bool ab = (l & 1) == 0;
    constexpr int I_G = 16 * 88, I_O = 16 * 32;
    const int I_IN = ab ? 16 * 120 : 16 * 136;
    const int I_LORA = ab ? (16 + 16 + 32) : 0;
    const int n0 = (parts & 1) ? 3 * I_G : 0, n1 = (parts & 2) ? 3 * I_G : 0, n2 = (parts & 4) ? (I_IN + I_O + I_LORA) : 0;
    const int total = n0 + n1 + n2;
    for (int it = gw; it < total; it += NGW) {
        int r = it;
        if (r < n0 + n1) {
            const int j = (r < n0) ? 0 : 1; r -= (j ? n0 : 0);
            const int kind = r / I_G; r -= kind * I_G;
            const size_t lw = (size_t)(l * 2 + j);
            if (kind < 2) { const float* W = p.in[kind == 0 ? 9 : 10] + lw * (size_t)D * FF;
                const int kb = r / 88, nb = r % 88, nn0 = nb * 32;
                tr_item(W, D, FF, (bf16_t*)(ws + WS_WGU) + (size_t)j * 5632 * 1024, (nn0 >> 7) * 256 + (nn0 & 127) + kind * 128, kb * 64, nn0, scr, lane);
            } else { const float* W = p.in[11] + lw * (size_t)FF * D;
                const int kb = r / 32, nb = r % 32;
                tr_item(W, FF, D, (bf16_t*)(ws + WS_WD) + (size_t)j * 1024 * 2816, nb * 32, kb * 64, nb * 32, scr, lane);
            }
            continue;
        }
        r -= n0 + n1;
        if (r < I_IN) {
            if (ab) { const int kb = r / 120, nb = r % 120; tr_item(p.in[12] + (size_t)i * D * AB_N, D, AB_N, (bf16_t*)(ws + WS_WIN), nb * 32, kb * 64, nb * 32, scr, lane); }
            else { const int kb = r / 136, nb = r % 136; tr_item(p.in[27] + (size_t)i * D * GD_NREAL, D, GD_NREAL, (bf16_t*)(ws + WS_WIN), nb * 32, kb * 64, nb * 32, scr, lane); }
            continue;
        }
        r -= I_IN;
        if (r < I_O) { const int kb = r / 32, nb = r % 32;
            tr_item(p.in[ab ? 13 : 32] + (size_t)i * D * D, D, D, (bf16_t*)(ws + WS_WOUT), nb * 32, kb * 64, nb * 32, scr, lane); continue; }
        r -= I_O;
        if (r < 16) { tr_item(p.in[16] + (size_t)i * 64 * 512, 64, 512, (bf16_t*)(ws + WS_W2T), r * 32, 0, r * 32, scr, lane); continue; }
        r -= 16;
        if (r < 16) { tr_item(p.in[18] + (size_t)i * 64 * 512, 64, 512, (bf16_t*)(ws + WS_A2T), r * 32, 0, r * 32, scr, lane); continue; }
        r -= 16;
        { const int kb = r / 16, nb = r % 16; tr_item(p.in[19] + (size_t)i * 128 * 512, 128, 512, (bf16_t*)(ws + WS_G2T), nb * 32, kb * 64, nb * 32, scr, lane); }
    }
}
__device__ __forceinline__ void convert_ffn_ahead(const Params& p, int l, int gw, int NGW, unsigned char* smem) {
    __syncthreads();
    convert_items(p, l, 2, gw, NGW, smem);
    if (l < 3) convert_items(p, l + 1, 1, gw, NGW, smem);
    __syncthreads();
}

__device__ __forceinline__ void phase_start(const Params& p, unsigned char* smem) {
    const int tid = mk_ltid(), lane = tid & 63, wave = tid >> 6;
    const int gw = mk_lbid() * 8 + wave, NGW = gridDim.x * 8;
    convert_items(p, 0, 5, gw, NGW, smem);
    bf16_t* HB = (bf16_t*)(p.ws + WS_HB);
    for (int m = gw; m < M; m += NGW) {
        const float* src = (m < MP) ? p.in[0] + (size_t)m * D : p.in[1] + (size_t)(m - MP) * D;
#pragma unroll
        for (int j = 0; j < 4; ++j) { const int c = (lane + 64 * j) * 4; const f32x4 v = *(const f32x4*)(src + c);
            u32x2 o; o.x = pk2(v[0], v[1]); o.y = pk2(v[2], v[3]); *(u32x2*)(HB + (size_t)m * D + c) = o; }
    }
}

__device__ __forceinline__ void phase_ln(const Params& p, int l, int k, bool final_out) {
    const int tid = mk_ltid(), lane = tid & 63, wave = tid >> 6;
    const int gw = mk_lbid() * 8 + wave, NGW = gridDim.x * 8;
    const bf16_t* X = (const bf16_t*)(p.ws + WS_X); bf16_t* HB = (bf16_t*)(p.ws + WS_HB);
    const float* g = p.in[7] + (size_t)(l * 3 + k) * D; const float* b = p.in[8] + (size_t)(l * 3 + k) * D;
    float* dst = p.out;
    for (int mq = gw; mq < M / 4; mq += NGW) {
        f32x4 v[4][4]; float s[4];
#pragma unroll
        for (int rr = 0; rr < 4; ++rr) { s[rr] = 0.f;
#pragma unroll
            for (int j = 0; j < 4; ++j) { const u32x2 xu = *(const u32x2*)(X + (size_t)(mq * 4 + rr) * D + (lane + 64 * j) * 4);
                v[rr][j][0] = __uint_as_float(xu.x << 16); v[rr][j][1] = __uint_as_float(xu.x & 0xffff0000u); v[rr][j][2] = __uint_as_float(xu.y << 16); v[rr][j][3] = __uint_as_float(xu.y & 0xffff0000u); s[rr] += (v[rr][j][0] + v[rr][j][1]) + (v[rr][j][2] + v[rr][j][3]); } }
#pragma unroll
        for (int o = 1; o < 64; o <<= 1) {
#pragma unroll
            for (int rr = 0; rr < 4; ++rr) s[rr] += __shfl_xor(s[rr], o); }
        float s2[4];
#pragma unroll
        for (int rr = 0; rr < 4; ++rr) { const float mean = s[rr] * (1.f / D); s2[rr] = 0.f;
#pragma unroll
            for (int j = 0; j < 4; ++j) { v[rr][j] = v[rr][j] - mean; s2[rr] += (v[rr][j][0] * v[rr][j][0] + v[rr][j][1] * v[rr][j][1]) + (v[rr][j][2] * v[rr][j][2] + v[rr][j][3] * v[rr][j][3]); } }
#pragma unroll
        for (int o = 1; o < 64; o <<= 1) {
#pragma unroll
            for (int rr = 0; rr < 4; ++rr) s2[rr] += __shfl_xor(s2[rr], o); }
#pragma unroll
        for (int j = 0; j < 4; ++j) { const int c = (lane + 64 * j) * 4; const f32x4 gg = *(const f32x4*)(g + c), bb = *(const f32x4*)(b + c);
#pragma unroll
            for (int rr = 0; rr < 4; ++rr) { const int m = mq * 4 + rr; const float rstd = rsqrtf(s2[rr] * (1.f / D) + 1e-5f);
                const f32x4 y = v[rr][j] * rstd * gg + bb;
                if (final_out) *(f32x4*)(dst + (size_t)m * D + c) = y;
                else { u32x2 o; o.x = pk2(y[0], y[1]); o.y = pk2(y[2], y[3]); *(u32x2*)(HB + (size_t)m * D + c) = o; } } }
    }
}

__device__ __forceinline__ void small_resid_gemm(const bf16_t* __restrict__ A, const bf16_t* __restrict__ Bt, int K, bf16_t* X, const bf16_t* H, float scale, unsigned char* smem) {
    const int tid = mk_ltid(), lane = tid & 63, w = __builtin_amdgcn_readfirstlane(tid >> 6);
    const int r = lane & 15, q = lane >> 4;
    float* part = (float*)smem;
    for (int t = mk_lbid(); t < 256; t += gridDim.x) {
        const int R0 = MP + (t >> 4) * 32, C0 = (t & 15) * 64;
        f32x4 acc[2][4];
#pragma unroll
        for (int a = 0; a < 2; ++a)
#pragma unroll
            for (int b = 0; b < 4; ++b) acc[a][b] = (f32x4){0.f, 0.f, 0.f, 0.f};
        const int nks = K / 32;
#pragma unroll 2
        for (int ks = w; ks < nks; ks += 8) {
            bf16x8 fa[2], fb[4];
#pragma unroll
            for (int a = 0; a < 2; ++a) fa[a] = *(const bf16x8*)(A + (size_t)(R0 + a * 16 + r) * K + ks * 32 + q * 8);
#pragma unroll
            for (int b = 0; b < 4; ++b) fb[b] = *(const bf16x8*)(Bt + (size_t)(C0 + b * 16 + r) * K + ks * 32 + q * 8);
#pragma unroll
            for (int a = 0; a < 2; ++a)
#pragma unroll
                for (int b = 0; b < 4; ++b) acc[a][b] = __builtin_amdgcn_mfma_f32_16x16x32_bf16(fa[a], fb[b], acc[a][b], 0, 0, 0);
        }
        __syncthreads();
#pragma unroll
        for (int a = 0; a < 2; ++a)
#pragma unroll
            for (int b = 0; b < 4; ++b) *(f32x4*)(part + ((w * 8 + a * 4 + b) * 64 + lane) * 4) = acc[a][b];
        __syncthreads();
        {
            const int tile = tid >> 6, a = tile >> 2, b = tile & 3;
            f32x4 sum = (f32x4){0.f, 0.f, 0.f, 0.f};
#pragma unroll
            for (int ww = 0; ww < 8; ++ww) sum += *(const f32x4*)(part + ((ww * 8 + tile) * 64 + lane) * 4);
            const int col = C0 + b * 16 + r;
#pragma unroll
            for (int j = 0; j < 4; ++j) { const size_t off = (size_t)(R0 + a * 16 + q * 4 + j) * D + col;
                X[off] = f2bf(bf2f(H[off]) * ALPHA + sum[j] * scale); }
        }
    }
}

__device__ __forceinline__ void phase_ab_prep(const Params& p, int i, unsigned char* smem) {
    const int tid = mk_ltid(), lane = tid & 63, wave = __builtin_amdgcn_readfirstlane(tid >> 6);
    const int r = lane & 15, q = lane >> 4;
    unsigned char* ws = p.ws;
    const bf16_t* ZB = (const bf16_t*)(ws + WS_ZB);
    float* OPS = (float*)(ws + WS_OPS); float* GATE = (float*)(ws + WS_GATE); float* BONUS = (float*)(ws + WS_BONUS);
    bf16_t* RQ = (bf16_t*)(ws + WS_RQ); bf16_t* RK = (bf16_t*)(ws + WS_RK);
    const bf16_t* W2T = (const bf16_t*)(ws + WS_W2T); const bf16_t* A2T = (const bf16_t*)(ws + WS_A2T); const bf16_t* G2T = (const bf16_t*)(ws + WS_G2T);
    const float* mu = p.in[14] + (size_t)i * 1792; const float* w0 = p.in[15] + i * 512; const float* a0 = p.in[17] + i * 512;
    const float* k_k = p.in[20] + i * 512; const float* k_a = p.in[21] + i * 512; const float* r_k = p.in[22] + i * 512;
    const float* shift_in = p.in[2] + (size_t)i * 128 * 1792;
    constexpr int ZS_LD = 1796, ACT_LD = 264;
    float* zs = (float*)smem;
    bf16_t* act = (bf16_t*)(smem + 16 * ZS_LD * 4);
    for (int tile = mk_lbid(); tile < M / 16; tile += gridDim.x) {
        const int R0 = tile * 16;
        unsigned pfa = 0u, pfb = 0u;
        { const int ntile = tile + gridDim.x;
          if (ntile < M / 16) { const bf16_t* nz = ZB + (size_t)ntile * 16 * AB_N;
              pfa = *(const unsigned*)(nz + (size_t)tid * 64); pfb = *(const unsigned*)(((size_t)(tid + 512) * 64 < (size_t)16 * AB_N) ? nz + (size_t)(tid + 512) * 64 : nz); } }
#ifndef REP_A_ST
#define REP_A_ST 1
#endif
#ifndef REP_A_RO
#define REP_A_RO 1
#endif
#ifndef REP_A_EP
#define REP_A_EP 1
#endif
        __syncthreads();
#pragma unroll 1
        for (int rp_ = 0; rp_ < REP_A_ST; ++rp_)
#pragma unroll 7
        for (int idx = tid; idx < 16 * 448; idx += 512) {
            const int tok = idx / 448, c4 = (idx % 448) * 4; const int row = R0 + tok;
            const int t = (row < MP) ? (row & 2047) : ((row - MP) & 3);
            const int Lm1 = (row < MP) ? 2047 : 3;
            const u32x2 cu = *(const u32x2*)(ZB + (size_t)row * AB_N + c4);
            f32x4 cur; cur[0] = __uint_as_float(cu.x << 16); cur[1] = __uint_as_float(cu.x & 0xffff0000u); cur[2] = __uint_as_float(cu.y << 16); cur[3] = __uint_as_float(cu.y & 0xffff0000u);
            f32x4 prev;
            if (t == 0) { if (row < MP) prev = (f32x4){0.f, 0.f, 0.f, 0.f}; else prev = *(const f32x4*)(shift_in + (size_t)((row - MP) >> 2) * 1792 + c4); }
            else { const u32x2 pu = *(const u32x2*)(ZB + (size_t)(row - 1) * AB_N + c4);
                prev[0] = __uint_as_float(pu.x << 16); prev[1] = __uint_as_float(pu.x & 0xffff0000u); prev[2] = __uint_as_float(pu.y << 16); prev[3] = __uint_as_float(pu.y & 0xffff0000u); }
            if (t == Lm1) {
                float* o = (row < MP) ? p.out + O_PSHIFT + (size_t)(i * 8 + (row >> 11)) * 1792 : p.out + O_SSHIFT + (size_t)(i * 128 + ((row - MP) >> 2)) * 1792;
                *(f32x4*)(o + c4) = cur;
            }
            const f32x4 m4 = *(const f32x4*)(mu + c4);
            const f32x4 z = cur + (prev - cur) * m4;
            *(f32x4*)(zs + tok * ZS_LD + c4) = z;
            if (c4 >= 1536) {
                f32x4 a;
                if (c4 < 1600) { a[0] = tanhf(z[0]); a[1] = tanhf(z[1]); a[2] = tanhf(z[2]); a[3] = tanhf(z[3]); }
                else if (c4 < 1664) a = z;
                else { a[0] = sigm(z[0]); a[1] = sigm(z[1]); a[2] = sigm(z[2]); a[3] = sigm(z[3]); }
                u32x2 o; o.x = pk2(a[0], a[1]); o.y = pk2(a[2], a[3]); *(u32x2*)(act + tok * ACT_LD + (c4 - 1536)) = o;
            }
        }
#pragma unroll 1
        for (int rp_ = 0; rp_ < REP_A_RO; ++rp_)
#pragma unroll 8
        for (int idx = tid; idx < 16 * 256; idx += 512) {
            const int tok = idx >> 8, hh = (idx >> 6) & 3, ii = idx & 63; const int row = R0 + tok;
            const float pos = (row < MP) ? (float)(row & 2047) : (float)(16384 + ((row - MP) & 3));
            const float inv_freq = exp2f(-(float)ii * (13.287712379549449f / 63.0f));
            const float ang = pos * inv_freq;
            const float n = rintf(ang * 0.15915494309189535f);
            float rr = fmaf(-n, 6.2831854820251465f, ang); rr = fmaf(-n, -1.7484555e-7f, rr);
            const float rev = rr * 0.15915494309189535f;
            const float sn = __builtin_amdgcn_sinf(rev), cs = __builtin_amdgcn_cosf(rev);
            const bf16_t* zq = ZB + (size_t)row * AB_N + 1792 + hh * 128 + ii;
            const float q1 = bf2f(zq[0]), q2 = bf2f(zq[64]), k1 = bf2f(zq[512]), k2 = bf2f(zq[576]);
            const size_t o = (size_t)row * 512 + hh * 128 + ii;
            RQ[o] = f2bf(q1 * cs - q2 * sn); RQ[o + 64] = f2bf(q2 * cs + q1 * sn);
            const float ksc = 0.08838834764831845f;
            RK[o] = f2bf((k1 * cs - k2 * sn) * ksc); RK[o + 64] = f2bf((k2 * cs + k1 * sn) * ksc);
        }
        __syncthreads();
        const int cb = wave * 64;
#pragma unroll 1
        for (int rp_ = 0; rp_ < REP_A_EP; ++rp_) {
        f32x4 aw[4], aa[4], ag[4];
#pragma unroll
        for (int nt = 0; nt < 4; ++nt) { aw[nt] = (f32x4){0.f, 0.f, 0.f, 0.f}; aa[nt] = aw[nt]; ag[nt] = aw[nt]; }
#pragma unroll
        for (int ks = 0; ks < 2; ++ks) {
            const bf16x8 bw = *(const bf16x8*)(act + r * ACT_LD + ks * 32 + q * 8);
            const bf16x8 ba = *(const bf16x8*)(act + r * ACT_LD + 64 + ks * 32 + q * 8);
#pragma unroll
            for (int nt = 0; nt < 4; ++nt) {
                const bf16x8 fw = *(const bf16x8*)(W2T + (size_t)(cb + nt * 16 + r) * 64 + ks * 32 + q * 8);
                const bf16x8 fa = *(const bf16x8*)(A2T + (size_t)(cb + nt * 16 + r) * 64 + ks * 32 + q * 8);
                aw[nt] = __builtin_amdgcn_mfma_f32_16x16x32_bf16(fw, bw, aw[nt], 0, 0, 0);
                aa[nt] = __builtin_amdgcn_mfma_f32_16x16x32_bf16(fa, ba, aa[nt], 0, 0, 0);
            }
        }
#pragma unroll
        for (int ks = 0; ks < 4; ++ks) {
            const bf16x8 bg = *(const bf16x8*)(act + r * ACT_LD + 128 + ks * 32 + q * 8);
#pragma unroll
            for (int nt = 0; nt < 4; ++nt) {
                const bf16x8 fg = *(const bf16x8*)(G2T + (size_t)(cb + nt * 16 + r) * 128 + ks * 32 + q * 8);
                ag[nt] = __builtin_amdgcn_mfma_f32_16x16x32_bf16(fg, bg, ag[nt], 0, 0, 0);
            }
        }
        const int row = R0 + r;
        float ssq = 0.f, bon = 0.f;
        f32x4 kkraw[4], av[4];
#pragma unroll
        for (int nt = 0; nt < 4; ++nt) {
            const int c = cb + nt * 16 + q * 4;
            const f32x4 rr = *(const f32x4*)(zs + r * ZS_LD + c), kx = *(const f32x4*)(zs + r * ZS_LD + 512 + c), vv = *(const f32x4*)(zs + r * ZS_LD + 1024 + c);
            const f32x4 w04 = *(const f32x4*)(w0 + c), a04 = *(const f32x4*)(a0 + c), kk4 = *(const f32x4*)(k_k + c), ka4 = *(const f32x4*)(k_a + c), rk4 = *(const f32x4*)(r_k + c);
            f32x4 dec, a, kp;
#pragma unroll
            for (int j = 0; j < 4; ++j) {
                const float wl = w04[j] + aw[nt][j];
                const float sp = fmaxf(-wl, 0.f) + __logf(1.f + __expf(-fabsf(wl)));
                const float wlog = -sp - 0.5f;
                dec[j] = __expf(-__expf(wlog));
                a[j] = sigm(a04[j] + aa[nt][j]);
                kkraw[nt][j] = kx[j] * kk4[j];
                kp[j] = kx[j] * (1.f + (a[j] - 1.f) * ka4[j]);
                ssq += kkraw[nt][j] * kkraw[nt][j];
                bon += rr[j] * kp[j] * rk4[j];
            }
            av[nt] = a;
            float* ob = OPS + ((size_t)row * 8 + wave) * 384 + nt * 16 + q * 4;
            *(f32x4*)(ob) = rr; *(f32x4*)(ob + 64) = dec; *(f32x4*)(ob + 128) = kp; *(f32x4*)(ob + 192) = vv;
            *(f32x4*)(GATE + (size_t)row * 512 + c) = ag[nt];
        }
        ssq += __shfl_xor(ssq, 16); ssq += __shfl_xor(ssq, 32);
        bon += __shfl_xor(bon, 16); bon += __shfl_xor(bon, 32);
        const float rn = rsqrtf(fmaxf(ssq, 1e-12f));
#pragma unroll
        for (int nt = 0; nt < 4; ++nt) {
            float* ob = OPS + ((size_t)row * 8 + wave) * 384 + nt * 16 + q * 4;
            const f32x4 kk = kkraw[nt] * rn;
            *(f32x4*)(ob + 256) = kk; *(f32x4*)(ob + 320) = kk * av[nt];
        }
        if (q == 0) BONUS[(size_t)row * 8 + wave] = bon;
        }
        if (pfa == 0x7fc17fc1u && pfb == 0x7fc27fc2u) zs[0] = 1.f;
    }
}

__device__ __forceinline__ void rwkv_item(const Params& p, int i, int s, int h, int rg, unsigned char* smem) {
    const int tid = mk_ltid(), lane = tid & 63, wave = __builtin_amdgcn_readfirstlane(tid >> 6);
    int row0, L; seq_info(s, row0, L);
    const float* OPS = (const float*)(p.ws + WS_OPS); float* ORAW = (float*)(p.ws + WS_ORAW);
    float* buf = (float*)smem;
    const int rih = rg * 16 + (wave & 3) * 4 + (lane >> 4);
    const int c4 = (lane & 15) * 4;
    f32x4 S = (f32x4){0.f, 0.f, 0.f, 0.f};
    if (s >= 8 && wave < 4) S = *(const f32x4*)(p.in[3] + ((((size_t)i * 128 + (s - 8)) * 8 + h) * 64 + rih) * 64 + c4);
    f32x4 pre[6];
    const int nch = (L + 31) / 32;
#pragma unroll
    for (int k = 0; k < 6; ++k) { const int idx4 = tid + k * 512; const int tt = idx4 / 96, off = idx4 % 96;
        pre[k] = (tt < L) ? *(const f32x4*)(OPS + ((size_t)(row0 + tt) * 8 + h) * 384 + off * 4) : (f32x4){0.f, 0.f, 0.f, 0.f}; }
    for (int ch = 0; ch < nch; ++ch) {
        const int t0 = ch * 32;
        __syncthreads();
#pragma unroll
        for (int k = 0; k < 6; ++k) { const int idx4 = tid + k * 512; *(f32x4*)(buf + idx4 * 4) = pre[k]; }
        __syncthreads();
        if (ch + 1 < nch) {
#pragma unroll
            for (int k = 0; k < 6; ++k) { const int idx4 = tid + k * 512; const int tt = t0 + 32 + idx4 / 96, off = idx4 % 96;
                pre[k] = (tt < L) ? *(const f32x4*)(OPS + ((size_t)(row0 + tt) * 8 + h) * 384 + off * 4) : (f32x4){0.f, 0.f, 0.f, 0.f}; }
        }
        if (wave < 4) {
            const int ns = (L - t0) < 32 ? (L - t0) : 32;
            f32x4 r4 = *(const f32x4*)(buf + c4), w4 = *(const f32x4*)(buf + 64 + c4), k4 = *(const f32x4*)(buf + 128 + c4);
            f32x4 kk4 = *(const f32x4*)(buf + 256 + c4), ka4 = *(const f32x4*)(buf + 320 + c4);
            float vv = buf[192 + rih];
            float* op = ORAW + (size_t)(row0 + t0) * 512 + h * 64 + rih;
            f32x4 rprev = r4;
#pragma unroll 2
            for (int tt = 0; tt < ns; ++tt) {
                const float* nb = buf + ((tt + 1 < 32) ? (tt + 1) : 31) * 384;
                const f32x4 r4n = *(const f32x4*)(nb + c4), w4n = *(const f32x4*)(nb + 64 + c4), k4n = *(const f32x4*)(nb + 128 + c4);
                const f32x4 kk4n = *(const f32x4*)(nb + 256 + c4), ka4n = *(const f32x4*)(nb + 320 + c4);
                const float vvn = nb[192 + rih];
                float o = (S[0] * rprev[0] + S[1] * rprev[1]) + (S[2] * rprev[2] + S[3] * rprev[3]);
                const f32x4 kv = k4 * vv;
                float sk = (S[0] * kk4[0] + S[1] * kk4[1]) + (S[2] * kk4[2] + S[3] * kk4[3]);
                sk = row16_sum(sk);
                o = row16_sum(o);
                const f32x4 t1 = kv - ka4 * sk;
                S = S * w4 + t1;
                if ((lane & 15) == 0 && tt > 0) op[(size_t)(tt - 1) * 512] = o;
                rprev = r4;
                r4 = r4n; w4 = w4n; k4 = k4n; kk4 = kk4n; ka4 = ka4n; vv = vvn;
            }
            {
                float o = (S[0] * rprev[0] + S[1] * rprev[1]) + (S[2] * rprev[2] + S[3] * rprev[3]);
                o = row16_sum(o);
                if ((lane & 15) == 0) op[(size_t)(ns - 1) * 512] = o;
            }
        }
    }
    if (wave < 4) {
        float* so = (s < 8) ? p.out + O_PRWKV + ((((size_t)i * 8 + s) * 8 + h) * 64 + rih) * 64 + c4
                            : p.out + O_SRWKV + ((((size_t)i * 128 + (s - 8)) * 8 + h) * 64 + rih) * 64 + c4;
        *(f32x4*)so = S;
    }
}

__device__ __forceinline__ void rwkv_item2(const Params& p, int i, int s, int h, int rg, unsigned char* smem) {
    const int tid = mk_ltid(), lane = tid & 63, wave = __builtin_amdgcn_readfirstlane(tid >> 6);
    int row0, L; seq_info(s, row0, L);
    const float* OPS = (const float*)(p.ws + WS_OPS); float* ORAW = (float*)(p.ws + WS_ORAW);
    float* buf = (float*)smem;
    const int ra = rg * 32 + (wave & 3) * 4 + (lane >> 4), rb = ra + 16;
    const int c4 = (lane & 15) * 4;
    f32x4 Sa = (f32x4){0.f, 0.f, 0.f, 0.f}, Sb = Sa;
    if (s >= 8 && wave < 4) { const float* sp = p.in[3] + (((size_t)i * 128 + (s - 8)) * 8 + h) * 4096;
        Sa = *(const f32x4*)(sp + ra * 64 + c4); Sb = *(const f32x4*)(sp + rb * 64 + c4); }
    f32x4 pre[12];
    const int nch = (L + 63) / 64;
#pragma unroll
    for (int k = 0; k < 12; ++k) { const int idx4 = tid + k * 512; const int tt = idx4 / 96, off = idx4 % 96;
        pre[k] = (tt < L) ? *(const f32x4*)(OPS + ((size_t)(row0 + tt) * 8 + h) * 384 + off * 4) : (f32x4){0.f, 0.f, 0.f, 0.f}; }
    for (int ch = 0; ch < nch; ++ch) {
        const int t0 = ch * 64;
        __syncthreads();
#pragma unroll
        for (int k = 0; k < 12; ++k) { const int idx4 = tid + k * 512; *(f32x4*)(buf + idx4 * 4) = pre[k]; }
        __syncthreads();
        if (ch + 1 < nch) {
#pragma unroll
            for (int k = 0; k < 12; ++k) { const int idx4 = tid + k * 512; const int tt = t0 + 64 + idx4 / 96, off = idx4 % 96;
                pre[k] = (tt < L) ? *(const f32x4*)(OPS + ((size_t)(row0 + tt) * 8 + h) * 384 + off * 4) : (f32x4){0.f, 0.f, 0.f, 0.f}; }
        }
        if (wave < 4) {
            const int ns = (L - t0) < 64 ? (L - t0) : 64;
            f32x4 rA = *(const f32x4*)(buf + c4), wA = *(const f32x4*)(buf + 64 + c4), kA = *(const f32x4*)(buf + 128 + c4);
            f32x4 kkA = *(const f32x4*)(buf + 256 + c4), kaA = *(const f32x4*)(buf + 320 + c4);
            float vaA = buf[192 + ra], vbA = buf[192 + rb];
            f32x4 rB, wB, kB, kkB, kaB; float vaB, vbB;
            float* op = ORAW + (size_t)(row0 + t0) * 512 + h * 64 + ra;
            f32x4 rprev = rA;
#define RW_LOAD(R, W, K, KK, KA, VA, VB, nb_) do { const float* nb = (nb_); R = *(const f32x4*)(nb + c4); W = *(const f32x4*)(nb + 64 + c4); K = *(const f32x4*)(nb + 128 + c4); \
                KK = *(const f32x4*)(nb + 256 + c4); KA = *(const f32x4*)(nb + 320 + c4); VA = nb[192 + ra]; VB = nb[192 + rb]; } while (0)
#define RW_STEP(R, W, K, KK, KA, VA, VB, RP, tt_) do { \
                float oa = (Sa[0] * RP[0] + Sa[1] * RP[1]) + (Sa[2] * RP[2] + Sa[3] * RP[3]); \
                float ob = (Sb[0] * RP[0] + Sb[1] * RP[1]) + (Sb[2] * RP[2] + Sb[3] * RP[3]); \
                float ska = (Sa[0] * KK[0] + Sa[1] * KK[1]) + (Sa[2] * KK[2] + Sa[3] * KK[3]); \
                float skb = (Sb[0] * KK[0] + Sb[1] * KK[1]) + (Sb[2] * KK[2] + Sb[3] * KK[3]); \
                ska = row16_sum(ska); skb = row16_sum(skb); oa = row16_sum(oa); ob = row16_sum(ob); \
                Sa = Sa * W + (K * VA - KA * ska); Sb = Sb * W + (K * VB - KA * skb); \
                if ((lane & 15) == 0 && (tt_) > 0) { op[(size_t)((tt_) - 1) * 512] = oa; op[(size_t)((tt_) - 1) * 512 + 16] = ob; } } while (0)
            for (int tt = 0; tt < ns; tt += 2) {
                RW_LOAD(rB, wB, kB, kkB, kaB, vaB, vbB, buf + (tt + 1) * 384);
                RW_STEP(rA, wA, kA, kkA, kaA, vaA, vbA, rprev, tt);
                const f32x4 rEven = rA;
                RW_LOAD(rA, wA, kA, kkA, kaA, vaA, vbA, buf + ((tt + 2 < 64) ? (tt + 2) : 63) * 384);
                RW_STEP(rB, wB, kB, kkB, kaB, vaB, vbB, rEven, tt + 1);
                rprev = rB;
            }
            {
                float oa = (Sa[0] * rprev[0] + Sa[1] * rprev[1]) + (Sa[2] * rprev[2] + Sa[3] * rprev[3]);
                float ob = (Sb[0] * rprev[0] + Sb[1] * rprev[1]) + (Sb[2] * rprev[2] + Sb[3] * rprev[3]);
                oa = row16_sum(oa); ob = row16_sum(ob);
                if ((lane & 15) == 0) { op[(size_t)(ns - 1) * 512] = oa; op[(size_t)(ns - 1) * 512 + 16] = ob; }
            }
#undef RW_LOAD
#undef RW_STEP
        }
    }
    if (wave < 4) {
        float* so = (s < 8) ? p.out + O_PRWKV + (((size_t)i * 8 + s) * 8 + h) * 4096 : p.out + O_SRWKV + (((size_t)i * 128 + (s - 8)) * 8 + h) * 4096;
        *(f32x4*)(so + ra * 64 + c4) = Sa; *(f32x4*)(so + rb * 64 + c4) = Sb;
    }
}

__device__ __forceinline__ void ret_item(const Params& p, int i, int s, int hb, unsigned char* smem) {
    const int tid = mk_ltid(), lane = tid & 63, w = __builtin_amdgcn_readfirstlane(tid >> 6);
    const int r = lane & 15, q = lane >> 4;
    int row0, L; seq_info(s, row0, L);
    const int C = (s < 8) ? 128 : 4; const int nch = L / C;
    const float lg = log2f(1.0f - exp2f(-5.0f - (float)hb));
    const bf16_t* ZB = (const bf16_t*)(p.ws + WS_ZB); const bf16_t* RQ = (const bf16_t*)(p.ws + WS_RQ); const bf16_t* RK = (const bf16_t*)(p.ws + WS_RK);
    bf16_t* OMIX = (bf16_t*)(p.ws + WS_OMIX);
    const float* gn_g = p.in[25] + i * 512 + hb * 128; const float* gn_b = p.in[26] + i * 512 + hb * 128;
    constexpr int LD = 136;
    bf16_t* KC = (bf16_t*)smem; bf16_t* KZT = KC + 128 * LD; bf16_t* VT = KZT + 128 * LD; bf16_t* SB = VT + 128 * LD;
    f32x4 ST[8];
#pragma unroll
    for (int nt = 0; nt < 8; ++nt) ST[nt] = (f32x4){0.f, 0.f, 0.f, 0.f};
    if (s >= 8) {
        const float* S0 = p.in[4] + (((size_t)i * 128 + (s - 8)) * 4 + hb) * 16384;
#pragma unroll
        for (int nt = 0; nt < 8; ++nt) ST[nt] = *(const f32x4*)(S0 + (size_t)(nt * 16 + r) * 128 + 16 * w + q * 4);
    }
    const float gch = exp2f((float)C * lg);
    for (int ch = 0; ch < nch; ++ch) {
        const int rb = row0 + ch * C;
        __syncthreads();
        for (int idx = tid; idx < 128 * 16; idx += 512) {
            const int tok = idx & 127, c8 = (idx >> 7) * 8;
            u32x4 kv = (u32x4){0u, 0u, 0u, 0u}, vv = kv;
            if (tok < C) { kv = *(const u32x4*)(RK + (size_t)(rb + tok) * 512 + hb * 128 + c8);
                           vv = *(const u32x4*)(ZB + (size_t)(rb + tok) * AB_N + 1792 + 1024 + hb * 128 + c8); }
            *(u32x4*)(KC + tok * LD + c8) = kv;
            const float zeta = __builtin_amdgcn_exp2f((float)(C - 1 - tok) * lg);
            const unsigned kw[4] = {kv.x, kv.y, kv.z, kv.w}; const unsigned vw[4] = {vv.x, vv.y, vv.z, vv.w};
#pragma unroll
            for (int e = 0; e < 4; ++e) {
                const float k0 = __uint_as_float(kw[e] << 16) * zeta, k1 = __uint_as_float(kw[e] & 0xffff0000u) * zeta;
                KZT[(c8 + 2 * e) * LD + tok] = f2bf(k0); KZT[(c8 + 2 * e + 1) * LD + tok] = f2bf(k1);
                VT[(c8 + 2 * e) * LD + tok] = (bf16_t)(vw[e] & 0xffffu); VT[(c8 + 2 * e + 1) * LD + tok] = (bf16_t)(vw[e] >> 16);
            }
        }
#pragma unroll
        for (int nt = 0; nt < 8; ++nt)
#pragma unroll
            for (int j = 0; j < 4; ++j) SB[(16 * w + q * 4 + j) * LD + nt * 16 + r] = f2bf(ST[nt][j]);
        __syncthreads();
        bf16x8 aq[4];
#pragma unroll
        for (int ks = 0; ks < 4; ++ks) {
            if (16 * w + r < C) aq[ks] = *(const bf16x8*)(RQ + (size_t)(rb + 16 * w + r) * 512 + hb * 128 + ks * 32 + q * 8);
            else aq[ks] = (bf16x8){0, 0, 0, 0, 0, 0, 0, 0};
        }
        u32x2 P[8]; f32x4 O[8];
#pragma unroll
        for (int nt = 0; nt < 8; ++nt) {
            f32x4 acc = (f32x4){0.f, 0.f, 0.f, 0.f}, oc = acc;
#pragma unroll
            for (int ks = 0; ks < 4; ++ks) {
                const bf16x8 bk = *(const bf16x8*)(KC + (nt * 16 + r) * LD + ks * 32 + q * 8);
                const bf16x8 bs = *(const bf16x8*)(SB + (nt * 16 + r) * LD + ks * 32 + q * 8);
                acc = __builtin_amdgcn_mfma_f32_16x16x32_bf16(aq[ks], bk, acc, 0, 0, 0);
                oc = __builtin_amdgcn_mfma_f32_16x16x32_bf16(aq[ks], bs, oc, 0, 0, 0);
            }
#pragma unroll
            for (int j = 0; j < 4; ++j) {
                const int ii = 16 * w + q * 4 + j, jt = nt * 16 + r;
                acc[j] = (ii >= jt) ? acc[j] * __builtin_amdgcn_exp2f((float)(ii - jt) * lg) : 0.f;
                oc[j] *= __builtin_amdgcn_exp2f((float)(ii + 1) * lg);
            }
            P[nt].x = pk2(acc[0], acc[1]); P[nt].y = pk2(acc[2], acc[3]); O[nt] = oc;
        }
        __syncthreads();
#pragma unroll
        for (int nt = 0; nt < 8; ++nt)
#pragma unroll
            for (int j = 0; j < 4; ++j) KC[(16 * w + q * 4 + j) * LD + nt * 16 + r] = (bf16_t)(((j & 2) ? P[nt].y : P[nt].x) >> ((j & 1) * 16));
        __syncthreads();
#pragma unroll
        for (int nt = 0; nt < 8; ++nt) ST[nt] = ST[nt] * gch;
#pragma unroll
        for (int ks = 0; ks < 4; ++ks) {
            const bf16x8 ap = *(const bf16x8*)(KC + (16 * w + r) * LD + ks * 32 + q * 8);
            const bf16x8 av = *(const bf16x8*)(VT + (16 * w + r) * LD + ks * 32 + q * 8);
#pragma unroll
            for (int nt = 0; nt < 8; ++nt) {
                const bf16x8 bv = *(const bf16x8*)(VT + (nt * 16 + r) * LD + ks * 32 + q * 8);
                const bf16x8 bz = *(const bf16x8*)(KZT + (nt * 16 + r) * LD + ks * 32 + q * 8);
                O[nt] = __builtin_amdgcn_mfma_f32_16x16x32_bf16(ap, bv, O[nt], 0, 0, 0);
                ST[nt] = __builtin_amdgcn_mfma_f32_16x16x32_bf16(av, bz, ST[nt], 0, 0, 0);
            }
        }
#pragma unroll
        for (int j = 0; j < 4; ++j) {
            float s1 = 0.f;
#pragma unroll
            for (int nt = 0; nt < 8; ++nt) s1 += O[nt][j];
            s1 = row16_sum(s1); const float mean = s1 * (1.f / 128.f);
            float s2 = 0.f;
#pragma unroll
            for (int nt = 0; nt < 8; ++nt) { const float d = O[nt][j] - mean; s2 += d * d; }
            s2 = row16_sum(s2); const float rstd = rsqrtf(s2 * (1.f / 128.f) + 1e-5f);
            const int ii = 16 * w + q * 4 + j;
            if (ii < C) {
                const size_t row = (size_t)(rb + ii);
#pragma unroll
                for (int nt = 0; nt < 8; ++nt) { const int dv = nt * 16 + r;
                    const float val = (O[nt][j] - mean) * rstd * gn_g[dv] + gn_b[dv];
                    const float gr = bf2f(ZB[row * AB_N + 1792 + 1536 + hb * 128 + dv]);
                    OMIX[row * 1024 + 512 + hb * 128 + dv] = f2bf(val * silu(gr)); }
            }
        }
    }
    float* so = (s < 8) ? p.out + O_PRET + (((size_t)i * 8 + s) * 4 + hb) * 16384 : p.out + O_SRET + (((size_t)i * 128 + (s - 8)) * 4 + hb) * 16384;
#pragma unroll
    for (int nt = 0; nt < 8; ++nt) *(f32x4*)(so + (size_t)(nt * 16 + r) * 128 + 16 * w + q * 4) = ST[nt];
}

__device__ __forceinline__ void phase_ab_core(const Params& p, int i, int l, unsigned char* smem) {
    const int bid = mk_lbid(), G = gridDim.x; const int wv = mk_ltid() >> 6;
    if (G == 256) {
        if (bid < 128) rwkv_item2(p, i, bid >> 4, (bid >> 1) & 7, bid & 1, smem);
        else if (bid < 160) ret_item(p, i, (bid - 128) >> 2, (bid - 128) & 3, smem);
        else {
            for (int it = bid - 160; it < 128 * 16; it += 96) rwkv_item2(p, i, 8 + (it >> 4), (it >> 1) & 7, it & 1, smem);
            __syncthreads();
            for (int it = bid - 160; it < 128 * 4; it += 96) ret_item(p, i, 8 + (it >> 2), it & 3, smem);
        }
        if (bid >= 160) convert_ffn_ahead(p, l, (bid - 160) * 8 + wv, 96 * 8, smem);
    } else {
        for (int it = bid; it < 136 * 16; it += G) rwkv_item2(p, i, it >> 4, (it >> 1) & 7, it & 1, smem);
        __syncthreads();
        for (int it = bid; it < 136 * 4; it += G) ret_item(p, i, it >> 2, it & 3, smem);
        convert_ffn_ahead(p, l, bid * 8 + wv, G * 8, smem);
    }
}

__device__ __forceinline__ void phase_ab_post(const Params& p, int i) {
    const int tid = mk_ltid(), lane = tid & 63, wave = tid >> 6;
    const int gw = mk_lbid() * 8 + wave, NGW = gridDim.x * 8;
    const float* OPS = (const float*)(p.ws + WS_OPS); const float* ORAW = (const float*)(p.ws + WS_ORAW);
    const float* GATE = (const float*)(p.ws + WS_GATE); const float* BONUS = (const float*)(p.ws + WS_BONUS);
    bf16_t* OMIX = (bf16_t*)(p.ws + WS_OMIX);
    const float* gg = p.in[23] + i * 512; const float* gb = p.in[24] + i * 512;
    for (int m = gw; m < M; m += NGW) {
        const int c = lane * 8, h = lane >> 3, hc = c & 63;
        const f32x4 o0 = *(const f32x4*)(ORAW + (size_t)m * 512 + c), o1 = *(const f32x4*)(ORAW + (size_t)m * 512 + c + 4);
        float s1 = (o0[0] + o0[1]) + (o0[2] + o0[3]) + (o1[0] + o1[1]) + (o1[2] + o1[3]);
        s1 += __shfl_xor(s1, 1); s1 += __shfl_xor(s1, 2); s1 += __shfl_xor(s1, 4);
        const float mean = s1 * (1.f / 64.f);
        const f32x4 d0 = o0 - mean, d1 = o1 - mean;
        float s2 = (d0[0] * d0[0] + d0[1] * d0[1]) + (d0[2] * d0[2] + d0[3] * d0[3]) + (d1[0] * d1[0] + d1[1] * d1[1]) + (d1[2] * d1[2] + d1[3] * d1[3]);
        s2 += __shfl_xor(s2, 1); s2 += __shfl_xor(s2, 2); s2 += __shfl_xor(s2, 4);
        const float rstd = rsqrtf(s2 * (1.f / 64.f) + 64e-5f);
        const float bon = BONUS[(size_t)m * 8 + h];
        const float* vb = OPS + ((size_t)m * 8 + h) * 384 + 192 + hc;
        const f32x4 v0 = *(const f32x4*)vb, v1 = *(const f32x4*)(vb + 4);
        const f32x4 g0 = *(const f32x4*)(gg + c), g1 = *(const f32x4*)(gg + c + 4), b0 = *(const f32x4*)(gb + c), b1 = *(const f32x4*)(gb + c + 4);
        const f32x4 t0 = *(const f32x4*)(GATE + (size_t)m * 512 + c), t1 = *(const f32x4*)(GATE + (size_t)m * 512 + c + 4);
        const f32x4 y0 = (d0 * rstd * g0 + b0 + v0 * bon) * t0, y1 = (d1 * rstd * g1 + b1 + v1 * bon) * t1;
        u32x4 o; o.x = pk2(y0[0], y0[1]); o.y = pk2(y0[2], y0[3]); o.z = pk2(y1[0], y1[1]); o.w = pk2(y1[2], y1[3]);
        *(u32x4*)(OMIX + (size_t)m * 1024 + c) = o;
    }
}

__device__ __forceinline__ int gdn_item_index(int s, int h, int c) { return (s < 8) ? ((s * 8 + h) * 32 + c) : (2048 + (s - 8) * 8 + h); }

__device__ __forceinline__ void gdn_chunk_item(const Params& p, int i, int s, int h, int c, int pf_row, int pf_h, unsigned char* smem) {
    const int tid = mk_ltid(), lane = tid & 63, w = __builtin_amdgcn_readfirstlane(tid >> 6);
    const int r = lane & 15, q = lane >> 4;
    int row0, L; seq_info(s, row0, L);
    const int t0 = c * 64; const int nvalid = (L - t0) < 64 ? (L - t0) : 64;
    const bf16_t* ZB = (const bf16_t*)(p.ws + WS_ZB);
    unsigned char* rec = p.ws + WS_CH + (size_t)gdn_item_index(s, h, c) * CH_BYTES;
    float* U = (float*)(rec + CH_U); bf16_t* Wd = (bf16_t*)(rec + CH_W); bf16_t* QG = (bf16_t*)(rec + CH_QG); bf16_t* QK = (bf16_t*)(rec + CH_QK); bf16_t* KDT = (bf16_t*)(rec + CH_KDT);
    constexpr int LD = 132, ALD = 68;
    float* qs = (float*)smem; float* ks = qs + 64 * LD; float* vs = ks + 64 * LD; float* As = vs + 64 * LD;
    float* AT = As + 64 * ALD; float* gcs = AT + 64 * ALD; float* bes = gcs + 64;
    unsigned short pfv = 0;
    if (pf_row >= 0 && tid < 384) { const int rr_ = tid / 6, pp_ = (tid % 6) >> 1, hh_ = tid & 1;
        pfv = ((const bf16_t*)(p.ws + WS_ZB))[(size_t)(pf_row + rr_) * GD_N + pp_ * 1024 + pf_h * 128 + hh_ * 64]; }
#ifndef REP_G_CONV
#define REP_G_CONV 1
#endif
#ifndef REP_G_MFMA
#define REP_G_MFMA 1
#endif
#ifndef REP_G_QG
#define REP_G_QG 1
#endif
#ifndef REP_G_SUB
#define REP_G_SUB 1
#endif
#pragma unroll 1
    for (int rp_ = 0; rp_ < REP_G_CONV; ++rp_) {
    __syncthreads();
    if (tid < 384) {
        if (nvalid == 64) {
            const int cg = tid % 48, tr = tid / 48;
            const int part = cg >> 4, ch0 = (cg & 15) * 8; const int zc0 = part * 1024 + h * 128 + ch0;
            const float* cw = p.in[28] + (size_t)i * 4 * 3072 + zc0;
            f32x4 wv[4][2];
#pragma unroll
            for (int j = 0; j < 4; ++j) { wv[j][0] = *(const f32x4*)(cw + j * 3072); wv[j][1] = *(const f32x4*)(cw + j * 3072 + 4); }
            u32x4 xr[11];
#pragma unroll
            for (int jr = 0; jr < 11; ++jr) { const int tt = t0 + tr * 8 - 3 + jr;
                xr[jr] = (tt >= 0) ? *(const u32x4*)(ZB + (size_t)(row0 + (tt >= 0 ? tt : 0)) * GD_N + zc0) : (u32x4){0u, 0u, 0u, 0u}; }
            float* dstb = (part == 0 ? qs : part == 1 ? ks : vs) + ch0;
#pragma unroll
            for (int e = 0; e < 8; ++e) {
                f32x4 o0, o1;
#pragma unroll
                for (int cc = 0; cc < 8; ++cc) {
                    float y = 0.f;
#pragma unroll
                    for (int j = 0; j < 4; ++j) { const unsigned wd = (cc >> 1) == 0 ? xr[e + j].x : (cc >> 1) == 1 ? xr[e + j].y : (cc >> 1) == 2 ? xr[e + j].z : xr[e + j].w;
                        const float xv = (cc & 1) ? __uint_as_float(wd & 0xffff0000u) : __uint_as_float(wd << 16);
                        y += wv[j][cc >> 2][cc & 3] * xv; }
                    const float sv = silu(y);
                    if (cc < 4) o0[cc] = sv; else o1[cc - 4] = sv;
                }
                *(f32x4*)(dstb + (tr * 8 + e) * LD) = o0; *(f32x4*)(dstb + (tr * 8 + e) * LD + 4) = o1;
            }
        } else {
            const int part = tid >> 7, ch = tid & 127; const int zc = part * 1024 + h * 128 + ch;
            const float* cw = p.in[28] + (size_t)i * 4 * 3072 + zc;
            const float cw0 = cw[0], cw1 = cw[3072], cw2 = cw[2 * 3072], cw3 = cw[3 * 3072];
            float* dst = (part == 0 ? qs : part == 1 ? ks : vs) + ch;
            float x3, x2, x1;
            { const float* cs = p.in[5] + (((size_t)i * 128 + (s - 8)) * 3) * 3072 + zc; x3 = cs[0]; x2 = cs[3072]; x1 = cs[2 * 3072]; }
#pragma unroll
            for (int e = 0; e < 64; ++e) {
                float v = 0.f;
                if (e < 4) { const float xe = (e < nvalid) ? bf2f(ZB[(size_t)(row0 + e) * GD_N + zc]) : 0.f;
                    const float y = cw0 * x3 + cw1 * x2 + cw2 * x1 + cw3 * xe; v = (e < nvalid) ? silu(y) : 0.f; x3 = x2; x2 = x1; x1 = xe; }
                dst[e * LD] = v;
            }
        }
    } else if (tid < 448) {
        const int t = tid - 384;
        float be = 0.f, g = 0.f;
        if (t < nvalid) { const size_t zr = (size_t)(row0 + t0 + t) * GD_N;
            be = sigm(bf2f(ZB[zr + 3072 + h]));
            const float a = bf2f(ZB[zr + 3080 + h]) + p.in[30][i * 8 + h];
            const float sp = fmaxf(a, 0.f) + __logf(1.f + __expf(-fabsf(a)));
            g = -__expf(p.in[29][i * 8 + h]) * sp; }
#pragma unroll
        for (int o = 1; o < 64; o <<= 1) { const float y = __shfl_up(g, o); if (t >= o) g += y; }
        gcs[t] = g; bes[t] = be;
    }
    }
    __syncthreads();
    for (int pass = 0; pass < 4; ++pass) {
        const int rowi = w * 16 + pass * 4 + q;
        const int t = rowi & 63;
        if ((w * 16 + pass * 4) % 64 < nvalid) {
            float* base = ((rowi < 64) ? qs : ks) + t * LD + r * 8;
            f32x4 a = *(f32x4*)base, b = *(f32x4*)(base + 4);
            float ss = (a[0] * a[0] + a[1] * a[1]) + (a[2] * a[2] + a[3] * a[3]) + (b[0] * b[0] + b[1] * b[1]) + (b[2] * b[2] + b[3] * b[3]);
            ss = row16_sum(ss);
            const float rn = rsqrtf(fmaxf(ss, 1e-12f));
            *(f32x4*)base = a * rn; *(f32x4*)(base + 4) = b * rn;
        }
    }
    __syncthreads();
#pragma unroll 1
    for (int rp_ = 0; rp_ < REP_G_MFMA; ++rp_)
#pragma unroll
    for (int tl = 0; tl < 2; ++tl) {
        const int tile = 2 * w + tl, mi = tile >> 2, ni = tile & 3;
        f32x4 akk = (f32x4){0.f, 0.f, 0.f, 0.f}, aqk = akk;
        if (mi * 16 < nvalid) {
#pragma unroll 8
            for (int k0 = 0; k0 < 128; k0 += 4) {
                const float ka = ks[(mi * 16 + r) * LD + k0 + q], kb = ks[(ni * 16 + r) * LD + k0 + q], qa = qs[(mi * 16 + r) * LD + k0 + q];
                akk = __builtin_amdgcn_mfma_f32_16x16x4f32(ka, kb, akk, 0, 0, 0);
                aqk = __builtin_amdgcn_mfma_f32_16x16x4f32(qa, kb, aqk, 0, 0, 0);
            }
        }
#pragma unroll
        for (int j = 0; j < 4; ++j) { const int ii = mi * 16 + q * 4 + j, jj = ni * 16 + r;
            const float dm = (ii >= jj) ? __expf(gcs[ii] - gcs[jj]) : 0.f;
            const float aij = (ii > jj) ? bes[ii] * akk[j] * dm : 0.f;
            As[ii * ALD + jj] = aij; AT[jj * ALD + ii] = aij;
            if (mi * 16 < nvalid) QK[ii * 64 + jj] = f2bf(aqk[j] * 0.08838834764831845f * dm); }
    }
    __syncthreads();
#pragma unroll 1
    for (int rp_ = 0; rp_ < REP_G_QG; ++rp_)
    {
        const float gl = gcs[63];
        const int nrow = (nvalid == 64) ? 64 : 16;
        for (int idx = tid; idx < nrow * 128; idx += 512) { const int t = idx >> 7, d = idx & 127;
            QG[idx] = f2bf(qs[t * LD + d] * 0.08838834764831845f * __expf(gcs[t])); }
        if (nvalid == 64) {
            for (int idx = tid; idx < 64 * 128; idx += 512) { const int d = idx >> 6, t = idx & 63;
                KDT[idx] = f2bf(ks[t * LD + d] * __expf(gl - gcs[t])); }
        } else {
            for (int idx = tid; idx < 16 * 128; idx += 512) { const int d = idx >> 4, t = idx & 15;
                KDT[d * 64 + t] = f2bf(ks[t * LD + d] * __expf(gl - gcs[t])); }
        }
        if (tid == 0) ((float*)(p.ws + WS_GL))[gdn_item_index(s, h, c)] = __expf(gl);
    }
    __syncthreads();
    for (int idx = tid; idx < 64 * 128; idx += 512) { const int t = idx >> 7, d = idx & 127; const float be = bes[t];
        vs[t * LD + d] *= be; ks[t * LD + d] *= be * __expf(gcs[t]); }
    __syncthreads();
    const int nblk = (nvalid + 15) >> 4;
#pragma unroll 1
    for (int blk = 0; blk < 4; ++blk) {
        if (blk >= nblk) continue;
        if (blk > 0) {
#pragma unroll
            for (int tl = 0; tl < 2; ++tl) {
                const int nt = 2 * w + tl; float* bb = (nt < 8 ? vs : ks) + (nt & 7) * 16 + r;
                f32x4 acc = (f32x4){0.f, 0.f, 0.f, 0.f};
                const float* ap = As + (blk * 16 + r) * ALD + q;
                for (int k0 = 0; k0 < blk * 16; k0 += 4)
                    acc = __builtin_amdgcn_mfma_f32_16x16x4f32(ap[k0], bb[(k0 + q) * LD], acc, 0, 0, 0);
#pragma unroll
                for (int j = 0; j < 4; ++j) bb[(blk * 16 + q * 4 + j) * LD] -= acc[j];
            }
            __syncthreads();
        }
        if (tid < 256) {
            const int col = tid & 127; const bool isu = tid < 128;
            float* buf = (isu ? vs : ks) + col;
            float acc[16];
#pragma unroll
            for (int e = 0; e < 16; ++e) acc[e] = buf[(blk * 16 + e) * LD];
#pragma unroll
            for (int e = 1; e < 16; ++e) {
#pragma unroll
                for (int f = 0; f < e; ++f) acc[e] -= As[(blk * 16 + e) * ALD + blk * 16 + f] * acc[f];
            }
#pragma unroll
            for (int e = 0; e < 16; ++e) { const int ii = blk * 16 + e; buf[ii * LD] = acc[e];
                if (isu) U[ii * 128 + col] = acc[e]; else Wd[ii * 128 + col] = f2bf(acc[e]); }
        }
        __syncthreads();
    }
    if (pfv == 0x7fc3u) gcs[0] = 1.f;
    asm volatile("s_waitcnt vmcnt(0)" ::: "memory");
    __syncthreads();
}

__device__ __forceinline__ void phase_gdn_chunk(const Params& p, int i, unsigned char* smem) {
    if (gridDim.x == 256) {
        for (int it = mk_lbid(); it < 64 * GDN_LATE; it += 256) {
            const int s = it / (8 * GDN_LATE), rem = it % (8 * GDN_LATE), h = rem / GDN_LATE, c = rem % GDN_LATE;
            const int nit = it + 256; int pf_row = -1, pf_h = 0;
            if (nit < 64 * GDN_LATE) { const int rem2 = nit % (8 * GDN_LATE); pf_row = (nit / (8 * GDN_LATE)) * 2048 + (rem2 % GDN_LATE) * 64; pf_h = rem2 / GDN_LATE; }
            gdn_chunk_item(p, i, s, h, c, pf_row, pf_h, smem);
        }
    } else
    for (int it = mk_lbid(); it < N_CH; it += gridDim.x) {
        int s, h, c;
        if (it < 2048) { s = it >> 8; h = (it >> 5) & 7; c = it & 31; } else { const int k = it - 2048; s = 8 + (k >> 3); h = k & 7; c = 0; }
        const int nit = it + gridDim.x; int pf_row = -1, pf_h = 0;
        if (nit < 2048) { pf_row = (nit >> 8) * 2048 + (nit & 31) * 64; pf_h = (nit >> 5) & 7; }
        gdn_chunk_item(p, i, s, h, c, pf_row, pf_h, smem);
    }
    const bf16_t* ZB = (const bf16_t*)(p.ws + WS_ZB);
    const int gt = mk_lbid() * 512 + mk_ltid(), GT = gridDim.x * 512;
    for (int idx = gt; idx < 136 * 3 * 3072; idx += GT) {
        const int s = idx / (3 * 3072), rem = idx % (3 * 3072), j = rem / 3072, zc = rem % 3072;
        int row0, L; seq_info(s, row0, L);
        const float v = bf2f(ZB[(size_t)(row0 + L - 3 + j) * GD_N + zc]);
        if (s < 8) p.out[O_PCONV + (((size_t)i * 8 + s) * 3 + j) * 3072 + zc] = v;
        else p.out[O_SCONV + (((size_t)i * 128 + (s - 8)) * 3 + j) * 3072 + zc] = v;
    }
}

__device__ __forceinline__ void gdn_scan_item(const Params& p, int i, int s, int h, unsigned* flags, unsigned tag, unsigned char* smem) {
    const int tid = mk_ltid(), lane = tid & 63, w = __builtin_amdgcn_readfirstlane(tid >> 6);
    const int r = lane & 15, q = lane >> 4;
    int row0, L; seq_info(s, row0, L);
    const int nch = (s < 8) ? 32 : 1;
    const bf16_t* ZB = (const bf16_t*)(p.ws + WS_ZB); bf16_t* OMIX = (bf16_t*)(p.ws + WS_OMIX);
    const float* GL = (const float*)(p.ws + WS_GL);
    const float* ng = p.in[31] + i * 128;
    constexpr int LD = 136, VLD = 72, ULD = 132;
    bf16_t* SB = (bf16_t*)smem;
    bf16_t* VN = (bf16_t*)(smem + 34816);
    float* red = (float*)(smem + 53248);
    bf16_t* WL = (bf16_t*)(smem + 53760);
    bf16_t* QGL = (bf16_t*)(smem + 71168);
    bf16_t* QKL = (bf16_t*)(smem + 88576);
    bf16_t* KDL = (bf16_t*)(smem + 97792);
    float* UL = (float*)(smem + 116224);
    f32x4 ST[8];
#pragma unroll
    for (int nt = 0; nt < 8; ++nt) ST[nt] = (f32x4){0.f, 0.f, 0.f, 0.f};
    if (s >= 8) {
        const float* S0 = p.in[6] + (((size_t)i * 128 + (s - 8)) * 8 + h) * 16384;
#pragma unroll
        for (int nt = 0; nt < 8; ++nt) ST[nt] = *(const f32x4*)(S0 + (size_t)(nt * 16 + r) * 128 + 16 * w + q * 4);
    }
    const int mt = w & 3, nh = w >> 2;
    u32x4 pw[2], pq[2], pk, pd[2]; f32x4 pu[4]; float pgl;
    const bool smp = (s >= 8);
#define GDN_PREFETCH(cc) do { const int item_ = gdn_item_index(s, h, (cc)); const unsigned char* rec_ = p.ws + WS_CH + (size_t)item_ * CH_BYTES; \
        const u32x4 z4_ = (u32x4){0u, 0u, 0u, 0u}; \
        _Pragma("unroll") for (int k_ = 0; k_ < 2; ++k_) { const int idx_ = tid + k_ * 512; \
            pw[k_] = (smp && (idx_ >> 4) >= 16) ? z4_ : *(const u32x4*)((const bf16_t*)(rec_ + CH_W) + (idx_ >> 4) * 128 + (idx_ & 15) * 8); \
            pq[k_] = (smp && (idx_ >> 4) >= 16) ? z4_ : *(const u32x4*)((const bf16_t*)(rec_ + CH_QG) + (idx_ >> 4) * 128 + (idx_ & 15) * 8); \
            pd[k_] = (smp && (idx_ & 7) >= 2) ? z4_ : *(const u32x4*)((const bf16_t*)(rec_ + CH_KDT) + (idx_ >> 3) * 64 + (idx_ & 7) * 8); } \
        pk = (smp && (tid >> 3) >= 16) ? z4_ : *(const u32x4*)((const bf16_t*)(rec_ + CH_QK) + (tid >> 3) * 64 + (tid & 7) * 8); \
        _Pragma("unroll") for (int k_ = 0; k_ < 4; ++k_) { const int idx_ = tid + k_ * 512; \
            pu[k_] = (smp && (idx_ >> 5) >= 16) ? (f32x4){0.f, 0.f, 0.f, 0.f} : *(const f32x4*)((const float*)(rec_ + CH_U) + (idx_ >> 5) * 128 + (idx_ & 31) * 4); } \
        pgl = GL[item_]; } while (0)
#define GDN_WAIT(cc) do { if (flags && (cc) >= GDN_LATE) { if (tid == 0) { unsigned* f_ = flags + (s * 8 + h) * 32 + (cc); \
        while (__hip_atomic_load(f_, __ATOMIC_RELAXED, __HIP_MEMORY_SCOPE_AGENT) != tag) __builtin_amdgcn_s_sleep(2); \
        __builtin_amdgcn_fence(__ATOMIC_ACQUIRE, "agent"); asm volatile("s_waitcnt vmcnt(0)" ::: "memory"); } \
        __syncthreads(); } } while (0)
    GDN_PREFETCH(0);
    for (int c = 0; c < nch; ++c) {
        const float glast = pgl;
        const int rb = row0 + c * 64; const int nvalid = (L - c * 64) < 64 ? (L - c * 64) : 64;
#pragma unroll
        for (int k = 0; k < 2; ++k) { const int idx = tid + k * 512;
            *(u32x4*)(WL + (idx >> 4) * LD + (idx & 15) * 8) = pw[k]; *(u32x4*)(QGL + (idx >> 4) * LD + (idx & 15) * 8) = pq[k];
            *(u32x4*)(KDL + (idx >> 3) * VLD + (idx & 7) * 8) = pd[k]; }
        *(u32x4*)(QKL + (tid >> 3) * VLD + (tid & 7) * 8) = pk;
#pragma unroll
        for (int k = 0; k < 4; ++k) { const int idx = tid + k * 512; *(f32x4*)(UL + (idx >> 5) * ULD + (idx & 31) * 4) = pu[k]; }
#pragma unroll
        for (int nt = 0; nt < 8; ++nt)
#pragma unroll
            for (int j = 0; j < 4; ++j) SB[(16 * w + q * 4 + j) * LD + nt * 16 + r] = f2bf(ST[nt][j]);
        __syncthreads();
        if (c + 1 < nch) { GDN_WAIT(c + 1); GDN_PREFETCH(c + 1); }
        bf16_t zgr[4][4];
#pragma unroll
        for (int j = 0; j < 4; ++j) { const int tk = mt * 16 + q * 4 + j; const size_t row = (size_t)(rb + (tk < nvalid ? tk : 0));
#pragma unroll
            for (int n4 = 0; n4 < 4; ++n4) zgr[j][n4] = ZB[row * GD_N + 3088 + h * 128 + (nh * 4 + n4) * 16 + r]; }
        f32x4 aws[4], aqg[4];
#pragma unroll
        for (int n4 = 0; n4 < 4; ++n4) { aws[n4] = (f32x4){0.f, 0.f, 0.f, 0.f}; aqg[n4] = aws[n4]; }
#pragma unroll
        for (int ks = 0; ks < 4; ++ks) {
            const bf16x8 fw = *(const bf16x8*)(WL + (mt * 16 + r) * LD + ks * 32 + q * 8);
            const bf16x8 fq = *(const bf16x8*)(QGL + (mt * 16 + r) * LD + ks * 32 + q * 8);
#pragma unroll
            for (int n4 = 0; n4 < 4; ++n4) {
                const bf16x8 bs = *(const bf16x8*)(SB + ((nh * 4 + n4) * 16 + r) * LD + ks * 32 + q * 8);
                aws[n4] = __builtin_amdgcn_mfma_f32_16x16x32_bf16(fw, bs, aws[n4], 0, 0, 0);
                aqg[n4] = __builtin_amdgcn_mfma_f32_16x16x32_bf16(fq, bs, aqg[n4], 0, 0, 0);
            }
        }
#pragma unroll
        for (int n4 = 0; n4 < 4; ++n4) {
            const int dv = (nh * 4 + n4) * 16 + r;
            float vn[4];
#pragma unroll
            for (int j = 0; j < 4; ++j) vn[j] = UL[(mt * 16 + q * 4 + j) * ULD + dv] - aws[n4][j];
            u32x2 o; o.x = pk2(vn[0], vn[1]); o.y = pk2(vn[2], vn[3]);
            *(u32x2*)(VN + dv * VLD + mt * 16 + q * 4) = o;
        }
        __syncthreads();
#pragma unroll
        for (int ks = 0; ks < 2; ++ks) {
            const bf16x8 fk = *(const bf16x8*)(QKL + (mt * 16 + r) * VLD + ks * 32 + q * 8);
#pragma unroll
            for (int n4 = 0; n4 < 4; ++n4) {
                const bf16x8 bv = *(const bf16x8*)(VN + ((nh * 4 + n4) * 16 + r) * VLD + ks * 32 + q * 8);
                aqg[n4] = __builtin_amdgcn_mfma_f32_16x16x32_bf16(fk, bv, aqg[n4], 0, 0, 0);
            }
        }
        {
            float ssq[4];
#pragma unroll
            for (int j = 0; j < 4; ++j) { float a = 0.f;
#pragma unroll
                for (int n4 = 0; n4 < 4; ++n4) a += aqg[n4][j] * aqg[n4][j];
                ssq[j] = row16_sum(a); }
            if (r == 0) {
#pragma unroll
                for (int j = 0; j < 4; ++j) red[(mt * 16 + q * 4 + j) * 2 + nh] = ssq[j];
            }
        }
#pragma unroll
        for (int nt = 0; nt < 8; ++nt) ST[nt] = ST[nt] * glast;
#pragma unroll
        for (int ks = 0; ks < 2; ++ks) {
            const bf16x8 av = *(const bf16x8*)(VN + (16 * w + r) * VLD + ks * 32 + q * 8);
#pragma unroll
            for (int nt = 0; nt < 8; ++nt) {
                const bf16x8 bk = *(const bf16x8*)(KDL + (nt * 16 + r) * VLD + ks * 32 + q * 8);
                ST[nt] = __builtin_amdgcn_mfma_f32_16x16x32_bf16(av, bk, ST[nt], 0, 0, 0);
            }
        }
        __syncthreads();
#pragma unroll
        for (int j = 0; j < 4; ++j) {
            const int tk = mt * 16 + q * 4 + j;
            if (tk < nvalid) {
                const float rs = rsqrtf((red[tk * 2] + red[tk * 2 + 1]) * (1.f / 128.f) + 1e-6f);
                const size_t row = (size_t)(rb + tk);
#pragma unroll
                for (int n4 = 0; n4 < 4; ++n4) { const int dv = (nh * 4 + n4) * 16 + r;
                    OMIX[row * 1024 + h * 128 + dv] = f2bf(aqg[n4][j] * rs * ng[dv] * silu(bf2f(zgr[j][n4]))); }
            }
        }
    }
#undef GDN_PREFETCH
#undef GDN_WAIT
    float* so = (s < 8) ? p.out + O_PGDN + (((size_t)i * 8 + s) * 8 + h) * 16384 : p.out + O_SGDN + (((size_t)i * 128 + (s - 8)) * 8 + h) * 16384;
#pragma unroll
    for (int nt = 0; nt < 8; ++nt) *(f32x4*)(so + (size_t)(nt * 16 + r) * 128 + 16 * w + q * 4) = ST[nt];
    __syncthreads();
}

__device__ __forceinline__ void phase_gdn_scan(const Params& p, int i, int l, unsigned char* smem) {
    const int bid = mk_lbid(), G = gridDim.x; const int wv = mk_ltid() >> 6;
    if (G == 256) {
        unsigned* flags = (unsigned*)(p.ws + WS_FLAGS); const unsigned tag = (unsigned)(i + 1);
        if (bid < 64) gdn_scan_item(p, i, bid >> 3, bid & 7, flags, tag, smem);
        else {
            for (int j = bid - 64; j < 64 * (32 - GDN_LATE); j += 192) {
                const int c = GDN_LATE + (j >> 6), sh = j & 63;
                gdn_chunk_item(p, i, sh >> 3, sh & 7, c, -1, 0, smem);
                if (mk_ltid() == 0) { __builtin_amdgcn_fence(__ATOMIC_RELEASE, "agent"); asm volatile("s_waitcnt vmcnt(0)" ::: "memory");
                    __hip_atomic_store(&flags[sh * 32 + c], tag, __ATOMIC_RELAXED, __HIP_MEMORY_SCOPE_AGENT); }
            }
            for (int it = bid - 64; it < 128 * 8; it += 192) { gdn_chunk_item(p, i, 8 + (it >> 3), it & 7, 0, -1, 0, smem); gdn_scan_item(p, i, 8 + (it >> 3), it & 7, nullptr, 0u, smem); }
            convert_ffn_ahead(p, l, (bid - 64) * 8 + wv, 192 * 8, smem);
        }
    } else {
        for (int it = bid; it < 136 * 8; it += G) { const int s = it >> 3, h = it & 7; gdn_scan_item(p, i, s, h, nullptr, 0u, smem); }
        convert_ffn_ahead(p, l, bid * 8 + wv, G * 8, smem);
    }
}

__global__ void __launch_bounds__(512, 2) mega(Params p) {
    extern __shared__ __attribute__((aligned(16))) unsigned char lds[];
    cg::grid_group grid = cg::this_grid();
    constexpr int NPH = 1 + 4 * 12;
    unsigned* bar = (unsigned*)(p.ws + WS_BAR);
    volatile unsigned* bst = (volatile unsigned*)(lds + LDS_BYTES - 16);
    if (mk_ltid() == 0) { bst[0] = 0u; bst[1] = 0u; }
    if (mk_lbid() == 0) for (int u = mk_ltid(); u < CTL_WORDS; u += 512) __hip_atomic_store(bar + u, 0u, __ATOMIC_RELAXED, __HIP_MEMORY_SCOPE_AGENT);
    __syncthreads();
#pragma unroll 1
    for (int ph = 0; ph < NPH; ++ph) {
        int l = (ph == 0) ? 0 : (ph - 1) / 12, k = (ph == 0) ? -1 : (ph - 1) % 12;
        asm volatile("" : "+s"(l), "+s"(k));
        const int i = l >> 1; const bool ab = (l & 1) == 0;
        if (k == 6 && !ab) continue;
        unsigned char* ws = p.ws; asm volatile("" : "+s"(ws));
        unsigned char* smem = (unsigned char*)lds;
        PG8_LAS unsigned char* ldsp = (PG8_LAS unsigned char*)lds;
        const int G = gridDim.x, cu = mk_lbid();
#ifndef REPMASK
#define REPMASK 0
#endif
#ifndef REPAB
#define REPAB 3
#endif
        const int nrep = (((REPMASK >> (k + 1)) & 1) && ((REPAB >> (l & 1)) & 1)) ? 2 : 1;
#pragma unroll 1
        for (int rep = 0; rep < nrep; ++rep) {
        if (rep) grid.sync();
        if (k == -1) phase_start(p, smem);
        else if (k == 0 || k == 9) {
            const int j = (k == 9);
            pg8::Gemm g{(const bf16_t*)(ws + WS_HB), (const bf16_t*)(ws + WS_WGU) + (size_t)j * 5632 * 1024, M, 5632, D};
            pg8::StaticOrder S; S.init(g.M, g.N, G, cu); EpiSwiglu E{(bf16_t*)(ws + WS_HID)};
            pg8::gemm_phase<EpiSwiglu, pg8::StaticOrder, true, true>(ldsp, g, S, E);
        } else if (k == 1 || k == 10 || k == 7) {
            const int j = (k == 10);
            pg8::Gemm g{(const bf16_t*)(ws + (k == 7 ? WS_OMIX : WS_HID)), k == 7 ? (const bf16_t*)(ws + WS_WOUT) : (const bf16_t*)(ws + WS_WD) + (size_t)j * 1024 * 2816, MP, D, k == 7 ? D : FF};
            pg8::StaticOrder S; S.init(g.M, g.N, G, cu); EpiResid E{(bf16_t*)(ws + WS_X), (const bf16_t*)(ws + WS_HB), k == 7 ? 1.0f : 0.5f};
            pg8::gemm_phase<EpiResid, pg8::StaticOrder, true, true>(ldsp, g, S, E);
            small_resid_gemm(g.A, g.Bt, g.K, E.X, E.H, E.scale, smem);
        } else if (k == 2 || k == 8 || k == 11) {
            phase_ln(p, l, k == 2 ? 0 : (k == 8 ? 1 : 2), (l == 3 && k == 11));
            if (k == 11 && l < 3) convert_items(p, l + 1, 4, mk_lbid() * 8 + (mk_ltid() >> 6), gridDim.x * 8, smem);
        } else if (k == 3) {
            pg8::Gemm g{(const bf16_t*)(ws + WS_HB), (const bf16_t*)(ws + WS_WIN), M, ab ? AB_N : GD_N, D};
            pg8::StaticOrder S; S.init(g.M, g.N, G, cu); EpiZ E{(bf16_t*)(ws + WS_ZB), g.N};
            pg8::gemm_phase<EpiZ, pg8::StaticOrder, true, true>(ldsp, g, S, E);
        } else if (k == 4) { if (ab) phase_ab_prep(p, i, smem); else phase_gdn_chunk(p, i, smem); }
        else if (k == 5) { if (ab) phase_ab_core(p, i, l, smem); else phase_gdn_scan(p, i, l, smem); }
        else if (k == 6) phase_ab_post(p, i);
        }
        if (ph + 1 < NPH) { if (ph == 0) { grid.sync(); if (mk_ltid() == 0) (void)xb_add(&bar[XB_XCNT(xb_xcc_id())], 1u); } else gbar(bar, bst); }
#ifdef REPSYNC
        if (ph > 0) { gbar(bar, bst); gbar(bar, bst); }
#endif
    }
}
}

extern "C" void kernel_launch(void* const* d_in, const int* in_sizes, int n_in, void* d_out, int out_size, void* d_ws, size_t ws_size, hipStream_t stream) {
    static int grid_blocks = 0;
    if (grid_blocks == 0) {
        if (n_in != 33 || ws_size < mk::WS_NEED) { fprintf(stderr, "kernel_launch: need 33 inputs and %zu bytes of workspace; got %d, %zu\n", (size_t)mk::WS_NEED, n_in, ws_size); grid_blocks = -1; return; }
        int dev = 0, cus = 0, per_cu = 0;
        hipGetDevice(&dev);
        hipDeviceGetAttribute(&cus, hipDeviceAttributeMultiprocessorCount, dev);
        if (hipFuncSetAttribute((const void*)mk::mega, hipFuncAttributeMaxDynamicSharedMemorySize, mk::LDS_BYTES) != hipSuccess) { fprintf(stderr, "kernel_launch: hipFuncSetAttribute failed\n"); grid_blocks = -1; return; }
        if (hipOccupancyMaxActiveBlocksPerMultiprocessor(&per_cu, (const void*)mk::mega, 512, mk::LDS_BYTES) != hipSuccess || per_cu < 1) { fprintf(stderr, "kernel_launch: occupancy query failed (%d)\n", per_cu); (void)hipGetLastError(); per_cu = 1; }
        grid_blocks = cus * 1;
        fprintf(stderr, "kernel_launch: grid %d (cus %d, per_cu %d)\n", grid_blocks, cus, per_cu);
    }
    if (grid_blocks < 0) return;
    mk::Params prm{};
    for (int k = 0; k < 33; ++k) prm.in[k] = (const float*)d_in[k];
    prm.out = (float*)d_out; prm.ws = (unsigned char*)d_ws;
    void* args[] = {&prm};
    hipError_t e = hipLaunchCooperativeKernel((const void*)mk::mega, dim3(grid_blocks), dim3(512), args, mk::LDS_BYTES, stream);
    if (e != hipSuccess) fprintf(stderr, "cooperative launch failed: %s (grid %d)\n", hipGetErrorString(e), grid_blocks);
}
```

```cpp
#include <hip/hip_runtime.h>
#include <hip/hip_cooperative_groups.h>
#include <cstdio>
#include <cstdint>
namespace cg = cooperative_groups;
__device__ __forceinline__ int mk_ltid() { int t = threadIdx.x; asm volatile("" : "+v"(t)); return t; }
__device__ __forceinline__ int mk_lbid() { int t = blockIdx.x; asm volatile("" : "+s"(t)); return t; }
namespace pg8 {
#define PG8_LAS __attribute__((address_space(3)))
typedef unsigned short bf16_t;
typedef short bf16x8 __attribute__((ext_vector_type(8)));
typedef float f32x4 __attribute__((ext_vector_type(4)));
typedef unsigned u32x4 __attribute__((ext_vector_type(4)));
constexpr int BM = 256, BK = 64, HALF = 128, HTB = HALF * BK * 2  , STAGE_BYTES = 8 * HTB, NXCD = 8, WGM = 8;

__host__ __device__ __forceinline__ int lds_byte(int r, int c) { const int st = (r >> 4) * 2 + (c >> 5), rr = r & 15, cc = c & 31, ob = rr * 64 + cc * 2; return st * 1024 + (ob ^ (((ob >> 9) & 1) << 5)); }
__host__ __device__ __forceinline__ void stage_rc(int b, int& R, int& C) { const int st = b / 1024, sb = b % 1024, swz = sb ^ (((sb >> 9) & 1) << 5); R = (st >> 1) * 16 + swz / 64; C = (st & 1) * 32 + (swz % 64) / 2; }
__host__ __device__ __forceinline__ int perm32(int rho) { const int n = rho >> 4, i = rho & 15; return 8 * (i >> 2) + 4 * n + (i & 3); }

struct Unit { int pm, pn; };
struct Gemm { const bf16_t* A; const bf16_t* Bt; int M, N, K; };

struct StaticOrder {
    int nM, nN, nwg, G, c;
    __host__ __device__ void init(int M, int N, int G_, int c_) { nM = M / BM; nN = N / BM; nwg = nM * nN; G = G_; c = c_; }
    __host__ __device__ bool next(int i, Unit& u) const {
        const long L = (long)i * G + c; if (L >= nwg) return false;
        int wgid = (int)L; { const int q = nwg / NXCD, r = nwg % NXCD, xcd = wgid % NXCD, off = wgid / NXCD; wgid = (xcd < r ? xcd * (q + 1) : r * (q + 1) + (xcd - r) * q) + off; }
        const int nig = WGM * nN, gid = wgid / nig, fm = gid * WGM, gsz = (nM - fm) < WGM ? (nM - fm) : WGM;
        u.pm = fm + ((wgid % nig) % gsz); u.pn = (wgid % nig) / gsz; return true;
    }
    __device__ __forceinline__ void a_ready(const Unit&) const {}
    __device__ __forceinline__ void done(const Unit&) const {}
};

template <class Epi, class Sched, bool ALIGN_EPI = false, bool SP2 = false>
__device__ __forceinline__ void gemm_phase(PG8_LAS unsigned char* lds, const Gemm g, const Sched& S, const Epi& E) {
    const int tid = mk_ltid(), wid = __builtin_amdgcn_readfirstlane(tid >> 6), lane = tid & 63, wr = wid >> 2, wc = wid & 3, fr = lane & 15, fq = lane >> 4;
    const int K = g.K, nt = K / BK;
    unsigned voffA[2], voffB[2];
#pragma unroll
    for (int i = 0; i < 2; ++i) { int R, C; stage_rc(tid * 16 + i * 8192, R, C); const int Rb = Epi::PERM ? ((R & ~31) + perm32(R & 31)) : R;
        voffA[i] = (unsigned)(R * K + C) * 2u; voffB[i] = (unsigned)(Rb * K + C) * 2u; }
    const size_t kstep = (size_t)(BK * 2);
    const size_t hstep = (size_t)HALF * K * 2;
    const size_t tstep = 2 * hstep;
    const unsigned ldsw = (unsigned)wid * 1024u;
    const int aoff = lds_byte(wr * 64 + fr, fq * 8), boff = lds_byte(wc * 32 + fr, fq * 8);
#define PG8_SA(b, h) (((b) * 2 + (h)) * HTB)
#define PG8_SB(b, h) ((4 + (b) * 2 + (h)) * HTB)
#define PG8_STAGE(bufoff, gbase, voff) do { _Pragma("unroll") for (int _i = 0; _i < 2; ++_i) \
        __builtin_amdgcn_global_load_lds((const unsigned*)((const char*)(gbase) + (voff)[_i]), (PG8_LAS unsigned*)(lds + (bufoff) + ldsw + _i * 8192), 16, 0, 0); } while (0)
#define PG8_LDA(dst, b, h) do { _Pragma("unroll") for (int m = 0; m < 4; ++m) _Pragma("unroll") for (int k = 0; k < 2; ++k) dst[m][k] = *(const PG8_LAS bf16x8*)(lds + PG8_SA(b, h) + aoff + m * 2048 + k * 1024); } while (0)
#define PG8_LDB(dst, b, h) do { _Pragma("unroll") for (int n = 0; n < 2; ++n) _Pragma("unroll") for (int k = 0; k < 2; ++k) dst[n][k] = *(const PG8_LAS bf16x8*)(lds + PG8_SB(b, h) + boff + n * 2048 + k * 1024); } while (0)
#define PG8_MMA(ai, bj, At, Bt) do { __builtin_amdgcn_s_setprio(1); _Pragma("unroll") for (int m = 0; m < 4; ++m) _Pragma("unroll") for (int n = 0; n < 2; ++n) _Pragma("unroll") for (int k = 0; k < 2; ++k) \
        acc[ai][bj][m][n] = __builtin_amdgcn_mfma_f32_16x16x32_bf16(Bt[n][k], At[m][k], acc[ai][bj][m][n], 0, 0, 0); __builtin_amdgcn_s_setprio(0); } while (0)
#define PG8_WAIT_V(n) asm volatile("s_waitcnt vmcnt(" #n ")" ::: "memory")
#define PG8_WAIT_L(n) asm volatile("s_waitcnt lgkmcnt(" #n ")" ::: "memory")
#define PG8_BAR __builtin_amdgcn_s_barrier()
#define PG8_SCHED __builtin_amdgcn_sched_barrier(0)
    Unit cur, nxt; int ui = 0;
    if (!S.next(0, cur)) return;
    f32x4 acc[2][2][4][2];
#pragma unroll
    for (int a = 0; a < 2; ++a)
#pragma unroll
        for (int b = 0; b < 2; ++b)
#pragma unroll
            for (int m = 0; m < 4; ++m)
#pragma unroll
                for (int n = 0; n < 2; ++n) acc[a][b][m][n] = (f32x4){0.f, 0.f, 0.f, 0.f};
    bf16x8 At[4][2], B0[2][2], B1[2][2];
    const char* cA = (const char*)g.A + (size_t)cur.pm * tstep; const char* cB = (const char*)g.Bt + (size_t)cur.pn * tstep;
    S.a_ready(cur);
    if constexpr (SP2) {
        PG8_STAGE(PG8_SB(0, 0), cB, voffB); PG8_STAGE(PG8_SB(0, 1), cB + hstep, voffB); PG8_STAGE(PG8_SA(0, 0), cA, voffA); PG8_STAGE(PG8_SA(0, 1), cA + hstep, voffA);
        if (wr == 1) PG8_BAR;
        PG8_WAIT_V(2); PG8_BAR;
        PG8_STAGE(PG8_SB(1, 0), cB + kstep, voffB); PG8_STAGE(PG8_SA(1, 0), cA + kstep, voffA); PG8_STAGE(PG8_SB(1, 1), cB + hstep + kstep, voffB);
        PG8_WAIT_V(6); PG8_BAR;
    } else {
        PG8_STAGE(PG8_SB(0, 0), cB, voffB); PG8_STAGE(PG8_SA(0, 0), cA, voffA); PG8_STAGE(PG8_SB(0, 1), cB + hstep, voffB); PG8_STAGE(PG8_SA(0, 1), cA + hstep, voffA);
        if (wr == 1) PG8_BAR;
        PG8_WAIT_V(4); PG8_BAR;
        PG8_STAGE(PG8_SB(1, 0), cB + kstep, voffB); PG8_STAGE(PG8_SA(1, 0), cA + kstep, voffA); PG8_STAGE(PG8_SB(1, 1), cB + hstep + kstep, voffB);
        PG8_WAIT_V(6); PG8_BAR;
    }
    for (;;) {
        const bool has_next = S.next(ui + 1, nxt);
        const char* nA = has_next ? (const char*)g.A + (size_t)nxt.pm * tstep : cA; const char* nB = has_next ? (const char*)g.Bt + (size_t)nxt.pn * tstep : cB;
        for (int t = 0; t < nt; t += 2) {
            const bool last = (t == nt - 2);
            const char* a1 = cA + (size_t)(t + 1) * kstep;
            const char* a2 = last ? nA : cA + (size_t)(t + 2) * kstep; const char* b2 = last ? nB : cB + (size_t)(t + 2) * kstep;
            const char* a3 = a2 + kstep; const char* b3 = b2 + kstep;
            if (last && has_next) S.a_ready(nxt);
            if constexpr (SP2) {
            PG8_LDB(B0, 0, 0); PG8_LDB(B1, 0, 1); PG8_SCHED; PG8_LDA(At, 0, 0); PG8_STAGE(PG8_SA(1, 1), a1 + hstep, voffA);
            PG8_WAIT_V(8); PG8_WAIT_L(0); PG8_BAR; PG8_MMA(0, 0, At, B0); PG8_MMA(0, 1, At, B1); PG8_BAR; PG8_SCHED;
            PG8_LDA(At, 0, 1); PG8_STAGE(PG8_SB(0, 0), b2, voffB); PG8_STAGE(PG8_SB(0, 1), b2 + hstep, voffB); PG8_STAGE(PG8_SA(0, 0), a2, voffA);
            PG8_WAIT_V(8); PG8_WAIT_L(0); PG8_BAR; PG8_MMA(1, 0, At, B0); PG8_MMA(1, 1, At, B1); PG8_BAR; PG8_SCHED;
            PG8_LDB(B0, 1, 0); PG8_LDB(B1, 1, 1); PG8_SCHED; PG8_LDA(At, 1, 0); PG8_STAGE(PG8_SA(0, 1), a2 + hstep, voffA);
            PG8_WAIT_V(8); PG8_WAIT_L(0); PG8_BAR; PG8_MMA(0, 0, At, B0); PG8_MMA(0, 1, At, B1); PG8_BAR; PG8_SCHED;
            PG8_LDA(At, 1, 1); PG8_STAGE(PG8_SB(1, 0), b3, voffB); PG8_STAGE(PG8_SB(1, 1), b3 + hstep, voffB); PG8_STAGE(PG8_SA(1, 0), a3, voffA);
            PG8_WAIT_V(8); PG8_WAIT_L(0); PG8_BAR; PG8_MMA(1, 0, At, B0); PG8_MMA(1, 1, At, B1); PG8_BAR; PG8_SCHED;
            } else {
            PG8_LDB(B0, 0, 0); PG8_SCHED; PG8_LDA(At, 0, 0); PG8_STAGE(PG8_SA(1, 1), a1 + hstep, voffA);
            PG8_WAIT_L(8); PG8_BAR; PG8_WAIT_L(0); PG8_MMA(0, 0, At, B0); PG8_BAR; PG8_SCHED;
            PG8_LDB(B1, 0, 1); PG8_STAGE(PG8_SB(0, 0), b2, voffB);
            PG8_BAR; PG8_WAIT_L(0); PG8_MMA(0, 1, At, B1); PG8_BAR;
            PG8_LDA(At, 0, 1); PG8_STAGE(PG8_SA(0, 0), a2, voffA);
            PG8_BAR; PG8_WAIT_L(0); PG8_MMA(1, 0, At, B0); PG8_BAR; PG8_SCHED;
            PG8_STAGE(PG8_SB(0, 1), b2 + hstep, voffB);
            PG8_WAIT_V(6); PG8_BAR; PG8_MMA(1, 1, At, B1); PG8_BAR;
            PG8_LDB(B0, 1, 0); PG8_SCHED; PG8_LDA(At, 1, 0); PG8_STAGE(PG8_SA(0, 1), a2 + hstep, voffA);
            PG8_WAIT_L(8); PG8_BAR; PG8_WAIT_L(0); PG8_MMA(0, 0, At, B0); PG8_BAR; PG8_SCHED;
            PG8_LDB(B1, 1, 1); PG8_STAGE(PG8_SB(1, 0), b3, voffB);
            PG8_BAR; PG8_WAIT_L(0); PG8_MMA(0, 1, At, B1); PG8_BAR;
            PG8_LDA(At, 1, 1); PG8_STAGE(PG8_SA(1, 0), a3, voffA);
            PG8_BAR; PG8_WAIT_L(0); PG8_MMA(1, 0, At, B0); PG8_BAR; PG8_SCHED;
            PG8_STAGE(PG8_SB(1, 1), b3 + hstep, voffB);
            PG8_WAIT_V(6); PG8_BAR; PG8_MMA(1, 1, At, B1); PG8_BAR;
            }
        }
        if constexpr (ALIGN_EPI) { if (wr == 0) PG8_BAR; }
        if constexpr (!Epi::AFTER_DRAIN) { E(acc, cur, wr, wc, fr, fq); S.done(cur); }
        if (!has_next) break;
#pragma unroll
        for (int a = 0; a < 2; ++a)
#pragma unroll
            for (int b = 0; b < 2; ++b)
#pragma unroll
                for (int m = 0; m < 4; ++m)
#pragma unroll
                    for (int n = 0; n < 2; ++n) acc[a][b][m][n] = (f32x4){0.f, 0.f, 0.f, 0.f};
        cur = nxt; cA = nA; cB = nB; ++ui;
        if constexpr (ALIGN_EPI) { if (wr == 1) PG8_BAR; }
    }
    PG8_WAIT_V(0);
    if constexpr (!ALIGN_EPI) { if (wr == 0) PG8_BAR; }
    PG8_BAR;
    if constexpr (Epi::AFTER_DRAIN) { E.fused(acc, cur, wr, wc, fr, fq, lds, wid, lane); S.done(cur); }
#undef PG8_SA
#undef PG8_SB
#undef PG8_STAGE
#undef PG8_LDA
#undef PG8_LDB
#undef PG8_MMA
#undef PG8_WAIT_V
#undef PG8_WAIT_L
#undef PG8_BAR
#undef PG8_SCHED
}
}

namespace mk {
using pg8::bf16_t; using pg8::bf16x8; using pg8::f32x4; using pg8::Unit;
typedef unsigned u32x4 __attribute__((ext_vector_type(4)));
typedef unsigned u32x2 __attribute__((ext_vector_type(2)));

constexpr int M = 16896, MP = 16384, D = 1024, FF = 2816;
constexpr int AB_N = 3840, GD_N = 4352, GD_NREAL = 4112;
constexpr float ALPHA = 1.6817928305074290f;
constexpr int LDS_BYTES = 163840;

constexpr size_t O_PSHIFT = 17301504, O_PRWKV = 17330176, O_PRET = 17854464, O_PCONV = 18903040, O_PGDN = 19050496;
constexpr size_t O_SSHIFT = 21147648, O_SRWKV = 21606400, O_SRET = 29995008, O_SCONV = 46772224, O_SGDN = 49131520;

constexpr size_t WS_WGU = 0;
constexpr size_t WS_WD = WS_WGU + 2ull * 5632 * 1024 * 2;
constexpr size_t WS_WIN = WS_WD + 2ull * 1024 * 2816 * 2;
constexpr size_t WS_WOUT = WS_WIN + 4352ull * 1024 * 2;
constexpr size_t WS_W2T = WS_WOUT + 1024ull * 1024 * 2;
constexpr size_t WS_A2T = WS_W2T + 65536;
constexpr size_t WS_G2T = WS_A2T + 65536;
constexpr size_t WS_X = WS_G2T + 131072;
constexpr size_t WS_HB = WS_X + (size_t)M * 1024 * 4;
constexpr size_t WS_S = WS_HB + (size_t)M * 1024 * 2;
constexpr size_t WS_HID = WS_S;
constexpr size_t WS_OMIX = WS_S;
constexpr size_t WS_ZB = WS_OMIX + (size_t)M * 1024 * 2;
constexpr size_t WS_OPS = WS_ZB + (size_t)M * AB_N * 2;
constexpr size_t WS_GATE = WS_OPS + (size_t)M * 3072 * 4;
constexpr size_t WS_ORAW = WS_GATE + (size_t)M * 512 * 4;
constexpr size_t WS_BONUS = WS_ORAW + (size_t)M * 512 * 4;
constexpr size_t WS_RQ = WS_BONUS + (size_t)M * 8 * 4;
constexpr size_t WS_RK = WS_RQ + (size_t)M * 512 * 2;
constexpr size_t WS_AB_END = WS_RK + (size_t)M * 512 * 2;
constexpr size_t WS_CH = WS_ZB + (size_t)M * GD_N * 2;
constexpr size_t CH_U = 0, CH_W = 32768, CH_QG = 49152, CH_QK = 65536, CH_KDT = 73728, CH_BYTES = 90112;
constexpr int N_CH = 2048 + 1024;
constexpr size_t WS_GL = WS_CH + (size_t)N_CH * CH_BYTES;
constexpr size_t WS_GD_END = WS_GL + N_CH * 4;
constexpr size_t WS_BAR = ((WS_AB_END > WS_GD_END ? WS_AB_END : WS_GD_END) + 255) / 256 * 256;
constexpr size_t WS_FLAGS = WS_BAR + 16384;
constexpr int CTL_WORDS = (16384 + 8192) / 4;
constexpr size_t WS_NEED = WS_FLAGS + 8192;
constexpr int GDN_LATE = 28;

struct Params { const float* in[33]; float* out; unsigned char* ws; };

__device__ __forceinline__ float bf2f(bf16_t h) { return __uint_as_float(((unsigned)h) << 16); }
__device__ __forceinline__ unsigned pk2(float lo, float hi) { unsigned r; asm volatile("v_cvt_pk_bf16_f32 %0, %1, %2" : "=v"(r) : "v"(lo), "v"(hi)); return r; }
__device__ __forceinline__ bf16_t f2bf(float x) { return (bf16_t)(pk2(x, 0.f) & 0xffffu); }
__device__ __forceinline__ float sigm(float x) { return __builtin_amdgcn_rcpf(1.f + __expf(-x)); }
__device__ __forceinline__ float silu(float x) { return x * __builtin_amdgcn_rcpf(1.f + __expf(-x)); }
__device__ __forceinline__ float dppf(float v, const int ctrl_sel) {
    int x = __builtin_bit_cast(int, v), y;
    if (ctrl_sel == 0) y = __builtin_amdgcn_update_dpp(0, x, 0xB1, 0xF, 0xF, true);
    else if (ctrl_sel == 1) y = __builtin_amdgcn_update_dpp(0, x, 0x4E, 0xF, 0xF, true);
    else if (ctrl_sel == 2) y = __builtin_amdgcn_update_dpp(0, x, 0x141, 0xF, 0xF, true);
    else y = __builtin_amdgcn_update_dpp(0, x, 0x140, 0xF, 0xF, true);
    return __builtin_bit_cast(float, y);
}
__device__ __forceinline__ float row16_sum(float v) { v += dppf(v, 0); v += dppf(v, 1); v += dppf(v, 2); v += dppf(v, 3); return v; }
__device__ __forceinline__ float wave_sum(float v) {
#pragma unroll
    for (int o = 1; o < 64; o <<= 1) v += __shfl_xor(v, o);
    return v;
}
#define XB_XCNT(j)  (256  + 64 * (j))
#define XB_XSUB(j)  (1280 + 64 * (j))
#define XB_XGEN(j)  (2304 + 64 * (j))
#define XB_TOP      3328
#define XB_TOPGEN   3392
#define XCD_BAR_WORDS 3456
__device__ __forceinline__ unsigned xb_ld(unsigned* p)              { return __hip_atomic_load(p, __ATOMIC_RELAXED, __HIP_MEMORY_SCOPE_AGENT); }
__device__ __forceinline__ unsigned xb_add(unsigned* p, unsigned v) { return __hip_atomic_fetch_add(p, v, __ATOMIC_RELAXED, __HIP_MEMORY_SCOPE_AGENT); }
__device__ __forceinline__ unsigned xb_xcc_id() { return (unsigned)__builtin_amdgcn_s_getreg((3 << 11) | 20) & 0xFu; }
__device__ __forceinline__ void gbar(unsigned* bar, volatile unsigned* st) {
    asm volatile("s_waitcnt vmcnt(0)" ::: "memory");
    __syncthreads();
    if (mk_ltid() == 0) {
        __builtin_amdgcn_s_waitcnt(0);
        const unsigned x = xb_xcc_id();
        unsigned nloc = st[0], nx = st[1];
        if (nloc == 0u) {
            const unsigned G = gridDim.x;
            unsigned sum, cnt, mine;
            for (;;) {
                sum = 0u; cnt = 0u; mine = 0u;
#pragma unroll
                for (unsigned j = 0; j < 16; ++j) { const unsigned c = xb_ld(&bar[XB_XCNT(j)]); sum += c; cnt += (c > 0u) ? 1u : 0u; mine = (j == x) ? c : mine; }
                if (sum == G) break;
                __builtin_amdgcn_s_sleep(1);
            }
            nloc = mine > 0u ? mine : 1u; nx = cnt > 0u ? cnt : 1u; st[0] = nloc; st[1] = nx;
        }
        const unsigned old = xb_add(&bar[XB_XSUB(x)], 1u);
        const unsigned gen = old / nloc;
        if (old + 1u == (gen + 1u) * nloc) {
            __builtin_amdgcn_fence(__ATOMIC_RELEASE, "agent");
            asm volatile("s_waitcnt vmcnt(0)" ::: "memory");
            const unsigned og = xb_add(&bar[XB_TOP], 1u);
            const unsigned tg = og / nx;
            if (og + 1u == (tg + 1u) * nx) xb_add(&bar[XB_TOPGEN], 1u);
            else while (xb_ld(&bar[XB_TOPGEN]) == tg) __builtin_amdgcn_s_sleep(1);
            __builtin_amdgcn_fence(__ATOMIC_ACQUIRE, "agent");
            xb_add(&bar[XB_XGEN(x)], 1u);
            asm volatile("s_waitcnt vmcnt(0)" ::: "memory");
        } else {
            while (xb_ld(&bar[XB_XGEN(x)]) == gen) __builtin_amdgcn_s_sleep(1);
            __builtin_amdgcn_fence(__ATOMIC_ACQUIRE, "agent");
            asm volatile("s_waitcnt vmcnt(0)" ::: "memory");
        }
    }
    __syncthreads();
}
__device__ __forceinline__ void seq_info(int s, int& row0, int& L) { if (s < 8) { row0 = s * 2048; L = 2048; } else { row0 = MP + (s - 8) * 4; L = 4; } }

struct EpiSwiglu { static constexpr bool PERM = true, AFTER_DRAIN = false; bf16_t* O;
    __device__ __forceinline__ void operator()(const f32x4 (&acc)[2][2][4][2], const Unit& u, int wr, int wc, int fr, int fq) const {
        const int row0 = u.pm * 256 + wr * 64 + fr, col0 = u.pn * 128 + wc * 32 + 8 * fq;
#pragma unroll
        for (int ai = 0; ai < 2; ++ai)
#pragma unroll
            for (int m = 0; m < 4; ++m) {
                bf16_t* rp = O + (size_t)(row0 + ai * 128 + m * 16) * FF + col0;
                const f32x4 g0 = acc[ai][0][m][0], g1 = acc[ai][0][m][1], u0 = acc[ai][1][m][0], u1 = acc[ai][1][m][1];
                u32x4 w;
                w.x = pk2(silu(g0[0]) * u0[0], silu(g0[1]) * u0[1]); w.y = pk2(silu(g0[2]) * u0[2], silu(g0[3]) * u0[3]);
                w.z = pk2(silu(g1[0]) * u1[0], silu(g1[1]) * u1[1]); w.w = pk2(silu(g1[2]) * u1[2], silu(g1[3]) * u1[3]);
                *(u32x4*)rp = w;
            }
    }
};
struct EpiResid { static constexpr bool PERM = true, AFTER_DRAIN = false; bf16_t* X; const bf16_t* H; float scale;
    __device__ __forceinline__ void operator()(const f32x4 (&acc)[2][2][4][2], const Unit& u, int wr, int wc, int fr, int fq) const {
        const int row0 = u.pm * 256 + wr * 64 + fr, col0 = u.pn * 256 + wc * 32 + 8 * fq;
#pragma unroll
        for (int ai = 0; ai < 2; ++ai)
#pragma unroll
            for (int m = 0; m < 4; ++m)
#pragma unroll
                for (int bj = 0; bj < 2; ++bj)
#pragma unroll
                    for (int n = 0; n < 2; ++n) {
                        const size_t off = (size_t)(row0 + ai * 128 + m * 16) * D + col0 + bj * 128 + 4 * n;
                        const u32x2 hu = *(const u32x2*)(H + off);
                        f32x4 x; x[0] = __uint_as_float(hu.x << 16); x[1] = __uint_as_float(hu.x & 0xffff0000u); x[2] = __uint_as_float(hu.y << 16); x[3] = __uint_as_float(hu.y & 0xffff0000u);
                        x = x * ALPHA + acc[ai][bj][m][n] * scale; u32x2 xo; xo.x = pk2(x[0], x[1]); xo.y = pk2(x[2], x[3]); *(u32x2*)(X + off) = xo;
                    }
    }
};
struct EpiZ { static constexpr bool PERM = true, AFTER_DRAIN = false; bf16_t* Z; int ld;
    __device__ __forceinline__ void operator()(const f32x4 (&acc)[2][2][4][2], const Unit& u, int wr, int wc, int fr, int fq) const {
        const int row0 = u.pm * 256 + wr * 64 + fr, col0 = u.pn * 256 + wc * 32 + 8 * fq;
#pragma unroll
        for (int ai = 0; ai < 2; ++ai)
#pragma unroll
            for (int m = 0; m < 4; ++m)
#pragma unroll
                for (int bj = 0; bj < 2; ++bj) {
                    const f32x4 a = acc[ai][bj][m][0], b = acc[ai][bj][m][1];
                    u32x4 w; w.x = pk2(a[0], a[1]); w.y = pk2(a[2], a[3]); w.z = pk2(b[0], b[1]); w.w = pk2(b[2], b[3]);
                    *(u32x4*)(Z + (size_t)(row0 + ai * 128 + m * 16) * ld + col0 + bj * 128) = w;
                }
    }
};

__device__ __forceinline__ void tr_item(const float* __restrict__ W, int K, int N, bf16_t* WT, int dst_row0, int k0, int n0, float* scr, int lane) {
#pragma unroll
    for (int i = 0; i < 32; ++i) { const int kk = 2 * i + (lane >> 5); const int col = n0 + (lane & 31);
        scr[kk * 33 + (lane & 31)] = (col < N) ? W[(size_t)(k0 + kk) * N + col] : 0.f; }
    asm volatile("s_waitcnt lgkmcnt(0)" ::: "memory");
    const int c = lane & 7;
#pragma unroll
    for (int j = 0; j < 4; ++j) { const int n = (lane >> 3) + 8 * j; const float* s = scr + (8 * c) * 33 + n;
        u32x4 o; o.x = pk2(s[0], s[33]); o.y = pk2(s[2 * 33], s[3 * 33]); o.z = pk2(s[4 * 33], s[5 * 33]); o.w = pk2(s[6 * 33], s[7 * 33]);
        *(u32x4*)(WT + (size_t)(dst_row0 + n) * K + k0 + 8 * c) = o; }
    asm volatile("s_waitcnt lgkmcnt(0)" ::: "memory");
}

__device__ __forceinline__ void convert_items(const Params& p, int l, int parts, int gw, int NGW, unsigned char* smem) {
    const int lane = mk_ltid() & 63, wave = mk_ltid() >> 6;
    float* scr = (float*)smem + wave * (64 * 33);
    unsigned char* ws = p.ws;
    const int i = l >> 1; const bool ab = (l & 1) == 0;
    constexpr int I_G = 16 * 88, I_O = 16 * 32;
    const int I_IN = ab ? 16 * 120 : 16 * 136;
    const int I_LORA = ab ? (16 + 16 + 32) : 0;
    const int n0 = (parts & 1) ? 3 * I_G : 0, n1 = (parts & 2) ? 3 * I_G : 0, n2 = (parts & 4) ? (I_IN + I_O + I_LORA) : 0;
    const int total = n0 + n1 + n2;
    for (int it = gw; it < total; it += NGW) {
        int r = it;
        if (r < n0 + n1) {
            const int j = (r < n0) ? 0 : 1; r -= (j ? n0 : 0);
            const int kind = r / I_G; r -= kind * I_G;
            const size_t lw = (size_t)(l * 2 + j);
            if (kind < 2) { const float* W = p.in[kind == 0 ? 9 : 10] + lw * (size_t)D * FF;
                const int kb = r / 88, nb = r % 88, nn0 = nb * 32;
                tr_item(W, D, FF, (bf16_t*)(ws + WS_WGU) + (size_t)j * 5632 * 1024, (nn0 >> 7) * 256 + (nn0 & 127) + kind * 128, kb * 64, nn0, scr, lane);
            } else { const float* W = p.in[11] + lw * (size_t)FF * D;
                const int kb = r / 32, nb = r % 32;
                tr_item(W, FF, D, (bf16_t*)(ws + WS_WD) + (size_t)j * 1024 * 2816, nb * 32, kb * 64, nb * 32, scr, lane);
            }
            continue;
        }
        r -= n0 + n1;
        if (r < I_IN) {
            if (ab) { const int kb = r / 120, nb = r % 120; tr_item(p.in[12] + (size_t)i * D * AB_N, D, AB_N, (bf16_t*)(ws + WS_WIN), nb * 32, kb * 64, nb * 32, scr, lane); }
            else { const int kb = r / 136, nb = r % 136; tr_item(p.in[27] + (size_t)i * D * GD_NREAL, D, GD_NREAL, (bf16_t*)(ws + WS_WIN), nb * 32, kb * 64, nb * 32, scr, lane); }
            continue;
        }
        r -= I_IN;
        if (r < I_O) { const int kb = r / 32, nb = r % 32;
            tr_item(p.in[ab ? 13 : 32] + (size_t)i * D * D, D, D, (bf16_t*)(ws + WS_WOUT), nb * 32, kb * 64, nb * 32, scr, lane); continue; }
        r -= I_O;
        if (r < 16) { tr_item(p.in[16] + (size_t)i * 64 * 512, 64, 512, (bf16_t*)(ws + WS_W2T), r * 32, 0, r * 32, scr, lane); continue; }
        r -= 16;
        if (r < 16) { tr_item(p.in[18] + (size_t)i * 64 * 512, 64, 512, (bf16_t*)(ws + WS_A2T), r * 32, 0, r * 32, scr, lane); continue; }
        r -= 16;
        { const int kb = r / 16, nb = r % 16; tr_item(p.in[19] + (size_t)i * 128 * 512, 128, 512, (bf16_t*)(ws + WS_G2T), nb * 32, kb * 64, nb * 32, scr, lane); }
    }
}
__device__ __forceinline__ void convert_ffn_ahead(const Params& p, int l, int gw, int NGW, unsigned char* smem) {
    __syncthreads();
    convert_items(p, l, 2, gw, NGW, smem);
    if (l < 3) convert_items(p, l + 1, 1, gw, NGW, smem);
    __syncthreads();
}

__device__ __forceinline__ void phase_start(const Params& p, unsigned char* smem) {
    const int tid = mk_ltid(), lane = tid & 63, wave = tid >> 6;
    const int gw = mk_lbid() * 8 + wave, NGW = gridDim.x * 8;
    convert_items(p, 0, 5, gw, NGW, smem);
    bf16_t* HB = (bf16_t*)(p.ws + WS_HB);
    for (int m = gw; m < M; m += NGW) {
        const float* src = (m < MP) ? p.in[0] + (size_t)m * D : p.in[1] + (size_t)(m - MP) * D;
#pragma unroll
        for (int j = 0; j < 4; ++j) { const int c = (lane + 64 * j) * 4; const f32x4 v = *(const f32x4*)(src + c);
            u32x2 o; o.x = pk2(v[0], v[1]); o.y = pk2(v[2], v[3]); *(u32x2*)(HB + (size_t)m * D + c) = o; }
    }
}

__device__ __forceinline__ void phase_ln(const Params& p, int l, int k, bool final_out) {
    const int tid = mk_ltid(), lane = tid & 63, wave = tid >> 6;
    const int gw = mk_lbid() * 8 + wave, NGW = gridDim.x * 8;
    const bf16_t* X = (const bf16_t*)(p.ws + WS_X); bf16_t* HB = (bf16_t*)(p.ws + WS_HB);
    const float* g = p.in[7] + (size_t)(l * 3 + k) * D; const float* b = p.in[8] + (size_t)(l * 3 + k) * D;
    float* dst = p.out;
    for (int mq = gw; mq < M / 4; mq += NGW) {
        f32x4 v[4][4]; float s[4];
#pragma unroll
        for (int rr = 0; rr < 4; ++rr) { s[rr] = 0.f;
#pragma unroll
            for (int j = 0; j < 4; ++j) { const u32x2 xu = *(const u32x2*)(X + (size_t)(mq * 4 + rr) * D + (lane + 64 * j) * 4);
                v[rr][j][0] = __uint_as_float(xu.x << 16); v[rr][j][1] = __uint_as_float(xu.x & 0xffff0000u); v[rr][j][2] = __uint_as_float(xu.y << 16); v[rr][j][3] = __uint_as_float(xu.y & 0xffff0000u); s[rr] += (v[rr][j][0] + v[rr][j][1]) + (v[rr][j][2] + v[rr][j][3]); } }
#pragma unroll
        for (int o = 1; o < 64; o <<= 1) {
#pragma unroll
            for (int rr = 0; rr < 4; ++rr) s[rr] += __shfl_xor(s[rr], o); }
        float s2[4];
#pragma unroll
        for (int rr = 0; rr < 4; ++rr) { const float mean = s[rr] * (1.f / D); s2[rr] = 0.f;
#pragma unroll
            for (int j = 0; j < 4; ++j) { v[rr][j] = v[rr][j] - mean; s2[rr] += (v[rr][j][0] * v[rr][j][0] + v[rr][j][1] * v[rr][j][1]) + (v[rr][j][2] * v[rr][j][2] + v[rr][j][3] * v[rr][j][3]); } }
#pragma unroll
        for (int o = 1; o < 64; o <<= 1) {
#pragma unroll
            for (int rr = 0; rr < 4; ++rr) s2[rr] += __shfl_xor(s2[rr], o); }
#pragma unroll
        for (int j = 0; j < 4; ++j) { const int c = (lane + 64 * j) * 4; const f32x4 gg = *(const f32x4*)(g + c), bb = *(const f32x4*)(b + c);
#pragma unroll
            for (int rr = 0; rr < 4; ++rr) { const int m = mq * 4 + rr; const float rstd = rsqrtf(s2[rr] * (1.f / D) + 1e-5f);
                const f32x4 y = v[rr][j] * rstd * gg + bb;
                if (final_out) *(f32x4*)(dst + (size_t)m * D + c) = y;
                else { u32x2 o; o.x = pk2(y[0], y[1]); o.y = pk2(y[2], y[3]); *(u32x2*)(HB + (size_t)m * D + c) = o; } } }
    }
}

__device__ __forceinline__ void small_resid_gemm(const bf16_t* __restrict__ A, const bf16_t* __restrict__ Bt, int K, bf16_t* X, const bf16_t* H, float scale, unsigned char* smem) {
    const int tid = mk_ltid(), lane = tid & 63, w = __builtin_amdgcn_readfirstlane(tid >> 6);
    const int r = lane & 15, q = lane >> 4;
    float* part = (float*)smem;
    for (int t = mk_lbid(); t < 256; t += gridDim.x) {
        const int R0 = MP + (t >> 4) * 32, C0 = (t & 15) * 64;
        f32x4 acc[2][4];
#pragma unroll
        for (int a = 0; a < 2; ++a)
#pragma unroll
            for (int b = 0; b < 4; ++b) acc[a][b] = (f32x4){0.f, 0.f, 0.f, 0.f};
        const int nks = K / 32;
#pragma unroll 2
        for (int ks = w; ks < nks; ks += 8) {
            bf16x8 fa[2], fb[4];
#pragma unroll
            for (int a = 0; a < 2; ++a) fa[a] = *(const bf16x8*)(A + (size_t)(R0 + a * 16 + r) * K + ks * 32 + q * 8);
#pragma unroll
            for (int b = 0; b < 4; ++b) fb[b] = *(const bf16x8*)(Bt + (size_t)(C0 + b * 16 + r) * K + ks * 32 + q * 8);
#pragma unroll
            for (int a = 0; a < 2; ++a)
#pragma unroll
                for (int b = 0; b < 4; ++b) acc[a][b] = __builtin_amdgcn_mfma_f32_16x16x32_bf16(fa[a], fb[b], acc[a][b], 0, 0, 0);
        }
        __syncthreads();
#pragma unroll
        for (int a = 0; a < 2; ++a)
#pragma unroll
            for (int b = 0; b < 4; ++b) *(f32x4*)(part + ((w * 8 + a * 4 + b) * 64 + lane) * 4) = acc[a][b];
        __syncthreads();
        {
            const int tile = tid >> 6, a = tile >> 2, b = tile & 3;
            f32x4 sum = (f32x4){0.f, 0.f, 0.f, 0.f};
#pragma unroll
            for (int ww = 0; ww < 8; ++ww) sum += *(const f32x4*)(part + ((ww * 8 + tile) * 64 + lane) * 4);
            const int col = C0 + b * 16 + r;
#pragma unroll
            for (int j = 0; j < 4; ++j) { const size_t off = (size_t)(R0 + a * 16 + q * 4 + j) * D + col;
                X[off] = f2bf(bf2f(H[off]) * ALPHA + sum[j] * scale); }
        }
    }
}

__device__ __forceinline__ void phase_ab_prep(const Params& p, int i, unsigned char* smem) {
    const int tid = mk_ltid(), lane = tid & 63, wave = __builtin_amdgcn_readfirstlane(tid >> 6);
    const int r = lane & 15, q = lane >> 4;
    unsigned char* ws = p.ws;
    const bf16_t* ZB = (const bf16_t*)(ws + WS_ZB);
    float* OPS = (float*)(ws + WS_OPS); float* GATE = (float*)(ws + WS_GATE); float* BONUS = (float*)(ws + WS_BONUS);
    bf16_t* RQ = (bf16_t*)(ws + WS_RQ); bf16_t* RK = (bf16_t*)(ws + WS_RK);
    const bf16_t* W2T = (const bf16_t*)(ws + WS_W2T); const bf16_t* A2T = (const bf16_t*)(ws + WS_A2T); const bf16_t* G2T = (const bf16_t*)(ws + WS_G2T);
    const float* mu = p.in[14] + (size_t)i * 1792; const float* w0 = p.in[15] + i * 512; const float* a0 = p.in[17] + i * 512;
    const float* k_k = p.in[20] + i * 512; const float* k_a = p.in[21] + i * 512; const float* r_k = p.in[22] + i * 512;
    const float* shift_in = p.in[2] + (size_t)i * 128 * 1792;
    constexpr int ZS_LD = 1796, ACT_LD = 264;
    float* zs = (float*)smem;
    bf16_t* act = (bf16_t*)(smem + 16 * ZS_LD * 4);
    for (int tile = mk_lbid(); tile < M / 16; tile += gridDim.x) {
        const int R0 = tile * 16;
        unsigned pfa = 0u, pfb = 0u;
        { const int ntile = tile + gridDim.x;
          if (ntile < M / 16) { const bf16_t* nz = ZB + (size_t)ntile * 16 * AB_N;
              pfa = *(const unsigned*)(nz + (size_t)tid * 64); pfb = *(const unsigned*)(((size_t)(tid + 512) * 64 < (size_t)16 * AB_N) ? nz + (size_t)(tid + 512) * 64 : nz); } }
#ifndef REP_A_ST
#define REP_A_ST 1
#endif
#ifndef REP_A_RO
#define REP_A_RO 1
#endif
#ifndef REP_A_EP
#define REP_A_EP 1
#endif
        __syncthreads();
#pragma unroll 1
        for (int rp_ = 0; rp_ < REP_A_ST; ++rp_)
#pragma unroll 7
        for (int idx = tid; idx < 16 * 448; idx += 512) {
            const int tok = idx / 448, c4 = (idx % 448) * 4; const int row = R0 + tok;
            const int t = (row < MP) ? (row & 2047) : ((row - MP) & 3);
            const int Lm1 = (row < MP) ? 2047 : 3;
            const u32x2 cu = *(const u32x2*)(ZB + (size_t)row * AB_N + c4);
            f32x4 cur; cur[0] = __uint_as_float(cu.x << 16); cur[1] = __uint_as_float(cu.x & 0xffff0000u); cur[2] = __uint_as_float(cu.y << 16); cur[3] = __uint_as_float(cu.y & 0xffff0000u);
            f32x4 prev;
            if (t == 0) { if (row < MP) prev = (f32x4){0.f, 0.f, 0.f, 0.f}; else prev = *(const f32x4*)(shift_in + (size_t)((row - MP) >> 2) * 1792 + c4); }
            else { const u32x2 pu = *(const u32x2*)(ZB + (size_t)(row - 1) * AB_N + c4);
                prev[0] = __uint_as_float(pu.x << 16); prev[1] = __uint_as_float(pu.x & 0xffff0000u); prev[2] = __uint_as_float(pu.y << 16); prev[3] = __uint_as_float(pu.y & 0xffff0000u); }
            if (t == Lm1) {
                float* o = (row < MP) ? p.out + O_PSHIFT + (size_t)(i * 8 + (row >> 11)) * 1792 : p.out + O_SSHIFT + (size_t)(i * 128 + ((row - MP) >> 2)) * 1792;
                *(f32x4*)(o + c4) = cur;
            }
            const f32x4 m4 = *(const f32x4*)(mu + c4);
            const f32x4 z = cur + (prev - cur) * m4;
            *(f32x4*)(zs + tok * ZS_LD + c4) = z;
            if (c4 >= 1536) {
                f32x4 a;
                if (c4 < 1600) { a[0] = tanhf(z[0]); a[1] = tanhf(z[1]); a[2] = tanhf(z[2]); a[3] = tanhf(z[3]); }
                else if (c4 < 1664) a = z;
                else { a[0] = sigm(z[0]); a[1] = sigm(z[1]); a[2] = sigm(z[2]); a[3] = sigm(z[3]); }
                u32x2 o; o.x = pk2(a[0], a[1]); o.y = pk2(a[2], a[3]); *(u32x2*)(act + tok * ACT_LD + (c4 - 1536)) = o;
            }
        }
        {
            const int tok = tid >> 5, hh = (tid >> 3) & 3, c8 = (tid & 7) * 8; const int row = R0 + tok;
            const float pos = (row < MP) ? (float)(row & 2047) : (float)(16384 + ((row - MP) & 3));
            const bf16_t* zq = ZB + (size_t)row * AB_N + 1792 + hh * 128 + c8;
            const u32x4 q1v = *(const u32x4*)zq, q2v = *(const u32x4*)(zq + 64), k1v = *(const u32x4*)(zq + 512), k2v = *(const u32x4*)(zq + 576);
            const unsigned q1w[4] = {q1v.x, q1v.y, q1v.z, q1v.w}, q2w[4] = {q2v.x, q2v.y, q2v.z, q2v.w}, k1w[4] = {k1v.x, k1v.y, k1v.z, k1v.w}, k2w[4] = {k2v.x, k2v.y, k2v.z, k2v.w};
            float oq1[8], oq2[8], ok1[8], ok2[8];
            const float ksc = 0.08838834764831845f;
#pragma unroll
            for (int e = 0; e < 8; ++e) {
                const int ii = c8 + e;
                const float inv_freq = exp2f(-(float)ii * (13.287712379549449f / 63.0f));
                const float ang = pos * inv_freq;
                const float n = rintf(ang * 0.15915494309189535f);
                float rr = fmaf(-n, 6.2831854820251465f, ang); rr = fmaf(-n, -1.7484555e-7f, rr);
                const float rev = rr * 0.15915494309189535f;
                const float sn = __builtin_amdgcn_sinf(rev), cs = __builtin_amdgcn_cosf(rev);
                const float q1 = (e & 1) ? __uint_as_float(q1w[e >> 1] & 0xffff0000u) : __uint_as_float(q1w[e >> 1] << 16);
                const float q2 = (e & 1) ? __uint_as_float(q2w[e >> 1] & 0xffff0000u) : __uint_as_float(q2w[e >> 1] << 16);
                const float k1 = (e & 1) ? __uint_as_float(k1w[e >> 1] & 0xffff0000u) : __uint_as_float(k1w[e >> 1] << 16);
                const float k2 = (e & 1) ? __uint_as_float(k2w[e >> 1] & 0xffff0000u) : __uint_as_float(k2w[e >> 1] << 16);
                oq1[e] = q1 * cs - q2 * sn; oq2[e] = q2 * cs + q1 * sn;
                ok1[e] = (k1 * cs - k2 * sn) * ksc; ok2[e] = (k2 * cs + k1 * sn) * ksc;
            }
            const size_t o = (size_t)row * 512 + hh * 128 + c8;
            u32x4 w;
            w.x = pk2(oq1[0], oq1[1]); w.y = pk2(oq1[2], oq1[3]); w.z = pk2(oq1[4], oq1[5]); w.w = pk2(oq1[6], oq1[7]); *(u32x4*)(RQ + o) = w;
            w.x = pk2(oq2[0], oq2[1]); w.y = pk2(oq2[2], oq2[3]); w.z = pk2(oq2[4], oq2[5]); w.w = pk2(oq2[6], oq2[7]); *(u32x4*)(RQ + o + 64) = w;
            w.x = pk2(ok1[0], ok1[1]); w.y = pk2(ok1[2], ok1[3]); w.z = pk2(ok1[4], ok1[5]); w.w = pk2(ok1[6], ok1[7]); *(u32x4*)(RK + o) = w;
            w.x = pk2(ok2[0], ok2[1]); w.y = pk2(ok2[2], ok2[3]); w.z = pk2(ok2[4], ok2[5]); w.w = pk2(ok2[6], ok2[7]); *(u32x4*)(RK + o + 64) = w;
        }
        __syncthreads();
        const int cb = wave * 64;
#pragma unroll 1
        for (int rp_ = 0; rp_ < REP_A_EP; ++rp_) {
        f32x4 aw[4], aa[4], ag[4];
#pragma unroll
        for (int nt = 0; nt < 4; ++nt) { aw[nt] = (f32x4){0.f, 0.f, 0.f, 0.f}; aa[nt] = aw[nt]; ag[nt] = aw[nt]; }
#pragma unroll
        for (int ks = 0; ks < 2; ++ks) {
            const bf16x8 bw = *(const bf16x8*)(act + r * ACT_LD + ks * 32 + q * 8);
            const bf16x8 ba = *(const bf16x8*)(act + r * ACT_LD + 64 + ks * 32 + q * 8);
#pragma unroll
            for (int nt = 0; nt < 4; ++nt) {
                const bf16x8 fw = *(const bf16x8*)(W2T + (size_t)(cb + nt * 16 + r) * 64 + ks * 32 + q * 8);
                const bf16x8 fa = *(const bf16x8*)(A2T + (size_t)(cb + nt * 16 + r) * 64 + ks * 32 + q * 8);
                aw[nt] = __builtin_amdgcn_mfma_f32_16x16x32_bf16(fw, bw, aw[nt], 0, 0, 0);
                aa[nt] = __builtin_amdgcn_mfma_f32_16x16x32_bf16(fa, ba, aa[nt], 0, 0, 0);
            }
        }
#pragma unroll
        for (int ks = 0; ks < 4; ++ks) {
            const bf16x8 bg = *(const bf16x8*)(act + r * ACT_LD + 128 + ks * 32 + q * 8);
#pragma unroll
            for (int nt = 0; nt < 4; ++nt) {
                const bf16x8 fg = *(const bf16x8*)(G2T + (size_t)(cb + nt * 16 + r) * 128 + ks * 32 + q * 8);
                ag[nt] = __builtin_amdgcn_mfma_f32_16x16x32_bf16(fg, bg, ag[nt], 0, 0, 0);
            }
        }
        const int row = R0 + r;
        float ssq = 0.f, bon = 0.f;
        f32x4 kkraw[4], av[4];
#pragma unroll
        for (int nt = 0; nt < 4; ++nt) {
            const int c = cb + nt * 16 + q * 4;
            const f32x4 rr = *(const f32x4*)(zs + r * ZS_LD + c), kx = *(const f32x4*)(zs + r * ZS_LD + 512 + c), vv = *(const f32x4*)(zs + r * ZS_LD + 1024 + c);
            const f32x4 w04 = *(const f32x4*)(w0 + c), a04 = *(const f32x4*)(a0 + c), kk4 = *(const f32x4*)(k_k + c), ka4 = *(const f32x4*)(k_a + c), rk4 = *(const f32x4*)(r_k + c);
            f32x4 dec, a, kp;
#pragma unroll
            for (int j = 0; j < 4; ++j) {
                const float wl = w04[j] + aw[nt][j];
                const float sp = fmaxf(-wl, 0.f) + __logf(1.f + __expf(-fabsf(wl)));
                const float wlog = -sp - 0.5f;
                dec[j] = __expf(-__expf(wlog));
                a[j] = sigm(a04[j] + aa[nt][j]);
                kkraw[nt][j] = kx[j] * kk4[j];
                kp[j] = kx[j] * (1.f + (a[j] - 1.f) * ka4[j]);
                ssq += kkraw[nt][j] * kkraw[nt][j];
                bon += rr[j] * kp[j] * rk4[j];
            }
            av[nt] = a;
            float* ob = OPS + ((size_t)row * 8 + wave) * 384 + nt * 16 + q * 4;
            *(f32x4*)(ob) = rr; *(f32x4*)(ob + 64) = dec; *(f32x4*)(ob + 128) = kp; *(f32x4*)(ob + 192) = vv;
            *(f32x4*)(GATE + (size_t)row * 512 + c) = ag[nt];
        }
        ssq += __shfl_xor(ssq, 16); ssq += __shfl_xor(ssq, 32);
        bon += __shfl_xor(bon, 16); bon += __shfl_xor(bon, 32);
        const float rn = rsqrtf(fmaxf(ssq, 1e-12f));
#pragma unroll
        for (int nt = 0; nt < 4; ++nt) {
            float* ob = OPS + ((size_t)row * 8 + wave) * 384 + nt * 16 + q * 4;
            const f32x4 kk = kkraw[nt] * rn;
            *(f32x4*)(ob + 256) = kk; *(f32x4*)(ob + 320) = kk * av[nt];
        }
        if (q == 0) BONUS[(size_t)row * 8 + wave] = bon;
        }
        if (pfa == 0x7fc17fc1u && pfb == 0x7fc27fc2u) zs[0] = 1.f;
    }
}

__device__ __forceinline__ void rwkv_item(const Params& p, int i, int s, int h, int rg, unsigned char* smem) {
    const int tid = mk_ltid(), lane = tid & 63, wave = __builtin_amdgcn_readfirstlane(tid >> 6);
    int row0, L; seq_info(s, row0, L);
    const float* OPS = (const float*)(p.ws + WS_OPS); float* ORAW = (float*)(p.ws + WS_ORAW);
    float* buf = (float*)smem;
    const int rih = rg * 16 + (wave & 3) * 4 + (lane >> 4);
    const int c4 = (lane & 15) * 4;
    f32x4 S = (f32x4){0.f, 0.f, 0.f, 0.f};
    if (s >= 8 && wave < 4) S = *(const f32x4*)(p.in[3] + ((((size_t)i * 128 + (s - 8)) * 8 + h) * 64 + rih) * 64 + c4);
    f32x4 pre[6];
    const int nch = (L + 31) / 32;
#pragma unroll
    for (int k = 0; k < 6; ++k) { const int idx4 = tid + k * 512; const int tt = idx4 / 96, off = idx4 % 96;
        pre[k] = (tt < L) ? *(const f32x4*)(OPS + ((size_t)(row0 + tt) * 8 + h) * 384 + off * 4) : (f32x4){0.f, 0.f, 0.f, 0.f}; }
    for (int ch = 0; ch < nch; ++ch) {
        const int t0 = ch * 32;
        __syncthreads();
#pragma unroll
        for (int k = 0; k < 6; ++k) { const int idx4 = tid + k * 512; *(f32x4*)(buf + idx4 * 4) = pre[k]; }
        __syncthreads();
        if (ch + 1 < nch) {
#pragma unroll
            for (int k = 0; k < 6; ++k) { const int idx4 = tid + k * 512; const int tt = t0 + 32 + idx4 / 96, off = idx4 % 96;
                pre[k] = (tt < L) ? *(const f32x4*)(OPS + ((size_t)(row0 + tt) * 8 + h) * 384 + off * 4) : (f32x4){0.f, 0.f, 0.f, 0.f}; }
        }
        if (wave < 4) {
            const int ns = (L - t0) < 32 ? (L - t0) : 32;
            f32x4 r4 = *(const f32x4*)(buf + c4), w4 = *(const f32x4*)(buf + 64 + c4), k4 = *(const f32x4*)(buf + 128 + c4);
            f32x4 kk4 = *(const f32x4*)(buf + 256 + c4), ka4 = *(const f32x4*)(buf + 320 + c4);
            float vv = buf[192 + rih];
            float* op = ORAW + (size_t)(row0 + t0) * 512 + h * 64 + rih;
            f32x4 rprev = r4;
#pragma unroll 2
            for (int tt = 0; tt < ns; ++tt) {
                const float* nb = buf + ((tt + 1 < 32) ? (tt + 1) : 31) * 384;
                const f32x4 r4n = *(const f32x4*)(nb + c4), w4n = *(const f32x4*)(nb + 64 + c4), k4n = *(const f32x4*)(nb + 128 + c4);
                const f32x4 kk4n = *(const f32x4*)(nb + 256 + c4), ka4n = *(const f32x4*)(nb + 320 + c4);
                const float vvn = nb[192 + rih];
                float o = (S[0] * rprev[0] + S[1] * rprev[1]) + (S[2] * rprev[2] + S[3] * rprev[3]);
                const f32x4 kv = k4 * vv;
                float sk = (S[0] * kk4[0] + S[1] * kk4[1]) + (S[2] * kk4[2] + S[3] * kk4[3]);
                sk = row16_sum(sk);
                o = row16_sum(o);
                const f32x4 t1 = kv - ka4 * sk;
                S = S * w4 + t1;
                if ((lane & 15) == 0 && tt > 0) op[(size_t)(tt - 1) * 512] = o;
                rprev = r4;
                r4 = r4n; w4 = w4n; k4 = k4n; kk4 = kk4n; ka4 = ka4n; vv = vvn;
            }
            {
                float o = (S[0] * rprev[0] + S[1] * rprev[1]) + (S[2] * rprev[2] + S[3] * rprev[3]);
                o = row16_sum(o);
                if ((lane & 15) == 0) op[(size_t)(ns - 1) * 512] = o;
            }
        }
    }
    if (wave < 4) {
        float* so = (s < 8) ? p.out + O_PRWKV + ((((size_t)i * 8 + s) * 8 + h) * 64 + rih) * 64 + c4
                            : p.out + O_SRWKV + ((((size_t)i * 128 + (s - 8)) * 8 + h) * 64 + rih) * 64 + c4;
        *(f32x4*)so = S;
    }
}

__device__ __forceinline__ void rwkv_item2(const Params& p, int i, int s, int h, int rg, unsigned char* smem) {
    const int tid = mk_ltid(), lane = tid & 63, wave = __builtin_amdgcn_readfirstlane(tid >> 6);
    int row0, L; seq_info(s, row0, L);
    const float* OPS = (const float*)(p.ws + WS_OPS); float* ORAW = (float*)(p.ws + WS_ORAW);
    float* buf = (float*)smem;
    const int ra = rg * 32 + (wave & 3) * 4 + (lane >> 4), rb = ra + 16;
    const int c4 = (lane & 15) * 4;
    f32x4 Sa = (f32x4){0.f, 0.f, 0.f, 0.f}, Sb = Sa;
    if (s >= 8 && wave < 4) { const float* sp = p.in[3] + (((size_t)i * 128 + (s - 8)) * 8 + h) * 4096;
        Sa = *(const f32x4*)(sp + ra * 64 + c4); Sb = *(const f32x4*)(sp + rb * 64 + c4); }
    f32x4 pre[12];
    const int nch = (L + 63) / 64;
#pragma unroll
    for (int k = 0; k < 12; ++k) { const int idx4 = tid + k * 512; const int tt = idx4 / 96, off = idx4 % 96;
        pre[k] = (tt < L) ? *(const f32x4*)(OPS + ((size_t)(row0 + tt) * 8 + h) * 384 + off * 4) : (f32x4){0.f, 0.f, 0.f, 0.f}; }
    for (int ch = 0; ch < nch; ++ch) {
        const int t0 = ch * 64;
        __syncthreads();
#pragma unroll
        for (int k = 0; k < 12; ++k) { const int idx4 = tid + k * 512; *(f32x4*)(buf + idx4 * 4) = pre[k]; }
        __syncthreads();
        if (ch + 1 < nch) {
#pragma unroll
            for (int k = 0; k < 12; ++k) { const int idx4 = tid + k * 512; const int tt = t0 + 64 + idx4 / 96, off = idx4 % 96;
                pre[k] = (tt < L) ? *(const f32x4*)(OPS + ((size_t)(row0 + tt) * 8 + h) * 384 + off * 4) : (f32x4){0.f, 0.f, 0.f, 0.f}; }
        }
        if (wave < 4) {
            const int ns = (L - t0) < 64 ? (L - t0) : 64;
            f32x4 rA = *(const f32x4*)(buf + c4), wA = *(const f32x4*)(buf + 64 + c4), kA = *(const f32x4*)(buf + 128 + c4);
            f32x4 kkA = *(const f32x4*)(buf + 256 + c4), kaA = *(const f32x4*)(buf + 320 + c4);
            float vaA = buf[192 + ra], vbA = buf[192 + rb];
            f32x4 rB, wB, kB, kkB, kaB; float vaB, vbB;
            float* op = ORAW + (size_t)(row0 + t0) * 512 + h * 64 + ra;
            f32x4 rprev = rA;
#define RW_LOAD(R, W, K, KK, KA, VA, VB, nb_) do { const float* nb = (nb_); R = *(const f32x4*)(nb + c4); W = *(const f32x4*)(nb + 64 + c4); K = *(const f32x4*)(nb + 128 + c4); \
                KK = *(const f32x4*)(nb + 256 + c4); KA = *(const f32x4*)(nb + 320 + c4); VA = nb[192 + ra]; VB = nb[192 + rb]; } while (0)
#define RW_STEP(R, W, K, KK, KA, VA, VB, RP, tt_) do { \
                float oa = (Sa[0] * RP[0] + Sa[1] * RP[1]) + (Sa[2] * RP[2] + Sa[3] * RP[3]); \
                float ob = (Sb[0] * RP[0] + Sb[1] * RP[1]) + (Sb[2] * RP[2] + Sb[3] * RP[3]); \
                float ska = (Sa[0] * KK[0] + Sa[1] * KK[1]) + (Sa[2] * KK[2] + Sa[3] * KK[3]); \
                float skb = (Sb[0] * KK[0] + Sb[1] * KK[1]) + (Sb[2] * KK[2] + Sb[3] * KK[3]); \
                ska = row16_sum(ska); skb = row16_sum(skb); oa = row16_sum(oa); ob = row16_sum(ob); \
                Sa = Sa * W + (K * VA - KA * ska); Sb = Sb * W + (K * VB - KA * skb); \
                if ((lane & 15) == 0 && (tt_) > 0) { op[(size_t)((tt_) - 1) * 512] = oa; op[(size_t)((tt_) - 1) * 512 + 16] = ob; } } while (0)
            for (int tt = 0; tt < ns; tt += 2) {
                RW_LOAD(rB, wB, kB, kkB, kaB, vaB, vbB, buf + (tt + 1) * 384);
                RW_STEP(rA, wA, kA, kkA, kaA, vaA, vbA, rprev, tt);
                const f32x4 rEven = rA;
                RW_LOAD(rA, wA, kA, kkA, kaA, vaA, vbA, buf + ((tt + 2 < 64) ? (tt + 2) : 63) * 384);
                RW_STEP(rB, wB, kB, kkB, kaB, vaB, vbB, rEven, tt + 1);
                rprev = rB;
            }
            {
                float oa = (Sa[0] * rprev[0] + Sa[1] * rprev[1]) + (Sa[2] * rprev[2] + Sa[3] * rprev[3]);
                float ob = (Sb[0] * rprev[0] + Sb[1] * rprev[1]) + (Sb[2] * rprev[2] + Sb[3] * rprev[3]);
                oa = row16_sum(oa); ob = row16_sum(ob);
                if ((lane & 15) == 0) { op[(size_t)(ns - 1) * 512] = oa; op[(size_t)(ns - 1) * 512 + 16] = ob; }
            }
#undef RW_LOAD
#undef RW_STEP
        }
    }
    if (wave < 4) {
        float* so = (s < 8) ? p.out + O_PRWKV + (((size_t)i * 8 + s) * 8 + h) * 4096 : p.out + O_SRWKV + (((size_t)i * 128 + (s - 8)) * 8 + h) * 4096;
        *(f32x4*)(so + ra * 64 + c4) = Sa; *(f32x4*)(so + rb * 64 + c4) = Sb;
    }
}

__device__ __forceinline__ void ret_item(const Params& p, int i, int s, int hb, unsigned char* smem) {
    const int tid = mk_ltid(), lane = tid & 63, w = __builtin_amdgcn_readfirstlane(tid >> 6);
    const int r = lane & 15, q = lane >> 4;
    int row0, L; seq_info(s, row0, L);
    const int C = (s < 8) ? 128 : 4; const int nch = L / C;
    const float lg = log2f(1.0f - exp2f(-5.0f - (float)hb));
    const bf16_t* ZB = (const bf16_t*)(p.ws + WS_ZB); const bf16_t* RQ = (const bf16_t*)(p.ws + WS_RQ); const bf16_t* RK = (const bf16_t*)(p.ws + WS_RK);
    bf16_t* OMIX = (bf16_t*)(p.ws + WS_OMIX);
    const float* gn_g = p.in[25] + i * 512 + hb * 128; const float* gn_b = p.in[26] + i * 512 + hb * 128;
    constexpr int LD = 136;
    bf16_t* KC = (bf16_t*)smem; bf16_t* KZT = KC + 128 * LD; bf16_t* VT = KZT + 128 * LD; bf16_t* SB = VT + 128 * LD;
    f32x4 ST[8];
#pragma unroll
    for (int nt = 0; nt < 8; ++nt) ST[nt] = (f32x4){0.f, 0.f, 0.f, 0.f};
    if (s >= 8) {
        const float* S0 = p.in[4] + (((size_t)i * 128 + (s - 8)) * 4 + hb) * 16384;
#pragma unroll
        for (int nt = 0; nt < 8; ++nt) ST[nt] = *(const f32x4*)(S0 + (size_t)(nt * 16 + r) * 128 + 16 * w + q * 4);
    }
    const float gch = exp2f((float)C * lg);
    for (int ch = 0; ch < nch; ++ch) {
        const int rb = row0 + ch * C;
        __syncthreads();
        for (int idx = tid; idx < 128 * 16; idx += 512) {
            const int tok = idx & 127, c8 = (idx >> 7) * 8;
            u32x4 kv = (u32x4){0u, 0u, 0u, 0u}, vv = kv;
            if (tok < C) { kv = *(const u32x4*)(RK + (size_t)(rb + tok) * 512 + hb * 128 + c8);
                           vv = *(const u32x4*)(ZB + (size_t)(rb + tok) * AB_N + 1792 + 1024 + hb * 128 + c8); }
            *(u32x4*)(KC + tok * LD + c8) = kv;
            const float zeta = __builtin_amdgcn_exp2f((float)(C - 1 - tok) * lg);
            const unsigned kw[4] = {kv.x, kv.y, kv.z, kv.w}; const unsigned vw[4] = {vv.x, vv.y, vv.z, vv.w};
#pragma unroll
            for (int e = 0; e < 4; ++e) {
                const float k0 = __uint_as_float(kw[e] << 16) * zeta, k1 = __uint_as_float(kw[e] & 0xffff0000u) * zeta;
                KZT[(c8 + 2 * e) * LD + tok] = f2bf(k0); KZT[(c8 + 2 * e + 1) * LD + tok] = f2bf(k1);
                VT[(c8 + 2 * e) * LD + tok] = (bf16_t)(vw[e] & 0xffffu); VT[(c8 + 2 * e + 1) * LD + tok] = (bf16_t)(vw[e] >> 16);
            }
        }
#pragma unroll
        for (int nt = 0; nt < 8; ++nt)
#pragma unroll
            for (int j = 0; j < 4; ++j) SB[(16 * w + q * 4 + j) * LD + nt * 16 + r] = f2bf(ST[nt][j]);
        __syncthreads();
        bf16x8 aq[4];
#pragma unroll
        for (int ks = 0; ks < 4; ++ks) {
            if (16 * w + r < C) aq[ks] = *(const bf16x8*)(RQ + (size_t)(rb + 16 * w + r) * 512 + hb * 128 + ks * 32 + q * 8);
            else aq[ks] = (bf16x8){0, 0, 0, 0, 0, 0, 0, 0};
        }
        u32x2 P[8]; f32x4 O[8];
#pragma unroll
        for (int nt = 0; nt < 8; ++nt) {
            f32x4 acc = (f32x4){0.f, 0.f, 0.f, 0.f}, oc = acc;
#pragma unroll
            for (int ks = 0; ks < 4; ++ks) {
                const bf16x8 bk = *(const bf16x8*)(KC + (nt * 16 + r) * LD + ks * 32 + q * 8);
                const bf16x8 bs = *(const bf16x8*)(SB + (nt * 16 + r) * LD + ks * 32 + q * 8);
                acc = __builtin_amdgcn_mfma_f32_16x16x32_bf16(aq[ks], bk, acc, 0, 0, 0);
                oc = __builtin_amdgcn_mfma_f32_16x16x32_bf16(aq[ks], bs, oc, 0, 0, 0);
            }
#pragma unroll
            for (int j = 0; j < 4; ++j) {
                const int ii = 16 * w + q * 4 + j, jt = nt * 16 + r;
                acc[j] = (ii >= jt) ? acc[j] * __builtin_amdgcn_exp2f((float)(ii - jt) * lg) : 0.f;
                oc[j] *= __builtin_amdgcn_exp2f((float)(ii + 1) * lg);
            }
            P[nt].x = pk2(acc[0], acc[1]); P[nt].y = pk2(acc[2], acc[3]); O[nt] = oc;
        }
        __syncthreads();
#pragma unroll
        for (int nt = 0; nt < 8; ++nt)
#pragma unroll
            for (int j = 0; j < 4; ++j) KC[(16 * w + q * 4 + j) * LD + nt * 16 + r] = (bf16_t)(((j & 2) ? P[nt].y : P[nt].x) >> ((j & 1) * 16));
        __syncthreads();
#pragma unroll
        for (int nt = 0; nt < 8; ++nt) ST[nt] = ST[nt] * gch;
#pragma unroll
        for (int ks = 0; ks < 4; ++ks) {
            const bf16x8 ap = *(const bf16x8*)(KC + (16 * w + r) * LD + ks * 32 + q * 8);
            const bf16x8 av = *(const bf16x8*)(VT + (16 * w + r) * LD + ks * 32 + q * 8);
#pragma unroll
            for (int nt = 0; nt < 8; ++nt) {
                const bf16x8 bv = *(const bf16x8*)(VT + (nt * 16 + r) * LD + ks * 32 + q * 8);
                const bf16x8 bz = *(const bf16x8*)(KZT + (nt * 16 + r) * LD + ks * 32 + q * 8);
                O[nt] = __builtin_amdgcn_mfma_f32_16x16x32_bf16(ap, bv, O[nt], 0, 0, 0);
                ST[nt] = __builtin_amdgcn_mfma_f32_16x16x32_bf16(av, bz, ST[nt], 0, 0, 0);
            }
        }
#pragma unroll
        for (int j = 0; j < 4; ++j) {
            float s1 = 0.f;
#pragma unroll
            for (int nt = 0; nt < 8; ++nt) s1 += O[nt][j];
            s1 = row16_sum(s1); const float mean = s1 * (1.f / 128.f);
            float s2 = 0.f;
#pragma unroll
            for (int nt = 0; nt < 8; ++nt) { const float d = O[nt][j] - mean; s2 += d * d; }
            s2 = row16_sum(s2); const float rstd = rsqrtf(s2 * (1.f / 128.f) + 1e-5f);
            const int ii = 16 * w + q * 4 + j;
            if (ii < C) {
                const size_t row = (size_t)(rb + ii);
#pragma unroll
                for (int nt = 0; nt < 8; ++nt) { const int dv = nt * 16 + r;
                    const float val = (O[nt][j] - mean) * rstd * gn_g[dv] + gn_b[dv];
                    const float gr = bf2f(ZB[row * AB_N + 1792 + 1536 + hb * 128 + dv]);
                    OMIX[row * 1024 + 512 + hb * 128 + dv] = f2bf(val * silu(gr)); }
            }
        }
    }
    float* so = (s < 8) ? p.out + O_PRET + (((size_t)i * 8 + s) * 4 + hb) * 16384 : p.out + O_SRET + (((size_t)i * 128 + (s - 8)) * 4 + hb) * 16384;
#pragma unroll
    for (int nt = 0; nt < 8; ++nt) *(f32x4*)(so + (size_t)(nt * 16 + r) * 128 + 16 * w + q * 4) = ST[nt];
}

__device__ __forceinline__ void phase_ab_core(const Params& p, int i, int l, unsigned char* smem) {
    const int bid = mk_lbid(), G = gridDim.x; const int wv = mk_ltid() >> 6;
    if (G == 256) {
        if (bid < 128) rwkv_item2(p, i, bid >> 4, (bid >> 1) & 7, bid & 1, smem);
        else if (bid < 160) ret_item(p, i, (bid - 128) >> 2, (bid - 128) & 3, smem);
        else {
            for (int it = bid - 160; it < 128 * 16; it += 96) rwkv_item2(p, i, 8 + (it >> 4), (it >> 1) & 7, it & 1, smem);
            __syncthreads();
            for (int it = bid - 160; it < 128 * 4; it += 96) ret_item(p, i, 8 + (it >> 2), it & 3, smem);
        }
        if (bid >= 160) convert_ffn_ahead(p, l, (bid - 160) * 8 + wv, 96 * 8, smem);
    } else {
        for (int it = bid; it < 136 * 16; it += G) rwkv_item2(p, i, it >> 4, (it >> 1) & 7, it & 1, smem);
        __syncthreads();
        for (int it = bid; it < 136 * 4; it += G) ret_item(p, i, it >> 2, it & 3, smem);
        convert_ffn_ahead(p, l, bid * 8 + wv, G * 8, smem);
    }
}

__device__ __forceinline__ void phase_ab_post(const Params& p, int i) {
    const int tid = mk_ltid(), lane = tid & 63, wave = tid >> 6;
    const int gw = mk_lbid() * 8 + wave, NGW = gridDim.x * 8;
    const float* OPS = (const float*)(p.ws + WS_OPS); const float* ORAW = (const float*)(p.ws + WS_ORAW);
    const float* GATE = (const float*)(p.ws + WS_GATE); const float* BONUS = (const float*)(p.ws + WS_BONUS);
    bf16_t* OMIX = (bf16_t*)(p.ws + WS_OMIX);
    const float* gg = p.in[23] + i * 512; const float* gb = p.in[24] + i * 512;
    for (int m = gw; m < M; m += NGW) {
        const int c = lane * 8, h = lane >> 3, hc = c & 63;
        const f32x4 o0 = *(const f32x4*)(ORAW + (size_t)m * 512 + c), o1 = *(const f32x4*)(ORAW + (size_t)m * 512 + c + 4);
        float s1 = (o0[0] + o0[1]) + (o0[2] + o0[3]) + (o1[0] + o1[1]) + (o1[2] + o1[3]);
        s1 += __shfl_xor(s1, 1); s1 += __shfl_xor(s1, 2); s1 += __shfl_xor(s1, 4);
        const float mean = s1 * (1.f / 64.f);
        const f32x4 d0 = o0 - mean, d1 = o1 - mean;
        float s2 = (d0[0] * d0[0] + d0[1] * d0[1]) + (d0[2] * d0[2] + d0[3] * d0[3]) + (d1[0] * d1[0] + d1[1] * d1[1]) + (d1[2] * d1[2] + d1[3] * d1[3]);
        s2 += __shfl_xor(s2, 1); s2 += __shfl_xor(s2, 2); s2 += __shfl_xor(s2, 4);
        const float rstd = rsqrtf(s2 * (1.f / 64.f) + 64e-5f);
        const float bon = BONUS[(size_t)m * 8 + h];
        const float* vb = OPS + ((size_t)m * 8 + h) * 384 + 192 + hc;
        const f32x4 v0 = *(const f32x4*)vb, v1 = *(const f32x4*)(vb + 4);
        const f32x4 g0 = *(const f32x4*)(gg + c), g1 = *(const f32x4*)(gg + c + 4), b0 = *(const f32x4*)(gb + c), b1 = *(const f32x4*)(gb + c + 4);
        const f32x4 t0 = *(const f32x4*)(GATE + (size_t)m * 512 + c), t1 = *(const f32x4*)(GATE + (size_t)m * 512 + c + 4);
        const f32x4 y0 = (d0 * rstd * g0 + b0 + v0 * bon) * t0, y1 = (d1 * rstd * g1 + b1 + v1 * bon) * t1;
        u32x4 o; o.x = pk2(y0[0], y0[1]); o.y = pk2(y0[2], y0[3]); o.z = pk2(y1[0], y1[1]); o.w = pk2(y1[2], y1[3]);
        *(u32x4*)(OMIX + (size_t)m * 1024 + c) = o;
    }
}

__device__ __forceinline__ int gdn_item_index(int s, int h, int c) { return (s < 8) ? ((s * 8 + h) * 32 + c) : (2048 + (s - 8) * 8 + h); }

__device__ __forceinline__ void gdn_chunk_item(const Params& p, int i, int s, int h, int c, int pf_row, int pf_h, unsigned char* smem) {
    const int tid = mk_ltid(), lane = tid & 63, w = __builtin_amdgcn_readfirstlane(tid >> 6);
    const int r = lane & 15, q = lane >> 4;
    int row0, L; seq_info(s, row0, L);
    const int t0 = c * 64; const int nvalid = (L - t0) < 64 ? (L - t0) : 64;
    const bf16_t* ZB = (const bf16_t*)(p.ws + WS_ZB);
    unsigned char* rec = p.ws + WS_CH + (size_t)gdn_item_index(s, h, c) * CH_BYTES;
    float* U = (float*)(rec + CH_U); bf16_t* Wd = (bf16_t*)(rec + CH_W); bf16_t* QG = (bf16_t*)(rec + CH_QG); bf16_t* QK = (bf16_t*)(rec + CH_QK); bf16_t* KDT = (bf16_t*)(rec + CH_KDT);
    constexpr int LD = 132, ALD = 68;
    float* qs = (float*)smem; float* ks = qs + 64 * LD; float* vs = ks + 64 * LD; float* As = vs + 64 * LD;
    float* AT = As + 64 * ALD; float* gcs = AT + 64 * ALD; float* bes = gcs + 64;
    unsigned short pfv = 0;
    if (pf_row >= 0 && tid < 384) { const int rr_ = tid / 6, pp_ = (tid % 6) >> 1, hh_ = tid & 1;
        pfv = ((const bf16_t*)(p.ws + WS_ZB))[(size_t)(pf_row + rr_) * GD_N + pp_ * 1024 + pf_h * 128 + hh_ * 64]; }
#ifndef REP_G_CONV
#define REP_G_CONV 1
#endif
#ifndef REP_G_MFMA
#define REP_G_MFMA 1
#endif
#ifndef REP_G_QG
#define REP_G_QG 1
#endif
#ifndef REP_G_SUB
#define REP_G_SUB 1
#endif
#pragma unroll 1
    for (int rp_ = 0; rp_ < REP_G_CONV; ++rp_) {
    __syncthreads();
    if (tid < 384) {
        if (nvalid == 64) {
            const int cg = tid % 48, tr = tid / 48;
            const int part = cg >> 4, ch0 = (cg & 15) * 8; const int zc0 = part * 1024 + h * 128 + ch0;
            const float* cw = p.in[28] + (size_t)i * 4 * 3072 + zc0;
            f32x4 wv[4][2];
#pragma unroll
            for (int j = 0; j < 4; ++j) { wv[j][0] = *(const f32x4*)(cw + j * 3072); wv[j][1] = *(const f32x4*)(cw + j * 3072 + 4); }
            u32x4 xr[11];
#pragma unroll
            for (int jr = 0; jr < 11; ++jr) { const int tt = t0 + tr * 8 - 3 + jr;
                xr[jr] = (tt >= 0) ? *(const u32x4*)(ZB + (size_t)(row0 + (tt >= 0 ? tt : 0)) * GD_N + zc0) : (u32x4){0u, 0u, 0u, 0u}; }
            float* dstb = (part == 0 ? qs : part == 1 ? ks : vs) + ch0;
#pragma unroll
            for (int e = 0; e < 8; ++e) {
                f32x4 o0, o1;
#pragma unroll
                for (int cc = 0; cc < 8; ++cc) {
                    float y = 0.f;
#pragma unroll
                    for (int j = 0; j < 4; ++j) { const unsigned wd = (cc >> 1) == 0 ? xr[e + j].x : (cc >> 1) == 1 ? xr[e + j].y : (cc >> 1) == 2 ? xr[e + j].z : xr[e + j].w;
                        const float xv = (cc & 1) ? __uint_as_float(wd & 0xffff0000u) : __uint_as_float(wd << 16);
                        y += wv[j][cc >> 2][cc & 3] * xv; }
                    const float sv = silu(y);
                    if (cc < 4) o0[cc] = sv; else o1[cc - 4] = sv;
                }
                *(f32x4*)(dstb + (tr * 8 + e) * LD) = o0; *(f32x4*)(dstb + (tr * 8 + e) * LD + 4) = o1;
            }
        } else {
            const int part = tid >> 7, ch = tid & 127; const int zc = part * 1024 + h * 128 + ch;
            const float* cw = p.in[28] + (size_t)i * 4 * 3072 + zc;
            const float cw0 = cw[0], cw1 = cw[3072], cw2 = cw[2 * 3072], cw3 = cw[3 * 3072];
            float* dst = (part == 0 ? qs : part == 1 ? ks : vs) + ch;
            float x3, x2, x1;
            { const float* cs = p.in[5] + (((size_t)i * 128 + (s - 8)) * 3) * 3072 + zc; x3 = cs[0]; x2 = cs[3072]; x1 = cs[2 * 3072]; }
#pragma unroll
            for (int e = 0; e < 64; ++e) {
                float v = 0.f;
                if (e < 4) { const float xe = (e < nvalid) ? bf2f(ZB[(size_t)(row0 + e) * GD_N + zc]) : 0.f;
                    const float y = cw0 * x3 + cw1 * x2 + cw2 * x1 + cw3 * xe; v = (e < nvalid) ? silu(y) : 0.f; x3 = x2; x2 = x1; x1 = xe; }
                dst[e * LD] = v;
            }
        }
    } else if (tid < 448) {
        const int t = tid - 384;
        float be = 0.f, g = 0.f;
        if (t < nvalid) { const size_t zr = (size_t)(row0 + t0 + t) * GD_N;
            be = sigm(bf2f(ZB[zr + 3072 + h]));
            const float a = bf2f(ZB[zr + 3080 + h]) + p.in[30][i * 8 + h];
            const float sp = fmaxf(a, 0.f) + __logf(1.f + __expf(-fabsf(a)));
            g = -__expf(p.in[29][i * 8 + h]) * sp; }
#pragma unroll
        for (int o = 1; o < 64; o <<= 1) { const float y = __shfl_up(g, o); if (t >= o) g += y; }
        gcs[t] = g; bes[t] = be;
    }
    }
    __syncthreads();
    for (int pass = 0; pass < 4; ++pass) {
        const int rowi = w * 16 + pass * 4 + q;
        const int t = rowi & 63;
        if ((w * 16 + pass * 4) % 64 < nvalid) {
            float* base = ((rowi < 64) ? qs : ks) + t * LD + r * 8;
            f32x4 a = *(f32x4*)base, b = *(f32x4*)(base + 4);
            float ss = (a[0] * a[0] + a[1] * a[1]) + (a[2] * a[2] + a[3] * a[3]) + (b[0] * b[0] + b[1] * b[1]) + (b[2] * b[2] + b[3] * b[3]);
            ss = row16_sum(ss);
            const float rn = rsqrtf(fmaxf(ss, 1e-12f));
            *(f32x4*)base = a * rn; *(f32x4*)(base + 4) = b * rn;
        }
    }
    __syncthreads();
#pragma unroll 1
    for (int rp_ = 0; rp_ < REP_G_MFMA; ++rp_)
#pragma unroll
    for (int tl = 0; tl < 2; ++tl) {
        const int tile = 2 * w + tl, mi = tile >> 2, ni = tile & 3;
        f32x4 akk = (f32x4){0.f, 0.f, 0.f, 0.f}, aqk = akk;
        if (mi * 16 < nvalid) {
#pragma unroll 8
            for (int k0 = 0; k0 < 128; k0 += 4) {
                const float ka = ks[(mi * 16 + r) * LD + k0 + q], kb = ks[(ni * 16 + r) * LD + k0 + q], qa = qs[(mi * 16 + r) * LD + k0 + q];
                akk = __builtin_amdgcn_mfma_f32_16x16x4f32(ka, kb, akk, 0, 0, 0);
                aqk = __builtin_amdgcn_mfma_f32_16x16x4f32(qa, kb, aqk, 0, 0, 0);
            }
        }
#pragma unroll
        for (int j = 0; j < 4; ++j) { const int ii = mi * 16 + q * 4 + j, jj = ni * 16 + r;
            const float dm = (ii >= jj) ? __expf(gcs[ii] - gcs[jj]) : 0.f;
            const float aij = (ii > jj) ? bes[ii] * akk[j] * dm : 0.f;
            As[ii * ALD + jj] = aij; AT[jj * ALD + ii] = aij;
            if (mi * 16 < nvalid) QK[ii * 64 + jj] = f2bf(aqk[j] * 0.08838834764831845f * dm); }
    }
    __syncthreads();
#pragma unroll 1
    for (int rp_ = 0; rp_ < REP_G_QG; ++rp_)
    {
        const float gl = gcs[63];
        const int nrow = (nvalid == 64) ? 64 : 16;
        for (int idx = tid; idx < nrow * 16; idx += 512) { const int t = idx >> 4, d0 = (idx & 15) * 8; const float sc = 0.08838834764831845f * __expf(gcs[t]);
            const f32x4 a = *(const f32x4*)(qs + t * LD + d0) * sc, b = *(const f32x4*)(qs + t * LD + d0 + 4) * sc;
            u32x4 o; o.x = pk2(a[0], a[1]); o.y = pk2(a[2], a[3]); o.z = pk2(b[0], b[1]); o.w = pk2(b[2], b[3]);
            *(u32x4*)(QG + t * 128 + d0) = o; }
        for (int idx = tid; idx < 128 * (nrow >> 3); idx += 512) { const int d = idx & 127, tc = (idx >> 7) * 8;
            float v[8];
#pragma unroll
            for (int e = 0; e < 8; ++e) v[e] = ks[(tc + e) * LD + d] * __expf(gl - gcs[tc + e]);
            u32x4 o; o.x = pk2(v[0], v[1]); o.y = pk2(v[2], v[3]); o.z = pk2(v[4], v[5]); o.w = pk2(v[6], v[7]);
            *(u32x4*)(KDT + d * 64 + tc) = o; }
        if (tid == 0) ((float*)(p.ws + WS_GL))[gdn_item_index(s, h, c)] = __expf(gl);
    }
    __syncthreads();
    for (int idx = tid; idx < 64 * 128; idx += 512) { const int t = idx >> 7, d = idx & 127; const float be = bes[t];
        vs[t * LD + d] *= be; ks[t * LD + d] *= be * __expf(gcs[t]); }
    __syncthreads();
    const int nblk = (nvalid + 15) >> 4;
#pragma unroll 1
    for (int blk = 0; blk < 4; ++blk) {
        if (blk >= nblk) continue;
        if (blk > 0) {
#pragma unroll
            for (int tl = 0; tl < 2; ++tl) {
                const int nt = 2 * w + tl; float* bb = (nt < 8 ? vs : ks) + (nt & 7) * 16 + r;
                f32x4 acc = (f32x4){0.f, 0.f, 0.f, 0.f};
                const float* ap = As + (blk * 16 + r) * ALD + q;
                for (int k0 = 0; k0 < blk * 16; k0 += 4)
                    acc = __builtin_amdgcn_mfma_f32_16x16x4f32(ap[k0], bb[(k0 + q) * LD], acc, 0, 0, 0);
#pragma unroll
                for (int j = 0; j < 4; ++j) bb[(blk * 16 + q * 4 + j) * LD] -= acc[j];
            }
            __syncthreads();
        }
        if (tid < 256) {
            const int col = tid & 127; const bool isu = tid < 128;
            float* buf = (isu ? vs : ks) + col;
            float acc[16];
#pragma unroll
            for (int e = 0; e < 16; ++e) acc[e] = buf[(blk * 16 + e) * LD];
#pragma unroll
            for (int e = 1; e < 16; ++e) {
#pragma unroll
                for (int f = 0; f < e; ++f) acc[e] -= As[(blk * 16 + e) * ALD + blk * 16 + f] * acc[f];
            }
#pragma unroll
            for (int e = 0; e < 16; ++e) { const int ii = blk * 16 + e; buf[ii * LD] = acc[e];
                if (isu) U[ii * 128 + col] = acc[e]; else Wd[ii * 128 + col] = f2bf(acc[e]); }
        }
        __syncthreads();
    }
    if (pfv == 0x7fc3u) gcs[0] = 1.f;
    asm volatile("s_waitcnt vmcnt(0)" ::: "memory");
    __syncthreads();
}

__device__ __forceinline__ void phase_gdn_chunk(const Params& p, int i, unsigned char* smem) {
    if (gridDim.x == 256) {
        for (int it = mk_lbid(); it < 64 * GDN_LATE; it += 256) {
            const int s = it / (8 * GDN_LATE), rem = it % (8 * GDN_LATE), h = rem / GDN_LATE, c = rem % GDN_LATE;
            const int nit = it + 256; int pf_row = -1, pf_h = 0;
            if (nit < 64 * GDN_LATE) { const int rem2 = nit % (8 * GDN_LATE); pf_row = (nit / (8 * GDN_LATE)) * 2048 + (rem2 % GDN_LATE) * 64; pf_h = rem2 / GDN_LATE; }
            gdn_chunk_item(p, i, s, h, c, pf_row, pf_h, smem);
        }
    } else
    for (int it = mk_lbid(); it < N_CH; it += gridDim.x) {
        int s, h, c;
        if (it < 2048) { s = it >> 8; h = (it >> 5) & 7; c = it & 31; } else { const int k = it - 2048; s = 8 + (k >> 3); h = k & 7; c = 0; }
        const int nit = it + gridDim.x; int pf_row = -1, pf_h = 0;
        if (nit < 2048) { pf_row = (nit >> 8) * 2048 + (nit & 31) * 64; pf_h = (nit >> 5) & 7; }
        gdn_chunk_item(p, i, s, h, c, pf_row, pf_h, smem);
    }
    const bf16_t* ZB = (const bf16_t*)(p.ws + WS_ZB);
    const int gt = mk_lbid() * 512 + mk_ltid(), GT = gridDim.x * 512;
    for (int idx = gt; idx < 136 * 3 * 3072; idx += GT) {
        const int s = idx / (3 * 3072), rem = idx % (3 * 3072), j = rem / 3072, zc = rem % 3072;
        int row0, L; seq_info(s, row0, L);
        const float v = bf2f(ZB[(size_t)(row0 + L - 3 + j) * GD_N + zc]);
        if (s < 8) p.out[O_PCONV + (((size_t)i * 8 + s) * 3 + j) * 3072 + zc] = v;
        else p.out[O_SCONV + (((size_t)i * 128 + (s - 8)) * 3 + j) * 3072 + zc] = v;
    }
}

__device__ __forceinline__ void gdn_scan_item(const Params& p, int i, int s, int h, unsigned* flags, unsigned tag, unsigned char* smem) {
    const int tid = mk_ltid(), lane = tid & 63, w = __builtin_amdgcn_readfirstlane(tid >> 6);
    const int r = lane & 15, q = lane >> 4;
    int row0, L; seq_info(s, row0, L);
    const int nch = (s < 8) ? 32 : 1;
    const bf16_t* ZB = (const bf16_t*)(p.ws + WS_ZB); bf16_t* OMIX = (bf16_t*)(p.ws + WS_OMIX);
    const float* GL = (const float*)(p.ws + WS_GL);
    const float* ng = p.in[31] + i * 128;
    constexpr int LD = 136, VLD = 72, ULD = 132;
    bf16_t* SB = (bf16_t*)smem;
    bf16_t* VN = (bf16_t*)(smem + 34816);
    float* red = (float*)(smem + 53248);
    bf16_t* WL = (bf16_t*)(smem + 53760);
    bf16_t* QGL = (bf16_t*)(smem + 71168);
    bf16_t* QKL = (bf16_t*)(smem + 88576);
    bf16_t* KDL = (bf16_t*)(smem + 97792);
    float* UL = (float*)(smem + 116224);
    f32x4 ST[8];
#pragma unroll
    for (int nt = 0; nt < 8; ++nt) ST[nt] = (f32x4){0.f, 0.f, 0.f, 0.f};
    if (s >= 8) {
        const float* S0 = p.in[6] + (((size_t)i * 128 + (s - 8)) * 8 + h) * 16384;
#pragma unroll
        for (int nt = 0; nt < 8; ++nt) ST[nt] = *(const f32x4*)(S0 + (size_t)(nt * 16 + r) * 128 + 16 * w + q * 4);
    }
    const int mt = w & 3, nh = w >> 2;
    u32x4 pw[2], pq[2], pk, pd[2]; f32x4 pu[4]; float pgl;
    const bool smp = (s >= 8);
#define GDN_PREFETCH(cc) do { const int item_ = gdn_item_index(s, h, (cc)); const unsigned char* rec_ = p.ws + WS_CH + (size_t)item_ * CH_BYTES; \
        const u32x4 z4_ = (u32x4){0u, 0u, 0u, 0u}; \
        _Pragma("unroll") for (int k_ = 0; k_ < 2; ++k_) { const int idx_ = tid + k_ * 512; \
            pw[k_] = (smp && (idx_ >> 4) >= 16) ? z4_ : *(const u32x4*)((const bf16_t*)(rec_ + CH_W) + (idx_ >> 4) * 128 + (idx_ & 15) * 8); \
            pq[k_] = (smp && (idx_ >> 4) >= 16) ? z4_ : *(const u32x4*)((const bf16_t*)(rec_ + CH_QG) + (idx_ >> 4) * 128 + (idx_ & 15) * 8); \
            pd[k_] = (smp && (idx_ & 7) >= 2) ? z4_ : *(const u32x4*)((const bf16_t*)(rec_ + CH_KDT) + (idx_ >> 3) * 64 + (idx_ & 7) * 8); } \
        pk = (smp && (tid >> 3) >= 16) ? z4_ : *(const u32x4*)((const bf16_t*)(rec_ + CH_QK) + (tid >> 3) * 64 + (tid & 7) * 8); \
        _Pragma("unroll") for (int k_ = 0; k_ < 4; ++k_) { const int idx_ = tid + k_ * 512; \
            pu[k_] = (smp && (idx_ >> 5) >= 16) ? (f32x4){0.f, 0.f, 0.f, 0.f} : *(const f32x4*)((const float*)(rec_ + CH_U) + (idx_ >> 5) * 128 + (idx_ & 31) * 4); } \
        pgl = GL[item_]; } while (0)
#define GDN_WAIT(cc) do { if (flags && (cc) >= GDN_LATE) { if (tid == 0) { unsigned* f_ = flags + (s * 8 + h) * 32 + (cc); \
        while (__hip_atomic_load(f_, __ATOMIC_RELAXED, __HIP_MEMORY_SCOPE_AGENT) != tag) __builtin_amdgcn_s_sleep(2); \
        __builtin_amdgcn_fence(__ATOMIC_ACQUIRE, "agent"); asm volatile("s_waitcnt vmcnt(0)" ::: "memory"); } \
        __syncthreads(); } } while (0)
    GDN_PREFETCH(0);
    for (int c = 0; c < nch; ++c) {
        const float glast = pgl;
        const int rb = row0 + c * 64; const int nvalid = (L - c * 64) < 64 ? (L - c * 64) : 64;
#pragma unroll
        for (int k = 0; k < 2; ++k) { const int idx = tid + k * 512;
            *(u32x4*)(WL + (idx >> 4) * LD + (idx & 15) * 8) = pw[k]; *(u32x4*)(QGL + (idx >> 4) * LD + (idx & 15) * 8) = pq[k];
            *(u32x4*)(KDL + (idx >> 3) * VLD + (idx & 7) * 8) = pd[k]; }
        *(u32x4*)(QKL + (tid >> 3) * VLD + (tid & 7) * 8) = pk;
#pragma unroll
        for (int k = 0; k < 4; ++k) { const int idx = tid + k * 512; *(f32x4*)(UL + (idx >> 5) * ULD + (idx & 31) * 4) = pu[k]; }
#pragma unroll
        for (int nt = 0; nt < 8; ++nt)
#pragma unroll
            for (int j = 0; j < 4; ++j) SB[(16 * w + q * 4 + j) * LD + nt * 16 + r] = f2bf(ST[nt][j]);
        __syncthreads();
        if (c + 1 < nch) { GDN_WAIT(c + 1); GDN_PREFETCH(c + 1); }
        bf16_t zgr[4][4];
#pragma unroll
        for (int j = 0; j < 4; ++j) { const int tk = mt * 16 + q * 4 + j; const size_t row = (size_t)(rb + (tk < nvalid ? tk : 0));
#pragma unroll
            for (int n4 = 0; n4 < 4; ++n4) zgr[j][n4] = ZB[row * GD_N + 3088 + h * 128 + (nh * 4 + n4) * 16 + r]; }
        f32x4 aws[4], aqg[4];
#pragma unroll
        for (int n4 = 0; n4 < 4; ++n4) { aws[n4] = (f32x4){0.f, 0.f, 0.f, 0.f}; aqg[n4] = aws[n4]; }
#pragma unroll
        for (int ks = 0; ks < 4; ++ks) {
            const bf16x8 fw = *(const bf16x8*)(WL + (mt * 16 + r) * LD + ks * 32 + q * 8);
            const bf16x8 fq = *(const bf16x8*)(QGL + (mt * 16 + r) * LD + ks * 32 + q * 8);
#pragma unroll
            for (int n4 = 0; n4 < 4; ++n4) {
                const bf16x8 bs = *(const bf16x8*)(SB + ((nh * 4 + n4) * 16 + r) * LD + ks * 32 + q * 8);
                aws[n4] = __builtin_amdgcn_mfma_f32_16x16x32_bf16(fw, bs, aws[n4], 0, 0, 0);
                aqg[n4] = __builtin_amdgcn_mfma_f32_16x16x32_bf16(fq, bs, aqg[n4], 0, 0, 0);
            }
        }
#pragma unroll
        for (int n4 = 0; n4 < 4; ++n4) {
            const int dv = (nh * 4 + n4) * 16 + r;
            float vn[4];
#pragma unroll
            for (int j = 0; j < 4; ++j) vn[j] = UL[(mt * 16 + q * 4 + j) * ULD + dv] - aws[n4][j];
            u32x2 o; o.x = pk2(vn[0], vn[1]); o.y = pk2(vn[2], vn[3]);
            *(u32x2*)(VN + dv * VLD + mt * 16 + q * 4) = o;
        }
        __syncthreads();
#pragma unroll
        for (int ks = 0; ks < 2; ++ks) {
            const bf16x8 fk = *(const bf16x8*)(QKL + (mt * 16 + r) * VLD + ks * 32 + q * 8);
#pragma unroll
            for (int n4 = 0; n4 < 4; ++n4) {
                const bf16x8 bv = *(const bf16x8*)(VN + ((nh * 4 + n4) * 16 + r) * VLD + ks * 32 + q * 8);
                aqg[n4] = __builtin_amdgcn_mfma_f32_16x16x32_bf16(fk, bv, aqg[n4], 0, 0, 0);
            }
        }
        {
            float ssq[4];
#pragma unroll
            for (int j = 0; j < 4; ++j) { float a = 0.f;
#pragma unroll
                for (int n4 = 0; n4 < 4; ++n4) a += aqg[n4][j] * aqg[n4][j];
                ssq[j] = row16_sum(a); }
            if (r == 0) {
#pragma unroll
                for (int j = 0; j < 4; ++j) red[(mt * 16 + q * 4 + j) * 2 + nh] = ssq[j];
            }
        }
#pragma unroll
        for (int nt = 0; nt < 8; ++nt) ST[nt] = ST[nt] * glast;
#pragma unroll
        for (int ks = 0; ks < 2; ++ks) {
            const bf16x8 av = *(const bf16x8*)(VN + (16 * w + r) * VLD + ks * 32 + q * 8);
#pragma unroll
            for (int nt = 0; nt < 8; ++nt) {
                const bf16x8 bk = *(const bf16x8*)(KDL + (nt * 16 + r) * VLD + ks * 32 + q * 8);
                ST[nt] = __builtin_amdgcn_mfma_f32_16x16x32_bf16(av, bk, ST[nt], 0, 0, 0);
            }
        }
        __syncthreads();
#pragma unroll
        for (int j = 0; j < 4; ++j) {
            const int tk = mt * 16 + q * 4 + j;
            if (tk < nvalid) {
                const float rs = rsqrtf((red[tk * 2] + red[tk * 2 + 1]) * (1.f / 128.f) + 1e-6f);
                const size_t row = (size_t)(rb + tk);
#pragma unroll
                for (int n4 = 0; n4 < 4; ++n4) { const int dv = (nh * 4 + n4) * 16 + r;
                    OMIX[row * 1024 + h * 128 + dv] = f2bf(aqg[n4][j] * rs * ng[dv] * silu(bf2f(zgr[j][n4]))); }
            }
        }
    }
#undef GDN_PREFETCH
#undef GDN_WAIT
    float* so = (s < 8) ? p.out + O_PGDN + (((size_t)i * 8 + s) * 8 + h) * 16384 : p.out + O_SGDN + (((size_t)i * 128 + (s - 8)) * 8 + h) * 16384;
#pragma unroll
    for (int nt = 0; nt < 8; ++nt) *(f32x4*)(so + (size_t)(nt * 16 + r) * 128 + 16 * w + q * 4) = ST[nt];
    __syncthreads();
}

__device__ __forceinline__ void phase_gdn_scan(const Params& p, int i, int l, unsigned char* smem) {
    const int bid = mk_lbid(), G = gridDim.x; const int wv = mk_ltid() >> 6;
    if (G == 256) {
        unsigned* flags = (unsigned*)(p.ws + WS_FLAGS); const unsigned tag = (unsigned)(i + 1);
        if (bid < 64) gdn_scan_item(p, i, bid >> 3, bid & 7, flags, tag, smem);
        else {
            for (int j = bid - 64; j < 64 * (32 - GDN_LATE); j += 192) {
                const int c = GDN_LATE + (j >> 6), sh = j & 63;
                gdn_chunk_item(p, i, sh >> 3, sh & 7, c, -1, 0, smem);
                if (mk_ltid() == 0) { __builtin_amdgcn_fence(__ATOMIC_RELEASE, "agent"); asm volatile("s_waitcnt vmcnt(0)" ::: "memory");
                    __hip_atomic_store(&flags[sh * 32 + c], tag, __ATOMIC_RELAXED, __HIP_MEMORY_SCOPE_AGENT); }
            }
            for (int it = bid - 64; it < 128 * 8; it += 192) { gdn_chunk_item(p, i, 8 + (it >> 3), it & 7, 0, -1, 0, smem); gdn_scan_item(p, i, 8 + (it >> 3), it & 7, nullptr, 0u, smem); }
            convert_ffn_ahead(p, l, (bid - 64) * 8 + wv, 192 * 8, smem);
        }
    } else {
        for (int it = bid; it < 136 * 8; it += G) { const int s = it >> 3, h = it & 7; gdn_scan_item(p, i, s, h, nullptr, 0u, smem); }
        convert_ffn_ahead(p, l, bid * 8 + wv, G * 8, smem);
    }
}

__global__ void __launch_bounds__(512, 2) mega(Params p) {
    extern __shared__ __attribute__((aligned(16))) unsigned char lds[];
    cg::grid_group grid = cg::this_grid();
    constexpr int NPH = 1 + 4 * 12;
    unsigned* bar = (unsigned*)(p.ws + WS_BAR);
    volatile unsigned* bst = (volatile unsigned*)(lds + LDS_BYTES - 16);
    if (mk_ltid() == 0) { bst[0] = 0u; bst[1] = 0u; }
    if (mk_lbid() == 0) for (int u = mk_ltid(); u < CTL_WORDS; u += 512) __hip_atomic_store(bar + u, 0u, __ATOMIC_RELAXED, __HIP_MEMORY_SCOPE_AGENT);
    __syncthreads();
#pragma unroll 1
    for (int ph = 0; ph < NPH; ++ph) {
        int l = (ph == 0) ? 0 : (ph - 1) / 12, k = (ph == 0) ? -1 : (ph - 1) % 12;
        asm volatile("" : "+s"(l), "+s"(k));
        const int i = l >> 1; const bool ab = (l & 1) == 0;
        if (k == 6 && !ab) continue;
        unsigned char* ws = p.ws; asm volatile("" : "+s"(ws));
        unsigned char* smem = (unsigned char*)lds;
        PG8_LAS unsigned char* ldsp = (PG8_LAS unsigned char*)lds;
        const int G = gridDim.x, cu = mk_lbid();
#ifndef REPMASK
#define REPMASK 0
#endif
#ifndef REPAB
#define REPAB 3
#endif
        const int nrep = (((REPMASK >> (k + 1)) & 1) && ((REPAB >> (l & 1)) & 1)) ? 2 : 1;
#pragma unroll 1
        for (int rep = 0; rep < nrep; ++rep) {
        if (rep) grid.sync();
        if (k == -1) phase_start(p, smem);
        else if (k == 0 || k == 9) {
            const int j = (k == 9);
            pg8::Gemm g{(const bf16_t*)(ws + WS_HB), (const bf16_t*)(ws + WS_WGU) + (size_t)j * 5632 * 1024, M, 5632, D};
            pg8::StaticOrder S; S.init(g.M, g.N, G, cu); EpiSwiglu E{(bf16_t*)(ws + WS_HID)};
            pg8::gemm_phase<EpiSwiglu, pg8::StaticOrder, true, true>(ldsp, g, S, E);
        } else if (k == 1 || k == 10 || k == 7) {
            const int j = (k == 10);
            pg8::Gemm g{(const bf16_t*)(ws + (k == 7 ? WS_OMIX : WS_HID)), k == 7 ? (const bf16_t*)(ws + WS_WOUT) : (const bf16_t*)(ws + WS_WD) + (size_t)j * 1024 * 2816, MP, D, k == 7 ? D : FF};
            pg8::StaticOrder S; S.init(g.M, g.N, G, cu); EpiResid E{(bf16_t*)(ws + WS_X), (const bf16_t*)(ws + WS_HB), k == 7 ? 1.0f : 0.5f};
            pg8::gemm_phase<EpiResid, pg8::StaticOrder, true, true>(ldsp, g, S, E);
            small_resid_gemm(g.A, g.Bt, g.K, E.X, E.H, E.scale, smem);
        } else if (k == 2 || k == 8 || k == 11) {
            phase_ln(p, l, k == 2 ? 0 : (k == 8 ? 1 : 2), (l == 3 && k == 11));
            if (k == 11 && l < 3) convert_items(p, l + 1, 4, mk_lbid() * 8 + (mk_ltid() >> 6), gridDim.x * 8, smem);
        } else if (k == 3) {
            pg8::Gemm g{(const bf16_t*)(ws + WS_HB), (const bf16_t*)(ws + WS_WIN), M, ab ? AB_N : GD_N, D};
            pg8::StaticOrder S; S.init(g.M, g.N, G, cu); EpiZ E{(bf16_t*)(ws + WS_ZB), g.N};
            pg8::gemm_phase<EpiZ, pg8::StaticOrder, true, true>(ldsp, g, S, E);
        } else if (k == 4) { if (ab) phase_ab_prep(p, i, smem); else phase_gdn_chunk(p, i, smem); }
        else if (k == 5) { if (ab) phase_ab_core(p, i, l, smem); else phase_gdn_scan(p, i, l, smem); }
        else if (k == 6) phase_ab_post(p, i);
        }
        if (ph + 1 < NPH) { if (ph == 0) { grid.sync(); if (mk_ltid() == 0) (void)xb_add(&bar[XB_XCNT(xb_xcc_id())], 1u); } else gbar(bar, bst); }
#ifdef REPSYNC
        if (ph > 0) { gbar(bar, bst); gbar(bar, bst); }
#endif
    }
}
}

extern "C" void kernel_launch(void* const* d_in, const int* in_sizes, int n_in, void* d_out, int out_size, void* d_ws, size_t ws_size, hipStream_t stream) {
    static int grid_blocks = 0;
    if (grid_blocks == 0) {
        if (n_in != 33 || ws_size < mk::WS_NEED) { fprintf(stderr, "kernel_launch: need 33 inputs and %zu bytes of workspace; got %d, %zu\n", (size_t)mk::WS_NEED, n_in, ws_size); grid_blocks = -1; return; }
        int dev = 0, cus = 0, per_cu = 0;
        hipGetDevice(&dev);
        hipDeviceGetAttribute(&cus, hipDeviceAttributeMultiprocessorCount, dev);
        if (hipFuncSetAttribute((const void*)mk::mega, hipFuncAttributeMaxDynamicSharedMemorySize, mk::LDS_BYTES) != hipSuccess) { fprintf(stderr, "kernel_launch: hipFuncSetAttribute failed\n"); grid_blocks = -1; return; }
        if (hipOccupancyMaxActiveBlocksPerMultiprocessor(&per_cu, (const void*)mk::mega, 512, mk::LDS_BYTES) != hipSuccess || per_cu < 1) { fprintf(stderr, "kernel_launch: occupancy query failed (%d)\n", per_cu); (void)hipGetLastError(); per_cu = 1; }
        grid_blocks = cus * 1;
        fprintf(stderr, "kernel_launch: grid %d (cus %d, per_cu %d)\n", grid_blocks, cus, per_cu);
    }
    if (grid_blocks < 0) return;
    mk::Params prm{};
    for (int k = 0; k < 33; ++k) prm.in[k] = (const float*)d_in[k];
    prm.out = (float*)d_out; prm.ws = (unsigned char*)d_ws;
    void* args[] = {&prm};
    hipError_t e = hipLaunchCooperativeKernel((const void*)mk::mega, dim3(grid_blocks), dim3(512), args, mk::LDS_BYTES, stream);
    if (e != hipSuccess) fprintf(stderr, "cooperative launch failed: %s (grid %d)\n", hipGetErrorString(e), grid_blocks);
}
```

```cpp
#include <hip/hip_runtime.h>
#include <hip/hip_cooperative_groups.h>
#include <cstdio>
#include <cstdint>
namespace cg = cooperative_groups;
__device__ __forceinline__ int mk_ltid() { int t = threadIdx.x; asm volatile("" : "+v"(t)); return t; }
__device__ __forceinline__ int mk_lbid() { int t = blockIdx.x; asm volatile("" : "+s"(t)); return t; }
namespace pg8 {
#define PG8_LAS __attribute__((address_space(3)))
typedef unsigned short bf16_t;
typedef short bf16x8 __attribute__((ext_vector_type(8)));
typedef float f32x4 __attribute__((ext_vector_type(4)));
typedef unsigned u32x4 __attribute__((ext_vector_type(4)));
constexpr int BM = 256, BK = 64, HALF = 128, HTB = HALF * BK * 2  , STAGE_BYTES = 8 * HTB, NXCD = 8, WGM = 8;

__host__ __device__ __forceinline__ int lds_byte(int r, int c) { const int st = (r >> 4) * 2 + (c >> 5), rr = r & 15, cc = c & 31, ob = rr * 64 + cc * 2; return st * 1024 + (ob ^ (((ob >> 9) & 1) << 5)); }
__host__ __device__ __forceinline__ void stage_rc(int b, int& R, int& C) { const int st = b / 1024, sb = b % 1024, swz = sb ^ (((sb >> 9) & 1) << 5); R = (st >> 1) * 16 + swz / 64; C = (st & 1) * 32 + (swz % 64) / 2; }
__host__ __device__ __forceinline__ int perm32(int rho) { const int n = rho >> 4, i = rho & 15; return 8 * (i >> 2) + 4 * n + (i & 3); }

struct Unit { int pm, pn; };
struct Gemm { const bf16_t* A; const bf16_t* Bt; int M, N, K; };

struct StaticOrder {
    int nM, nN, nwg, G, c;
    __host__ __device__ void init(int M, int N, int G_, int c_) { nM = M / BM; nN = N / BM; nwg = nM * nN; G = G_; c = c_; }
    __host__ __device__ bool next(int i, Unit& u) const {
        const long L = (long)i * G + c; if (L >= nwg) return false;
        int wgid = (int)L; { const int q = nwg / NXCD, r = nwg % NXCD, xcd = wgid % NXCD, off = wgid / NXCD; wgid = (xcd < r ? xcd * (q + 1) : r * (q + 1) + (xcd - r) * q) + off; }
        const int nig = WGM * nN, gid = wgid / nig, fm = gid * WGM, gsz = (nM - fm) < WGM ? (nM - fm) : WGM;
        u.pm = fm + ((wgid % nig) % gsz); u.pn = (wgid % nig) / gsz; return true;
    }
    __device__ __forceinline__ void a_ready(const Unit&) const {}
    __device__ __forceinline__ void done(const Unit&) const {}
};

template <class Epi, class Sched, bool ALIGN_EPI = false, bool SP2 = false>
__device__ __forceinline__ void gemm_phase(PG8_LAS unsigned char* lds, const Gemm g, const Sched& S, const Epi& E) {
    const int tid = mk_ltid(), wid = __builtin_amdgcn_readfirstlane(tid >> 6), lane = tid & 63, wr = wid >> 2, wc = wid & 3, fr = lane & 15, fq = lane >> 4;
    const int K = g.K, nt = K / BK;
    unsigned voffA[2], voffB[2];
#pragma unroll
    for (int i = 0; i < 2; ++i) { int R, C; stage_rc(tid * 16 + i * 8192, R, C); const int Rb = Epi::PERM ? ((R & ~31) + perm32(R & 31)) : R;
        voffA[i] = (unsigned)(R * K + C) * 2u; voffB[i] = (unsigned)(Rb * K + C) * 2u; }
    const size_t kstep = (size_t)(BK * 2);
    const size_t hstep = (size_t)HALF * K * 2;
    const size_t tstep = 2 * hstep;
    const unsigned ldsw = (unsigned)wid * 1024u;
    const int aoff = lds_byte(wr * 64 + fr, fq * 8), boff = lds_byte(wc * 32 + fr, fq * 8);
#define PG8_SA(b, h) (((b) * 2 + (h)) * HTB)
#define PG8_SB(b, h) ((4 + (b) * 2 + (h)) * HTB)
#define PG8_STAGE(bufoff, gbase, voff) do { _Pragma("unroll") for (int _i = 0; _i < 2; ++_i) \
        __builtin_amdgcn_global_load_lds((const unsigned*)((const char*)(gbase) + (voff)[_i]), (PG8_LAS unsigned*)(lds + (bufoff) + ldsw + _i * 8192), 16, 0, 0); } while (0)
#define PG8_LDA(dst, b, h) do { _Pragma("unroll") for (int m = 0; m < 4; ++m) _Pragma("unroll") for (int k = 0; k < 2; ++k) dst[m][k] = *(const PG8_LAS bf16x8*)(lds + PG8_SA(b, h) + aoff + m * 2048 + k * 1024); } while (0)
#define PG8_LDB(dst, b, h) do { _Pragma("unroll") for (int n = 0; n < 2; ++n) _Pragma("unroll") for (int k = 0; k < 2; ++k) dst[n][k] = *(const PG8_LAS bf16x8*)(lds + PG8_SB(b, h) + boff + n * 2048 + k * 1024); } while (0)
#define PG8_MMA(ai, bj, At, Bt) do { __builtin_amdgcn_s_setprio(1); _Pragma("unroll") for (int m = 0; m < 4; ++m) _Pragma("unroll") for (int n = 0; n < 2; ++n) _Pragma("unroll") for (int k = 0; k < 2; ++k) \
        acc[ai][bj][m][n] = __builtin_amdgcn_mfma_f32_16x16x32_bf16(Bt[n][k], At[m][k], acc[ai][bj][m][n], 0, 0, 0); __builtin_amdgcn_s_setprio(0); } while (0)
#define PG8_WAIT_V(n) asm volatile("s_waitcnt vmcnt(" #n ")" ::: "memory")
#define PG8_WAIT_L(n) asm volatile("s_waitcnt lgkmcnt(" #n ")" ::: "memory")
#define PG8_BAR __builtin_amdgcn_s_barrier()
#define PG8_SCHED __builtin_amdgcn_sched_barrier(0)
    Unit cur, nxt; int ui = 0;
    if (!S.next(0, cur)) return;
    f32x4 acc[2][2][4][2];
#pragma unroll
    for (int a = 0; a < 2; ++a)
#pragma unroll
        for (int b = 0; b < 2; ++b)
#pragma unroll
            for (int m = 0; m < 4; ++m)
#pragma unroll
                for (int n = 0; n < 2; ++n) acc[a][b][m][n] = (f32x4){0.f, 0.f, 0.f, 0.f};
    bf16x8 At[4][2], B0[2][2], B1[2][2];
    const char* cA = (const char*)g.A + (size_t)cur.pm * tstep; const char* cB = (const char*)g.Bt + (size_t)cur.pn * tstep;
    S.a_ready(cur);
    if constexpr (SP2) {
        PG8_STAGE(PG8_SB(0, 0), cB, voffB); PG8_STAGE(PG8_SB(0, 1), cB + hstep, voffB); PG8_STAGE(PG8_SA(0, 0), cA, voffA); PG8_STAGE(PG8_SA(0, 1), cA + hstep, voffA);
        if (wr == 1) PG8_BAR;
        PG8_WAIT_V(2); PG8_BAR;
        PG8_STAGE(PG8_SB(1, 0), cB + kstep, voffB); PG8_STAGE(PG8_SA(1, 0), cA + kstep, voffA); PG8_STAGE(PG8_SB(1, 1), cB + hstep + kstep, voffB);
        PG8_WAIT_V(6); PG8_BAR;
    } else {
        PG8_STAGE(PG8_SB(0, 0), cB, voffB); PG8_STAGE(PG8_SA(0, 0), cA, voffA); PG8_STAGE(PG8_SB(0, 1), cB + hstep, voffB); PG8_STAGE(PG8_SA(0, 1), cA + hstep, voffA);
        if (wr == 1) PG8_BAR;
        PG8_WAIT_V(4); PG8_BAR;
        PG8_STAGE(PG8_SB(1, 0), cB + kstep, voffB); PG8_STAGE(PG8_SA(1, 0), cA + kstep, voffA); PG8_STAGE(PG8_SB(1, 1), cB + hstep + kstep, voffB);
        PG8_WAIT_V(6); PG8_BAR;
    }
    for (;;) {
        const bool has_next = S.next(ui + 1, nxt);
        const char* nA = has_next ? (const char*)g.A + (size_t)nxt.pm * tstep : cA; const char* nB = has_next ? (const char*)g.Bt + (size_t)nxt.pn * tstep : cB;
        for (int t = 0; t < nt; t += 2) {
            const bool last = (t == nt - 2);
            const char* a1 = cA + (size_t)(t + 1) * kstep;
            const char* a2 = last ? nA : cA + (size_t)(t + 2) * kstep; const char* b2 = last ? nB : cB + (size_t)(t + 2) * kstep;
            const char* a3 = a2 + kstep; const char* b3 = b2 + kstep;
            if (last && has_next) S.a_ready(nxt);
            if constexpr (SP2) {
            PG8_LDB(B0, 0, 0); PG8_LDB(B1, 0, 1); PG8_SCHED; PG8_LDA(At, 0, 0); PG8_STAGE(PG8_SA(1, 1), a1 + hstep, voffA);
            PG8_WAIT_V(8); PG8_WAIT_L(0); PG8_BAR; PG8_MMA(0, 0, At, B0); PG8_MMA(0, 1, At, B1); PG8_BAR; PG8_SCHED;
            PG8_LDA(At, 0, 1); PG8_STAGE(PG8_SB(0, 0), b2, voffB); PG8_STAGE(PG8_SB(0, 1), b2 + hstep, voffB); PG8_STAGE(PG8_SA(0, 0), a2, voffA);
            PG8_WAIT_V(8); PG8_WAIT_L(0); PG8_BAR; PG8_MMA(1, 0, At, B0); PG8_MMA(1, 1, At, B1); PG8_BAR; PG8_SCHED;
            PG8_LDB(B0, 1, 0); PG8_LDB(B1, 1, 1); PG8_SCHED; PG8_LDA(At, 1, 0); PG8_STAGE(PG8_SA(0, 1), a2 + hstep, voffA);
            PG8_WAIT_V(8); PG8_WAIT_L(0); PG8_BAR; PG8_MMA(0, 0, At, B0); PG8_MMA(0, 1, At, B1); PG8_BAR; PG8_SCHED;
            PG8_LDA(At, 1, 1); PG8_STAGE(PG8_SB(1, 0), b3, voffB); PG8_STAGE(PG8_SB(1, 1), b3 + hstep, voffB); PG8_STAGE(PG8_SA(1, 0), a3, voffA);
            PG8_WAIT_V(8); PG8_WAIT_L(0); PG8_BAR; PG8_MMA(1, 0, At, B0); PG8_MMA(1, 1, At, B1); PG8_BAR; PG8_SCHED;
            } else {
            PG8_LDB(B0, 0, 0); PG8_SCHED; PG8_LDA(At, 0, 0); PG8_STAGE(PG8_SA(1, 1), a1 + hstep, voffA);
            PG8_WAIT_L(8); PG8_BAR; PG8_WAIT_L(0); PG8_MMA(0, 0, At, B0); PG8_BAR; PG8_SCHED;
            PG8_LDB(B1, 0, 1); PG8_STAGE(PG8_SB(0, 0), b2, voffB);
            PG8_BAR; PG8_WAIT_L(0); PG8_MMA(0, 1, At, B1); PG8_BAR;
            PG8_LDA(At, 0, 1); PG8_STAGE(PG8_SA(0, 0), a2, voffA);
            PG8_BAR; PG8_WAIT_L(0); PG8_MMA(1, 0, At, B0); PG8_BAR; PG8_SCHED;
            PG8_STAGE(PG8_SB(0, 1), b2 + hstep, voffB);
            PG8_WAIT_V(6); PG8_BAR; PG8_MMA(1, 1, At, B1); PG8_BAR;
            PG8_LDB(B0, 1, 0); PG8_SCHED; PG8_LDA(At, 1, 0); PG8_STAGE(PG8_SA(0, 1), a2 + hstep, voffA);
            PG8_WAIT_L(8); PG8_BAR; PG8_WAIT_L(0); PG8_MMA(0, 0, At, B0); PG8_BAR; PG8_SCHED;
            PG8_LDB(B1, 1, 1); PG8_STAGE(PG8_SB(1, 0), b3, voffB);
            PG8_BAR; PG8_WAIT_L(0); PG8_MMA(0, 1, At, B1); PG8_BAR;
            PG8_LDA(At, 1, 1); PG8_STAGE(PG8_SA(1, 0), a3, voffA);
            PG8_BAR; PG8_WAIT_L(0); PG8_MMA(1, 0, At, B0); PG8_BAR; PG8_SCHED;
            PG8_STAGE(PG8_SB(1, 1), b3 + hstep, voffB);
            PG8_WAIT_V(6); PG8_BAR; PG8_MMA(1, 1, At, B1); PG8_BAR;
            }
        }
        if constexpr (ALIGN_EPI) { if (wr == 0) PG8_BAR; }
        if constexpr (!Epi::AFTER_DRAIN) { E(acc, cur, wr, wc, fr, fq); S.done(cur); }
        if (!has_next) break;
#pragma unroll
        for (int a = 0; a < 2; ++a)
#pragma unroll
            for (int b = 0; b < 2; ++b)
#pragma unroll
                for (int m = 0; m < 4; ++m)
#pragma unroll
                    for (int n = 0; n < 2; ++n) acc[a][b][m][n] = (f32x4){0.f, 0.f, 0.f, 0.f};
        cur = nxt; cA = nA; cB = nB; ++ui;
        if constexpr (ALIGN_EPI) { if (wr == 1) PG8_BAR; }
    }
    PG8_WAIT_V(0);
    if constexpr (!ALIGN_EPI) { if (wr == 0) PG8_BAR; }
    PG8_BAR;
    if constexpr (Epi::AFTER_DRAIN) { E.fused(acc, cur, wr, wc, fr, fq, lds, wid, lane); S.done(cur); }
#undef PG8_SA
#undef PG8_SB
#undef PG8_STAGE
#undef PG8_LDA
#undef PG8_LDB
#undef PG8_MMA
#undef PG8_WAIT_V
#undef PG8_WAIT_L
#undef PG8_BAR
#undef PG8_SCHED
}
}

namespace mk {
using pg8::bf16_t; using pg8::bf16x8; using pg8::f32x4; using pg8::Unit;
typedef unsigned u32x4 __attribute__((ext_vector_type(4)));
typedef unsigned u32x2 __attribute__((ext_vector_type(2)));

constexpr int M = 16896, MP = 16384, D = 1024, FF = 2816;
constexpr int AB_N = 3840, GD_N = 4352, GD_NREAL = 4112;
constexpr float ALPHA = 1.6817928305074290f;
constexpr int LDS_BYTES = 163840;

constexpr size_t O_PSHIFT = 17301504, O_PRWKV = 17330176, O_PRET = 17854464, O_PCONV = 18903040, O_PGDN = 19050496;
constexpr size_t O_SSHIFT = 21147648, O_SRWKV = 21606400, O_SRET = 29995008, O_SCONV = 46772224, O_SGDN = 49131520;

constexpr size_t WS_WGU = 0;
constexpr size_t WS_WD = WS_WGU + 2ull * 5632 * 1024 * 2;
constexpr size_t WS_WIN = WS_WD + 2ull * 1024 * 2816 * 2;
constexpr size_t WS_WOUT = WS_WIN + 4352ull * 1024 * 2;
constexpr size_t WS_W2T = WS_WOUT + 1024ull * 1024 * 2;
constexpr size_t WS_A2T = WS_W2T + 65536;
constexpr size_t WS_G2T = WS_A2T + 65536;
constexpr size_t WS_X = WS_G2T + 131072;
constexpr size_t WS_HB = WS_X + (size_t)M * 1024 * 4;
constexpr size_t WS_S = WS_HB + (size_t)M * 1024 * 2;
constexpr size_t WS_HID = WS_S;
constexpr size_t WS_OMIX = WS_S;
constexpr size_t WS_ZB = WS_OMIX + (size_t)M * 1024 * 2;
constexpr size_t WS_OPS = WS_ZB + (size_t)M * AB_N * 2;
constexpr size_t WS_GATE = WS_OPS + (size_t)M * 3072 * 4;
constexpr size_t WS_ORAW = WS_GATE + (size_t)M * 512 * 4;
constexpr size_t WS_BONUS = WS_ORAW + (size_t)M * 512 * 4;
constexpr size_t WS_RQ = WS_BONUS + (size_t)M * 8 * 4;
constexpr size_t WS_RK = WS_RQ + (size_t)M * 512 * 2;
constexpr size_t WS_AB_END = WS_RK + (size_t)M * 512 * 2;
constexpr size_t WS_CH = WS_ZB + (size_t)M * GD_N * 2;
constexpr size_t CH_U = 0, CH_W = 32768, CH_QG = 49152, CH_QK = 65536, CH_KDT = 73728, CH_BYTES = 90112;
constexpr int N_CH = 2048 + 1024;
constexpr size_t WS_GL = WS_CH + (size_t)N_CH * CH_BYTES;
constexpr size_t WS_GD_END = WS_GL + N_CH * 4;
constexpr size_t WS_BAR = ((WS_AB_END > WS_GD_END ? WS_AB_END : WS_GD_END) + 255) / 256 * 256;
constexpr size_t WS_FLAGS = WS_BAR + 16384;
constexpr int CTL_WORDS = (16384 + 8192) / 4;
constexpr size_t WS_NEED = WS_FLAGS + 8192;
constexpr int GDN_LATE = 28;

struct Params { const float* in[33]; float* out; unsigned char* ws; };

__device__ __forceinline__ float bf2f(bf16_t h) { return __uint_as_float(((unsigned)h) << 16); }
__device__ __forceinline__ unsigned pk2(float lo, float hi) { unsigned r; asm volatile("v_cvt_pk_bf16_f32 %0, %1, %2" : "=v"(r) : "v"(lo), "v"(hi)); return r; }
__device__ __forceinline__ bf16_t f2bf(float x) { return (bf16_t)(pk2(x, 0.f) & 0xffffu); }
__device__ __forceinline__ float sigm(float x) { return __builtin_amdgcn_rcpf(1.f + __expf(-x)); }
__device__ __forceinline__ float silu(float x) { return x * __builtin_amdgcn_rcpf(1.f + __expf(-x)); }
__device__ __forceinline__ float dppf(float v, const int ctrl_sel) {
    int x = __builtin_bit_cast(int, v), y;
    if (ctrl_sel == 0) y = __builtin_amdgcn_update_dpp(0, x, 0xB1, 0xF, 0xF, true);
    else if (ctrl_sel == 1) y = __builtin_amdgcn_update_dpp(0, x, 0x4E, 0xF, 0xF, true);
    else if (ctrl_sel == 2) y = __builtin_amdgcn_update_dpp(0, x, 0x141, 0xF, 0xF, true);
    else y = __builtin_amdgcn_update_dpp(0, x, 0x140, 0xF, 0xF, true);
    return __builtin_bit_cast(float, y);
}
__device__ __forceinline__ float row16_sum(float v) { v += dppf(v, 0); v += dppf(v, 1); v += dppf(v, 2); v += dppf(v, 3); return v; }
__device__ __forceinline__ float wave_sum(float v) {
#pragma unroll
    for (int o = 1; o < 64; o <<= 1) v += __shfl_xor(v, o);
    return v;
}
#define XB_XCNT(j)  (256  + 64 * (j))
#define XB_XSUB(j)  (1280 + 64 * (j))
#define XB_XGEN(j)  (2304 + 64 * (j))
#define XB_TOP      3328
#define XB_TOPGEN   3392
#define XCD_BAR_WORDS 3456
__device__ __forceinline__ unsigned xb_ld(unsigned* p)              { return __hip_atomic_load(p, __ATOMIC_RELAXED, __HIP_MEMORY_SCOPE_AGENT); }
__device__ __forceinline__ unsigned xb_add(unsigned* p, unsigned v) { return __hip_atomic_fetch_add(p, v, __ATOMIC_RELAXED, __HIP_MEMORY_SCOPE_AGENT); }
__device__ __forceinline__ unsigned xb_xcc_id() { return (unsigned)__builtin_amdgcn_s_getreg((3 << 11) | 20) & 0xFu; }
__device__ __forceinline__ void gbar(unsigned* bar, volatile unsigned* st) {
    asm volatile("s_waitcnt vmcnt(0)" ::: "memory");
    __syncthreads();
    if (mk_ltid() == 0) {
        __builtin_amdgcn_s_waitcnt(0);
        const unsigned x = xb_xcc_id();
        unsigned nloc = st[0], nx = st[1];
        if (nloc == 0u) {
            const unsigned G = gridDim.x;
            unsigned sum, cnt, mine;
            for (;;) {
                sum = 0u; cnt = 0u; mine = 0u;
#pragma unroll
                for (unsigned j = 0; j < 16; ++j) { const unsigned c = xb_ld(&bar[XB_XCNT(j)]); sum += c; cnt += (c > 0u) ? 1u : 0u; mine = (j == x) ? c : mine; }
                if (sum == G) break;
                __builtin_amdgcn_s_sleep(1);
            }
            nloc = mine > 0u ? mine : 1u; nx = cnt > 0u ? cnt : 1u; st[0] = nloc; st[1] = nx;
        }
        const unsigned old = xb_add(&bar[XB_XSUB(x)], 1u);
        const unsigned gen = old / nloc;
        if (old + 1u == (gen + 1u) * nloc) {
            __builtin_amdgcn_fence(__ATOMIC_RELEASE, "agent");
            asm volatile("s_waitcnt vmcnt(0)" ::: "memory");
            const unsigned og = xb_add(&bar[XB_TOP], 1u);
            const unsigned tg = og / nx;
            if (og + 1u == (tg + 1u) * nx) xb_add(&bar[XB_TOPGEN], 1u);
            else while (xb_ld(&bar[XB_TOPGEN]) == tg) __builtin_amdgcn_s_sleep(1);
            __builtin_amdgcn_fence(__ATOMIC_ACQUIRE, "agent");
            xb_add(&bar[XB_XGEN(x)], 1u);
            asm volatile("s_waitcnt vmcnt(0)" ::: "memory");
        } else {
            while (xb_ld(&bar[XB_XGEN(x)]) == gen) __builtin_amdgcn_s_sleep(1);
            __builtin_amdgcn_fence(__ATOMIC_ACQUIRE, "agent");
            asm volatile("s_waitcnt vmcnt(0)" ::: "memory");
        }
    }
    __syncthreads();
}
__device__ __forceinline__ void seq_info(int s, int& row0, int& L) { if (s < 8) { row0 = s * 2048; L = 2048; } else { row0 = MP + (s - 8) * 4; L = 4; } }

struct EpiSwiglu { static constexpr bool PERM = true, AFTER_DRAIN = false; bf16_t* O;
    __device__ __forceinline__ void operator()(const f32x4 (&acc)[2][2][4][2], const Unit& u, int wr, int wc, int fr, int fq) const {
        const int row0 = u.pm * 256 + wr * 64 + fr, col0 = u.pn * 128 + wc * 32 + 8 * fq;
#pragma unroll
        for (int ai = 0; ai < 2; ++ai)
#pragma unroll
            for (int m = 0; m < 4; ++m) {
                bf16_t* rp = O + (size_t)(row0 + ai * 128 + m * 16) * FF + col0;
                const f32x4 g0 = acc[ai][0][m][0], g1 = acc[ai][0][m][1], u0 = acc[ai][1][m][0], u1 = acc[ai][1][m][1];
                u32x4 w;
                w.x = pk2(silu(g0[0]) * u0[0], silu(g0[1]) * u0[1]); w.y = pk2(silu(g0[2]) * u0[2], silu(g0[3]) * u0[3]);
                w.z = pk2(silu(g1[0]) * u1[0], silu(g1[1]) * u1[1]); w.w = pk2(silu(g1[2]) * u1[2], silu(g1[3]) * u1[3]);
                *(u32x4*)rp = w;
            }
    }
};
struct EpiResid { static constexpr bool PERM = true, AFTER_DRAIN = false; bf16_t* X; const bf16_t* H; float scale;
    __device__ __forceinline__ void operator()(const f32x4 (&acc)[2][2][4][2], const Unit& u, int wr, int wc, int fr, int fq) const {
        const int row0 = u.pm * 256 + wr * 64 + fr, col0 = u.pn * 256 + wc * 32 + 8 * fq;
#pragma unroll
        for (int ai = 0; ai < 2; ++ai)
#pragma unroll
            for (int m = 0; m < 4; ++m)
#pragma unroll
                for (int bj = 0; bj < 2; ++bj)
#pragma unroll
                    for (int n = 0; n < 2; ++n) {
                        const size_t off = (size_t)(row0 + ai * 128 + m * 16) * D + col0 + bj * 128 + 4 * n;
                        const u32x2 hu = *(const u32x2*)(H + off);
                        f32x4 x; x[0] = __uint_as_float(hu.x << 16); x[1] = __uint_as_float(hu.x & 0xffff0000u); x[2] = __uint_as_float(hu.y << 16); x[3] = __uint_as_float(hu.y & 0xffff0000u);
                        x = x * ALPHA + acc[ai][bj][m][n] * scale; u32x2 xo; xo.x = pk2(x[0], x[1]); xo.y = pk2(x[2], x[3]); *(u32x2*)(X + off) = xo;
                    }
    }
};
struct EpiZ { static constexpr bool PERM = true, AFTER_DRAIN = false; bf16_t* Z; int ld;
    __device__ __forceinline__ void operator()(const f32x4 (&acc)[2][2][4][2], const Unit& u, int wr, int wc, int fr, int fq) const {
        const int row0 = u.pm * 256 + wr * 64 + fr, col0 = u.pn * 256 + wc * 32 + 8 * fq;
#pragma unroll
        for (int ai = 0; ai < 2; ++ai)
#pragma unroll
            for (int m = 0; m < 4; ++m)
#pragma unroll
                for (int bj = 0; bj < 2; ++bj) {
                    const f32x4 a = acc[ai][bj][m][0], b = acc[ai][bj][m][1];
                    u32x4 w; w.x = pk2(a[0], a[1]); w.y = pk2(a[2], a[3]); w.z = pk2(b[0], b[1]); w.w = pk2(b[2], b[3]);
                    *(u32x4*)(Z + (size_t)(row0 + ai * 128 + m * 16) * ld + col0 + bj * 128) = w;
                }
    }
};

__device__ __forceinline__ void tr_item(const float* __restrict__ W, int K, int N, bf16_t* WT, int dst_row0, int k0, int n0, float* scr, int lane) {
#pragma unroll
    for (int i = 0; i < 32; ++i) { const int kk = 2 * i + (lane >> 5); const int col = n0 + (lane & 31);
        scr[kk * 33 + (lane & 31)] = (col < N) ? W[(size_t)(k0 + kk) * N + col] : 0.f; }
    asm volatile("s_waitcnt lgkmcnt(0)" ::: "memory");
    const int c = lane & 7;
#pragma unroll
    for (int j = 0; j < 4; ++j) { const int n = (lane >> 3) + 8 * j; const float* s = scr + (8 * c) * 33 + n;
        u32x4 o; o.x = pk2(s[0], s[33]); o.y = pk2(s[2 * 33], s[3 * 33]); o.z = pk2(s[4 * 33], s[5 * 33]); o.w = pk2(s[6 * 33], s[7 * 33]);
        *(u32x4*)(WT + (size_t)(dst_row0 + n) * K + k0 + 8 * c) = o; }
    asm volatile("s_waitcnt lgkmcnt(0)" ::: "memory");
}

__device__ __forceinline__ void convert_items(const Params& p, int l, int parts, int gw, int NGW, unsigned char* smem) {
    const int lane = mk_ltid() & 63, wave = mk_ltid() >> 6;
    float* scr = (float*)smem + wave * (64 * 33);
    unsigned char* ws = p.ws;
    const int i = l >> 1; const bool ab = (l & 1) == 0;
    constexpr int I_G = 16 * 88, I_O = 16 * 32;
    const int I_IN = ab ? 16 * 120 : 16 * 136;
    const int I_LORA = ab ? (16 + 16 + 32) : 0;
    const int n0 = (parts & 1) ? 3 * I_G : 0, n1 = (parts & 2) ? 3 * I_G : 0, n2 = (parts & 4) ? (I_IN + I_O + I_LORA) : 0;
    const int total = n0 + n1 + n2;
    for (int it = gw; it < total; it += NGW) {
        int r = it;
        if (r < n0 + n1) {
            const int j = (r < n0) ? 0 : 1; r -= (j ? n0 : 0);
            const int kind = r / I_G; r -= kind * I_G;
            const size_t lw = (size_t)(l * 2 + j);
            if (kind < 2) { const float* W = p.in[kind == 0 ? 9 : 10] + lw * (size_t)D * FF;
                const int kb = r / 88, nb = r % 88, nn0 = nb * 32;
                tr_item(W, D, FF, (bf16_t*)(ws + WS_WGU) + (size_t)j * 5632 * 1024, (nn0 >> 7) * 256 + (nn0 & 127) + kind * 128, kb * 64, nn0, scr, lane);
            } else { const float* W = p.in[11] + lw * (size_t)FF * D;
                const int kb = r / 32, nb = r % 32;
                tr_item(W, FF, D, (bf16_t*)(ws + WS_WD) + (size_t)j * 1024 * 2816, nb * 32, kb * 64, nb * 32, scr, lane);
            }
            continue;
        }
        r -= n0 + n1;
        if (r < I_IN) {
            if (ab) { const int kb = r / 120, nb = r % 120; tr_item(p.in[12] + (size_t)i * D * AB_N, D, AB_N, (bf16_t*)(ws + WS_WIN), nb * 32, kb * 64, nb * 32, scr, lane); }
            else { const int kb = r / 136, nb = r % 136; tr_item(p.in[27] + (size_t)i * D * GD_NREAL, D, GD_NREAL, (bf16_t*)(ws + WS_WIN), nb * 32, kb * 64, nb * 32, scr, lane); }
            continue;
        }
        r -= I_IN;
        if (r < I_O) { const int kb = r / 32, nb = r % 32;
            tr_item(p.in[ab ? 13 : 32] + (size_t)i * D * D, D, D, (bf16_t*)(ws + WS_WOUT), nb * 32, kb * 64, nb * 32, scr, lane); continue; }
        r -= I_O;
        if (r < 16) { tr_item(p.in[16] + (size_t)i * 64 * 512, 64, 512, (bf16_t*)(ws + WS_W2T), r * 32, 0, r * 32, scr, lane); continue; }
        r -= 16;
        if (r < 16) { tr_item(p.in[18] + (size_t)i * 64 * 512, 64, 512, (bf16_t*)(ws + WS_A2T), r * 32, 0, r * 32, scr, lane); continue; }
        r -= 16;
        { const int kb = r / 16, nb = r % 16; tr_item(p.in[19] + (size_t)i * 128 * 512, 128, 512, (bf16_t*)(ws + WS_G2T), nb * 32, kb * 64, nb * 32, scr, lane); }
    }
}
__device__ __forceinline__ void convert_ffn_ahead(const Params& p, int l, int gw, int NGW, unsigned char* smem) {
    __syncthreads();
    convert_items(p, l, 2, gw, NGW, smem);
    if (l < 3) convert_items(p, l + 1, 1, gw, NGW, smem);
    __syncthreads();
}

__device__ __forceinline__ void phase_start(const Params& p, unsigned char* smem) {
    const int tid = mk_ltid(), lane = tid & 63, wave = tid >> 6;
    const int gw = mk_lbid() * 8 + wave, NGW = gridDim.x * 8;
    convert_items(p, 0, 5, gw, NGW, smem);
    bf16_t* HB = (bf16_t*)(p.ws + WS_HB);
    for (int m = gw; m < M; m += NGW) {
        const float* src = (m < MP) ? p.in[0] + (size_t)m * D : p.in[1] + (size_t)(m - MP) * D;
#pragma unroll
        for (int j = 0; j < 4; ++j) { const int c = (lane + 64 * j) * 4; const f32x4 v = *(const f32x4*)(src + c);
            u32x2 o; o.x = pk2(v[0], v[1]); o.y = pk2(v[2], v[3]); *(u32x2*)(HB + (size_t)m * D + c) = o; }
    }
}

__device__ __forceinline__ void phase_ln(const Params& p, int l, int k, bool final_out) {
    const int tid = mk_ltid(), lane = tid & 63, wave = tid >> 6;
    const int gw = mk_lbid() * 8 + wave, NGW = gridDim.x * 8;
    const bf16_t* X = (const bf16_t*)(p.ws + WS_X); bf16_t* HB = (bf16_t*)(p.ws + WS_HB);
    const float* g = p.in[7] + (size_t)(l * 3 + k) * D; const float* b = p.in[8] + (size_t)(l * 3 + k) * D;
    float* dst = p.out;
    for (int mq = gw; mq < M / 4; mq += NGW) {
        f32x4 v[4][4]; float s[4];
#pragma unroll
        for (int rr = 0; rr < 4; ++rr) { s[rr] = 0.f;
#pragma unroll
            for (int j = 0; j < 4; ++j) { const u32x2 xu = *(const u32x2*)(X + (size_t)(mq * 4 + rr) * D + (lane + 64 * j) * 4);
                v[rr][j][0] = __uint_as_float(xu.x << 16); v[rr][j][1] = __uint_as_float(xu.x & 0xffff0000u); v[rr][j][2] = __uint_as_float(xu.y << 16); v[rr][j][3] = __uint_as_float(xu.y & 0xffff0000u); s[rr] += (v[rr][j][0] + v[rr][j][1]) + (v[rr][j][2] + v[rr][j][3]); } }
#pragma unroll
        for (int o = 1; o < 64; o <<= 1) {
#pragma unroll
            for (int rr = 0; rr < 4; ++rr) s[rr] += __shfl_xor(s[rr], o); }
        float s2[4];
#pragma unroll
        for (int rr = 0; rr < 4; ++rr) { const float mean = s[rr] * (1.f / D); s2[rr] = 0.f;
#pragma unroll
            for (int j = 0; j < 4; ++j) { v[rr][j] = v[rr][j] - mean; s2[rr] += (v[rr][j][0] * v[rr][j][0] + v[rr][j][1] * v[rr][j][1]) + (v[rr][j][2] * v[rr][j][2] + v[rr][j][3] * v[rr][j][3]); } }
#pragma unroll
        for (int o = 1; o < 64; o <<= 1) {
#pragma unroll
            for (int rr = 0; rr < 4; ++rr) s2[rr] += __shfl_xor(s2[rr], o); }
#pragma unroll
        for (int j = 0; j < 4; ++j) { const int c = (lane + 64 * j) * 4; const f32x4 gg = *(const f32x4*)(g + c), bb = *(const f32x4*)(b + c);
#pragma unroll
            for (int rr = 0; rr < 4; ++rr) { const int m = mq * 4 + rr; const float rstd = rsqrtf(s2[rr] * (1.f / D) + 1e-5f);
                const f32x4 y = v[rr][j] * rstd * gg + bb;
                if (final_out) *(f32x4*)(dst + (size_t)m * D + c) = y;
                else { u32x2 o; o.x = pk2(y[0], y[1]); o.y = pk2(y[2], y[3]); *(u32x2*)(HB + (size_t)m * D + c) = o; } } }
    }
}

__device__ __forceinline__ void small_resid_gemm(const bf16_t* __restrict__ A, const bf16_t* __restrict__ Bt, int K, bf16_t* X, const bf16_t* H, float scale, unsigned char* smem) {
    const int tid = mk_ltid(), lane = tid & 63, w = __builtin_amdgcn_readfirstlane(tid >> 6);
    const int r = lane & 15, q = lane >> 4;
    float* part = (float*)smem;
    for (int t = mk_lbid(); t < 256; t += gridDim.x) {
        const int R0 = MP + (t >> 4) * 32, C0 = (t & 15) * 64;
        f32x4 acc[2][4];
#pragma unroll
        for (int a = 0; a < 2; ++a)
#pragma unroll
            for (int b = 0; b < 4; ++b) acc[a][b] = (f32x4){0.f, 0.f, 0.f, 0.f};
        const int nks = K / 32;
#pragma unroll 2
        for (int ks = w; ks < nks; ks += 8) {
            bf16x8 fa[2], fb[4];
#pragma unroll
            for (int a = 0; a < 2; ++a) fa[a] = *(const bf16x8*)(A + (size_t)(R0 + a * 16 + r) * K + ks * 32 + q * 8);
#pragma unroll
            for (int b = 0; b < 4; ++b) fb[b] = *(const bf16x8*)(Bt + (size_t)(C0 + b * 16 + r) * K + ks * 32 + q * 8);
#pragma unroll
            for (int a = 0; a < 2; ++a)
#pragma unroll
                for (int b = 0; b < 4; ++b) acc[a][b] = __builtin_amdgcn_mfma_f32_16x16x32_bf16(fa[a], fb[b], acc[a][b], 0, 0, 0);
        }
        __syncthreads();
#pragma unroll
        for (int a = 0; a < 2; ++a)
#pragma unroll
            for (int b = 0; b < 4; ++b) *(f32x4*)(part + ((w * 8 + a * 4 + b) * 64 + lane) * 4) = acc[a][b];
        __syncthreads();
        {
            const int tile = tid >> 6, a = tile >> 2, b = tile & 3;
            f32x4 sum = (f32x4){0.f, 0.f, 0.f, 0.f};
#pragma unroll
            for (int ww = 0; ww < 8; ++ww) sum += *(const f32x4*)(part + ((ww * 8 + tile) * 64 + lane) * 4);
            const int col = C0 + b * 16 + r;
#pragma unroll
            for (int j = 0; j < 4; ++j) { const size_t off = (size_t)(R0 + a * 16 + q * 4 + j) * D + col;
                X[off] = f2bf(bf2f(H[off]) * ALPHA + sum[j] * scale); }
        }
    }
}

__device__ __forceinline__ void phase_ab_prep(const Params& p, int i, unsigned char* smem) {
    const int tid = mk_ltid(), lane = tid & 63, wave = __builtin_amdgcn_readfirstlane(tid >> 6);
    const int r = lane & 15, q = lane >> 4;
    unsigned char* ws = p.ws;
    const bf16_t* ZB = (const bf16_t*)(ws + WS_ZB);
    float* OPS = (float*)(ws + WS_OPS); float* GATE = (float*)(ws + WS_GATE); float* BONUS = (float*)(ws + WS_BONUS);
    bf16_t* RQ = (bf16_t*)(ws + WS_RQ); bf16_t* RK = (bf16_t*)(ws + WS_RK);
    const bf16_t* W2T = (const bf16_t*)(ws + WS_W2T); const bf16_t* A2T = (const bf16_t*)(ws + WS_A2T); const bf16_t* G2T = (const bf16_t*)(ws + WS_G2T);
    const float* mu = p.in[14] + (size_t)i * 1792; const float* w0 = p.in[15] + i * 512; const float* a0 = p.in[17] + i * 512;
    const float* k_k = p.in[20] + i * 512; const float* k_a = p.in[21] + i * 512; const float* r_k = p.in[22] + i * 512;
    const float* shift_in = p.in[2] + (size_t)i * 128 * 1792;
    constexpr int ZS_LD = 1796, ACT_LD = 264;
    float* zs = (float*)smem;
    bf16_t* act = (bf16_t*)(smem + 16 * ZS_LD * 4);
    for (int tile = mk_lbid(); tile < M / 16; tile += gridDim.x) {
        const int R0 = tile * 16;
        unsigned pfa = 0u, pfb = 0u;
        { const int ntile = tile + gridDim.x;
          if (ntile < M / 16) { const bf16_t* nz = ZB + (size_t)ntile * 16 * AB_N;
              pfa = *(const unsigned*)(nz + (size_t)tid * 64); pfb = *(const unsigned*)(((size_t)(tid + 512) * 64 < (size_t)16 * AB_N) ? nz + (size_t)(tid + 512) * 64 : nz); } }
#ifndef REP_A_ST
#define REP_A_ST 1
#endif
#ifndef REP_A_RO
#define REP_A_RO 1
#endif
#ifndef REP_A_EP
#define REP_A_EP 1
#endif
        __syncthreads();
#pragma unroll 1
        for (int rp_ = 0; rp_ < REP_A_ST; ++rp_)
#pragma unroll 7
        for (int idx = tid; idx < 16 * 448; idx += 512) {
            const int tok = idx / 448, c4 = (idx % 448) * 4; const int row = R0 + tok;
            const int t = (row < MP) ? (row & 2047) : ((row - MP) & 3);
            const int Lm1 = (row < MP) ? 2047 : 3;
            const u32x2 cu = *(const u32x2*)(ZB + (size_t)row * AB_N + c4);
            f32x4 cur; cur[0] = __uint_as_float(cu.x << 16); cur[1] = __uint_as_float(cu.x & 0xffff0000u); cur[2] = __uint_as_float(cu.y << 16); cur[3] = __uint_as_float(cu.y & 0xffff0000u);
            f32x4 prev;
            if (t == 0) { if (row < MP) prev = (f32x4){0.f, 0.f, 0.f, 0.f}; else prev = *(const f32x4*)(shift_in + (size_t)((row - MP) >> 2) * 1792 + c4); }
            else { const u32x2 pu = *(const u32x2*)(ZB + (size_t)(row - 1) * AB_N + c4);
                prev[0] = __uint_as_float(pu.x << 16); prev[1] = __uint_as_float(pu.x & 0xffff0000u); prev[2] = __uint_as_float(pu.y << 16); prev[3] = __uint_as_float(pu.y & 0xffff0000u); }
            if (t == Lm1) {
                float* o = (row < MP) ? p.out + O_PSHIFT + (size_t)(i * 8 + (row >> 11)) * 1792 : p.out + O_SSHIFT + (size_t)(i * 128 + ((row - MP) >> 2)) * 1792;
                *(f32x4*)(o + c4) = cur;
            }
            const f32x4 m4 = *(const f32x4*)(mu + c4);
            const f32x4 z = cur + (prev - cur) * m4;
            *(f32x4*)(zs + tok * ZS_LD + c4) = z;
            if (c4 >= 1536) {
                f32x4 a;
                if (c4 < 1600) { a[0] = tanhf(z[0]); a[1] = tanhf(z[1]); a[2] = tanhf(z[2]); a[3] = tanhf(z[3]); }
                else if (c4 < 1664) a = z;
                else { a[0] = sigm(z[0]); a[1] = sigm(z[1]); a[2] = sigm(z[2]); a[3] = sigm(z[3]); }
                u32x2 o; o.x = pk2(a[0], a[1]); o.y = pk2(a[2], a[3]); *(u32x2*)(act + tok * ACT_LD + (c4 - 1536)) = o;
            }
        }
        {
            const int tok = tid >> 5, hh = (tid >> 3) & 3, c8 = (tid & 7) * 8; const int row = R0 + tok;
            const float pos = (row < MP) ? (float)(row & 2047) : (float)(16384 + ((row - MP) & 3));
            const bf16_t* zq = ZB + (size_t)row * AB_N + 1792 + hh * 128 + c8;
            const u32x4 q1v = *(const u32x4*)zq, q2v = *(const u32x4*)(zq + 64), k1v = *(const u32x4*)(zq + 512), k2v = *(const u32x4*)(zq + 576);
            const unsigned q1w[4] = {q1v.x, q1v.y, q1v.z, q1v.w}, q2w[4] = {q2v.x, q2v.y, q2v.z, q2v.w}, k1w[4] = {k1v.x, k1v.y, k1v.z, k1v.w}, k2w[4] = {k2v.x, k2v.y, k2v.z, k2v.w};
            float oq1[8], oq2[8], ok1[8], ok2[8];
            const float ksc = 0.08838834764831845f;
#pragma unroll
            for (int e = 0; e < 8; ++e) {
                const int ii = c8 + e;
                const float inv_freq = exp2f(-(float)ii * (13.287712379549449f / 63.0f));
                const float ang = pos * inv_freq;
                const float n = rintf(ang * 0.15915494309189535f);
                float rr = fmaf(-n, 6.2831854820251465f, ang); rr = fmaf(-n, -1.7484555e-7f, rr);
                const float rev = rr * 0.15915494309189535f;
                const float sn = __builtin_amdgcn_sinf(rev), cs = __builtin_amdgcn_cosf(rev);
                const float q1 = (e & 1) ? __uint_as_float(q1w[e >> 1] & 0xffff0000u) : __uint_as_float(q1w[e >> 1] << 16);
                const float q2 = (e & 1) ? __uint_as_float(q2w[e >> 1] & 0xffff0000u) : __uint_as_float(q2w[e >> 1] << 16);
                const float k1 = (e & 1) ? __uint_as_float(k1w[e >> 1] & 0xffff0000u) : __uint_as_float(k1w[e >> 1] << 16);
                const float k2 = (e & 1) ? __uint_as_float(k2w[e >> 1] & 0xffff0000u) : __uint_as_float(k2w[e >> 1] << 16);
                oq1[e] = q1 * cs - q2 * sn; oq2[e] = q2 * cs + q1 * sn;
                ok1[e] = (k1 * cs - k2 * sn) * ksc; ok2[e] = (k2 * cs + k1 * sn) * ksc;
            }
            const size_t o = (size_t)row * 512 + hh * 128 + c8;
            u32x4 w;
            w.x = pk2(oq1[0], oq1[1]); w.y = pk2(oq1[2], oq1[3]); w.z = pk2(oq1[4], oq1[5]); w.w = pk2(oq1[6], oq1[7]); *(u32x4*)(RQ + o) = w;
            w.x = pk2(oq2[0], oq2[1]); w.y = pk2(oq2[2], oq2[3]); w.z = pk2(oq2[4], oq2[5]); w.w = pk2(oq2[6], oq2[7]); *(u32x4*)(RQ + o + 64) = w;
            w.x = pk2(ok1[0], ok1[1]); w.y = pk2(ok1[2], ok1[3]); w.z = pk2(ok1[4], ok1[5]); w.w = pk2(ok1[6], ok1[7]); *(u32x4*)(RK + o) = w;
            w.x = pk2(ok2[0], ok2[1]); w.y = pk2(ok2[2], ok2[3]); w.z = pk2(ok2[4], ok2[5]); w.w = pk2(ok2[6], ok2[7]); *(u32x4*)(RK + o + 64) = w;
        }
        __syncthreads();
        const int cb = wave * 64;
#pragma unroll 1
        for (int rp_ = 0; rp_ < REP_A_EP; ++rp_) {
        f32x4 aw[4], aa[4], ag[4];
#pragma unroll
        for (int nt = 0; nt < 4; ++nt) { aw[nt] = (f32x4){0.f, 0.f, 0.f, 0.f}; aa[nt] = aw[nt]; ag[nt] = aw[nt]; }
#pragma unroll
        for (int ks = 0; ks < 2; ++ks) {
            const bf16x8 bw = *(const bf16x8*)(act + r * ACT_LD + ks * 32 + q * 8);
            const bf16x8 ba = *(const bf16x8*)(act + r * ACT_LD + 64 + ks * 32 + q * 8);
#pragma unroll
            for (int nt = 0; nt < 4; ++nt) {
                const bf16x8 fw = *(const bf16x8*)(W2T + (size_t)(cb + nt * 16 + r) * 64 + ks * 32 + q * 8);
                const bf16x8 fa = *(const bf16x8*)(A2T + (size_t)(cb + nt * 16 + r) * 64 + ks * 32 + q * 8);
                aw[nt] = __builtin_amdgcn_mfma_f32_16x16x32_bf16(fw, bw, aw[nt], 0, 0, 0);
                aa[nt] = __builtin_amdgcn_mfma_f32_16x16x32_bf16(fa, ba, aa[nt], 0, 0, 0);
            }
        }
#pragma unroll
        for (int ks = 0; ks < 4; ++ks) {
            const bf16x8 bg = *(const bf16x8*)(act + r * ACT_LD + 128 + ks * 32 + q * 8);
#pragma unroll
            for (int nt = 0; nt < 4; ++nt) {
                const bf16x8 fg = *(const bf16x8*)(G2T + (size_t)(cb + nt * 16 + r) * 128 + ks * 32 + q * 8);
                ag[nt] = __builtin_amdgcn_mfma_f32_16x16x32_bf16(fg, bg, ag[nt], 0, 0, 0);
            }
        }
        const int row = R0 + r;
        float ssq = 0.f, bon = 0.f;
        f32x4 kkraw[4], av[4];
#pragma unroll
        for (int nt = 0; nt < 4; ++nt) {
            const int c = cb + nt * 16 + q * 4;
            const f32x4 rr = *(const f32x4*)(zs + r * ZS_LD + c), kx = *(const f32x4*)(zs + r * ZS_LD + 512 + c), vv = *(const f32x4*)(zs + r * ZS_LD + 1024 + c);
            const f32x4 w04 = *(const f32x4*)(w0 + c), a04 = *(const f32x4*)(a0 + c), kk4 = *(const f32x4*)(k_k + c), ka4 = *(const f32x4*)(k_a + c), rk4 = *(const f32x4*)(r_k + c);
            f32x4 dec, a, kp;
#pragma unroll
            for (int j = 0; j < 4; ++j) {
                const float wl = w04[j] + aw[nt][j];
                const float sp = fmaxf(-wl, 0.f) + __logf(1.f + __expf(-fabsf(wl)));
                const float wlog = -sp - 0.5f;
                dec[j] = __expf(-__expf(wlog));
                a[j] = sigm(a04[j] + aa[nt][j]);
                kkraw[nt][j] = kx[j] * kk4[j];
                kp[j] = kx[j] * (1.f + (a[j] - 1.f) * ka4[j]);
                ssq += kkraw[nt][j] * kkraw[nt][j];
                bon += rr[j] * kp[j] * rk4[j];
            }
            av[nt] = a;
            float* ob = OPS + ((size_t)row * 8 + wave) * 384 + nt * 16 + q * 4;
            *(f32x4*)(ob) = rr; *(f32x4*)(ob + 64) = dec; *(f32x4*)(ob + 128) = kp; *(f32x4*)(ob + 192) = vv;
            *(f32x4*)(GATE + (size_t)row * 512 + c) = ag[nt];
        }
        ssq += __shfl_xor(ssq, 16); ssq += __shfl_xor(ssq, 32);
        bon += __shfl_xor(bon, 16); bon += __shfl_xor(bon, 32);
        const float rn = rsqrtf(fmaxf(ssq, 1e-12f));
#pragma unroll
        for (int nt = 0; nt < 4; ++nt) {
            float* ob = OPS + ((size_t)row * 8 + wave) * 384 + nt * 16 + q * 4;
            const f32x4 kk = kkraw[nt] * rn;
            *(f32x4*)(ob + 256) = kk; *(f32x4*)(ob + 320) = kk * av[nt];
        }
        if (q == 0) BONUS[(size_t)row * 8 + wave] = bon;
        }
        if (pfa == 0x7fc17fc1u && pfb == 0x7fc27fc2u) zs[0] = 1.f;
    }
}

__device__ __forceinline__ void rwkv_item(const Params& p, int i, int s, int h, int rg, unsigned char* smem) {
    const int tid = mk_ltid(), lane = tid & 63, wave = __builtin_amdgcn_readfirstlane(tid >> 6);
    int row0, L; seq_info(s, row0, L);
    const float* OPS = (const float*)(p.ws + WS_OPS); float* ORAW = (float*)(p.ws + WS_ORAW);
    float* buf = (float*)smem;
    const int rih = rg * 16 + (wave & 3) * 4 + (lane >> 4);
    const int c4 = (lane & 15) * 4;
    f32x4 S = (f32x4){0.f, 0.f, 0.f, 0.f};
    if (s >= 8 && wave < 4) S = *(const f32x4*)(p.in[3] + ((((size_t)i * 128 + (s - 8)) * 8 + h) * 64 + rih) * 64 + c4);
    f32x4 pre[6];
    const int nch = (L + 31) / 32;
#pragma unroll
    for (int k = 0; k < 6; ++k) { const int idx4 = tid + k * 512; const int tt = idx4 / 96, off = idx4 % 96;
        pre[k] = (tt < L) ? *(const f32x4*)(OPS + ((size_t)(row0 + tt) * 8 + h) * 384 + off * 4) : (f32x4){0.f, 0.f, 0.f, 0.f}; }
    for (int ch = 0; ch < nch; ++ch) {
        const int t0 = ch * 32;
        __syncthreads();
#pragma unroll
        for (int k = 0; k < 6; ++k) { const int idx4 = tid + k * 512; *(f32x4*)(buf + idx4 * 4) = pre[k]; }
        __syncthreads();
        if (ch + 1 < nch) {
#pragma unroll
            for (int k = 0; k < 6; ++k) { const int idx4 = tid + k * 512; const int tt = t0 + 32 + idx4 / 96, off = idx4 % 96;
                pre[k] = (tt < L) ? *(const f32x4*)(OPS + ((size_t)(row0 + tt) * 8 + h) * 384 + off * 4) : (f32x4){0.f, 0.f, 0.f, 0.f}; }
        }
        if (wave < 4) {
            const int ns = (L - t0) < 32 ? (L - t0) : 32;
            f32x4 r4 = *(const f32x4*)(buf + c4), w4 = *(const f32x4*)(buf + 64 + c4), k4 = *(const f32x4*)(buf + 128 + c4);
            f32x4 kk4 = *(const f32x4*)(buf + 256 + c4), ka4 = *(const f32x4*)(buf + 320 + c4);
            float vv = buf[192 + rih];
            float* op = ORAW + (size_t)(row0 + t0) * 512 + h * 64 + rih;
            f32x4 rprev = r4;
#pragma unroll 2
            for (int tt = 0; tt < ns; ++tt) {
                const float* nb = buf + ((tt + 1 < 32) ? (tt + 1) : 31) * 384;
                const f32x4 r4n = *(const f32x4*)(nb + c4), w4n = *(const f32x4*)(nb + 64 + c4), k4n = *(const f32x4*)(nb + 128 + c4);
                const f32x4 kk4n = *(const f32x4*)(nb + 256 + c4), ka4n = *(const f32x4*)(nb + 320 + c4);
                const float vvn = nb[192 + rih];
                float o = (S[0] * rprev[0] + S[1] * rprev[1]) + (S[2] * rprev[2] + S[3] * rprev[3]);
                const f32x4 kv = k4 * vv;
                float sk = (S[0] * kk4[0] + S[1] * kk4[1]) + (S[2] * kk4[2] + S[3] * kk4[3]);
                sk = row16_sum(sk);
                o = row16_sum(o);
                const f32x4 t1 = kv - ka4 * sk;
                S = S * w4 + t1;
                if ((lane & 15) == 0 && tt > 0) op[(size_t)(tt - 1) * 512] = o;
                rprev = r4;
                r4 = r4n; w4 = w4n; k4 = k4n; kk4 = kk4n; ka4 = ka4n; vv = vvn;
            }
            {
                float o = (S[0] * rprev[0] + S[1] * rprev[1]) + (S[2] * rprev[2] + S[3] * rprev[3]);
                o = row16_sum(o);
                if ((lane & 15) == 0) op[(size_t)(ns - 1) * 512] = o;
            }
        }
    }
    if (wave < 4) {
        float* so = (s < 8) ? p.out + O_PRWKV + ((((size_t)i * 8 + s) * 8 + h) * 64 + rih) * 64 + c4
                            : p.out + O_SRWKV + ((((size_t)i * 128 + (s - 8)) * 8 + h) * 64 + rih) * 64 + c4;
        *(f32x4*)so = S;
    }
}

__device__ __forceinline__ void rwkv_item2(const Params& p, int i, int s, int h, int rg, unsigned char* smem) {
    const int tid = mk_ltid(), lane = tid & 63, wave = __builtin_amdgcn_readfirstlane(tid >> 6);
    int row0, L; seq_info(s, row0, L);
    const float* OPS = (const float*)(p.ws + WS_OPS); float* ORAW = (float*)(p.ws + WS_ORAW);
    float* buf = (float*)smem;
    const int ra = rg * 32 + (wave & 3) * 4 + (lane >> 4), rb = ra + 16;
    const int c4 = (lane & 15) * 4;
    f32x4 Sa = (f32x4){0.f, 0.f, 0.f, 0.f}, Sb = Sa;
    if (s >= 8 && wave < 4) { const float* sp = p.in[3] + (((size_t)i * 128 + (s - 8)) * 8 + h) * 4096;
        Sa = *(const f32x4*)(sp + ra * 64 + c4); Sb = *(const f32x4*)(sp + rb * 64 + c4); }
    f32x4 pre[12];
    const int nch = (L + 63) / 64;
#pragma unroll
    for (int k = 0; k < 12; ++k) { const int idx4 = tid + k * 512; const int tt = idx4 / 96, off = idx4 % 96;
        pre[k] = (tt < L) ? *(const f32x4*)(OPS + ((size_t)(row0 + tt) * 8 + h) * 384 + off * 4) : (f32x4){0.f, 0.f, 0.f, 0.f}; }
    for (int ch = 0; ch < nch; ++ch) {
        const int t0 = ch * 64;
        __syncthreads();
#pragma unroll
        for (int k = 0; k < 12; ++k) { const int idx4 = tid + k * 512; *(f32x4*)(buf + idx4 * 4) = pre[k]; }
        __syncthreads();
        if (ch + 1 < nch) {
#pragma unroll
            for (int k = 0; k < 12; ++k) { const int idx4 = tid + k * 512; const int tt = t0 + 64 + idx4 / 96, off = idx4 % 96;
                pre[k] = (tt < L) ? *(const f32x4*)(OPS + ((size_t)(row0 + tt) * 8 + h) * 384 + off * 4) : (f32x4){0.f, 0.f, 0.f, 0.f}; }
        }
        if (wave < 4) {
            const int ns = (L - t0) < 64 ? (L - t0) : 64;
            f32x4 rA = *(const f32x4*)(buf + c4), wA = *(const f32x4*)(buf + 64 + c4), kA = *(const f32x4*)(buf + 128 + c4);
            f32x4 kkA = *(const f32x4*)(buf + 256 + c4), kaA = *(const f32x4*)(buf + 320 + c4);
            float vaA = buf[192 + ra], vbA = buf[192 + rb];
            f32x4 rB, wB, kB, kkB, kaB; float vaB, vbB;
            float* op = ORAW + (size_t)(row0 + t0) * 512 + h * 64 + ra;
            f32x4 rprev = rA;
#define RW_LOAD(R, W, K, KK, KA, VA, VB, nb_) do { const float* nb = (nb_); R = *(const f32x4*)(nb + c4); W = *(const f32x4*)(nb + 64 + c4); K = *(const f32x4*)(nb + 128 + c4); \
                KK = *(const f32x4*)(nb + 256 + c4); KA = *(const f32x4*)(nb + 320 + c4); VA = nb[192 + ra]; VB = nb[192 + rb]; } while (0)
#define RW_STEP(R, W, K, KK, KA, VA, VB, RP, tt_) do { \
                float oa = (Sa[0] * RP[0] + Sa[1] * RP[1]) + (Sa[2] * RP[2] + Sa[3] * RP[3]); \
                float ob = (Sb[0] * RP[0] + Sb[1] * RP[1]) + (Sb[2] * RP[2] + Sb[3] * RP[3]); \
                float ska = (Sa[0] * KK[0] + Sa[1] * KK[1]) + (Sa[2] * KK[2] + Sa[3] * KK[3]); \
                float skb = (Sb[0] * KK[0] + Sb[1] * KK[1]) + (Sb[2] * KK[2] + Sb[3] * KK[3]); \
                ska = row16_sum(ska); skb = row16_sum(skb); oa = row16_sum(oa); ob = row16_sum(ob); \
                Sa = Sa * W + (K * VA - KA * ska); Sb = Sb * W + (K * VB - KA * skb); \
                if ((lane & 15) == 0 && (tt_) > 0) { op[(size_t)((tt_) - 1) * 512] = oa; op[(size_t)((tt_) - 1) * 512 + 16] = ob; } } while (0)
            for (int tt = 0; tt < ns; tt += 2) {
                RW_LOAD(rB, wB, kB, kkB, kaB, vaB, vbB, buf + (tt + 1) * 384);
                RW_STEP(rA, wA, kA, kkA, kaA, vaA, vbA, rprev, tt);
                const f32x4 rEven = rA;
                RW_LOAD(rA, wA, kA, kkA, kaA, vaA, vbA, buf + ((tt + 2 < 64) ? (tt + 2) : 63) * 384);
                RW_STEP(rB, wB, kB, kkB, kaB, vaB, vbB, rEven, tt + 1);
                rprev = rB;
            }
            {
                float oa = (Sa[0] * rprev[0] + Sa[1] * rprev[1]) + (Sa[2] * rprev[2] + Sa[3] * rprev[3]);
                float ob = (Sb[0] * rprev[0] + Sb[1] * rprev[1]) + (Sb[2] * rprev[2] + Sb[3] * rprev[3]);
                oa = row16_sum(oa); ob = row16_sum(ob);
                if ((lane & 15) == 0) { op[(size_t)(ns - 1) * 512] = oa; op[(size_t)(ns - 1) * 512 + 16] = ob; }
            }
#undef RW_LOAD
#undef RW_STEP
        }
    }
    if (wave < 4) {
        float* so = (s < 8) ? p.out + O_PRWKV + (((size_t)i * 8 + s) * 8 + h) * 4096 : p.out + O_SRWKV + (((size_t)i * 128 + (s - 8)) * 8 + h) * 4096;
        *(f32x4*)(so + ra * 64 + c4) = Sa; *(f32x4*)(so + rb * 64 + c4) = Sb;
    }
}

__device__ __forceinline__ void ret_item(const Params& p, int i, int s, int hb, unsigned char* smem) {
    const int tid = mk_ltid(), lane = tid & 63, w = __builtin_amdgcn_readfirstlane(tid >> 6);
    const int r = lane & 15, q = lane >> 4;
    int row0, L; seq_info(s, row0, L);
    const int C = (s < 8) ? 128 : 4; const int nch = L / C;
    const float lg = log2f(1.0f - exp2f(-5.0f - (float)hb));
    const bf16_t* ZB = (const bf16_t*)(p.ws + WS_ZB); const bf16_t* RQ = (const bf16_t*)(p.ws + WS_RQ); const bf16_t* RK = (const bf16_t*)(p.ws + WS_RK);
    bf16_t* OMIX = (bf16_t*)(p.ws + WS_OMIX);
    const float* gn_g = p.in[25] + i * 512 + hb * 128; const float* gn_b = p.in[26] + i * 512 + hb * 128;
    constexpr int LD = 136;
    bf16_t* KC = (bf16_t*)smem; bf16_t* KZT = KC + 128 * LD; bf16_t* VT = KZT + 128 * LD; bf16_t* SB = VT + 128 * LD;
    f32x4 ST[8];
#pragma unroll
    for (int nt = 0; nt < 8; ++nt) ST[nt] = (f32x4){0.f, 0.f, 0.f, 0.f};
    if (s >= 8) {
        const float* S0 = p.in[4] + (((size_t)i * 128 + (s - 8)) * 4 + hb) * 16384;
#pragma unroll
        for (int nt = 0; nt < 8; ++nt) ST[nt] = *(const f32x4*)(S0 + (size_t)(nt * 16 + r) * 128 + 16 * w + q * 4);
    }
    const float gch = exp2f((float)C * lg);
    for (int ch = 0; ch < nch; ++ch) {
        const int rb = row0 + ch * C;
        __syncthreads();
        for (int idx = tid; idx < 128 * 16; idx += 512) {
            const int tok = idx & 127, c8 = (idx >> 7) * 8;
            u32x4 kv = (u32x4){0u, 0u, 0u, 0u}, vv = kv;
            if (tok < C) { kv = *(const u32x4*)(RK + (size_t)(rb + tok) * 512 + hb * 128 + c8);
                           vv = *(const u32x4*)(ZB + (size_t)(rb + tok) * AB_N + 1792 + 1024 + hb * 128 + c8); }
            *(u32x4*)(KC + tok * LD + c8) = kv;
            const float zeta = __builtin_amdgcn_exp2f((float)(C - 1 - tok) * lg);
            const unsigned kw[4] = {kv.x, kv.y, kv.z, kv.w}; const unsigned vw[4] = {vv.x, vv.y, vv.z, vv.w};
#pragma unroll
            for (int e = 0; e < 4; ++e) {
                const float k0 = __uint_as_float(kw[e] << 16) * zeta, k1 = __uint_as_float(kw[e] & 0xffff0000u) * zeta;
                KZT[(c8 + 2 * e) * LD + tok] = f2bf(k0); KZT[(c8 + 2 * e + 1) * LD + tok] = f2bf(k1);
                VT[(c8 + 2 * e) * LD + tok] = (bf16_t)(vw[e] & 0xffffu); VT[(c8 + 2 * e + 1) * LD + tok] = (bf16_t)(vw[e] >> 16);
            }
        }
#pragma unroll
        for (int nt = 0; nt < 8; ++nt)
#pragma unroll
            for (int j = 0; j < 4; ++j) SB[(16 * w + q * 4 + j) * LD + nt * 16 + r] = f2bf(ST[nt][j]);
        __syncthreads();
        bf16x8 aq[4];
#pragma unroll
        for (int ks = 0; ks < 4; ++ks) {
            if (16 * w + r < C) aq[ks] = *(const bf16x8*)(RQ + (size_t)(rb + 16 * w + r) * 512 + hb * 128 + ks * 32 + q * 8);
            else aq[ks] = (bf16x8){0, 0, 0, 0, 0, 0, 0, 0};
        }
        u32x2 P[8]; f32x4 O[8];
#pragma unroll
        for (int nt = 0; nt < 8; ++nt) {
            f32x4 acc = (f32x4){0.f, 0.f, 0.f, 0.f}, oc = acc;
#pragma unroll
            for (int ks = 0; ks < 4; ++ks) {
                const bf16x8 bk = *(const bf16x8*)(KC + (nt * 16 + r) * LD + ks * 32 + q * 8);
                const bf16x8 bs = *(const bf16x8*)(SB + (nt * 16 + r) * LD + ks * 32 + q * 8);
                acc = __builtin_amdgcn_mfma_f32_16x16x32_bf16(aq[ks], bk, acc, 0, 0, 0);
                oc = __builtin_amdgcn_mfma_f32_16x16x32_bf16(aq[ks], bs, oc, 0, 0, 0);
            }
#pragma unroll
            for (int j = 0; j < 4; ++j) {
                const int ii = 16 * w + q * 4 + j, jt = nt * 16 + r;
                acc[j] = (ii >= jt) ? acc[j] * __builtin_amdgcn_exp2f((float)(ii - jt) * lg) : 0.f;
                oc[j] *= __builtin_amdgcn_exp2f((float)(ii + 1) * lg);
            }
            P[nt].x = pk2(acc[0], acc[1]); P[nt].y = pk2(acc[2], acc[3]); O[nt] = oc;
        }
        __syncthreads();
#pragma unroll
        for (int nt = 0; nt < 8; ++nt)
#pragma unroll
            for (int j = 0; j < 4; ++j) KC[(16 * w + q * 4 + j) * LD + nt * 16 + r] = (bf16_t)(((j & 2) ? P[nt].y : P[nt].x) >> ((j & 1) * 16));
        __syncthreads();
#pragma unroll
        for (int nt = 0; nt < 8; ++nt) ST[nt] = ST[nt] * gch;
#pragma unroll
        for (int ks = 0; ks < 4; ++ks) {
            const bf16x8 ap = *(const bf16x8*)(KC + (16 * w + r) * LD + ks * 32 + q * 8);
            const bf16x8 av = *(const bf16x8*)(VT + (16 * w + r) * LD + ks * 32 + q * 8);
#pragma unroll
            for (int nt = 0; nt < 8; ++nt) {
                const bf16x8 bv = *(const bf16x8*)(VT + (nt * 16 + r) * LD + ks * 32 + q * 8);
                const bf16x8 bz = *(const bf16x8*)(KZT + (nt * 16 + r) * LD + ks * 32 + q * 8);
                O[nt] = __builtin_amdgcn_mfma_f32_16x16x32_bf16(ap, bv, O[nt], 0, 0, 0);
                ST[nt] = __builtin_amdgcn_mfma_f32_16x16x32_bf16(av, bz, ST[nt], 0, 0, 0);
            }
        }
#pragma unroll
        for (int j = 0; j < 4; ++j) {
            float s1 = 0.f;
#pragma unroll
            for (int nt = 0; nt < 8; ++nt) s1 += O[nt][j];
            s1 = row16_sum(s1); const float mean = s1 * (1.f / 128.f);
            float s2 = 0.f;
#pragma unroll
            for (int nt = 0; nt < 8; ++nt) { const float d = O[nt][j] - mean; s2 += d * d; }
            s2 = row16_sum(s2); const float rstd = rsqrtf(s2 * (1.f / 128.f) + 1e-5f);
            const int ii = 16 * w + q * 4 + j;
            if (ii < C) {
                const size_t row = (size_t)(rb + ii);
#pragma unroll
                for (int nt = 0; nt < 8; ++nt) { const int dv = nt * 16 + r;
                    const float val = (O[nt][j] - mean) * rstd * gn_g[dv] + gn_b[dv];
                    const float gr = bf2f(ZB[row * AB_N + 1792 + 1536 + hb * 128 + dv]);
                    OMIX[row * 1024 + 512 + hb * 128 + dv] = f2bf(val * silu(gr)); }
            }
        }
    }
    float* so = (s < 8) ? p.out + O_PRET + (((size_t)i * 8 + s) * 4 + hb) * 16384 : p.out + O_SRET + (((size_t)i * 128 + (s - 8)) * 4 + hb) * 16384;
#pragma unroll
    for (int nt = 0; nt < 8; ++nt) *(f32x4*)(so + (size_t)(nt * 16 + r) * 128 + 16 * w + q * 4) = ST[nt];
}

__device__ __forceinline__ void phase_ab_core(const Params& p, int i, int l, unsigned char* smem) {
    const int bid = mk_lbid(), G = gridDim.x; const int wv = mk_ltid() >> 6;
    if (G == 256) {
        if (bid < 128) rwkv_item2(p, i, bid >> 4, (bid >> 1) & 7, bid & 1, smem);
        else if (bid < 160) ret_item(p, i, (bid - 128) >> 2, (bid - 128) & 3, smem);
        else {
            for (int it = bid - 160; it < 128 * 16; it += 96) rwkv_item2(p, i, 8 + (it >> 4), (it >> 1) & 7, it & 1, smem);
            __syncthreads();
            for (int it = bid - 160; it < 128 * 4; it += 96) ret_item(p, i, 8 + (it >> 2), it & 3, smem);
        }
        if (bid >= 160) convert_ffn_ahead(p, l, (bid - 160) * 8 + wv, 96 * 8, smem);
    } else {
        for (int it = bid; it < 136 * 16; it += G) rwkv_item2(p, i, it >> 4, (it >> 1) & 7, it & 1, smem);
        __syncthreads();
        for (int it = bid; it < 136 * 4; it += G) ret_item(p, i, it >> 2, it & 3, smem);
        convert_ffn_ahead(p, l, bid * 8 + wv, G * 8, smem);
    }
}

__device__ __forceinline__ void phase_ab_post(const Params& p, int i) {
    const int tid = mk_ltid(), lane = tid & 63, wave = tid >> 6;
    const int gw = mk_lbid() * 8 + wave, NGW = gridDim.x * 8;
    const float* OPS = (const float*)(p.ws + WS_OPS); const float* ORAW = (const float*)(p.ws + WS_ORAW);
    const float* GATE = (const float*)(p.ws + WS_GATE); const float* BONUS = (const float*)(p.ws + WS_BONUS);
    bf16_t* OMIX = (bf16_t*)(p.ws + WS_OMIX);
    const float* gg = p.in[23] + i * 512; const float* gb = p.in[24] + i * 512;
    for (int m = gw; m < M; m += NGW) {
        const int c = lane * 8, h = lane >> 3, hc = c & 63;
        const f32x4 o0 = *(const f32x4*)(ORAW + (size_t)m * 512 + c), o1 = *(const f32x4*)(ORAW + (size_t)m * 512 + c + 4);
        float s1 = (o0[0] + o0[1]) + (o0[2] + o0[3]) + (o1[0] + o1[1]) + (o1[2] + o1[3]);
        s1 += __shfl_xor(s1, 1); s1 += __shfl_xor(s1, 2); s1 += __shfl_xor(s1, 4);
        const float mean = s1 * (1.f / 64.f);
        const f32x4 d0 = o0 - mean, d1 = o1 - mean;
        float s2 = (d0[0] * d0[0] + d0[1] * d0[1]) + (d0[2] * d0[2] + d0[3] * d0[3]) + (d1[0] * d1[0] + d1[1] * d1[1]) + (d1[2] * d1[2] + d1[3] * d1[3]);
        s2 += __shfl_xor(s2, 1); s2 += __shfl_xor(s2, 2); s2 += __shfl_xor(s2, 4);
        const float rstd = rsqrtf(s2 * (1.f / 64.f) + 64e-5f);
        const float bon = BONUS[(size_t)m * 8 + h];
        const float* vb = OPS + ((size_t)m * 8 + h) * 384 + 192 + hc;
        const f32x4 v0 = *(const f32x4*)vb, v1 = *(const f32x4*)(vb + 4);
        const f32x4 g0 = *(const f32x4*)(gg + c), g1 = *(const f32x4*)(gg + c + 4), b0 = *(const f32x4*)(gb + c), b1 = *(const f32x4*)(gb + c + 4);
        const f32x4 t0 = *(const f32x4*)(GATE + (size_t)m * 512 + c), t1 = *(const f32x4*)(GATE + (size_t)m * 512 + c + 4);
        const f32x4 y0 = (d0 * rstd * g0 + b0 + v0 * bon) * t0, y1 = (d1 * rstd * g1 + b1 + v1 * bon) * t1;
        u32x4 o; o.x = pk2(y0[0], y0[1]); o.y = pk2(y0[2], y0[3]); o.z = pk2(y1[0], y1[1]); o.w = pk2(y1[2], y1[3]);
        *(u32x4*)(OMIX + (size_t)m * 1024 + c) = o;
    }
}

__device__ __forceinline__ int gdn_item_index(int s, int h, int c) { return (s < 8) ? ((s * 8 + h) * 32 + c) : (2048 + (s - 8) * 8 + h); }

__device__ __forceinline__ void gdn_chunk_item(const Params& p, int i, int s, int h, int c, int pf_row, int pf_h, unsigned char* smem) {
    const int tid = mk_ltid(), lane = tid & 63, w = __builtin_amdgcn_readfirstlane(tid >> 6);
    const int r = lane & 15, q = lane >> 4;
    int row0, L; seq_info(s, row0, L);
    const int t0 = c * 64; const int nvalid = (L - t0) < 64 ? (L - t0) : 64;
    const bf16_t* ZB = (const bf16_t*)(p.ws + WS_ZB);
    unsigned char* rec = p.ws + WS_CH + (size_t)gdn_item_index(s, h, c) * CH_BYTES;
    float* U = (float*)(rec + CH_U); bf16_t* Wd = (bf16_t*)(rec + CH_W); bf16_t* QG = (bf16_t*)(rec + CH_QG); bf16_t* QK = (bf16_t*)(rec + CH_QK); bf16_t* KDT = (bf16_t*)(rec + CH_KDT);
    constexpr int LD = 132, ALD = 68;
    float* qs = (float*)smem; float* ks = qs + 64 * LD; float* vs = ks + 64 * LD; float* As = vs + 64 * LD;
    float* AT = As + 64 * ALD; float* gcs = AT + 64 * ALD; float* bes = gcs + 64;
    unsigned short pfv = 0;
    if (pf_row >= 0 && tid < 384) { const int rr_ = tid / 6, pp_ = (tid % 6) >> 1, hh_ = tid & 1;
        pfv = ((const bf16_t*)(p.ws + WS_ZB))[(size_t)(pf_row + rr_) * GD_N + pp_ * 1024 + pf_h * 128 + hh_ * 64]; }
#ifndef REP_G_CONV
#define REP_G_CONV 1
#endif
#ifndef REP_G_MFMA
#define REP_G_MFMA 1
#endif
#ifndef REP_G_QG
#define REP_G_QG 1
#endif
#ifndef REP_G_SUB
#define REP_G_SUB 1
#endif
#pragma unroll 1
    for (int rp_ = 0; rp_ < REP_G_CONV; ++rp_) {
    __syncthreads();
    if (tid < 384) {
        if (nvalid == 64) {
            const int cg = tid % 48, tr = tid / 48;
            const int part = cg >> 4, ch0 = (cg & 15) * 8; const int zc0 = part * 1024 + h * 128 + ch0;
            const float* cw = p.in[28] + (size_t)i * 4 * 3072 + zc0;
            f32x4 wv[4][2];
#pragma unroll
            for (int j = 0; j < 4; ++j) { wv[j][0] = *(const f32x4*)(cw + j * 3072); wv[j][1] = *(const f32x4*)(cw + j * 3072 + 4); }
            u32x4 xr[11];
#pragma unroll
            for (int jr = 0; jr < 11; ++jr) { const int tt = t0 + tr * 8 - 3 + jr;
                xr[jr] = (tt >= 0) ? *(const u32x4*)(ZB + (size_t)(row0 + (tt >= 0 ? tt : 0)) * GD_N + zc0) : (u32x4){0u, 0u, 0u, 0u}; }
            float* dstb = (part == 0 ? qs : part == 1 ? ks : vs) + ch0;
#pragma unroll
            for (int e = 0; e < 8; ++e) {
                f32x4 o0, o1;
#pragma unroll
                for (int cc = 0; cc < 8; ++cc) {
                    float y = 0.f;
#pragma unroll
                    for (int j = 0; j < 4; ++j) { const unsigned wd = (cc >> 1) == 0 ? xr[e + j].x : (cc >> 1) == 1 ? xr[e + j].y : (cc >> 1) == 2 ? xr[e + j].z : xr[e + j].w;
                        const float xv = (cc & 1) ? __uint_as_float(wd & 0xffff0000u) : __uint_as_float(wd << 16);
                        y += wv[j][cc >> 2][cc & 3] * xv; }
                    const float sv = silu(y);
                    if (cc < 4) o0[cc] = sv; else o1[cc - 4] = sv;
                }
                *(f32x4*)(dstb + (tr * 8 + e) * LD) = o0; *(f32x4*)(dstb + (tr * 8 + e) * LD + 4) = o1;
            }
        } else {
            const int part = tid >> 7, ch = tid & 127; const int zc = part * 1024 + h * 128 + ch;
            const float* cw = p.in[28] + (size_t)i * 4 * 3072 + zc;
            const float cw0 = cw[0], cw1 = cw[3072], cw2 = cw[2 * 3072], cw3 = cw[3 * 3072];
            float* dst = (part == 0 ? qs : part == 1 ? ks : vs) + ch;
            float x3, x2, x1;
            { const float* cs = p.in[5] + (((size_t)i * 128 + (s - 8)) * 3) * 3072 + zc; x3 = cs[0]; x2 = cs[3072]; x1 = cs[2 * 3072]; }
#pragma unroll
            for (int e = 0; e < 64; ++e) {
                float v = 0.f;
                if (e < 4) { const float xe = (e < nvalid) ? bf2f(ZB[(size_t)(row0 + e) * GD_N + zc]) : 0.f;
                    const float y = cw0 * x3 + cw1 * x2 + cw2 * x1 + cw3 * xe; v = (e < nvalid) ? silu(y) : 0.f; x3 = x2; x2 = x1; x1 = xe; }
                dst[e * LD] = v;
            }
        }
    } else if (tid < 448) {
        const int t = tid - 384;
        float be = 0.f, g = 0.f;
        if (t < nvalid) { const size_t zr = (size_t)(row0 + t0 + t) * GD_N;
            be = sigm(bf2f(ZB[zr + 3072 + h]));
            const float a = bf2f(ZB[zr + 3080 + h]) + p.in[30][i * 8 + h];
            const float sp = fmaxf(a, 0.f) + __logf(1.f + __expf(-fabsf(a)));
            g = -__expf(p.in[29][i * 8 + h]) * sp; }
#pragma unroll
        for (int o = 1; o < 64; o <<= 1) { const float y = __shfl_up(g, o); if (t >= o) g += y; }
        gcs[t] = g; bes[t] = be;
    }
    }
    __syncthreads();
    for (int pass = 0; pass < 4; ++pass) {
        const int rowi = w * 16 + pass * 4 + q;
        const int t = rowi & 63;
        if ((w * 16 + pass * 4) % 64 < nvalid) {
            float* base = ((rowi < 64) ? qs : ks) + t * LD + r * 8;
            f32x4 a = *(f32x4*)base, b = *(f32x4*)(base + 4);
            float ss = (a[0] * a[0] + a[1] * a[1]) + (a[2] * a[2] + a[3] * a[3]) + (b[0] * b[0] + b[1] * b[1]) + (b[2] * b[2] + b[3] * b[3]);
            ss = row16_sum(ss);
            const float rn = rsqrtf(fmaxf(ss, 1e-12f));
            *(f32x4*)base = a * rn; *(f32x4*)(base + 4) = b * rn;
        }
    }
    __syncthreads();
#pragma unroll 1
    for (int rp_ = 0; rp_ < REP_G_MFMA; ++rp_)
#pragma unroll
    for (int tl = 0; tl < 2; ++tl) {
        const int tile = 2 * w + tl, mi = tile >> 2, ni = tile & 3;
        f32x4 akk = (f32x4){0.f, 0.f, 0.f, 0.f}, aqk = akk;
        if (mi * 16 < nvalid) {
#pragma unroll 8
            for (int k0 = 0; k0 < 128; k0 += 4) {
                const float ka = ks[(mi * 16 + r) * LD + k0 + q], kb = ks[(ni * 16 + r) * LD + k0 + q], qa = qs[(mi * 16 + r) * LD + k0 + q];
                akk = __builtin_amdgcn_mfma_f32_16x16x4f32(ka, kb, akk, 0, 0, 0);
                aqk = __builtin_amdgcn_mfma_f32_16x16x4f32(qa, kb, aqk, 0, 0, 0);
            }
        }
#pragma unroll
        for (int j = 0; j < 4; ++j) { const int ii = mi * 16 + q * 4 + j, jj = ni * 16 + r;
            const float dm = (ii >= jj) ? __expf(gcs[ii] - gcs[jj]) : 0.f;
            const float aij = (ii > jj) ? bes[ii] * akk[j] * dm : 0.f;
            As[ii * ALD + jj] = aij; AT[jj * ALD + ii] = aij;
            if (mi * 16 < nvalid) QK[ii * 64 + jj] = f2bf(aqk[j] * 0.08838834764831845f * dm); }
    }
    __syncthreads();
#pragma unroll 1
    for (int rp_ = 0; rp_ < REP_G_QG; ++rp_)
    {
        const float gl = gcs[63];
        const int nrow = (nvalid == 64) ? 64 : 16;
        for (int idx = tid; idx < nrow * 16; idx += 512) { const int t = idx >> 4, d0 = (idx & 15) * 8; const float sc = 0.08838834764831845f * __expf(gcs[t]);
            const f32x4 a = *(const f32x4*)(qs + t * LD + d0) * sc, b = *(const f32x4*)(qs + t * LD + d0 + 4) * sc;
            u32x4 o; o.x = pk2(a[0], a[1]); o.y = pk2(a[2], a[3]); o.z = pk2(b[0], b[1]); o.w = pk2(b[2], b[3]);
            *(u32x4*)(QG + t * 128 + d0) = o; }
        for (int idx = tid; idx < 128 * (nrow >> 3); idx += 512) { const int d = idx & 127, tc = (idx >> 7) * 8;
            float v[8];
#pragma unroll
            for (int e = 0; e < 8; ++e) v[e] = ks[(tc + e) * LD + d] * __expf(gl - gcs[tc + e]);
            u32x4 o; o.x = pk2(v[0], v[1]); o.y = pk2(v[2], v[3]); o.z = pk2(v[4], v[5]); o.w = pk2(v[6], v[7]);
            *(u32x4*)(KDT + d * 64 + tc) = o; }
        if (tid == 0) ((float*)(p.ws + WS_GL))[gdn_item_index(s, h, c)] = __expf(gl);
    }
    __syncthreads();
    for (int idx = tid; idx < 64 * 128; idx += 512) { const int t = idx >> 7, d = idx & 127; const float be = bes[t];
        vs[t * LD + d] *= be; ks[t * LD + d] *= be * __expf(gcs[t]); }
    __syncthreads();
    const int nblk = (nvalid + 15) >> 4;
#pragma unroll 1
    for (int blk = 0; blk < 4; ++blk) {
        if (blk >= nblk) continue;
        if (blk > 0) {
#pragma unroll
            for (int tl = 0; tl < 2; ++tl) {
                const int nt = 2 * w + tl; float* bb = (nt < 8 ? vs : ks) + (nt & 7) * 16 + r;
                f32x4 acc = (f32x4){0.f, 0.f, 0.f, 0.f};
                const float* ap = As + (blk * 16 + r) * ALD + q;
                for (int k0 = 0; k0 < blk * 16; k0 += 4)
                    acc = __builtin_amdgcn_mfma_f32_16x16x4f32(ap[k0], bb[(k0 + q) * LD], acc, 0, 0, 0);
#pragma unroll
                for (int j = 0; j < 4; ++j) bb[(blk * 16 + q * 4 + j) * LD] -= acc[j];
            }
            __syncthreads();
        }
        if (tid < 256) {
            const int col = tid & 127; const bool isu = tid < 128;
            float* buf = (isu ? vs : ks) + col;
            float acc[16];
#pragma unroll
            for (int e = 0; e < 16; ++e) acc[e] = buf[(blk * 16 + e) * LD];
#pragma unroll
            for (int e = 1; e < 16; ++e) {
#pragma unroll
                for (int f = 0; f < e; ++f) acc[e] -= As[(blk * 16 + e) * ALD + blk * 16 + f] * acc[f];
            }
#pragma unroll
            for (int e = 0; e < 16; ++e) { const int ii = blk * 16 + e; buf[ii * LD] = acc[e];
                if (isu) U[ii * 128 + col] = acc[e]; else Wd[ii * 128 + col] = f2bf(acc[e]); }
        }
        __syncthreads();
    }
    if (pfv == 0x7fc3u) gcs[0] = 1.f;
    asm volatile("s_waitcnt vmcnt(0)" ::: "memory");
    __syncthreads();
}

__device__ __forceinline__ void phase_gdn_chunk(const Params& p, int i, unsigned char* smem) {
    if (gridDim.x == 256) {
        for (int it = mk_lbid(); it < 64 * GDN_LATE; it += 256) {
            const int s = it / (8 * GDN_LATE), rem = it % (8 * GDN_LATE), h = rem / GDN_LATE, c = rem % GDN_LATE;
            const int nit = it + 256; int pf_row = -1, pf_h = 0;
            if (nit < 64 * GDN_LATE) { const int rem2 = nit % (8 * GDN_LATE); pf_row = (nit / (8 * GDN_LATE)) * 2048 + (rem2 % GDN_LATE) * 64; pf_h = rem2 / GDN_LATE; }
            gdn_chunk_item(p, i, s, h, c, pf_row, pf_h, smem);
        }
    } else
    for (int it = mk_lbid(); it < N_CH; it += gridDim.x) {
        int s, h, c;
        if (it < 2048) { s = it >> 8; h = (it >> 5) & 7; c = it & 31; } else { const int k = it - 2048; s = 8 + (k >> 3); h = k & 7; c = 0; }
        const int nit = it + gridDim.x; int pf_row = -1, pf_h = 0;
        if (nit < 2048) { pf_row = (nit >> 8) * 2048 + (nit & 31) * 64; pf_h = (nit >> 5) & 7; }
        gdn_chunk_item(p, i, s, h, c, pf_row, pf_h, smem);
    }
    const bf16_t* ZB = (const bf16_t*)(p.ws + WS_ZB);
    const int gt = mk_lbid() * 512 + mk_ltid(), GT = gridDim.x * 512;
    for (int idx = gt; idx < 136 * 3 * 3072; idx += GT) {
        const int s = idx / (3 * 3072), rem = idx % (3 * 3072), j = rem / 3072, zc = rem % 3072;
        int row0, L; seq_info(s, row0, L);
        const float v = bf2f(ZB[(size_t)(row0 + L - 3 + j) * GD_N + zc]);
        if (s < 8) p.out[O_PCONV + (((size_t)i * 8 + s) * 3 + j) * 3072 + zc] = v;
        else p.out[O_SCONV + (((size_t)i * 128 + (s - 8)) * 3 + j) * 3072 + zc] = v;
    }
}

__device__ __forceinline__ void gdn_scan_item(const Params& p, int i, int s, int h, unsigned* flags, unsigned tag, unsigned char* smem) {
    const int tid = mk_ltid(), lane = tid & 63, w = __builtin_amdgcn_readfirstlane(tid >> 6);
    const int r = lane & 15, q = lane >> 4;
    int row0, L; seq_info(s, row0, L);
    const int nch = (s < 8) ? 32 : 1;
    const bf16_t* ZB = (const bf16_t*)(p.ws + WS_ZB); bf16_t* OMIX = (bf16_t*)(p.ws + WS_OMIX);
    const float* GL = (const float*)(p.ws + WS_GL);
    const float* ng = p.in[31] + i * 128;
    constexpr int LD = 136, VLD = 72, ULD = 132;
    bf16_t* SB = (bf16_t*)smem;
    bf16_t* VN = (bf16_t*)(smem + 34816);
    float* red = (float*)(smem + 53248);
    bf16_t* WL = (bf16_t*)(smem + 53760);
    bf16_t* QGL = (bf16_t*)(smem + 71168);
    bf16_t* QKL = (bf16_t*)(smem + 88576);
    bf16_t* KDL = (bf16_t*)(smem + 97792);
    float* UL = (float*)(smem + 116224);
    f32x4 ST[8];
#pragma unroll
    for (int nt = 0; nt < 8; ++nt) ST[nt] = (f32x4){0.f, 0.f, 0.f, 0.f};
    if (s >= 8) {
        const float* S0 = p.in[6] + (((size_t)i * 128 + (s - 8)) * 8 + h) * 16384;
#pragma unroll
        for (int nt = 0; nt < 8; ++nt) ST[nt] = *(const f32x4*)(S0 + (size_t)(nt * 16 + r) * 128 + 16 * w + q * 4);
    }
    const int mt = w & 3, nh = w >> 2;
    u32x4 pw[2], pq[2], pk, pd[2]; f32x4 pu[4]; float pgl;
    const bool smp = (s >= 8);
#define GDN_PREFETCH(cc) do { const int item_ = gdn_item_index(s, h, (cc)); const unsigned char* rec_ = p.ws + WS_CH + (size_t)item_ * CH_BYTES; \
        const u32x4 z4_ = (u32x4){0u, 0u, 0u, 0u}; \
        _Pragma("unroll") for (int k_ = 0; k_ < 2; ++k_) { const int idx_ = tid + k_ * 512; \
            pw[k_] = (smp && (idx_ >> 4) >= 16) ? z4_ : *(const u32x4*)((const bf16_t*)(rec_ + CH_W) + (idx_ >> 4) * 128 + (idx_ & 15) * 8); \
            pq[k_] = (smp && (idx_ >> 4) >= 16) ? z4_ : *(const u32x4*)((const bf16_t*)(rec_ + CH_QG) + (idx_ >> 4) * 128 + (idx_ & 15) * 8); \
            pd[k_] = (smp && (idx_ & 7) >= 2) ? z4_ : *(const u32x4*)((const bf16_t*)(rec_ + CH_KDT) + (idx_ >> 3) * 64 + (idx_ & 7) * 8); } \
        pk = (smp && (tid >> 3) >= 16) ? z4_ : *(const u32x4*)((const bf16_t*)(rec_ + CH_QK) + (tid >> 3) * 64 + (tid & 7) * 8); \
        _Pragma("unroll") for (int k_ = 0; k_ < 4; ++k_) { const int idx_ = tid + k_ * 512; \
            pu[k_] = (smp && (idx_ >> 5) >= 16) ? (f32x4){0.f, 0.f, 0.f, 0.f} : *(const f32x4*)((const float*)(rec_ + CH_U) + (idx_ >> 5) * 128 + (idx_ & 31) * 4); } \
        pgl = GL[item_]; } while (0)
#define GDN_WAIT(cc) do { if (flags && (cc) >= GDN_LATE) { if (tid == 0) { unsigned* f_ = flags + (s * 8 + h) * 32 + (cc); \
        while (__hip_atomic_load(f_, __ATOMIC_RELAXED, __HIP_MEMORY_SCOPE_AGENT) != tag) __builtin_amdgcn_s_sleep(2); \
        __builtin_amdgcn_fence(__ATOMIC_ACQUIRE, "agent"); asm volatile("s_waitcnt vmcnt(0)" ::: "memory"); } \
        __syncthreads(); } } while (0)
    GDN_PREFETCH(0);
    for (int c = 0; c < nch; ++c) {
        const float glast = pgl;
        const int rb = row0 + c * 64; const int nvalid = (L - c * 64) < 64 ? (L - c * 64) : 64;
#pragma unroll
        for (int k = 0; k < 2; ++k) { const int idx = tid + k * 512;
            *(u32x4*)(WL + (idx >> 4) * LD + (idx & 15) * 8) = pw[k]; *(u32x4*)(QGL + (idx >> 4) * LD + (idx & 15) * 8) = pq[k];
            *(u32x4*)(KDL + (idx >> 3) * VLD + (idx & 7) * 8) = pd[k]; }
        *(u32x4*)(QKL + (tid >> 3) * VLD + (tid & 7) * 8) = pk;
#pragma unroll
        for (int k = 0; k < 4; ++k) { const int idx = tid + k * 512; *(f32x4*)(UL + (idx >> 5) * ULD + (idx & 31) * 4) = pu[k]; }
#pragma unroll
        for (int nt = 0; nt < 8; ++nt)
#pragma unroll
            for (int j = 0; j < 4; ++j) SB[(16 * w + q * 4 + j) * LD + nt * 16 + r] = f2bf(ST[nt][j]);
        __syncthreads();
        if (c + 1 < nch) { GDN_WAIT(c + 1); GDN_PREFETCH(c + 1); }
        u32x2 zgv[4];
        { const int tk_ = mt * 16 + r; const size_t row_ = (size_t)(rb + (tk_ < nvalid ? tk_ : 0));
#pragma unroll
          for (int n4 = 0; n4 < 4; ++n4) zgv[n4] = *(const u32x2*)(ZB + row_ * GD_N + 3088 + h * 128 + (nh * 4 + n4) * 16 + q * 4); }
        f32x4 aws[4], aqg[4];
#pragma unroll
        for (int n4 = 0; n4 < 4; ++n4) { aws[n4] = (f32x4){0.f, 0.f, 0.f, 0.f}; aqg[n4] = aws[n4]; }
#pragma unroll
        for (int ks = 0; ks < 4; ++ks) {
            const bf16x8 fw = *(const bf16x8*)(WL + (mt * 16 + r) * LD + ks * 32 + q * 8);
            const bf16x8 fq = *(const bf16x8*)(QGL + (mt * 16 + r) * LD + ks * 32 + q * 8);
#pragma unroll
            for (int n4 = 0; n4 < 4; ++n4) {
                const bf16x8 bs = *(const bf16x8*)(SB + ((nh * 4 + n4) * 16 + r) * LD + ks * 32 + q * 8);
                aws[n4] = __builtin_amdgcn_mfma_f32_16x16x32_bf16(fw, bs, aws[n4], 0, 0, 0);
                aqg[n4] = __builtin_amdgcn_mfma_f32_16x16x32_bf16(bs, fq, aqg[n4], 0, 0, 0);
            }
        }
#pragma unroll
        for (int n4 = 0; n4 < 4; ++n4) {
            const int dv = (nh * 4 + n4) * 16 + r;
            float vn[4];
#pragma unroll
            for (int j = 0; j < 4; ++j) vn[j] = UL[(mt * 16 + q * 4 + j) * ULD + dv] - aws[n4][j];
            u32x2 o; o.x = pk2(vn[0], vn[1]); o.y = pk2(vn[2], vn[3]);
            *(u32x2*)(VN + dv * VLD + mt * 16 + q * 4) = o;
        }
        __syncthreads();
#pragma unroll
        for (int ks = 0; ks < 2; ++ks) {
            const bf16x8 fk = *(const bf16x8*)(QKL + (mt * 16 + r) * VLD + ks * 32 + q * 8);
#pragma unroll
            for (int n4 = 0; n4 < 4; ++n4) {
                const bf16x8 bv = *(const bf16x8*)(VN + ((nh * 4 + n4) * 16 + r) * VLD + ks * 32 + q * 8);
                aqg[n4] = __builtin_amdgcn_mfma_f32_16x16x32_bf16(bv, fk, aqg[n4], 0, 0, 0);
            }
        }
        {
            float a = 0.f;
#pragma unroll
            for (int n4 = 0; n4 < 4; ++n4)
#pragma unroll
                for (int j = 0; j < 4; ++j) a += aqg[n4][j] * aqg[n4][j];
            a += __shfl_xor(a, 16); a += __shfl_xor(a, 32);
            if (q == 0) red[(mt * 16 + r) * 2 + nh] = a;
        }
#pragma unroll
        for (int nt = 0; nt < 8; ++nt) ST[nt] = ST[nt] * glast;
#pragma unroll
        for (int ks = 0; ks < 2; ++ks) {
            const bf16x8 av = *(const bf16x8*)(VN + (16 * w + r) * VLD + ks * 32 + q * 8);
#pragma unroll
            for (int nt = 0; nt < 8; ++nt) {
                const bf16x8 bk = *(const bf16x8*)(KDL + (nt * 16 + r) * VLD + ks * 32 + q * 8);
                ST[nt] = __builtin_amdgcn_mfma_f32_16x16x32_bf16(av, bk, ST[nt], 0, 0, 0);
            }
        }
        __syncthreads();
        {
            const int tk = mt * 16 + r;
            if (tk < nvalid) {
                const float rs = rsqrtf((red[tk * 2] + red[tk * 2 + 1]) * (1.f / 128.f) + 1e-6f);
                const size_t row = (size_t)(rb + tk);
#pragma unroll
                for (int n4 = 0; n4 < 4; ++n4) { const int dvb = (nh * 4 + n4) * 16 + q * 4;
                    const f32x4 g4 = *(const f32x4*)(ng + dvb);
                    const float z0 = __uint_as_float(zgv[n4].x << 16), z1 = __uint_as_float(zgv[n4].x & 0xffff0000u), z2 = __uint_as_float(zgv[n4].y << 16), z3 = __uint_as_float(zgv[n4].y & 0xffff0000u);
                    u32x2 o; o.x = pk2(aqg[n4][0] * rs * g4[0] * silu(z0), aqg[n4][1] * rs * g4[1] * silu(z1));
                    o.y = pk2(aqg[n4][2] * rs * g4[2] * silu(z2), aqg[n4][3] * rs * g4[3] * silu(z3));
                    *(u32x2*)(OMIX + row * 1024 + h * 128 + dvb) = o; }
            }
        }
    }
#undef GDN_PREFETCH
#undef GDN_WAIT
    float* so = (s < 8) ? p.out + O_PGDN + (((size_t)i * 8 + s) * 8 + h) * 16384 : p.out + O_SGDN + (((size_t)i * 128 + (s - 8)) * 8 + h) * 16384;
#pragma unroll
    for (int nt = 0; nt < 8; ++nt) *(f32x4*)(so + (size_t)(nt * 16 + r) * 128 + 16 * w + q * 4) = ST[nt];
    __syncthreads();
}

__device__ __forceinline__ void phase_gdn_scan(const Params& p, int i, int l, unsigned char* smem) {
    const int bid = mk_lbid(), G = gridDim.x; const int wv = mk_ltid() >> 6;
    if (G == 256) {
        unsigned* flags = (unsigned*)(p.ws + WS_FLAGS); const unsigned tag = (unsigned)(i + 1);
        if (bid < 64) gdn_scan_item(p, i, bid >> 3, bid & 7, flags, tag, smem);
        else {
            for (int j = bid - 64; j < 64 * (32 - GDN_LATE); j += 192) {
                const int c = GDN_LATE + (j >> 6), sh = j & 63;
                gdn_chunk_item(p, i, sh >> 3, sh & 7, c, -1, 0, smem);
                if (mk_ltid() == 0) { __builtin_amdgcn_fence(__ATOMIC_RELEASE, "agent"); asm volatile("s_waitcnt vmcnt(0)" ::: "memory");
                    __hip_atomic_store(&flags[sh * 32 + c], tag, __ATOMIC_RELAXED, __HIP_MEMORY_SCOPE_AGENT); }
            }
            for (int it = bid - 64; it < 128 * 8; it += 192) { gdn_chunk_item(p, i, 8 + (it >> 3), it & 7, 0, -1, 0, smem); gdn_scan_item(p, i, 8 + (it >> 3), it & 7, nullptr, 0u, smem); }
            convert_ffn_ahead(p, l, (bid - 64) * 8 + wv, 192 * 8, smem);
        }
    } else {
        for (int it = bid; it < 136 * 8; it += G) { const int s = it >> 3, h = it & 7; gdn_scan_item(p, i, s, h, nullptr, 0u, smem); }
        convert_ffn_ahead(p, l, bid * 8 + wv, G * 8, smem);
    }
}

__global__ void __launch_bounds__(512, 2) mega(Params p) {
    extern __shared__ __attribute__((aligned(16))) unsigned char lds[];
    cg::grid_group grid = cg::this_grid();
    constexpr int NPH = 1 + 4 * 12;
    unsigned* bar = (unsigned*)(p.ws + WS_BAR);
    volatile unsigned* bst = (volatile unsigned*)(lds + LDS_BYTES - 16);
    if (mk_ltid() == 0) { bst[0] = 0u; bst[1] = 0u; }
    if (mk_lbid() == 0) for (int u = mk_ltid(); u < CTL_WORDS; u += 512) __hip_atomic_store(bar + u, 0u, __ATOMIC_RELAXED, __HIP_MEMORY_SCOPE_AGENT);
    __syncthreads();
#pragma unroll 1
    for (int ph = 0; ph < NPH; ++ph) {
        int l = (ph == 0) ? 0 : (ph - 1) / 12, k = (ph == 0) ? -1 : (ph - 1) % 12;
        asm volatile("" : "+s"(l), "+s"(k));
        const int i = l >> 1; const bool ab = (l & 1) == 0;
        if (k == 6 && !ab) continue;
        unsigned char* ws = p.ws; asm volatile("" : "+s"(ws));
        unsigned char* smem = (unsigned char*)lds;
        PG8_LAS unsigned char* ldsp = (PG8_LAS unsigned char*)lds;
        const int G = gridDim.x, cu = mk_lbid();
#ifndef REPMASK
#define REPMASK 0
#endif
#ifndef REPAB
#define REPAB 3
#endif
        const int nrep = (((REPMASK >> (k + 1)) & 1) && ((REPAB >> (l & 1)) & 1)) ? 2 : 1;
#pragma unroll 1
        for (int rep = 0; rep < nrep; ++rep) {
        if (rep) grid.sync();
        if (k == -1) phase_start(p, smem);
        else if (k == 0 || k == 9) {
            const int j = (k == 9);
            pg8::Gemm g{(const bf16_t*)(ws + WS_HB), (const bf16_t*)(ws + WS_WGU) + (size_t)j * 5632 * 1024, M, 5632, D};
            pg8::StaticOrder S; S.init(g.M, g.N, G, cu); EpiSwiglu E{(bf16_t*)(ws + WS_HID)};
            pg8::gemm_phase<EpiSwiglu, pg8::StaticOrder, true, true>(ldsp, g, S, E);
        } else if (k == 1 || k == 10 || k == 7) {
            const int j = (k == 10);
            pg8::Gemm g{(const bf16_t*)(ws + (k == 7 ? WS_OMIX : WS_HID)), k == 7 ? (const bf16_t*)(ws + WS_WOUT) : (const bf16_t*)(ws + WS_WD) + (size_t)j * 1024 * 2816, MP, D, k == 7 ? D : FF};
            pg8::StaticOrder S; S.init(g.M, g.N, G, cu); EpiResid E{(bf16_t*)(ws + WS_X), (const bf16_t*)(ws + WS_HB), k == 7 ? 1.0f : 0.5f};
            pg8::gemm_phase<EpiResid, pg8::StaticOrder, true, true>(ldsp, g, S, E);
            small_resid_gemm(g.A, g.Bt, g.K, E.X, E.H, E.scale, smem);
        } else if (k == 2 || k == 8 || k == 11) {
            phase_ln(p, l, k == 2 ? 0 : (k == 8 ? 1 : 2), (l == 3 && k == 11));
            if (k == 11 && l < 3) convert_items(p, l + 1, 4, mk_lbid() * 8 + (mk_ltid() >> 6), gridDim.x * 8, smem);
        } else if (k == 3) {
            pg8::Gemm g{(const bf16_t*)(ws + WS_HB), (const bf16_t*)(ws + WS_WIN), M, ab ? AB_N : GD_N, D};
            pg8::StaticOrder S; S.init(g.M, g.N, G, cu); EpiZ E{(bf16_t*)(ws + WS_ZB), g.N};
            pg8::gemm_phase<EpiZ, pg8::StaticOrder, true, true>(ldsp, g, S, E);
        } else if (k == 4) { if (ab) phase_ab_prep(p, i, smem); else phase_gdn_chunk(p, i, smem); }
        else if (k == 5) { if (ab) phase_ab_core(p, i, l, smem); else phase_gdn_scan(p, i, l, smem); }
        else if (k == 6) phase_ab_post(p, i);
        }
        if (ph + 1 < NPH) { if (ph == 0) { grid.sync(); if (mk_ltid() == 0) (void)xb_add(&bar[XB_XCNT(xb_xcc_id())], 1u); } else gbar(bar, bst); }
#ifdef REPSYNC
        if (ph > 0) { gbar(bar, bst); gbar(bar, bst); }
#endif
    }
}
}

extern "C" void kernel_launch(void* const* d_in, const int* in_sizes, int n_in, void* d_out, int out_size, void* d_ws, size_t ws_size, hipStream_t stream) {
    static int grid_blocks = 0;
    if (grid_blocks == 0) {
        if (n_in != 33 || ws_size < mk::WS_NEED) { fprintf(stderr, "kernel_launch: need 33 inputs and %zu bytes of workspace; got %d, %zu\n", (size_t)mk::WS_NEED, n_in, ws_size); grid_blocks = -1; return; }
        int dev = 0, cus = 0, per_cu = 0;
        hipGetDevice(&dev);
        hipDeviceGetAttribute(&cus, hipDeviceAttributeMultiprocessorCount, dev);
        if (hipFuncSetAttribute((const void*)mk::mega, hipFuncAttributeMaxDynamicSharedMemorySize, mk::LDS_BYTES) != hipSuccess) { fprintf(stderr, "kernel_launch: hipFuncSetAttribute failed\n"); grid_blocks = -1; return; }
        if (hipOccupancyMaxActiveBlocksPerMultiprocessor(&per_cu, (const void*)mk::mega, 512, mk::LDS_BYTES) != hipSuccess || per_cu < 1) { fprintf(stderr, "kernel_launch: occupancy query failed (%d)\n", per_cu); (void)hipGetLastError(); per_cu = 1; }
        grid_blocks = cus * 1;
        fprintf(stderr, "kernel_launch: grid %d (cus %d, per_cu %d)\n", grid_blocks, cus, per_cu);
    }
    if (grid_blocks < 0) return;
    mk::Params prm{};
    for (int k = 0; k < 33; ++k) prm.in[k] = (const float*)d_in[k];
    prm.out = (float*)d_out; prm.ws = (unsigned char*)d_ws;
    void* args[] = {&prm};
    hipError_t e = hipLaunchCooperativeKernel((const void*)mk::mega, dim3(grid_blocks), dim3(512), args, mk::LDS_BYTES, stream);
    if (e != hipSuccess) fprintf(stderr, "cooperative launch failed: %s (grid %d)\n", hipGetErrorString(e), grid_blocks);
}
```

```cpp
#include <hip/hip_runtime.h>
#include <hip/hip_cooperative_groups.h>
#include <cstdio>
#include <cstdint>
namespace cg = cooperative_groups;
__device__ __forceinline__ int mk_ltid() { int t = threadIdx.x; asm volatile("" : "+v"(t)); return t; }
__device__ __forceinline__ int mk_lbid() { int t = blockIdx.x; asm volatile("" : "+s"(t)); return t; }
namespace pg8 {
#define PG8_LAS __attribute__((address_space(3)))
typedef unsigned short bf16_t;
typedef short bf16x8 __attribute__((ext_vector_type(8)));
typedef float f32x4 __attribute__((ext_vector_type(4)));
typedef unsigned u32x4 __attribute__((ext_vector_type(4)));
constexpr int BM = 256, BK = 64, HALF = 128, HTB = HALF * BK * 2  , STAGE_BYTES = 8 * HTB, NXCD = 8, WGM = 8;

__host__ __device__ __forceinline__ int lds_byte(int r, int c) { const int st = (r >> 4) * 2 + (c >> 5), rr = r & 15, cc = c & 31, ob = rr * 64 + cc * 2; return st * 1024 + (ob ^ (((ob >> 9) & 1) << 5)); }
__host__ __device__ __forceinline__ void stage_rc(int b, int& R, int& C) { const int st = b / 1024, sb = b % 1024, swz = sb ^ (((sb >> 9) & 1) << 5); R = (st >> 1) * 16 + swz / 64; C = (st & 1) * 32 + (swz % 64) / 2; }
__host__ __device__ __forceinline__ int perm32(int rho) { const int n = rho >> 4, i = rho & 15; return 8 * (i >> 2) + 4 * n + (i & 3); }

struct Unit { int pm, pn; };
struct Gemm { const bf16_t* A; const bf16_t* Bt; int M, N, K; };

struct StaticOrder {
    int nM, nN, nwg, G, c;
    __host__ __device__ void init(int M, int N, int G_, int c_) { nM = M / BM; nN = N / BM; nwg = nM * nN; G = G_; c = c_; }
    __host__ __device__ bool next(int i, Unit& u) const {
        const long L = (long)i * G + c; if (L >= nwg) return false;
        int wgid = (int)L; { const int q = nwg / NXCD, r = nwg % NXCD, xcd = wgid % NXCD, off = wgid / NXCD; wgid = (xcd < r ? xcd * (q + 1) : r * (q + 1) + (xcd - r) * q) + off; }
        const int nig = WGM * nN, gid = wgid / nig, fm = gid * WGM, gsz = (nM - fm) < WGM ? (nM - fm) : WGM;
        u.pm = fm + ((wgid % nig) % gsz); u.pn = (wgid % nig) / gsz; return true;
    }
    __device__ __forceinline__ void a_ready(const Unit&) const {}
    __device__ __forceinline__ void done(const Unit&) const {}
};

template <class Epi, class Sched, bool ALIGN_EPI = false, bool SP2 = false>
__device__ __forceinline__ void gemm_phase(PG8_LAS unsigned char* lds, const Gemm g, const Sched& S, const Epi& E) {
    const int tid = mk_ltid(), wid = __builtin_amdgcn_readfirstlane(tid >> 6), lane = tid & 63, wr = wid >> 2, wc = wid & 3, fr = lane & 15, fq = lane >> 4;
    const int K = g.K, nt = K / BK;
    unsigned voffA[2], voffB[2];
#pragma unroll
    for (int i = 0; i < 2; ++i) { int R, C; stage_rc(tid * 16 + i * 8192, R, C); const int Rb = Epi::PERM ? ((R & ~31) + perm32(R & 31)) : R;
        voffA[i] = (unsigned)(R * K + C) * 2u; voffB[i] = (unsigned)(Rb * K + C) * 2u; }
    const size_t kstep = (size_t)(BK * 2);
    const size_t hstep = (size_t)HALF * K * 2;
    const size_t tstep = 2 * hstep;
    const unsigned ldsw = (unsigned)wid * 1024u;
    const int aoff = lds_byte(wr * 64 + fr, fq * 8), boff = lds_byte(wc * 32 + fr, fq * 8);
#define PG8_SA(b, h) (((b) * 2 + (h)) * HTB)
#define PG8_SB(b, h) ((4 + (b) * 2 + (h)) * HTB)
#define PG8_STAGE(bufoff, gbase, voff) do { _Pragma("unroll") for (int _i = 0; _i < 2; ++_i) \
        __builtin_amdgcn_global_load_lds((const unsigned*)((const char*)(gbase) + (voff)[_i]), (PG8_LAS unsigned*)(lds + (bufoff) + ldsw + _i * 8192), 16, 0, 0); } while (0)
#define PG8_LDA(dst, b, h) do { _Pragma("unroll") for (int m = 0; m < 4; ++m) _Pragma("unroll") for (int k = 0; k < 2; ++k) dst[m][k] = *(const PG8_LAS bf16x8*)(lds + PG8_SA(b, h) + aoff + m * 2048 + k * 1024); } while (0)
#define PG8_LDB(dst, b, h) do { _Pragma("unroll") for (int n = 0; n < 2; ++n) _Pragma("unroll") for (int k = 0; k < 2; ++k) dst[n][k] = *(const PG8_LAS bf16x8*)(lds + PG8_SB(b, h) + boff + n * 2048 + k * 1024); } while (0)
#define PG8_MMA(ai, bj, At, Bt) do { __builtin_amdgcn_s_setprio(1); _Pragma("unroll") for (int m = 0; m < 4; ++m) _Pragma("unroll") for (int n = 0; n < 2; ++n) _Pragma("unroll") for (int k = 0; k < 2; ++k) \
        acc[ai][bj][m][n] = __builtin_amdgcn_mfma_f32_16x16x32_bf16(Bt[n][k], At[m][k], acc[ai][bj][m][n], 0, 0, 0); __builtin_amdgcn_s_setprio(0); } while (0)
#define PG8_WAIT_V(n) asm volatile("s_waitcnt vmcnt(" #n ")" ::: "memory")
#define PG8_WAIT_L(n) asm volatile("s_waitcnt lgkmcnt(" #n ")" ::: "memory")
#define PG8_BAR __builtin_amdgcn_s_barrier()
#define PG8_SCHED __builtin_amdgcn_sched_barrier(0)
    Unit cur, nxt; int ui = 0;
    if (!S.next(0, cur)) return;
    f32x4 acc[2][2][4][2];
#pragma unroll
    for (int a = 0; a < 2; ++a)
#pragma unroll
        for (int b = 0; b < 2; ++b)
#pragma unroll
            for (int m = 0; m < 4; ++m)
#pragma unroll
                for (int n = 0; n < 2; ++n) acc[a][b][m][n] = (f32x4){0.f, 0.f, 0.f, 0.f};
    bf16x8 At[4][2], B0[2][2], B1[2][2];
    const char* cA = (const char*)g.A + (size_t)cur.pm * tstep; const char* cB = (const char*)g.Bt + (size_t)cur.pn * tstep;
    S.a_ready(cur);
    if constexpr (SP2) {
        PG8_STAGE(PG8_SB(0, 0), cB, voffB); PG8_STAGE(PG8_SB(0, 1), cB + hstep, voffB); PG8_STAGE(PG8_SA(0, 0), cA, voffA); PG8_STAGE(PG8_SA(0, 1), cA + hstep, voffA);
        if (wr == 1) PG8_BAR;
        PG8_WAIT_V(2); PG8_BAR;
        PG8_STAGE(PG8_SB(1, 0), cB + kstep, voffB); PG8_STAGE(PG8_SA(1, 0), cA + kstep, voffA); PG8_STAGE(PG8_SB(1, 1), cB + hstep + kstep, voffB);
        PG8_WAIT_V(6); PG8_BAR;
    } else {
        PG8_STAGE(PG8_SB(0, 0), cB, voffB); PG8_STAGE(PG8_SA(0, 0), cA, voffA); PG8_STAGE(PG8_SB(0, 1), cB + hstep, voffB); PG8_STAGE(PG8_SA(0, 1), cA + hstep, voffA);
        if (wr == 1) PG8_BAR;
        PG8_WAIT_V(4); PG8_BAR;
        PG8_STAGE(PG8_SB(1, 0), cB + kstep, voffB); PG8_STAGE(PG8_SA(1, 0), cA + kstep, voffA); PG8_STAGE(PG8_SB(1, 1), cB + hstep + kstep, voffB);
        PG8_WAIT_V(6); PG8_BAR;
    }
    for (;;) {
        const bool has_next = S.next(ui + 1, nxt);
        const char* nA = has_next ? (const char*)g.A + (size_t)nxt.pm * tstep : cA; const char* nB = has_next ? (const char*)g.Bt + (size_t)nxt.pn * tstep : cB;
        for (int t = 0; t < nt; t += 2) {
            const bool last = (t == nt - 2);
            const char* a1 = cA + (size_t)(t + 1) * kstep;
            const char* a2 = last ? nA : cA + (size_t)(t + 2) * kstep; const char* b2 = last ? nB : cB + (size_t)(t + 2) * kstep;
            const char* a3 = a2 + kstep; const char* b3 = b2 + kstep;
            if (last && has_next) S.a_ready(nxt);
            if constexpr (SP2) {
            PG8_LDB(B0, 0, 0); PG8_LDB(B1, 0, 1); PG8_SCHED; PG8_LDA(At, 0, 0); PG8_STAGE(PG8_SA(1, 1), a1 + hstep, voffA);
            PG8_WAIT_V(8); PG8_WAIT_L(0); PG8_BAR; PG8_MMA(0, 0, At, B0); PG8_MMA(0, 1, At, B1); PG8_BAR; PG8_SCHED;
            PG8_LDA(At, 0, 1); PG8_STAGE(PG8_SB(0, 0), b2, voffB); PG8_STAGE(PG8_SB(0, 1), b2 + hstep, voffB); PG8_STAGE(PG8_SA(0, 0), a2, voffA);
            PG8_WAIT_V(8); PG8_WAIT_L(0); PG8_BAR; PG8_MMA(1, 0, At, B0); PG8_MMA(1, 1, At, B1); PG8_BAR; PG8_SCHED;
            PG8_LDB(B0, 1, 0); PG8_LDB(B1, 1, 1); PG8_SCHED; PG8_LDA(At, 1, 0); PG8_STAGE(PG8_SA(0, 1), a2 + hstep, voffA);
            PG8_WAIT_V(8); PG8_WAIT_L(0); PG8_BAR; PG8_MMA(0, 0, At, B0); PG8_MMA(0, 1, At, B1); PG8_BAR; PG8_SCHED;
            PG8_LDA(At, 1, 1); PG8_STAGE(PG8_SB(1, 0), b3, voffB); PG8_STAGE(PG8_SB(1, 1), b3 + hstep, voffB); PG8_STAGE(PG8_SA(1, 0), a3, voffA);
            PG8_WAIT_V(8); PG8_WAIT_L(0); PG8_BAR; PG8_MMA(1, 0, At, B0); PG8_MMA(1, 1, At, B1); PG8_BAR; PG8_SCHED;
            } else {
            PG8_LDB(B0, 0, 0); PG8_SCHED; PG8_LDA(At, 0, 0); PG8_STAGE(PG8_SA(1, 1), a1 + hstep, voffA);
            PG8_WAIT_L(8); PG8_BAR; PG8_WAIT_L(0); PG8_MMA(0, 0, At, B0); PG8_BAR; PG8_SCHED;
            PG8_LDB(B1, 0, 1); PG8_STAGE(PG8_SB(0, 0), b2, voffB);
            PG8_BAR; PG8_WAIT_L(0); PG8_MMA(0, 1, At, B1); PG8_BAR;
            PG8_LDA(At, 0, 1); PG8_STAGE(PG8_SA(0, 0), a2, voffA);
            PG8_BAR; PG8_WAIT_L(0); PG8_MMA(1, 0, At, B0); PG8_BAR; PG8_SCHED;
            PG8_STAGE(PG8_SB(0, 1), b2 + hstep, voffB);
            PG8_WAIT_V(6); PG8_BAR; PG8_MMA(1, 1, At, B1); PG8_BAR;
            PG8_LDB(B0, 1, 0); PG8_SCHED; PG8_LDA(At, 1, 0); PG8_STAGE(PG8_SA(0, 1), a2 + hstep, voffA);
            PG8_WAIT_L(8); PG8_BAR; PG8_WAIT_L(0); PG8_MMA(0, 0, At, B0); PG8_BAR; PG8_SCHED;
            PG8_LDB(B1, 1, 1); PG8_STAGE(PG8_SB(1, 0), b3, voffB);
            PG8_BAR; PG8_WAIT_L(0); PG8_MMA(0, 1, At, B1); PG8_BAR;
            PG8_LDA(At, 1, 1); PG8_STAGE(PG8_SA(1, 0), a3, voffA);
            PG8_BAR; PG8_WAIT_L(0); PG8_MMA(1, 0, At, B0); PG8_BAR; PG8_SCHED;
            PG8_STAGE(PG8_SB(1, 1), b3 + hstep, voffB);
            PG8_WAIT_V(6); PG8_BAR; PG8_MMA(1, 1, At, B1); PG8_BAR;
            }
        }
        if constexpr (ALIGN_EPI) { if (wr == 0) PG8_BAR; }
        if constexpr (!Epi::AFTER_DRAIN) { E(acc, cur, wr, wc, fr, fq); S.done(cur); }
        if (!has_next) break;
#pragma unroll
        for (int a = 0; a < 2; ++a)
#pragma unroll
            for (int b = 0; b < 2; ++b)
#pragma unroll
                for (int m = 0; m < 4; ++m)
#pragma unroll
                    for (int n = 0; n < 2; ++n) acc[a][b][m][n] = (f32x4){0.f, 0.f, 0.f, 0.f};
        cur = nxt; cA = nA; cB = nB; ++ui;
        if constexpr (ALIGN_EPI) { if (wr == 1) PG8_BAR; }
    }
    PG8_WAIT_V(0);
    if constexpr (!ALIGN_EPI) { if (wr == 0) PG8_BAR; }
    PG8_BAR;
    if constexpr (Epi::AFTER_DRAIN) { E.fused(acc, cur, wr, wc, fr, fq, lds, wid, lane); S.done(cur); }
#undef PG8_SA
#undef PG8_SB
#undef PG8_STAGE
#undef PG8_LDA
#undef PG8_LDB
#undef PG8_MMA
#undef PG8_WAIT_V
#undef PG8_WAIT_L
#undef PG8_BAR
#undef PG8_SCHED
}
}

namespace mk {
using pg8::bf16_t; using pg8::bf16x8; using pg8::f32x4; using pg8::Unit;
typedef unsigned u32x4 __attribute__((ext_vector_type(4)));
typedef unsigned u32x2 __attribute__((ext_vector_type(2)));

constexpr int M = 16896, MP = 16384, D = 1024, FF = 2816;
constexpr int AB_N = 3840, GD_N = 4352, GD_NREAL = 4112;
constexpr float ALPHA = 1.6817928305074290f;
constexpr int LDS_BYTES = 163840;

constexpr size_t O_PSHIFT = 17301504, O_PRWKV = 17330176, O_PRET = 17854464, O_PCONV = 18903040, O_PGDN = 19050496;
constexpr size_t O_SSHIFT = 21147648, O_SRWKV = 21606400, O_SRET = 29995008, O_SCONV = 46772224, O_SGDN = 49131520;

constexpr size_t WS_WGU = 0;
constexpr size_t WS_WD = WS_WGU + 2ull * 5632 * 1024 * 2;
constexpr size_t WS_WIN = WS_WD + 2ull * 1024 * 2816 * 2;
constexpr size_t WS_WOUT = WS_WIN + 4352ull * 1024 * 2;
constexpr size_t WS_W2T = WS_WOUT + 1024ull * 1024 * 2;
constexpr size_t WS_A2T = WS_W2T + 65536;
constexpr size_t WS_G2T = WS_A2T + 65536;
constexpr size_t WS_X = WS_G2T + 131072;
constexpr size_t WS_HB = WS_X + (size_t)M * 1024 * 4;
constexpr size_t WS_S = WS_HB + (size_t)M * 1024 * 2;
constexpr size_t WS_HID = WS_S;
constexpr size_t WS_OMIX = WS_S;
constexpr size_t WS_ZB = WS_OMIX + (size_t)M * 1024 * 2;
constexpr size_t WS_OPS = WS_ZB + (size_t)M * AB_N * 2;
constexpr size_t WS_GATE = WS_OPS + (size_t)M * 3072 * 4;
constexpr size_t WS_ORAW = WS_GATE + (size_t)M * 512 * 4;
constexpr size_t WS_BONUS = WS_ORAW + (size_t)M * 512 * 4;
constexpr size_t WS_RQ = WS_BONUS + (size_t)M * 8 * 4;
constexpr size_t WS_RK = WS_RQ + (size_t)M * 512 * 2;
constexpr size_t WS_AB_END = WS_RK + (size_t)M * 512 * 2;
constexpr size_t WS_CH = WS_ZB + (size_t)M * GD_N * 2;
constexpr size_t CH_U = 0, CH_W = 32768, CH_QG = 49152, CH_QK = 65536, CH_KDT = 73728, CH_BYTES = 90112;
constexpr int N_CH = 2048 + 1024;
constexpr size_t WS_GL = WS_CH + (size_t)N_CH * CH_BYTES;
constexpr size_t WS_GD_END = WS_GL + N_CH * 4;
constexpr size_t WS_BAR = ((WS_AB_END > WS_GD_END ? WS_AB_END : WS_GD_END) + 255) / 256 * 256;
constexpr size_t WS_FLAGS = WS_BAR + 16384;
constexpr int CTL_WORDS = (16384 + 8192) / 4;
constexpr size_t WS_NEED = WS_FLAGS + 8192;
constexpr int GDN_LATE = 28;

struct Params { const float* in[33]; float* out; unsigned char* ws; };

__device__ __forceinline__ float bf2f(bf16_t h) { return __uint_as_float(((unsigned)h) << 16); }
__device__ __forceinline__ unsigned pk2(float lo, float hi) { unsigned r; asm volatile("v_cvt_pk_bf16_f32 %0, %1, %2" : "=v"(r) : "v"(lo), "v"(hi)); return r; }
__device__ __forceinline__ bf16_t f2bf(float x) { return (bf16_t)(pk2(x, 0.f) & 0xffffu); }
__device__ __forceinline__ float sigm(float x) { return __builtin_amdgcn_rcpf(1.f + __expf(-x)); }
__device__ __forceinline__ float silu(float x) { return x * __builtin_amdgcn_rcpf(1.f + __expf(-x)); }
__device__ __forceinline__ float dppf(float v, const int ctrl_sel) {
    int x = __builtin_bit_cast(int, v), y;
    if (ctrl_sel == 0) y = __builtin_amdgcn_update_dpp(0, x, 0xB1, 0xF, 0xF, true);
    else if (ctrl_sel == 1) y = __builtin_amdgcn_update_dpp(0, x, 0x4E, 0xF, 0xF, true);
    else if (ctrl_sel == 2) y = __builtin_amdgcn_update_dpp(0, x, 0x141, 0xF, 0xF, true);
    else y = __builtin_amdgcn_update_dpp(0, x, 0x140, 0xF, 0xF, true);
    return __builtin_bit_cast(float, y);
}
__device__ __forceinline__ float row16_sum(float v) { v += dppf(v, 0); v += dppf(v, 1); v += dppf(v, 2); v += dppf(v, 3); return v; }
__device__ __forceinline__ float wave_sum(float v) {
#pragma unroll
    for (int o = 1; o < 64; o <<= 1) v += __shfl_xor(v, o);
    return v;
}
#define XB_XCNT(j)  (256  + 64 * (j))
#define XB_XSUB(j)  (1280 + 64 * (j))
#define XB_XGEN(j)  (2304 + 64 * (j))
#define XB_TOP      3328
#define XB_TOPGEN   3392
#define XCD_BAR_WORDS 3456
__device__ __forceinline__ unsigned xb_ld(unsigned* p)              { return __hip_atomic_load(p, __ATOMIC_RELAXED, __HIP_MEMORY_SCOPE_AGENT); }
__device__ __forceinline__ unsigned xb_add(unsigned* p, unsigned v) { return __hip_atomic_fetch_add(p, v, __ATOMIC_RELAXED, __HIP_MEMORY_SCOPE_AGENT); }
__device__ __forceinline__ unsigned xb_xcc_id() { return (unsigned)__builtin_amdgcn_s_getreg((3 << 11) | 20) & 0xFu; }
__device__ __forceinline__ void gbar(unsigned* bar, volatile unsigned* st) {
    asm volatile("s_waitcnt vmcnt(0)" ::: "memory");
    __syncthreads();
    if (mk_ltid() == 0) {
        __builtin_amdgcn_s_waitcnt(0);
        const unsigned x = xb_xcc_id();
        unsigned nloc = st[0], nx = st[1];
        if (nloc == 0u) {
            const unsigned G = gridDim.x;
            unsigned sum, cnt, mine;
            for (;;) {
                sum = 0u; cnt = 0u; mine = 0u;
#pragma unroll
                for (unsigned j = 0; j < 16; ++j) { const unsigned c = xb_ld(&bar[XB_XCNT(j)]); sum += c; cnt += (c > 0u) ? 1u : 0u; mine = (j == x) ? c : mine; }
                if (sum == G) break;
                __builtin_amdgcn_s_sleep(1);
            }
            nloc = mine > 0u ? mine : 1u; nx = cnt > 0u ? cnt : 1u; st[0] = nloc; st[1] = nx;
        }
        const unsigned old = xb_add(&bar[XB_XSUB(x)], 1u);
        const unsigned gen = old / nloc;
        if (old + 1u == (gen + 1u) * nloc) {
            __builtin_amdgcn_fence(__ATOMIC_RELEASE, "agent");
            asm volatile("s_waitcnt vmcnt(0)" ::: "memory");
            const unsigned og = xb_add(&bar[XB_TOP], 1u);
            const unsigned tg = og / nx;
            if (og + 1u == (tg + 1u) * nx) xb_add(&bar[XB_TOPGEN], 1u);
            else while (xb_ld(&bar[XB_TOPGEN]) == tg) __builtin_amdgcn_s_sleep(1);
            __builtin_amdgcn_fence(__ATOMIC_ACQUIRE, "agent");
            xb_add(&bar[XB_XGEN(x)], 1u);
            asm volatile("s_waitcnt vmcnt(0)" ::: "memory");
        } else {
            while (xb_ld(&bar[XB_XGEN(x)]) == gen) __builtin_amdgcn_s_sleep(1);
            __builtin_amdgcn_fence(__ATOMIC_ACQUIRE, "agent");
            asm volatile("s_waitcnt vmcnt(0)" ::: "memory");
        }
    }
    __syncthreads();
}
__device__ __forceinline__ void seq_info(int s, int& row0, int& L) { if (s < 8) { row0 = s * 2048; L = 2048; } else { row0 = MP + (s - 8) * 4; L = 4; } }

struct EpiSwiglu { static constexpr bool PERM = true, AFTER_DRAIN = false; bf16_t* O;
    __device__ __forceinline__ void operator()(const f32x4 (&acc)[2][2][4][2], const Unit& u, int wr, int wc, int fr, int fq) const {
        const int row0 = u.pm * 256 + wr * 64 + fr, col0 = u.pn * 128 + wc * 32 + 8 * fq;
#pragma unroll
        for (int ai = 0; ai < 2; ++ai)
#pragma unroll
            for (int m = 0; m < 4; ++m) {
                bf16_t* rp = O + (size_t)(row0 + ai * 128 + m * 16) * FF + col0;
                const f32x4 g0 = acc[ai][0][m][0], g1 = acc[ai][0][m][1], u0 = acc[ai][1][m][0], u1 = acc[ai][1][m][1];
                u32x4 w;
                w.x = pk2(silu(g0[0]) * u0[0], silu(g0[1]) * u0[1]); w.y = pk2(silu(g0[2]) * u0[2], silu(g0[3]) * u0[3]);
                w.z = pk2(silu(g1[0]) * u1[0], silu(g1[1]) * u1[1]); w.w = pk2(silu(g1[2]) * u1[2], silu(g1[3]) * u1[3]);
                *(u32x4*)rp = w;
            }
    }
};
struct EpiResid { static constexpr bool PERM = true, AFTER_DRAIN = false; bf16_t* X; const bf16_t* H; float scale;
    __device__ __forceinline__ void operator()(const f32x4 (&acc)[2][2][4][2], const Unit& u, int wr, int wc, int fr, int fq) const {
        const int row0 = u.pm * 256 + wr * 64 + fr, col0 = u.pn * 256 + wc * 32 + 8 * fq;
#pragma unroll
        for (int ai = 0; ai < 2; ++ai)
#pragma unroll
            for (int m = 0; m < 4; ++m)
#pragma unroll
                for (int bj = 0; bj < 2; ++bj)
#pragma unroll
                    for (int n = 0; n < 2; ++n) {
                        const size_t off = (size_t)(row0 + ai * 128 + m * 16) * D + col0 + bj * 128 + 4 * n;
                        const u32x2 hu = *(const u32x2*)(H + off);
                        f32x4 x; x[0] = __uint_as_float(hu.x << 16); x[1] = __uint_as_float(hu.x & 0xffff0000u); x[2] = __uint_as_float(hu.y << 16); x[3] = __uint_as_float(hu.y & 0xffff0000u);
                        x = x * ALPHA + acc[ai][bj][m][n] * scale; u32x2 xo; xo.x = pk2(x[0], x[1]); xo.y = pk2(x[2], x[3]); *(u32x2*)(X + off) = xo;
                    }
    }
};
struct EpiZ { static constexpr bool PERM = true, AFTER_DRAIN = false; bf16_t* Z; int ld;
    __device__ __forceinline__ void operator()(const f32x4 (&acc)[2][2][4][2], const Unit& u, int wr, int wc, int fr, int fq) const {
        const int row0 = u.pm * 256 + wr * 64 + fr, col0 = u.pn * 256 + wc * 32 + 8 * fq;
#pragma unroll
        for (int ai = 0; ai < 2; ++ai)
#pragma unroll
            for (int m = 0; m < 4; ++m)
#pragma unroll
                for (int bj = 0; bj < 2; ++bj) {
                    const f32x4 a = acc[ai][bj][m][0], b = acc[ai][bj][m][1];
                    u32x4 w; w.x = pk2(a[0], a[1]); w.y = pk2(a[2], a[3]); w.z = pk2(b[0], b[1]); w.w = pk2(b[2], b[3]);
                    *(u32x4*)(Z + (size_t)(row0 + ai * 128 + m * 16) * ld + col0 + bj * 128) = w;
                }
    }
};

__device__ __forceinline__ void tr_item(const float* __restrict__ W, int K, int N, bf16_t* WT, int dst_row0, int k0, int n0, float* scr, int lane) {
#pragma unroll
    for (int i = 0; i < 32; ++i) { const int kk = 2 * i + (lane >> 5); const int col = n0 + (lane & 31);
        scr[kk * 33 + (lane & 31)] = (col < N) ? W[(size_t)(k0 + kk) * N + col] : 0.f; }
    asm volatile("s_waitcnt lgkmcnt(0)" ::: "memory");
    const int c = lane & 7;
#pragma unroll
    for (int j = 0; j < 4; ++j) { const int n = (lane >> 3) + 8 * j; const float* s = scr + (8 * c) * 33 + n;
        u32x4 o; o.x = pk2(s[0], s[33]); o.y = pk2(s[2 * 33], s[3 * 33]); o.z = pk2(s[4 * 33], s[5 * 33]); o.w = pk2(s[6 * 33], s[7 * 33]);
        *(u32x4*)(WT + (size_t)(dst_row0 + n) * K + k0 + 8 * c) = o; }
    asm volatile("s_waitcnt lgkmcnt(0)" ::: "memory");
}

__device__ __forceinline__ void convert_items(const Params& p, int l, int parts, int gw, int NGW, unsigned char* smem) {
    const int lane = mk_ltid() & 63, wave = mk_ltid() >> 6;
    float* scr = (float*)smem + wave * (64 * 33);
    unsigned char* ws = p.ws;
    const int i = l >> 1; const bool ab = (l & 1) == 0;
    constexpr int I_G = 16 * 88, I_O = 16 * 32;
    const int I_IN = ab ? 16 * 120 : 16 * 136;
    const int I_LORA = ab ? (16 + 16 + 32) : 0;
    const int n0 = (parts & 1) ? 3 * I_G : 0, n1 = (parts & 2) ? 3 * I_G : 0, n2 = (parts & 4) ? (I_IN + I_O + I_LORA) : 0;
    const int total = n0 + n1 + n2;
    for (int it = gw; it < total; it += NGW) {
        int r = it;
        if (r < n0 + n1) {
            const int j = (r < n0) ? 0 : 1; r -= (j ? n0 : 0);
            const int kind = r / I_G; r -= kind * I_G;
            const size_t lw = (size_t)(l * 2 + j);
            if (kind < 2) { const float* W = p.in[kind == 0 ? 9 : 10] + lw * (size_t)D * FF;
                const int kb = r / 88, nb = r % 88, nn0 = nb * 32;
                tr_item(W, D, FF, (bf16_t*)(ws + WS_WGU) + (size_t)j * 5632 * 1024, (nn0 >> 7) * 256 + (nn0 & 127) + kind * 128, kb * 64, nn0, scr, lane);
            } else { const float* W = p.in[11] + lw * (size_t)FF * D;
                const int kb = r / 32, nb = r % 32;
                tr_item(W, FF, D, (bf16_t*)(ws + WS_WD) + (size_t)j * 1024 * 2816, nb * 32, kb * 64, nb * 32, scr, lane);
            }
            continue;
        }
        r -= n0 + n1;
        if (r < I_IN) {
            if (ab) { const int kb = r / 120, nb = r % 120; tr_item(p.in[12] + (size_t)i * D * AB_N, D, AB_N, (bf16_t*)(ws + WS_WIN), nb * 32, kb * 64, nb * 32, scr, lane); }
            else { const int kb = r / 136, nb = r % 136; tr_item(p.in[27] + (size_t)i * D * GD_NREAL, D, GD_NREAL, (bf16_t*)(ws + WS_WIN), nb * 32, kb * 64, nb * 32, scr, lane); }
            continue;
        }
        r -= I_IN;
        if (r < I_O) { const int kb = r / 32, nb = r % 32;
            tr_item(p.in[ab ? 13 : 32] + (size_t)i * D * D, D, D, (bf16_t*)(ws + WS_WOUT), nb * 32, kb * 64, nb * 32, scr, lane); continue; }
        r -= I_O;
        if (r < 16) { tr_item(p.in[16] + (size_t)i * 64 * 512, 64, 512, (bf16_t*)(ws + WS_W2T), r * 32, 0, r * 32, scr, lane); continue; }
        r -= 16;
        if (r < 16) { tr_item(p.in[18] + (size_t)i * 64 * 512, 64, 512, (bf16_t*)(ws + WS_A2T), r * 32, 0, r * 32, scr, lane); continue; }
        r -= 16;
        { const int kb = r / 16, nb = r % 16; tr_item(p.in[19] + (size_t)i * 128 * 512, 128, 512, (bf16_t*)(ws + WS_G2T), nb * 32, kb * 64, nb * 32, scr, lane); }
    }
}
__device__ __forceinline__ void convert_ffn_ahead(const Params& p, int l, int gw, int NGW, unsigned char* smem) {
    __syncthreads();
    convert_items(p, l, 2, gw, NGW, smem);
    if (l < 3) convert_items(p, l + 1, 1, gw, NGW, smem);
    __syncthreads();
}

__device__ __forceinline__ void phase_start(const Params& p, unsigned char* smem) {
    const int tid = mk_ltid(), lane = tid & 63, wave = tid >> 6;
    const int gw = mk_lbid() * 8 + wave, NGW = gridDim.x * 8;
    convert_items(p, 0, 5, gw, NGW, smem);
    bf16_t* HB = (bf16_t*)(p.ws + WS_HB);
    for (int m = gw; m < M; m += NGW) {
        const float* src = (m < MP) ? p.in[0] + (size_t)m * D : p.in[1] + (size_t)(m - MP) * D;
#pragma unroll
        for (int j = 0; j < 4; ++j) { const int c = (lane + 64 * j) * 4; const f32x4 v = *(const f32x4*)(src + c);
            u32x2 o; o.x = pk2(v[0], v[1]); o.y = pk2(v[2], v[3]); *(u32x2*)(HB + (size_t)m * D + c) = o; }
    }
}

__device__ __forceinline__ void phase_ln(const Params& p, int l, int k, bool final_out) {
    const int tid = mk_ltid(), lane = tid & 63, wave = tid >> 6;
    const int gw = mk_lbid() * 8 + wave, NGW = gridDim.x * 8;
    const bf16_t* X = (const bf16_t*)(p.ws + WS_X); bf16_t* HB = (bf16_t*)(p.ws + WS_HB);
    const float* g = p.in[7] + (size_t)(l * 3 + k) * D; const float* b = p.in[8] + (size_t)(l * 3 + k) * D;
    float* dst = p.out;
    for (int mq = gw; mq < M / 4; mq += NGW) {
        f32x4 v[4][4]; float s[4];
#pragma unroll
        for (int rr = 0; rr < 4; ++rr) { s[rr] = 0.f;
#pragma unroll
            for (int j = 0; j < 4; ++j) { const u32x2 xu = *(const u32x2*)(X + (size_t)(mq * 4 + rr) * D + (lane + 64 * j) * 4);
                v[rr][j][0] = __uint_as_float(xu.x << 16); v[rr][j][1] = __uint_as_float(xu.x & 0xffff0000u); v[rr][j][2] = __uint_as_float(xu.y << 16); v[rr][j][3] = __uint_as_float(xu.y & 0xffff0000u); s[rr] += (v[rr][j][0] + v[rr][j][1]) + (v[rr][j][2] + v[rr][j][3]); } }
#pragma unroll
        for (int o = 1; o < 64; o <<= 1) {
#pragma unroll
            for (int rr = 0; rr < 4; ++rr) s[rr] += __shfl_xor(s[rr], o); }
        float s2[4];
#pragma unroll
        for (int rr = 0; rr < 4; ++rr) { const float mean = s[rr] * (1.f / D); s2[rr] = 0.f;
#pragma unroll
            for (int j = 0; j < 4; ++j) { v[rr][j] = v[rr][j] - mean; s2[rr] += (v[rr][j][0] * v[rr][j][0] + v[rr][j][1] * v[rr][j][1]) + (v[rr][j][2] * v[rr][j][2] + v[rr][j][3] * v[rr][j][3]); } }
#pragma unroll
        for (int o = 1; o < 64; o <<= 1) {
#pragma unroll
            for (int rr = 0; rr < 4; ++rr) s2[rr] += __shfl_xor(s2[rr], o); }
#pragma unroll
        for (int j = 0; j < 4; ++j) { const int c = (lane + 64 * j) * 4; const f32x4 gg = *(const f32x4*)(g + c), bb = *(const f32x4*)(b + c);
#pragma unroll
            for (int rr = 0; rr < 4; ++rr) { const int m = mq * 4 + rr; const float rstd = rsqrtf(s2[rr] * (1.f / D) + 1e-5f);
                const f32x4 y = v[rr][j] * rstd * gg + bb;
                if (final_out) *(f32x4*)(dst + (size_t)m * D + c) = y;
                else { u32x2 o; o.x = pk2(y[0], y[1]); o.y = pk2(y[2], y[3]); *(u32x2*)(HB + (size_t)m * D + c) = o; } } }
    }
}

__device__ __forceinline__ void small_resid_gemm(const bf16_t* __restrict__ A, const bf16_t* __restrict__ Bt, int K, bf16_t* X, const bf16_t* H, float scale, unsigned char* smem) {
    const int tid = mk_ltid(), lane = tid & 63, w = __builtin_amdgcn_readfirstlane(tid >> 6);
    const int r = lane & 15, q = lane >> 4;
    float* part = (float*)smem;
    for (int t = mk_lbid(); t < 256; t += gridDim.x) {
        const int R0 = MP + (t >> 4) * 32, C0 = (t & 15) * 64;
        f32x4 acc[2][4];
#pragma unroll
        for (int a = 0; a < 2; ++a)
#pragma unroll
            for (int b = 0; b < 4; ++b) acc[a][b] = (f32x4){0.f, 0.f, 0.f, 0.f};
        const int nks = K / 32;
#pragma unroll 2
        for (int ks = w; ks < nks; ks += 8) {
            bf16x8 fa[2], fb[4];
#pragma unroll
            for (int a = 0; a < 2; ++a) fa[a] = *(const bf16x8*)(A + (size_t)(R0 + a * 16 + r) * K + ks * 32 + q * 8);
#pragma unroll
            for (int b = 0; b < 4; ++b) fb[b] = *(const bf16x8*)(Bt + (size_t)(C0 + b * 16 + r) * K + ks * 32 + q * 8);
#pragma unroll
            for (int a = 0; a < 2; ++a)
#pragma unroll
                for (int b = 0; b < 4; ++b) acc[a][b] = __builtin_amdgcn_mfma_f32_16x16x32_bf16(fa[a], fb[b], acc[a][b], 0, 0, 0);
        }
        __syncthreads();
#pragma unroll
        for (int a = 0; a < 2; ++a)
#pragma unroll
            for (int b = 0; b < 4; ++b) *(f32x4*)(part + ((w * 8 + a * 4 + b) * 64 + lane) * 4) = acc[a][b];
        __syncthreads();
        {
            const int tile = tid >> 6, a = tile >> 2, b = tile & 3;
            f32x4 sum = (f32x4){0.f, 0.f, 0.f, 0.f};
#pragma unroll
            for (int ww = 0; ww < 8; ++ww) sum += *(const f32x4*)(part + ((ww * 8 + tile) * 64 + lane) * 4);
            const int col = C0 + b * 16 + r;
#pragma unroll
            for (int j = 0; j < 4; ++j) { const size_t off = (size_t)(R0 + a * 16 + q * 4 + j) * D + col;
                X[off] = f2bf(bf2f(H[off]) * ALPHA + sum[j] * scale); }
        }
    }
}

__device__ __forceinline__ void phase_ab_prep(const Params& p, int i, unsigned char* smem) {
    const int tid = mk_ltid(), lane = tid & 63, wave = __builtin_amdgcn_readfirstlane(tid >> 6);
    const int r = lane & 15, q = lane >> 4;
    unsigned char* ws = p.ws;
    const bf16_t* ZB = (const bf16_t*)(ws + WS_ZB);
    float* OPS = (float*)(ws + WS_OPS); float* GATE = (float*)(ws + WS_GATE); float* BONUS = (float*)(ws + WS_BONUS);
    bf16_t* RQ = (bf16_t*)(ws + WS_RQ); bf16_t* RK = (bf16_t*)(ws + WS_RK);
    const bf16_t* W2T = (const bf16_t*)(ws + WS_W2T); const bf16_t* A2T = (const bf16_t*)(ws + WS_A2T); const bf16_t* G2T = (const bf16_t*)(ws + WS_G2T);
    const float* mu = p.in[14] + (size_t)i * 1792; const float* w0 = p.in[15] + i * 512; const float* a0 = p.in[17] + i * 512;
    const float* k_k = p.in[20] + i * 512; const float* k_a = p.in[21] + i * 512; const float* r_k = p.in[22] + i * 512;
    const float* shift_in = p.in[2] + (size_t)i * 128 * 1792;
    constexpr int ZS_LD = 1796, ACT_LD = 264;
    float* zs = (float*)smem;
    bf16_t* act = (bf16_t*)(smem + 16 * ZS_LD * 4);
    for (int tile = mk_lbid(); tile < M / 16; tile += gridDim.x) {
        const int R0 = tile * 16;
        unsigned pfa = 0u, pfb = 0u;
        { const int ntile = tile + gridDim.x;
          if (ntile < M / 16) { const bf16_t* nz = ZB + (size_t)ntile * 16 * AB_N;
              pfa = *(const unsigned*)(nz + (size_t)tid * 64); pfb = *(const unsigned*)(((size_t)(tid + 512) * 64 < (size_t)16 * AB_N) ? nz + (size_t)(tid + 512) * 64 : nz); } }
#ifndef REP_A_ST
#define REP_A_ST 1
#endif
#ifndef REP_A_RO
#define REP_A_RO 1
#endif
#ifndef REP_A_EP
#define REP_A_EP 1
#endif
        __syncthreads();
#pragma unroll 1
        for (int rp_ = 0; rp_ < REP_A_ST; ++rp_)
#pragma unroll 7
        for (int idx = tid; idx < 16 * 448; idx += 512) {
            const int tok = idx / 448, c4 = (idx % 448) * 4; const int row = R0 + tok;
            const int t = (row < MP) ? (row & 2047) : ((row - MP) & 3);
            const int Lm1 = (row < MP) ? 2047 : 3;
            const u32x2 cu = *(const u32x2*)(ZB + (size_t)row * AB_N + c4);
            f32x4 cur; cur[0] = __uint_as_float(cu.x << 16); cur[1] = __uint_as_float(cu.x & 0xffff0000u); cur[2] = __uint_as_float(cu.y << 16); cur[3] = __uint_as_float(cu.y & 0xffff0000u);
            f32x4 prev;
            if (t == 0) { if (row < MP) prev = (f32x4){0.f, 0.f, 0.f, 0.f}; else prev = *(const f32x4*)(shift_in + (size_t)((row - MP) >> 2) * 1792 + c4); }
            else { const u32x2 pu = *(const u32x2*)(ZB + (size_t)(row - 1) * AB_N + c4);
                prev[0] = __uint_as_float(pu.x << 16); prev[1] = __uint_as_float(pu.x & 0xffff0000u); prev[2] = __uint_as_float(pu.y << 16); prev[3] = __uint_as_float(pu.y & 0xffff0000u); }
            if (t == Lm1) {
                float* o = (row < MP) ? p.out + O_PSHIFT + (size_t)(i * 8 + (row >> 11)) * 1792 : p.out + O_SSHIFT + (size_t)(i * 128 + ((row - MP) >> 2)) * 1792;
                *(f32x4*)(o + c4) = cur;
            }
            const f32x4 m4 = *(const f32x4*)(mu + c4);
            const f32x4 z = cur + (prev - cur) * m4;
            *(f32x4*)(zs + tok * ZS_LD + c4) = z;
            if (c4 >= 1536) {
                f32x4 a;
                if (c4 < 1600) { a[0] = tanhf(z[0]); a[1] = tanhf(z[1]); a[2] = tanhf(z[2]); a[3] = tanhf(z[3]); }
                else if (c4 < 1664) a = z;
                else { a[0] = sigm(z[0]); a[1] = sigm(z[1]); a[2] = sigm(z[2]); a[3] = sigm(z[3]); }
                u32x2 o; o.x = pk2(a[0], a[1]); o.y = pk2(a[2], a[3]); *(u32x2*)(act + tok * ACT_LD + (c4 - 1536)) = o;
            }
        }
        {
            const int tok = tid >> 5, hh = (tid >> 3) & 3, c8 = (tid & 7) * 8; const int row = R0 + tok;
            const float pos = (row < MP) ? (float)(row & 2047) : (float)(16384 + ((row - MP) & 3));
            const bf16_t* zq = ZB + (size_t)row * AB_N + 1792 + hh * 128 + c8;
            const u32x4 q1v = *(const u32x4*)zq, q2v = *(const u32x4*)(zq + 64), k1v = *(const u32x4*)(zq + 512), k2v = *(const u32x4*)(zq + 576);
            const unsigned q1w[4] = {q1v.x, q1v.y, q1v.z, q1v.w}, q2w[4] = {q2v.x, q2v.y, q2v.z, q2v.w}, k1w[4] = {k1v.x, k1v.y, k1v.z, k1v.w}, k2w[4] = {k2v.x, k2v.y, k2v.z, k2v.w};
            float oq1[8], oq2[8], ok1[8], ok2[8];
            const float ksc = 0.08838834764831845f;
#pragma unroll
            for (int e = 0; e < 8; ++e) {
                const int ii = c8 + e;
                const float inv_freq = exp2f(-(float)ii * (13.287712379549449f / 63.0f));
                const float ang = pos * inv_freq;
                const float n = rintf(ang * 0.15915494309189535f);
                float rr = fmaf(-n, 6.2831854820251465f, ang); rr = fmaf(-n, -1.7484555e-7f, rr);
                const float rev = rr * 0.15915494309189535f;
                const float sn = __builtin_amdgcn_sinf(rev), cs = __builtin_amdgcn_cosf(rev);
                const float q1 = (e & 1) ? __uint_as_float(q1w[e >> 1] & 0xffff0000u) : __uint_as_float(q1w[e >> 1] << 16);
                const float q2 = (e & 1) ? __uint_as_float(q2w[e >> 1] & 0xffff0000u) : __uint_as_float(q2w[e >> 1] << 16);
                const float k1 = (e & 1) ? __uint_as_float(k1w[e >> 1] & 0xffff0000u) : __uint_as_float(k1w[e >> 1] << 16);
                const float k2 = (e & 1) ? __uint_as_float(k2w[e >> 1] & 0xffff0000u) : __uint_as_float(k2w[e >> 1] << 16);
                oq1[e] = q1 * cs - q2 * sn; oq2[e] = q2 * cs + q1 * sn;
                ok1[e] = (k1 * cs - k2 * sn) * ksc; ok2[e] = (k2 * cs + k1 * sn) * ksc;
            }
            const size_t o = (size_t)row * 512 + hh * 128 + c8;
            u32x4 w;
            w.x = pk2(oq1[0], oq1[1]); w.y = pk2(oq1[2], oq1[3]); w.z = pk2(oq1[4], oq1[5]); w.w = pk2(oq1[6], oq1[7]); *(u32x4*)(RQ + o) = w;
            w.x = pk2(oq2[0], oq2[1]); w.y = pk2(oq2[2], oq2[3]); w.z = pk2(oq2[4], oq2[5]); w.w = pk2(oq2[6], oq2[7]); *(u32x4*)(RQ + o + 64) = w;
            w.x = pk2(ok1[0], ok1[1]); w.y = pk2(ok1[2], ok1[3]); w.z = pk2(ok1[4], ok1[5]); w.w = pk2(ok1[6], ok1[7]); *(u32x4*)(RK + o) = w;
            w.x = pk2(ok2[0], ok2[1]); w.y = pk2(ok2[2], ok2[3]); w.z = pk2(ok2[4], ok2[5]); w.w = pk2(ok2[6], ok2[7]); *(u32x4*)(RK + o + 64) = w;
        }
        __syncthreads();
        const int cb = wave * 64;
#pragma unroll 1
        for (int rp_ = 0; rp_ < REP_A_EP; ++rp_) {
        f32x4 aw[4], aa[4], ag[4];
#pragma unroll
        for (int nt = 0; nt < 4; ++nt) { aw[nt] = (f32x4){0.f, 0.f, 0.f, 0.f}; aa[nt] = aw[nt]; ag[nt] = aw[nt]; }
#pragma unroll
        for (int ks = 0; ks < 2; ++ks) {
            const bf16x8 bw = *(const bf16x8*)(act + r * ACT_LD + ks * 32 + q * 8);
            const bf16x8 ba = *(const bf16x8*)(act + r * ACT_LD + 64 + ks * 32 + q * 8);
#pragma unroll
            for (int nt = 0; nt < 4; ++nt) {
                const bf16x8 fw = *(const bf16x8*)(W2T + (size_t)(cb + nt * 16 + r) * 64 + ks * 32 + q * 8);
                const bf16x8 fa = *(const bf16x8*)(A2T + (size_t)(cb + nt * 16 + r) * 64 + ks * 32 + q * 8);
                aw[nt] = __builtin_amdgcn_mfma_f32_16x16x32_bf16(fw, bw, aw[nt], 0, 0, 0);
                aa[nt] = __builtin_amdgcn_mfma_f32_16x16x32_bf16(fa, ba, aa[nt], 0, 0, 0);
            }
        }
#pragma unroll
        for (int ks = 0; ks < 4; ++ks) {
            const bf16x8 bg = *(const bf16x8*)(act + r * ACT_LD + 128 + ks * 32 + q * 8);
#pragma unroll
            for (int nt = 0; nt < 4; ++nt) {
                const bf16x8 fg = *(const bf16x8*)(G2T + (size_t)(cb + nt * 16 + r) * 128 + ks * 32 + q * 8);
                ag[nt] = __builtin_amdgcn_mfma_f32_16x16x32_bf16(fg, bg, ag[nt], 0, 0, 0);
            }
        }
        const int row = R0 + r;
        float ssq = 0.f, bon = 0.f;
        f32x4 kkraw[4], av[4];
#pragma unroll
        for (int nt = 0; nt < 4; ++nt) {
            const int c = cb + nt * 16 + q * 4;
            const f32x4 rr = *(const f32x4*)(zs + r * ZS_LD + c), kx = *(const f32x4*)(zs + r * ZS_LD + 512 + c), vv = *(const f32x4*)(zs + r * ZS_LD + 1024 + c);
            const f32x4 w04 = *(const f32x4*)(w0 + c), a04 = *(const f32x4*)(a0 + c), kk4 = *(const f32x4*)(k_k + c), ka4 = *(const f32x4*)(k_a + c), rk4 = *(const f32x4*)(r_k + c);
            f32x4 dec, a, kp;
#pragma unroll
            for (int j = 0; j < 4; ++j) {
                const float wl = w04[j] + aw[nt][j];
                const float sp = fmaxf(-wl, 0.f) + __logf(1.f + __expf(-fabsf(wl)));
                const float wlog = -sp - 0.5f;
                dec[j] = __expf(-__expf(wlog));
                a[j] = sigm(a04[j] + aa[nt][j]);
                kkraw[nt][j] = kx[j] * kk4[j];
                kp[j] = kx[j] * (1.f + (a[j] - 1.f) * ka4[j]);
                ssq += kkraw[nt][j] * kkraw[nt][j];
                bon += rr[j] * kp[j] * rk4[j];
            }
            av[nt] = a;
            float* ob = OPS + ((size_t)row * 8 + wave) * 384 + nt * 16 + q * 4;
            *(f32x4*)(ob) = rr; *(f32x4*)(ob + 64) = dec; *(f32x4*)(ob + 128) = kp; *(f32x4*)(ob + 192) = vv;
            *(f32x4*)(GATE + (size_t)row * 512 + c) = ag[nt];
        }
        ssq += __shfl_xor(ssq, 16); ssq += __shfl_xor(ssq, 32);
        bon += __shfl_xor(bon, 16); bon += __shfl_xor(bon, 32);
        const float rn = rsqrtf(fmaxf(ssq, 1e-12f));
#pragma unroll
        for (int nt = 0; nt < 4; ++nt) {
            float* ob = OPS + ((size_t)row * 8 + wave) * 384 + nt * 16 + q * 4;
            const f32x4 kk = kkraw[nt] * rn;
            *(f32x4*)(ob + 256) = kk; *(f32x4*)(ob + 320) = kk * av[nt];
        }
        if (q == 0) BONUS[(size_t)row * 8 + wave] = bon;
        }
        if (pfa == 0x7fc17fc1u && pfb == 0x7fc27fc2u) zs[0] = 1.f;
    }
}

__device__ __forceinline__ void rwkv_item(const Params& p, int i, int s, int h, int rg, unsigned char* smem) {
    const int tid = mk_ltid(), lane = tid & 63, wave = __builtin_amdgcn_readfirstlane(tid >> 6);
    int row0, L; seq_info(s, row0, L);
    const float* OPS = (const float*)(p.ws + WS_OPS); float* ORAW = (float*)(p.ws + WS_ORAW);
    float* buf = (float*)smem;
    const int rih = rg * 16 + (wave & 3) * 4 + (lane >> 4);
    const int c4 = (lane & 15) * 4;
    f32x4 S = (f32x4){0.f, 0.f, 0.f, 0.f};
    if (s >= 8 && wave < 4) S = *(const f32x4*)(p.in[3] + ((((size_t)i * 128 + (s - 8)) * 8 + h) * 64 + rih) * 64 + c4);
    f32x4 pre[6];
    const int nch = (L + 31) / 32;
#pragma unroll
    for (int k = 0; k < 6; ++k) { const int idx4 = tid + k * 512; const int tt = idx4 / 96, off = idx4 % 96;
        pre[k] = (tt < L) ? *(const f32x4*)(OPS + ((size_t)(row0 + tt) * 8 + h) * 384 + off * 4) : (f32x4){0.f, 0.f, 0.f, 0.f}; }
    for (int ch = 0; ch < nch; ++ch) {
        const int t0 = ch * 32;
        __syncthreads();
#pragma unroll
        for (int k = 0; k < 6; ++k) { const int idx4 = tid + k * 512; *(f32x4*)(buf + idx4 * 4) = pre[k]; }
        __syncthreads();
        if (ch + 1 < nch) {
#pragma unroll
            for (int k = 0; k < 6; ++k) { const int idx4 = tid + k * 512; const int tt = t0 + 32 + idx4 / 96, off = idx4 % 96;
                pre[k] = (tt < L) ? *(const f32x4*)(OPS + ((size_t)(row0 + tt) * 8 + h) * 384 + off * 4) : (f32x4){0.f, 0.f, 0.f, 0.f}; }
        }
        if (wave < 4) {
            const int ns = (L - t0) < 32 ? (L - t0) : 32;
            f32x4 r4 = *(const f32x4*)(buf + c4), w4 = *(const f32x4*)(buf + 64 + c4), k4 = *(const f32x4*)(buf + 128 + c4);
            f32x4 kk4 = *(const f32x4*)(buf + 256 + c4), ka4 = *(const f32x4*)(buf + 320 + c4);
            float vv = buf[192 + rih];
            float* op = ORAW + (size_t)(row0 + t0) * 512 + h * 64 + rih;
            f32x4 rprev = r4;
#pragma unroll 2
            for (int tt = 0; tt < ns; ++tt) {
                const float* nb = buf + ((tt + 1 < 32) ? (tt + 1) : 31) * 384;
                const f32x4 r4n = *(const f32x4*)(nb + c4), w4n = *(const f32x4*)(nb + 64 + c4), k4n = *(const f32x4*)(nb + 128 + c4);
                const f32x4 kk4n = *(const f32x4*)(nb + 256 + c4), ka4n = *(const f32x4*)(nb + 320 + c4);
                const float vvn = nb[192 + rih];
                float o = (S[0] * rprev[0] + S[1] * rprev[1]) + (S[2] * rprev[2] + S[3] * rprev[3]);
                const f32x4 kv = k4 * vv;
                float sk = (S[0] * kk4[0] + S[1] * kk4[1]) + (S[2] * kk4[2] + S[3] * kk4[3]);
                sk = row16_sum(sk);
                o = row16_sum(o);
                const f32x4 t1 = kv - ka4 * sk;
                S = S * w4 + t1;
                if ((lane & 15) == 0 && tt > 0) op[(size_t)(tt - 1) * 512] = o;
                rprev = r4;
                r4 = r4n; w4 = w4n; k4 = k4n; kk4 = kk4n; ka4 = ka4n; vv = vvn;
            }
            {
                float o = (S[0] * rprev[0] + S[1] * rprev[1]) + (S[2] * rprev[2] + S[3] * rprev[3]);
                o = row16_sum(o);
                if ((lane & 15) == 0) op[(size_t)(ns - 1) * 512] = o;
            }
        }
    }
    if (wave < 4) {
        float* so = (s < 8) ? p.out + O_PRWKV + ((((size_t)i * 8 + s) * 8 + h) * 64 + rih) * 64 + c4
                            : p.out + O_SRWKV + ((((size_t)i * 128 + (s - 8)) * 8 + h) * 64 + rih) * 64 + c4;
        *(f32x4*)so = S;
    }
}

__device__ __forceinline__ void rwkv_item2(const Params& p, int i, int s, int h, int rg, unsigned char* smem) {
    const int tid = mk_ltid(), lane = tid & 63, wave = __builtin_amdgcn_readfirstlane(tid >> 6);
    int row0, L; seq_info(s, row0, L);
    const float* OPS = (const float*)(p.ws + WS_OPS); float* ORAW = (float*)(p.ws + WS_ORAW);
    float* buf = (float*)smem;
    const int ra = rg * 32 + (wave & 3) * 4 + (lane >> 4), rb = ra + 16;
    const int c4 = (lane & 15) * 4;
    f32x4 Sa = (f32x4){0.f, 0.f, 0.f, 0.f}, Sb = Sa;
    if (s >= 8 && wave < 4) { const float* sp = p.in[3] + (((size_t)i * 128 + (s - 8)) * 8 + h) * 4096;
        Sa = *(const f32x4*)(sp + ra * 64 + c4); Sb = *(const f32x4*)(sp + rb * 64 + c4); }
    f32x4 pre[12];
    const int nch = (L + 63) / 64;
#pragma unroll
    for (int k = 0; k < 12; ++k) { const int idx4 = tid + k * 512; const int tt = idx4 / 96, off = idx4 % 96;
        pre[k] = (tt < L) ? *(const f32x4*)(OPS + ((size_t)(row0 + tt) * 8 + h) * 384 + off * 4) : (f32x4){0.f, 0.f, 0.f, 0.f}; }
    for (int ch = 0; ch < nch; ++ch) {
        const int t0 = ch * 64;
        __syncthreads();
#pragma unroll
        for (int k = 0; k < 12; ++k) { const int idx4 = tid + k * 512; *(f32x4*)(buf + idx4 * 4) = pre[k]; }
        __syncthreads();
        if (ch + 1 < nch) {
#pragma unroll
            for (int k = 0; k < 12; ++k) { const int idx4 = tid + k * 512; const int tt = t0 + 64 + idx4 / 96, off = idx4 % 96;
                pre[k] = (tt < L) ? *(const f32x4*)(OPS + ((size_t)(row0 + tt) * 8 + h) * 384 + off * 4) : (f32x4){0.f, 0.f, 0.f, 0.f}; }
        }
        if (wave < 4) {
            const int ns = (L - t0) < 64 ? (L - t0) : 64;
            f32x4 rA = *(const f32x4*)(buf + c4), wA = *(const f32x4*)(buf + 64 + c4), kA = *(const f32x4*)(buf + 128 + c4);
            f32x4 kkA = *(const f32x4*)(buf + 256 + c4), kaA = *(const f32x4*)(buf + 320 + c4);
            float vaA = buf[192 + ra], vbA = buf[192 + rb];
            f32x4 rB, wB, kB, kkB, kaB; float vaB, vbB;
            float* op = ORAW + (size_t)(row0 + t0) * 512 + h * 64 + ra;
            f32x4 rprev = rA;
#define RW_LOAD(R, W, K, KK, KA, VA, VB, nb_) do { const float* nb = (nb_); R = *(const f32x4*)(nb + c4); W = *(const f32x4*)(nb + 64 + c4); K = *(const f32x4*)(nb + 128 + c4); \
                KK = *(const f32x4*)(nb + 256 + c4); KA = *(const f32x4*)(nb + 320 + c4); VA = nb[192 + ra]; VB = nb[192 + rb]; } while (0)
#define RW_STEP(R, W, K, KK, KA, VA, VB, RP, tt_) do { \
                float oa = (Sa[0] * RP[0] + Sa[1] * RP[1]) + (Sa[2] * RP[2] + Sa[3] * RP[3]); \
                float ob = (Sb[0] * RP[0] + Sb[1] * RP[1]) + (Sb[2] * RP[2] + Sb[3] * RP[3]); \
                float ska = (Sa[0] * KK[0] + Sa[1] * KK[1]) + (Sa[2] * KK[2] + Sa[3] * KK[3]); \
                float skb = (Sb[0] * KK[0] + Sb[1] * KK[1]) + (Sb[2] * KK[2] + Sb[3] * KK[3]); \
                ska = row16_sum(ska); skb = row16_sum(skb); oa = row16_sum(oa); ob = row16_sum(ob); \
                Sa = Sa * W + (K * VA - KA * ska); Sb = Sb * W + (K * VB - KA * skb); \
                if ((lane & 15) == 0 && (tt_) > 0) { op[(size_t)((tt_) - 1) * 512] = oa; op[(size_t)((tt_) - 1) * 512 + 16] = ob; } } while (0)
            for (int tt = 0; tt < ns; tt += 2) {
                RW_LOAD(rB, wB, kB, kkB, kaB, vaB, vbB, buf + (tt + 1) * 384);
                RW_STEP(rA, wA, kA, kkA, kaA, vaA, vbA, rprev, tt);
                const f32x4 rEven = rA;
                RW_LOAD(rA, wA, kA, kkA, kaA, vaA, vbA, buf + ((tt + 2 < 64) ? (tt + 2) : 63) * 384);
                RW_STEP(rB, wB, kB, kkB, kaB, vaB, vbB, rEven, tt + 1);
                rprev = rB;
            }
            {
                float oa = (Sa[0] * rprev[0] + Sa[1] * rprev[1]) + (Sa[2] * rprev[2] + Sa[3] * rprev[3]);
                float ob = (Sb[0] * rprev[0] + Sb[1] * rprev[1]) + (Sb[2] * rprev[2] + Sb[3] * rprev[3]);
                oa = row16_sum(oa); ob = row16_sum(ob);
                if ((lane & 15) == 0) { op[(size_t)(ns - 1) * 512] = oa; op[(size_t)(ns - 1) * 512 + 16] = ob; }
            }
#undef RW_LOAD
#undef RW_STEP
        }
    }
    if (wave < 4) {
        float* so = (s < 8) ? p.out + O_PRWKV + (((size_t)i * 8 + s) * 8 + h) * 4096 : p.out + O_SRWKV + (((size_t)i * 128 + (s - 8)) * 8 + h) * 4096;
        *(f32x4*)(so + ra * 64 + c4) = Sa; *(f32x4*)(so + rb * 64 + c4) = Sb;
    }
}

__device__ __forceinline__ void ret_item(const Params& p, int i, int s, int hb, unsigned char* smem) {
    const int tid = mk_ltid(), lane = tid & 63, w = __builtin_amdgcn_readfirstlane(tid >> 6);
    const int r = lane & 15, q = lane >> 4;
    int row0, L; seq_info(s, row0, L);
    const int C = (s < 8) ? 128 : 4; const int nch = L / C;
    const float lg = log2f(1.0f - exp2f(-5.0f - (float)hb));
    const bf16_t* ZB = (const bf16_t*)(p.ws + WS_ZB); const bf16_t* RQ = (const bf16_t*)(p.ws + WS_RQ); const bf16_t* RK = (const bf16_t*)(p.ws + WS_RK);
    bf16_t* OMIX = (bf16_t*)(p.ws + WS_OMIX);
    const float* gn_g = p.in[25] + i * 512 + hb * 128; const float* gn_b = p.in[26] + i * 512 + hb * 128;
    constexpr int LD = 136;
    bf16_t* KC = (bf16_t*)smem; bf16_t* KZT = KC + 128 * LD; bf16_t* VT = KZT + 128 * LD; bf16_t* SB = VT + 128 * LD;
    f32x4 ST[8];
#pragma unroll
    for (int nt = 0; nt < 8; ++nt) ST[nt] = (f32x4){0.f, 0.f, 0.f, 0.f};
    if (s >= 8) {
        const float* S0 = p.in[4] + (((size_t)i * 128 + (s - 8)) * 4 + hb) * 16384;
#pragma unroll
        for (int nt = 0; nt < 8; ++nt) ST[nt] = *(const f32x4*)(S0 + (size_t)(nt * 16 + r) * 128 + 16 * w + q * 4);
    }
    const float gch = exp2f((float)C * lg);
    for (int ch = 0; ch < nch; ++ch) {
        const int rb = row0 + ch * C;
        __syncthreads();
        for (int idx = tid; idx < 128 * 16; idx += 512) {
            const int tok = idx & 127, c8 = (idx >> 7) * 8;
            u32x4 kv = (u32x4){0u, 0u, 0u, 0u}, vv = kv;
            if (tok < C) { kv = *(const u32x4*)(RK + (size_t)(rb + tok) * 512 + hb * 128 + c8);
                           vv = *(const u32x4*)(ZB + (size_t)(rb + tok) * AB_N + 1792 + 1024 + hb * 128 + c8); }
            *(u32x4*)(KC + tok * LD + c8) = kv;
            const float zeta = __builtin_amdgcn_exp2f((float)(C - 1 - tok) * lg);
            const unsigned kw[4] = {kv.x, kv.y, kv.z, kv.w}; const unsigned vw[4] = {vv.x, vv.y, vv.z, vv.w};
#pragma unroll
            for (int e = 0; e < 4; ++e) {
                const float k0 = __uint_as_float(kw[e] << 16) * zeta, k1 = __uint_as_float(kw[e] & 0xffff0000u) * zeta;
                KZT[(c8 + 2 * e) * LD + tok] = f2bf(k0); KZT[(c8 + 2 * e + 1) * LD + tok] = f2bf(k1);
                VT[(c8 + 2 * e) * LD + tok] = (bf16_t)(vw[e] & 0xffffu); VT[(c8 + 2 * e + 1) * LD + tok] = (bf16_t)(vw[e] >> 16);
            }
        }
#pragma unroll
        for (int nt = 0; nt < 8; ++nt)
#pragma unroll
            for (int j = 0; j < 4; ++j) SB[(16 * w + q * 4 + j) * LD + nt * 16 + r] = f2bf(ST[nt][j]);
        __syncthreads();
        bf16x8 aq[4];
#pragma unroll
        for (int ks = 0; ks < 4; ++ks) {
            if (16 * w + r < C) aq[ks] = *(const bf16x8*)(RQ + (size_t)(rb + 16 * w + r) * 512 + hb * 128 + ks * 32 + q * 8);
            else aq[ks] = (bf16x8){0, 0, 0, 0, 0, 0, 0, 0};
        }
        u32x2 P[8]; f32x4 O[8];
#pragma unroll
        for (int nt = 0; nt < 8; ++nt) {
            f32x4 acc = (f32x4){0.f, 0.f, 0.f, 0.f}, oc = acc;
#pragma unroll
            for (int ks = 0; ks < 4; ++ks) {
                const bf16x8 bk = *(const bf16x8*)(KC + (nt * 16 + r) * LD + ks * 32 + q * 8);
                const bf16x8 bs = *(const bf16x8*)(SB + (nt * 16 + r) * LD + ks * 32 + q * 8);
                acc = __builtin_amdgcn_mfma_f32_16x16x32_bf16(aq[ks], bk, acc, 0, 0, 0);
                oc = __builtin_amdgcn_mfma_f32_16x16x32_bf16(aq[ks], bs, oc, 0, 0, 0);
            }
#pragma unroll
            for (int j = 0; j < 4; ++j) {
                const int ii = 16 * w + q * 4 + j, jt = nt * 16 + r;
                acc[j] = (ii >= jt) ? acc[j] * __builtin_amdgcn_exp2f((float)(ii - jt) * lg) : 0.f;
                oc[j] *= __builtin_amdgcn_exp2f((float)(ii + 1) * lg);
            }
            P[nt].x = pk2(acc[0], acc[1]); P[nt].y = pk2(acc[2], acc[3]); O[nt] = oc;
        }
        __syncthreads();
#pragma unroll
        for (int nt = 0; nt < 8; ++nt)
#pragma unroll
            for (int j = 0; j < 4; ++j) KC[(16 * w + q * 4 + j) * LD + nt * 16 + r] = (bf16_t)(((j & 2) ? P[nt].y : P[nt].x) >> ((j & 1) * 16));
        __syncthreads();
#pragma unroll
        for (int nt = 0; nt < 8; ++nt) ST[nt] = ST[nt] * gch;
#pragma unroll
        for (int ks = 0; ks < 4; ++ks) {
            const bf16x8 ap = *(const bf16x8*)(KC + (16 * w + r) * LD + ks * 32 + q * 8);
            const bf16x8 av = *(const bf16x8*)(VT + (16 * w + r) * LD + ks * 32 + q * 8);
#pragma unroll
            for (int nt = 0; nt < 8; ++nt) {
                const bf16x8 bv = *(const bf16x8*)(VT + (nt * 16 + r) * LD + ks * 32 + q * 8);
                const bf16x8 bz = *(const bf16x8*)(KZT + (nt * 16 + r) * LD + ks * 32 + q * 8);
                O[nt] = __builtin_amdgcn_mfma_f32_16x16x32_bf16(ap, bv, O[nt], 0, 0, 0);
                ST[nt] = __builtin_amdgcn_mfma_f32_16x16x32_bf16(av, bz, ST[nt], 0, 0, 0);
            }
        }
#pragma unroll
        for (int j = 0; j < 4; ++j) {
            float s1 = 0.f;
#pragma unroll
            for (int nt = 0; nt < 8; ++nt) s1 += O[nt][j];
            s1 = row16_sum(s1); const float mean = s1 * (1.f / 128.f);
            float s2 = 0.f;
#pragma unroll
            for (int nt = 0; nt < 8; ++nt) { const float d = O[nt][j] - mean; s2 += d * d; }
            s2 = row16_sum(s2); const float rstd = rsqrtf(s2 * (1.f / 128.f) + 1e-5f);
            const int ii = 16 * w + q * 4 + j;
            if (ii < C) {
                const size_t row = (size_t)(rb + ii);
#pragma unroll
                for (int nt = 0; nt < 8; ++nt) { const int dv = nt * 16 + r;
                    const float val = (O[nt][j] - mean) * rstd * gn_g[dv] + gn_b[dv];
                    const float gr = bf2f(ZB[row * AB_N + 1792 + 1536 + hb * 128 + dv]);
                    OMIX[row * 1024 + 512 + hb * 128 + dv] = f2bf(val * silu(gr)); }
            }
        }
    }
    float* so = (s < 8) ? p.out + O_PRET + (((size_t)i * 8 + s) * 4 + hb) * 16384 : p.out + O_SRET + (((size_t)i * 128 + (s - 8)) * 4 + hb) * 16384;
#pragma unroll
    for (int nt = 0; nt < 8; ++nt) *(f32x4*)(so + (size_t)(nt * 16 + r) * 128 + 16 * w + q * 4) = ST[nt];
}

__device__ __forceinline__ void phase_ab_core(const Params& p, int i, int l, unsigned char* smem) {
    const int bid = mk_lbid(), G = gridDim.x; const int wv = mk_ltid() >> 6;
    if (G == 256) {
        if (bid < 128) rwkv_item2(p, i, bid >> 4, (bid >> 1) & 7, bid & 1, smem);
        else if (bid < 160) ret_item(p, i, (bid - 128) >> 2, (bid - 128) & 3, smem);
        else {
            for (int it = bid - 160; it < 128 * 16; it += 96) rwkv_item2(p, i, 8 + (it >> 4), (it >> 1) & 7, it & 1, smem);
            __syncthreads();
            for (int it = bid - 160; it < 128 * 4; it += 96) ret_item(p, i, 8 + (it >> 2), it & 3, smem);
        }
        if (bid >= 160) convert_ffn_ahead(p, l, (bid - 160) * 8 + wv, 96 * 8, smem);
    } else {
        for (int it = bid; it < 136 * 16; it += G) rwkv_item2(p, i, it >> 4, (it >> 1) & 7, it & 1, smem);
        __syncthreads();
        for (int it = bid; it < 136 * 4; it += G) ret_item(p, i, it >> 2, it & 3, smem);
        convert_ffn_ahead(p, l, bid * 8 + wv, G * 8, smem);
    }
}

__device__ __forceinline__ void phase_ab_post(const Params& p, int i) {
    const int tid = mk_ltid(), lane = tid & 63, wave = tid >> 6;
    const int gw = mk_lbid() * 8 + wave, NGW = gridDim.x * 8;
    const float* OPS = (const float*)(p.ws + WS_OPS); const float* ORAW = (const float*)(p.ws + WS_ORAW);
    const float* GATE = (const float*)(p.ws + WS_GATE); const float* BONUS = (const float*)(p.ws + WS_BONUS);
    bf16_t* OMIX = (bf16_t*)(p.ws + WS_OMIX);
    const float* gg = p.in[23] + i * 512; const float* gb = p.in[24] + i * 512;
    for (int m = gw; m < M; m += NGW) {
        const int c = lane * 8, h = lane >> 3, hc = c & 63;
        const f32x4 o0 = *(const f32x4*)(ORAW + (size_t)m * 512 + c), o1 = *(const f32x4*)(ORAW + (size_t)m * 512 + c + 4);
        float s1 = (o0[0] + o0[1]) + (o0[2] + o0[3]) + (o1[0] + o1[1]) + (o1[2] + o1[3]);
        s1 += __shfl_xor(s1, 1); s1 += __shfl_xor(s1, 2); s1 += __shfl_xor(s1, 4);
        const float mean = s1 * (1.f / 64.f);
        const f32x4 d0 = o0 - mean, d1 = o1 - mean;
        float s2 = (d0[0] * d0[0] + d0[1] * d0[1]) + (d0[2] * d0[2] + d0[3] * d0[3]) + (d1[0] * d1[0] + d1[1] * d1[1]) + (d1[2] * d1[2] + d1[3] * d1[3]);
        s2 += __shfl_xor(s2, 1); s2 += __shfl_xor(s2, 2); s2 += __shfl_xor(s2, 4);
        const float rstd = rsqrtf(s2 * (1.f / 64.f) + 64e-5f);
        const float bon = BONUS[(size_t)m * 8 + h];
        const float* vb = OPS + ((size_t)m * 8 + h) * 384 + 192 + hc;
        const f32x4 v0 = *(const f32x4*)vb, v1 = *(const f32x4*)(vb + 4);
        const f32x4 g0 = *(const f32x4*)(gg + c), g1 = *(const f32x4*)(gg + c + 4), b0 = *(const f32x4*)(gb + c), b1 = *(const f32x4*)(gb + c + 4);
        const f32x4 t0 = *(const f32x4*)(GATE + (size_t)m * 512 + c), t1 = *(const f32x4*)(GATE + (size_t)m * 512 + c + 4);
        const f32x4 y0 = (d0 * rstd * g0 + b0 + v0 * bon) * t0, y1 = (d1 * rstd * g1 + b1 + v1 * bon) * t1;
        u32x4 o; o.x = pk2(y0[0], y0[1]); o.y = pk2(y0[2], y0[3]); o.z = pk2(y1[0], y1[1]); o.w = pk2(y1[2], y1[3]);
        *(u32x4*)(OMIX + (size_t)m * 1024 + c) = o;
    }
}

__device__ __forceinline__ int gdn_item_index(int s, int h, int c) { return (s < 8) ? ((s * 8 + h) * 32 + c) : (2048 + (s - 8) * 8 + h); }

__device__ __forceinline__ void gdn_chunk_item(const Params& p, int i, int s, int h, int c, int pf_row, int pf_h, unsigned char* smem) {
    const int tid = mk_ltid(), lane = tid & 63, w = __builtin_amdgcn_readfirstlane(tid >> 6);
    const int r = lane & 15, q = lane >> 4;
    int row0, L; seq_info(s, row0, L);
    const int t0 = c * 64; const int nvalid = (L - t0) < 64 ? (L - t0) : 64;
    const bf16_t* ZB = (const bf16_t*)(p.ws + WS_ZB);
    unsigned char* rec = p.ws + WS_CH + (size_t)gdn_item_index(s, h, c) * CH_BYTES;
    float* U = (float*)(rec + CH_U); bf16_t* Wd = (bf16_t*)(rec + CH_W); bf16_t* QG = (bf16_t*)(rec + CH_QG); bf16_t* QK = (bf16_t*)(rec + CH_QK); bf16_t* KDT = (bf16_t*)(rec + CH_KDT);
    constexpr int LD = 132, ALD = 68;
    float* qs = (float*)smem; float* ks = qs + 64 * LD; float* vs = ks + 64 * LD; float* As = vs + 64 * LD;
    float* AT = As + 64 * ALD; float* gcs = AT + 64 * ALD; float* bes = gcs + 64;
    unsigned short pfv = 0;
    if (pf_row >= 0 && tid < 384) { const int rr_ = tid / 6, pp_ = (tid % 6) >> 1, hh_ = tid & 1;
        pfv = ((const bf16_t*)(p.ws + WS_ZB))[(size_t)(pf_row + rr_) * GD_N + pp_ * 1024 + pf_h * 128 + hh_ * 64]; }
#ifndef REP_G_CONV
#define REP_G_CONV 1
#endif
#ifndef REP_G_MFMA
#define REP_G_MFMA 1
#endif
#ifndef REP_G_QG
#define REP_G_QG 1
#endif
#ifndef REP_G_SUB
#define REP_G_SUB 1
#endif
#pragma unroll 1
    for (int rp_ = 0; rp_ < REP_G_CONV; ++rp_) {
    __syncthreads();
    if (tid < 384) {
        if (nvalid == 64) {
            const int cg = tid % 48, tr = tid / 48;
            const int part = cg >> 4, ch0 = (cg & 15) * 8; const int zc0 = part * 1024 + h * 128 + ch0;
            const float* cw = p.in[28] + (size_t)i * 4 * 3072 + zc0;
            f32x4 wv[4][2];
#pragma unroll
            for (int j = 0; j < 4; ++j) { wv[j][0] = *(const f32x4*)(cw + j * 3072); wv[j][1] = *(const f32x4*)(cw + j * 3072 + 4); }
            u32x4 xr[11];
#pragma unroll
            for (int jr = 0; jr < 11; ++jr) { const int tt = t0 + tr * 8 - 3 + jr;
                xr[jr] = (tt >= 0) ? *(const u32x4*)(ZB + (size_t)(row0 + (tt >= 0 ? tt : 0)) * GD_N + zc0) : (u32x4){0u, 0u, 0u, 0u}; }
            float* dstb = (part == 0 ? qs : part == 1 ? ks : vs) + ch0;
#pragma unroll
            for (int e = 0; e < 8; ++e) {
                f32x4 o0, o1;
#pragma unroll
                for (int cc = 0; cc < 8; ++cc) {
                    float y = 0.f;
#pragma unroll
                    for (int j = 0; j < 4; ++j) { const unsigned wd = (cc >> 1) == 0 ? xr[e + j].x : (cc >> 1) == 1 ? xr[e + j].y : (cc >> 1) == 2 ? xr[e + j].z : xr[e + j].w;
                        const float xv = (cc & 1) ? __uint_as_float(wd & 0xffff0000u) : __uint_as_float(wd << 16);
                        y += wv[j][cc >> 2][cc & 3] * xv; }
                    const float sv = silu(y);
                    if (cc < 4) o0[cc] = sv; else o1[cc - 4] = sv;
                }
                *(f32x4*)(dstb + (tr * 8 + e) * LD) = o0; *(f32x4*)(dstb + (tr * 8 + e) * LD + 4) = o1;
            }
        } else {
            const int part = tid >> 7, ch = tid & 127; const int zc = part * 1024 + h * 128 + ch;
            const float* cw = p.in[28] + (size_t)i * 4 * 3072 + zc;
            const float cw0 = cw[0], cw1 = cw[3072], cw2 = cw[2 * 3072], cw3 = cw[3 * 3072];
            float* dst = (part == 0 ? qs : part == 1 ? ks : vs) + ch;
            float x3, x2, x1;
            { const float* cs = p.in[5] + (((size_t)i * 128 + (s - 8)) * 3) * 3072 + zc; x3 = cs[0]; x2 = cs[3072]; x1 = cs[2 * 3072]; }
#pragma unroll
            for (int e = 0; e < 64; ++e) {
                float v = 0.f;
                if (e < 4) { const float xe = (e < nvalid) ? bf2f(ZB[(size_t)(row0 + e) * GD_N + zc]) : 0.f;
                    const float y = cw0 * x3 + cw1 * x2 + cw2 * x1 + cw3 * xe; v = (e < nvalid) ? silu(y) : 0.f; x3 = x2; x2 = x1; x1 = xe; }
                dst[e * LD] = v;
            }
        }
    } else if (tid < 448) {
        const int t = tid - 384;
        float be = 0.f, g = 0.f;
        if (t < nvalid) { const size_t zr = (size_t)(row0 + t0 + t) * GD_N;
            be = sigm(bf2f(ZB[zr + 3072 + h]));
            const float a = bf2f(ZB[zr + 3080 + h]) + p.in[30][i * 8 + h];
            const float sp = fmaxf(a, 0.f) + __logf(1.f + __expf(-fabsf(a)));
            g = -__expf(p.in[29][i * 8 + h]) * sp; }
#pragma unroll
        for (int o = 1; o < 64; o <<= 1) { const float y = __shfl_up(g, o); if (t >= o) g += y; }
        gcs[t] = g; bes[t] = be;
    }
    }
    __syncthreads();
    for (int pass = 0; pass < 4; ++pass) {
        const int rowi = w * 16 + pass * 4 + q;
        const int t = rowi & 63;
        if ((w * 16 + pass * 4) % 64 < nvalid) {
            float* base = ((rowi < 64) ? qs : ks) + t * LD + r * 8;
            f32x4 a = *(f32x4*)base, b = *(f32x4*)(base + 4);
            float ss = (a[0] * a[0] + a[1] * a[1]) + (a[2] * a[2] + a[3] * a[3]) + (b[0] * b[0] + b[1] * b[1]) + (b[2] * b[2] + b[3] * b[3]);
            ss = row16_sum(ss);
            const float rn = rsqrtf(fmaxf(ss, 1e-12f));
            *(f32x4*)base = a * rn; *(f32x4*)(base + 4) = b * rn;
        }
    }
    __syncthreads();
#pragma unroll 1
    for (int rp_ = 0; rp_ < REP_G_MFMA; ++rp_)
#pragma unroll
    for (int tl = 0; tl < 2; ++tl) {
        const int tile = 2 * w + tl, mi = tile >> 2, ni = tile & 3;
        f32x4 akk = (f32x4){0.f, 0.f, 0.f, 0.f}, aqk = akk;
        if (mi * 16 < nvalid) {
#pragma unroll 8
            for (int k0 = 0; k0 < 128; k0 += 4) {
                const float ka = ks[(mi * 16 + r) * LD + k0 + q], kb = ks[(ni * 16 + r) * LD + k0 + q], qa = qs[(mi * 16 + r) * LD + k0 + q];
                akk = __builtin_amdgcn_mfma_f32_16x16x4f32(ka, kb, akk, 0, 0, 0);
                aqk = __builtin_amdgcn_mfma_f32_16x16x4f32(qa, kb, aqk, 0, 0, 0);
            }
        }
#pragma unroll
        for (int j = 0; j < 4; ++j) { const int ii = mi * 16 + q * 4 + j, jj = ni * 16 + r;
            const float dm = (ii >= jj) ? __expf(gcs[ii] - gcs[jj]) : 0.f;
            const float aij = (ii > jj) ? bes[ii] * akk[j] * dm : 0.f;
            As[ii * ALD + jj] = aij; AT[jj * ALD + ii] = aij;
            if (mi * 16 < nvalid) QK[ii * 64 + jj] = f2bf(aqk[j] * 0.08838834764831845f * dm); }
    }
    __syncthreads();
#pragma unroll 1
    for (int rp_ = 0; rp_ < REP_G_QG; ++rp_)
    {
        const float gl = gcs[63];
        const int nrow = (nvalid == 64) ? 64 : 16;
        for (int idx = tid; idx < nrow * 16; idx += 512) { const int t = idx >> 4, d0 = (idx & 15) * 8; const float sc = 0.08838834764831845f * __expf(gcs[t]);
            const f32x4 a = *(const f32x4*)(qs + t * LD + d0) * sc, b = *(const f32x4*)(qs + t * LD + d0 + 4) * sc;
            u32x4 o; o.x = pk2(a[0], a[1]); o.y = pk2(a[2], a[3]); o.z = pk2(b[0], b[1]); o.w = pk2(b[2], b[3]);
            *(u32x4*)(QG + t * 128 + d0) = o; }
        for (int idx = tid; idx < 128 * (nrow >> 3); idx += 512) { const int d = idx & 127, tc = (idx >> 7) * 8;
            float v[8];
#pragma unroll
            for (int e = 0; e < 8; ++e) v[e] = ks[(tc + e) * LD + d] * __expf(gl - gcs[tc + e]);
            u32x4 o; o.x = pk2(v[0], v[1]); o.y = pk2(v[2], v[3]); o.z = pk2(v[4], v[5]); o.w = pk2(v[6], v[7]);
            *(u32x4*)(KDT + d * 64 + tc) = o; }
        if (tid == 0) ((float*)(p.ws + WS_GL))[gdn_item_index(s, h, c)] = __expf(gl);
    }
    __syncthreads();
    for (int idx = tid; idx < 64 * 128; idx += 512) { const int t = idx >> 7, d = idx & 127; const float be = bes[t];
        vs[t * LD + d] *= be; ks[t * LD + d] *= be * __expf(gcs[t]); }
    __syncthreads();
    const int nblk = (nvalid + 15) >> 4;
#pragma unroll 1
    for (int blk = 0; blk < 4; ++blk) {
        if (blk >= nblk) continue;
        if (blk > 0) {
#pragma unroll
            for (int tl = 0; tl < 2; ++tl) {
                const int nt = 2 * w + tl; float* bb = (nt < 8 ? vs : ks) + (nt & 7) * 16 + r;
                f32x4 acc = (f32x4){0.f, 0.f, 0.f, 0.f};
                const float* ap = As + (blk * 16 + r) * ALD + q;
                for (int k0 = 0; k0 < blk * 16; k0 += 4)
                    acc = __builtin_amdgcn_mfma_f32_16x16x4f32(ap[k0], bb[(k0 + q) * LD], acc, 0, 0, 0);
#pragma unroll
                for (int j = 0; j < 4; ++j) bb[(blk * 16 + q * 4 + j) * LD] -= acc[j];
            }
            __syncthreads();
        }
        if (tid < 256) {
            const int col = tid & 127; const bool isu = tid < 128;
            float* buf = (isu ? vs : ks) + col;
            float acc[16];
#pragma unroll
            for (int e = 0; e < 16; ++e) acc[e] = buf[(blk * 16 + e) * LD];
#pragma unroll
            for (int e = 1; e < 16; ++e) {
#pragma unroll
                for (int f = 0; f < e; ++f) acc[e] -= As[(blk * 16 + e) * ALD + blk * 16 + f] * acc[f];
            }
#pragma unroll
            for (int e = 0; e < 16; ++e) { const int ii = blk * 16 + e; buf[ii * LD] = acc[e];
                if (isu) U[ii * 128 + col] = acc[e]; else Wd[ii * 128 + col] = f2bf(acc[e]); }
        }
        __syncthreads();
    }
    if (pfv == 0x7fc3u) gcs[0] = 1.f;
    asm volatile("s_waitcnt vmcnt(0)" ::: "memory");
    __syncthreads();
}

__device__ __forceinline__ void phase_gdn_chunk(const Params& p, int i, unsigned char* smem) {
    if (gridDim.x == 256) {
        for (int it = mk_lbid(); it < 64 * GDN_LATE; it += 256) {
            const int s = it / (8 * GDN_LATE), rem = it % (8 * GDN_LATE), h = rem / GDN_LATE, c = rem % GDN_LATE;
            const int nit = it + 256; int pf_row = -1, pf_h = 0;
            if (nit < 64 * GDN_LATE) { const int rem2 = nit % (8 * GDN_LATE); pf_row = (nit / (8 * GDN_LATE)) * 2048 + (rem2 % GDN_LATE) * 64; pf_h = rem2 / GDN_LATE; }
            gdn_chunk_item(p, i, s, h, c, pf_row, pf_h, smem);
        }
    } else
    for (int it = mk_lbid(); it < N_CH; it += gridDim.x) {
        int s, h, c;
        if (it < 2048) { s = it >> 8; h = (it >> 5) & 7; c = it & 31; } else { const int k = it - 2048; s = 8 + (k >> 3); h = k & 7; c = 0; }
        const int nit = it + gridDim.x; int pf_row = -1, pf_h = 0;
        if (nit < 2048) { pf_row = (nit >> 8) * 2048 + (nit & 31) * 64; pf_h = (nit >> 5) & 7; }
        gdn_chunk_item(p, i, s, h, c, pf_row, pf_h, smem);
    }
    const bf16_t* ZB = (const bf16_t*)(p.ws + WS_ZB);
    const int gt = mk_lbid() * 512 + mk_ltid(), GT = gridDim.x * 512;
    for (int idx = gt; idx < 136 * 3 * 3072; idx += GT) {
        const int s = idx / (3 * 3072), rem = idx % (3 * 3072), j = rem / 3072, zc = rem % 3072;
        int row0, L; seq_info(s, row0, L);
        const float v = bf2f(ZB[(size_t)(row0 + L - 3 + j) * GD_N + zc]);
        if (s < 8) p.out[O_PCONV + (((size_t)i * 8 + s) * 3 + j) * 3072 + zc] = v;
        else p.out[O_SCONV + (((size_t)i * 128 + (s - 8)) * 3 + j) * 3072 + zc] = v;
    }
}

__device__ __forceinline__ void gdn_scan_item(const Params& p, int i, int s, int h, unsigned* flags, unsigned tag, unsigned char* smem) {
    const int tid = mk_ltid(), lane = tid & 63, w = __builtin_amdgcn_readfirstlane(tid >> 6);
    const int r = lane & 15, q = lane >> 4;
    int row0, L; seq_info(s, row0, L);
    const int nch = (s < 8) ? 32 : 1;
    const bf16_t* ZB = (const bf16_t*)(p.ws + WS_ZB); bf16_t* OMIX = (bf16_t*)(p.ws + WS_OMIX);
    const float* GL = (const float*)(p.ws + WS_GL);
    const float* ng = p.in[31] + i * 128;
    constexpr int LD = 136, VLD = 72, ULD = 132;
    bf16_t* SB = (bf16_t*)smem;
    bf16_t* VN = (bf16_t*)(smem + 34816);
    float* red = (float*)(smem + 53248);
    bf16_t* WL = (bf16_t*)(smem + 53760);
    bf16_t* QGL = (bf16_t*)(smem + 71168);
    bf16_t* QKL = (bf16_t*)(smem + 88576);
    bf16_t* KDL = (bf16_t*)(smem + 97792);
    float* UL = (float*)(smem + 116224);
    f32x4 ST[8];
#pragma unroll
    for (int nt = 0; nt < 8; ++nt) ST[nt] = (f32x4){0.f, 0.f, 0.f, 0.f};
    if (s >= 8) {
        const float* S0 = p.in[6] + (((size_t)i * 128 + (s - 8)) * 8 + h) * 16384;
#pragma unroll
        for (int nt = 0; nt < 8; ++nt)
#pragma unroll
            for (int j = 0; j < 4; ++j) ST[nt][j] = S0[(size_t)(nt * 16 + q * 4 + j) * 128 + 16 * w + r];
    }
    const int mt = w & 3, nh = w >> 2;
    u32x4 pw[2], pq[2], pk, pd[2]; f32x4 pu[4]; float pgl;
    const bool smp = (s >= 8);
#define GDN_PREFETCH(cc) do { const int item_ = gdn_item_index(s, h, (cc)); const unsigned char* rec_ = p.ws + WS_CH + (size_t)item_ * CH_BYTES; \
        const u32x4 z4_ = (u32x4){0u, 0u, 0u, 0u}; \
        _Pragma("unroll") for (int k_ = 0; k_ < 2; ++k_) { const int idx_ = tid + k_ * 512; \
            pw[k_] = (smp && (idx_ >> 4) >= 16) ? z4_ : *(const u32x4*)((const bf16_t*)(rec_ + CH_W) + (idx_ >> 4) * 128 + (idx_ & 15) * 8); \
            pq[k_] = (smp && (idx_ >> 4) >= 16) ? z4_ : *(const u32x4*)((const bf16_t*)(rec_ + CH_QG) + (idx_ >> 4) * 128 + (idx_ & 15) * 8); \
            pd[k_] = (smp && (idx_ & 7) >= 2) ? z4_ : *(const u32x4*)((const bf16_t*)(rec_ + CH_KDT) + (idx_ >> 3) * 64 + (idx_ & 7) * 8); } \
        pk = (smp && (tid >> 3) >= 16) ? z4_ : *(const u32x4*)((const bf16_t*)(rec_ + CH_QK) + (tid >> 3) * 64 + (tid & 7) * 8); \
        _Pragma("unroll") for (int k_ = 0; k_ < 4; ++k_) { const int idx_ = tid + k_ * 512; \
            pu[k_] = (smp && (idx_ >> 5) >= 16) ? (f32x4){0.f, 0.f, 0.f, 0.f} : *(const f32x4*)((const float*)(rec_ + CH_U) + (idx_ >> 5) * 128 + (idx_ & 31) * 4); } \
        pgl = GL[item_]; } while (0)
#define GDN_WAIT(cc) do { if (flags && (cc) >= GDN_LATE) { if (tid == 0) { unsigned* f_ = flags + (s * 8 + h) * 32 + (cc); \
        while (__hip_atomic_load(f_, __ATOMIC_RELAXED, __HIP_MEMORY_SCOPE_AGENT) != tag) __builtin_amdgcn_s_sleep(2); \
        __builtin_amdgcn_fence(__ATOMIC_ACQUIRE, "agent"); asm volatile("s_waitcnt vmcnt(0)" ::: "memory"); } \
        __syncthreads(); } } while (0)
    GDN_PREFETCH(0);
    for (int c = 0; c < nch; ++c) {
        const float glast = pgl;
        const int rb = row0 + c * 64; const int nvalid = (L - c * 64) < 64 ? (L - c * 64) : 64;
#pragma unroll
        for (int k = 0; k < 2; ++k) { const int idx = tid + k * 512;
            *(u32x4*)(WL + (idx >> 4) * LD + (idx & 15) * 8) = pw[k]; *(u32x4*)(QGL + (idx >> 4) * LD + (idx & 15) * 8) = pq[k];
            *(u32x4*)(KDL + (idx >> 3) * VLD + (idx & 7) * 8) = pd[k]; }
        *(u32x4*)(QKL + (tid >> 3) * VLD + (tid & 7) * 8) = pk;
#pragma unroll
        for (int k = 0; k < 4; ++k) { const int idx = tid + k * 512; *(f32x4*)(UL + (idx >> 5) * ULD + (idx & 31) * 4) = pu[k]; }
#pragma unroll
        for (int nt = 0; nt < 8; ++nt) { u32x2 sv; sv.x = pk2(ST[nt][0], ST[nt][1]); sv.y = pk2(ST[nt][2], ST[nt][3]);
            *(u32x2*)(SB + (16 * w + r) * LD + nt * 16 + q * 4) = sv; }
        __syncthreads();
        if (c + 1 < nch) { GDN_WAIT(c + 1); GDN_PREFETCH(c + 1); }
        u32x2 zgv[4];
        { const int tk_ = mt * 16 + r; const size_t row_ = (size_t)(rb + (tk_ < nvalid ? tk_ : 0));
#pragma unroll
          for (int n4 = 0; n4 < 4; ++n4) zgv[n4] = *(const u32x2*)(ZB + row_ * GD_N + 3088 + h * 128 + (nh * 4 + n4) * 16 + q * 4); }
        f32x4 aws[4], aqg[4];
#pragma unroll
        for (int n4 = 0; n4 < 4; ++n4) { aws[n4] = (f32x4){0.f, 0.f, 0.f, 0.f}; aqg[n4] = aws[n4]; }
#pragma unroll
        for (int ks = 0; ks < 4; ++ks) {
            const bf16x8 fw = *(const bf16x8*)(WL + (mt * 16 + r) * LD + ks * 32 + q * 8);
            const bf16x8 fq = *(const bf16x8*)(QGL + (mt * 16 + r) * LD + ks * 32 + q * 8);
#pragma unroll
            for (int n4 = 0; n4 < 4; ++n4) {
                const bf16x8 bs = *(const bf16x8*)(SB + ((nh * 4 + n4) * 16 + r) * LD + ks * 32 + q * 8);
                aws[n4] = __builtin_amdgcn_mfma_f32_16x16x32_bf16(fw, bs, aws[n4], 0, 0, 0);
                aqg[n4] = __builtin_amdgcn_mfma_f32_16x16x32_bf16(bs, fq, aqg[n4], 0, 0, 0);
            }
        }
#pragma unroll
        for (int n4 = 0; n4 < 4; ++n4) {
            const int dv = (nh * 4 + n4) * 16 + r;
            float vn[4];
#pragma unroll
            for (int j = 0; j < 4; ++j) vn[j] = UL[(mt * 16 + q * 4 + j) * ULD + dv] - aws[n4][j];
            u32x2 o; o.x = pk2(vn[0], vn[1]); o.y = pk2(vn[2], vn[3]);
            *(u32x2*)(VN + dv * VLD + mt * 16 + q * 4) = o;
        }
        __syncthreads();
#pragma unroll
        for (int ks = 0; ks < 2; ++ks) {
            const bf16x8 fk = *(const bf16x8*)(QKL + (mt * 16 + r) * VLD + ks * 32 + q * 8);
#pragma unroll
            for (int n4 = 0; n4 < 4; ++n4) {
                const bf16x8 bv = *(const bf16x8*)(VN + ((nh * 4 + n4) * 16 + r) * VLD + ks * 32 + q * 8);
                aqg[n4] = __builtin_amdgcn_mfma_f32_16x16x32_bf16(bv, fk, aqg[n4], 0, 0, 0);
            }
        }
        {
            float a = 0.f;
#pragma unroll
            for (int n4 = 0; n4 < 4; ++n4)
#pragma unroll
                for (int j = 0; j < 4; ++j) a += aqg[n4][j] * aqg[n4][j];
            a += __shfl_xor(a, 16); a += __shfl_xor(a, 32);
            if (q == 0) red[(mt * 16 + r) * 2 + nh] = a;
        }
#pragma unroll
        for (int nt = 0; nt < 8; ++nt) ST[nt] = ST[nt] * glast;
#pragma unroll
        for (int ks = 0; ks < 2; ++ks) {
            const bf16x8 av = *(const bf16x8*)(VN + (16 * w + r) * VLD + ks * 32 + q * 8);
#pragma unroll
            for (int nt = 0; nt < 8; ++nt) {
                const bf16x8 bk = *(const bf16x8*)(KDL + (nt * 16 + r) * VLD + ks * 32 + q * 8);
                ST[nt] = __builtin_amdgcn_mfma_f32_16x16x32_bf16(bk, av, ST[nt], 0, 0, 0);
            }
        }
        __syncthreads();
        {
            const int tk = mt * 16 + r;
            if (tk < nvalid) {
                const float rs = rsqrtf((red[tk * 2] + red[tk * 2 + 1]) * (1.f / 128.f) + 1e-6f);
                const size_t row = (size_t)(rb + tk);
#pragma unroll
                for (int n4 = 0; n4 < 4; ++n4) { const int dvb = (nh * 4 + n4) * 16 + q * 4;
                    const f32x4 g4 = *(const f32x4*)(ng + dvb);
                    const float z0 = __uint_as_float(zgv[n4].x << 16), z1 = __uint_as_float(zgv[n4].x & 0xffff0000u), z2 = __uint_as_float(zgv[n4].y << 16), z3 = __uint_as_float(zgv[n4].y & 0xffff0000u);
                    u32x2 o; o.x = pk2(aqg[n4][0] * rs * g4[0] * silu(z0), aqg[n4][1] * rs * g4[1] * silu(z1));
                    o.y = pk2(aqg[n4][2] * rs * g4[2] * silu(z2), aqg[n4][3] * rs * g4[3] * silu(z3));
                    *(u32x2*)(OMIX + row * 1024 + h * 128 + dvb) = o; }
            }
        }
    }
#undef GDN_PREFETCH
#undef GDN_WAIT
    float* so = (s < 8) ? p.out + O_PGDN + (((size_t)i * 8 + s) * 8 + h) * 16384 : p.out + O_SGDN + (((size_t)i * 128 + (s - 8)) * 8 + h) * 16384;
#pragma unroll
    for (int nt = 0; nt < 8; ++nt)
#pragma unroll
        for (int j = 0; j < 4; ++j) so[(size_t)(nt * 16 + q * 4 + j) * 128 + 16 * w + r] = ST[nt][j];
    __syncthreads();
}

__device__ __forceinline__ void phase_gdn_scan(const Params& p, int i, int l, unsigned char* smem) {
    const int bid = mk_lbid(), G = gridDim.x; const int wv = mk_ltid() >> 6;
    if (G == 256) {
        unsigned* flags = (unsigned*)(p.ws + WS_FLAGS); const unsigned tag = (unsigned)(i + 1);
        if (bid < 64) gdn_scan_item(p, i, bid >> 3, bid & 7, flags, tag, smem);
        else {
            for (int j = bid - 64; j < 64 * (32 - GDN_LATE); j += 192) {
                const int c = GDN_LATE + (j >> 6), sh = j & 63;
                gdn_chunk_item(p, i, sh >> 3, sh & 7, c, -1, 0, smem);
                if (mk_ltid() == 0) { __builtin_amdgcn_fence(__ATOMIC_RELEASE, "agent"); asm volatile("s_waitcnt vmcnt(0)" ::: "memory");
                    __hip_atomic_store(&flags[sh * 32 + c], tag, __ATOMIC_RELAXED, __HIP_MEMORY_SCOPE_AGENT); }
            }
            for (int it = bid - 64; it < 128 * 8; it += 192) { gdn_chunk_item(p, i, 8 + (it >> 3), it & 7, 0, -1, 0, smem); gdn_scan_item(p, i, 8 + (it >> 3), it & 7, nullptr, 0u, smem); }
            convert_ffn_ahead(p, l, (bid - 64) * 8 + wv, 192 * 8, smem);
        }
    } else {
        for (int it = bid; it < 136 * 8; it += G) { const int s = it >> 3, h = it & 7; gdn_scan_item(p, i, s, h, nullptr, 0u, smem); }
        convert_ffn_ahead(p, l, bid * 8 + wv, G * 8, smem);
    }
}

__global__ void __launch_bounds__(512, 2) mega(Params p) {
    extern __shared__ __attribute__((aligned(16))) unsigned char lds[];
    cg::grid_group grid = cg::this_grid();
    constexpr int NPH = 1 + 4 * 12;
    unsigned* bar = (unsigned*)(p.ws + WS_BAR);
    volatile unsigned* bst = (volatile unsigned*)(lds + LDS_BYTES - 16);
    if (mk_ltid() == 0) { bst[0] = 0u; bst[1] = 0u; }
    if (mk_lbid() == 0) for (int u = mk_ltid(); u < CTL_WORDS; u += 512) __hip_atomic_store(bar + u, 0u, __ATOMIC_RELAXED, __HIP_MEMORY_SCOPE_AGENT);
    __syncthreads();
#pragma unroll 1
    for (int ph = 0; ph < NPH; ++ph) {
        int l = (ph == 0) ? 0 : (ph - 1) / 12, k = (ph == 0) ? -1 : (ph - 1) % 12;
        asm volatile("" : "+s"(l), "+s"(k));
        const int i = l >> 1; const bool ab = (l & 1) == 0;
        if (k == 6 && !ab) continue;
        unsigned char* ws = p.ws; asm volatile("" : "+s"(ws));
        unsigned char* smem = (unsigned char*)lds;
        PG8_LAS unsigned char* ldsp = (PG8_LAS unsigned char*)lds;
        const int G = gridDim.x, cu = mk_lbid();
#ifndef REPMASK
#define REPMASK 0
#endif
#ifndef REPAB
#define REPAB 3
#endif
        const int nrep = (((REPMASK >> (k + 1)) & 1) && ((REPAB >> (l & 1)) & 1)) ? 2 : 1;
#pragma unroll 1
        for (int rep = 0; rep < nrep; ++rep) {
        if (rep) grid.sync();
        if (k == -1) phase_start(p, smem);
        else if (k == 0 || k == 9) {
            const int j = (k == 9);
            pg8::Gemm g{(const bf16_t*)(ws + WS_HB), (const bf16_t*)(ws + WS_WGU) + (size_t)j * 5632 * 1024, M, 5632, D};
            pg8::StaticOrder S; S.init(g.M, g.N, G, cu); EpiSwiglu E{(bf16_t*)(ws + WS_HID)};
            pg8::gemm_phase<EpiSwiglu, pg8::StaticOrder, true, true>(ldsp, g, S, E);
        } else if (k == 1 || k == 10 || k == 7) {
            const int j = (k == 10);
            pg8::Gemm g{(const bf16_t*)(ws + (k == 7 ? WS_OMIX : WS_HID)), k == 7 ? (const bf16_t*)(ws + WS_WOUT) : (const bf16_t*)(ws + WS_WD) + (size_t)j * 1024 * 2816, MP, D, k == 7 ? D : FF};
            pg8::StaticOrder S; S.init(g.M, g.N, G, cu); EpiResid E{(bf16_t*)(ws + WS_X), (const bf16_t*)(ws + WS_HB), k == 7 ? 1.0f : 0.5f};
            pg8::gemm_phase<EpiResid, pg8::StaticOrder, true, true>(ldsp, g, S, E);
            small_resid_gemm(g.A, g.Bt, g.K, E.X, E.H, E.scale, smem);
        } else if (k == 2 || k == 8 || k == 11) {
            phase_ln(p, l, k == 2 ? 0 : (k == 8 ? 1 : 2), (l == 3 && k == 11));
            if (k == 11 && l < 3) convert_items(p, l + 1, 4, mk_lbid() * 8 + (mk_ltid() >> 6), gridDim.x * 8, smem);
        } else if (k == 3) {
            pg8::Gemm g{(const bf16_t*)(ws + WS_HB), (const bf16_t*)(ws + WS_WIN), M, ab ? AB_N : GD_N, D};
            pg8::StaticOrder S; S.init(g.M, g.N, G, cu); EpiZ E{(bf16_t*)(ws + WS_ZB), g.N};
            pg8::gemm_phase<EpiZ, pg8::StaticOrder, true, true>(ldsp, g, S, E);
        } else if (k == 4) { if (ab) phase_ab_prep(p, i, smem); else phase_gdn_chunk(p, i, smem); }
        else if (k == 5) { if (ab) phase_ab_core(p, i, l, smem); else phase_gdn_scan(p, i, l, smem); }
        else if (k == 6) phase_ab_post(p, i);
        }
        if (ph + 1 < NPH) { if (ph == 0) { grid.sync(); if (mk_ltid() == 0) (void)xb_add(&bar[XB_XCNT(xb_xcc_id())], 1u); } else gbar(bar, bst); }
#ifdef REPSYNC
        if (ph > 0) { gbar(bar, bst); gbar(bar, bst); }
#endif
    }
}
}

extern "C" void kernel_launch(void* const* d_in, const int* in_sizes, int n_in, void* d_out, int out_size, void* d_ws, size_t ws_size, hipStream_t stream) {
    static int grid_blocks = 0;
    if (grid_blocks == 0) {
        if (n_in != 33 || ws_size < mk::WS_NEED) { fprintf(stderr, "kernel_launch: need 33 inputs and %zu bytes of workspace; got %d, %zu\n", (size_t)mk::WS_NEED, n_in, ws_size); grid_blocks = -1; return; }
        int dev = 0, cus = 0, per_cu = 0;
        hipGetDevice(&dev);
        hipDeviceGetAttribute(&cus, hipDeviceAttributeMultiprocessorCount, dev);
        if (hipFuncSetAttribute((const void*)mk::mega, hipFuncAttributeMaxDynamicSharedMemorySize, mk::LDS_BYTES) != hipSuccess) { fprintf(stderr, "kernel_launch: hipFuncSetAttribute failed\n"); grid_blocks = -1; return; }
        if (hipOccupancyMaxActiveBlocksPerMultiprocessor(&per_cu, (const void*)mk::mega, 512, mk::LDS_BYTES) != hipSuccess || per_cu < 1) { fprintf(stderr, "kernel_launch: occupancy query failed (%d)\n", per_cu); (void)hipGetLastError(); per_cu = 1; }
        grid_blocks = cus * 1;
        fprintf(stderr, "kernel_launch: grid %d (cus %d, per_cu %d)\n", grid_blocks, cus, per_cu);
    }
    if (grid_blocks < 0) return;
    mk::Params prm{};
    for (int k = 0; k < 33; ++k) prm.in[k] = (const float*)d_in[k];
    prm.out = (float*)d_out; prm.ws = (unsigned char*)d_ws;
    void* args[] = {&prm};
    hipError_t e = hipLaunchCooperativeKernel((const void*)mk::mega, dim3(grid_blocks), dim3(512), args, mk::LDS_BYTES, stream);
    if (e != hipSuccess) fprintf(stderr, "cooperative launch failed: %s (grid %d)\n", hipGetErrorString(e), grid_blocks);
}
```

```cpp
#include <hip/hip_runtime.h>
#include <hip/hip_cooperative_groups.h>
#include <cstdio>
#include <cstdint>
namespace cg = cooperative_groups;
__device__ __forceinline__ int mk_ltid() { int t = threadIdx.x; asm volatile("" : "+v"(t)); return t; }
__device__ __forceinline__ int mk_lbid() { int t = blockIdx.x; asm volatile("" : "+s"(t)); return t; }
namespace pg8 {
#define PG8_LAS __attribute__((address_space(3)))
typedef unsigned short bf16_t;
typedef short bf16x8 __attribute__((ext_vector_type(8)));
typedef float f32x4 __attribute__((ext_vector_type(4)));
typedef unsigned u32x4 __attribute__((ext_vector_type(4)));
constexpr int BM = 256, BK = 64, HALF = 128, HTB = HALF * BK * 2  , STAGE_BYTES = 8 * HTB, NXCD = 8, WGM = 8;

__host__ __device__ __forceinline__ int lds_byte(int r, int c) { const int st = (r >> 4) * 2 + (c >> 5), rr = r & 15, cc = c & 31, ob = rr * 64 + cc * 2; return st * 1024 + (ob ^ (((ob >> 9) & 1) << 5)); }
__host__ __device__ __forceinline__ void stage_rc(int b, int& R, int& C) { const int st = b / 1024, sb = b % 1024, swz = sb ^ (((sb >> 9) & 1) << 5); R = (st >> 1) * 16 + swz / 64; C = (st & 1) * 32 + (swz % 64) / 2; }
__host__ __device__ __forceinline__ int perm32(int rho) { const int n = rho >> 4, i = rho & 15; return 8 * (i >> 2) + 4 * n + (i & 3); }

struct Unit { int pm, pn; };
struct Gemm { const bf16_t* A; const bf16_t* Bt; int M, N, K; };

struct StaticOrder {
    int nM, nN, nwg, G, c;
    __host__ __device__ void init(int M, int N, int G_, int c_) { nM = M / BM; nN = N / BM; nwg = nM * nN; G = G_; c = c_; }
    __host__ __device__ bool next(int i, Unit& u) const {
        const long L = (long)i * G + c; if (L >= nwg) return false;
        int wgid = (int)L; { const int q = nwg / NXCD, r = nwg % NXCD, xcd = wgid % NXCD, off = wgid / NXCD; wgid = (xcd < r ? xcd * (q + 1) : r * (q + 1) + (xcd - r) * q) + off; }
        const int nig = WGM * nN, gid = wgid / nig, fm = gid * WGM, gsz = (nM - fm) < WGM ? (nM - fm) : WGM;
        u.pm = fm + ((wgid % nig) % gsz); u.pn = (wgid % nig) / gsz; return true;
    }
    __device__ __forceinline__ void a_ready(const Unit&) const {}
    __device__ __forceinline__ void done(const Unit&) const {}
};

template <class Epi, class Sched, bool ALIGN_EPI = false, bool SP2 = false>
__device__ __forceinline__ void gemm_phase(PG8_LAS unsigned char* lds, const Gemm g, const Sched& S, const Epi& E) {
    const int tid = mk_ltid(), wid = __builtin_amdgcn_readfirstlane(tid >> 6), lane = tid & 63, wr = wid >> 2, wc = wid & 3, fr = lane & 15, fq = lane >> 4;
    const int K = g.K, nt = K / BK;
    unsigned voffA[2], voffB[2];
#pragma unroll
    for (int i = 0; i < 2; ++i) { int R, C; stage_rc(tid * 16 + i * 8192, R, C); const int Rb = Epi::PERM ? ((R & ~31) + perm32(R & 31)) : R;
        voffA[i] = (unsigned)(R * K + C) * 2u; voffB[i] = (unsigned)(Rb * K + C) * 2u; }
    const size_t kstep = (size_t)(BK * 2);
    const size_t hstep = (size_t)HALF * K * 2;
    const size_t tstep = 2 * hstep;
    const unsigned ldsw = (unsigned)wid * 1024u;
    const int aoff = lds_byte(wr * 64 + fr, fq * 8), boff = lds_byte(wc * 32 + fr, fq * 8);
#define PG8_SA(b, h) (((b) * 2 + (h)) * HTB)
#define PG8_SB(b, h) ((4 + (b) * 2 + (h)) * HTB)
#define PG8_STAGE(bufoff, gbase, voff) do { _Pragma("unroll") for (int _i = 0; _i < 2; ++_i) \
        __builtin_amdgcn_global_load_lds((const unsigned*)((const char*)(gbase) + (voff)[_i]), (PG8_LAS unsigned*)(lds + (bufoff) + ldsw + _i * 8192), 16, 0, 0); } while (0)
#define PG8_LDA(dst, b, h) do { _Pragma("unroll") for (int m = 0; m < 4; ++m) _Pragma("unroll") for (int k = 0; k < 2; ++k) dst[m][k] = *(const PG8_LAS bf16x8*)(lds + PG8_SA(b, h) + aoff + m * 2048 + k * 1024); } while (0)
#define PG8_LDB(dst, b, h) do { _Pragma("unroll") for (int n = 0; n < 2; ++n) _Pragma("unroll") for (int k = 0; k < 2; ++k) dst[n][k] = *(const PG8_LAS bf16x8*)(lds + PG8_SB(b, h) + boff + n * 2048 + k * 1024); } while (0)
#define PG8_MMA(ai, bj, At, Bt) do { __builtin_amdgcn_s_setprio(1); _Pragma("unroll") for (int m = 0; m < 4; ++m) _Pragma("unroll") for (int n = 0; n < 2; ++n) _Pragma("unroll") for (int k = 0; k < 2; ++k) \
        acc[ai][bj][m][n] = __builtin_amdgcn_mfma_f32_16x16x32_bf16(Bt[n][k], At[m][k], acc[ai][bj][m][n], 0, 0, 0); __builtin_amdgcn_s_setprio(0); } while (0)
#define PG8_WAIT_V(n) asm volatile("s_waitcnt vmcnt(" #n ")" ::: "memory")
#define PG8_WAIT_L(n) asm volatile("s_waitcnt lgkmcnt(" #n ")" ::: "memory")
#define PG8_BAR __builtin_amdgcn_s_barrier()
#define PG8_SCHED __builtin_amdgcn_sched_barrier(0)
    Unit cur, nxt; int ui = 0;
    if (!S.next(0, cur)) return;
    f32x4 acc[2][2][4][2];
#pragma unroll
    for (int a = 0; a < 2; ++a)
#pragma unroll
        for (int b = 0; b < 2; ++b)
#pragma unroll
            for (int m = 0; m < 4; ++m)
#pragma unroll
                for (int n = 0; n < 2; ++n) acc[a][b][m][n] = (f32x4){0.f, 0.f, 0.f, 0.f};
    bf16x8 At[4][2], B0[2][2], B1[2][2];
    const char* cA = (const char*)g.A + (size_t)cur.pm * tstep; const char* cB = (const char*)g.Bt + (size_t)cur.pn * tstep;
    S.a_ready(cur);
    if constexpr (SP2) {
        PG8_STAGE(PG8_SB(0, 0), cB, voffB); PG8_STAGE(PG8_SB(0, 1), cB + hstep, voffB); PG8_STAGE(PG8_SA(0, 0), cA, voffA); PG8_STAGE(PG8_SA(0, 1), cA + hstep, voffA);
        if (wr == 1) PG8_BAR;
        PG8_WAIT_V(2); PG8_BAR;
        PG8_STAGE(PG8_SB(1, 0), cB + kstep, voffB); PG8_STAGE(PG8_SA(1, 0), cA + kstep, voffA); PG8_STAGE(PG8_SB(1, 1), cB + hstep + kstep, voffB);
        PG8_WAIT_V(6); PG8_BAR;
    } else {
        PG8_STAGE(PG8_SB(0, 0), cB, voffB); PG8_STAGE(PG8_SA(0, 0), cA, voffA); PG8_STAGE(PG8_SB(0, 1), cB + hstep, voffB); PG8_STAGE(PG8_SA(0, 1), cA + hstep, voffA);
        if (wr == 1) PG8_BAR;
        PG8_WAIT_V(4); PG8_BAR;
        PG8_STAGE(PG8_SB(1, 0), cB + kstep, voffB); PG8_STAGE(PG8_SA(1, 0), cA + kstep, voffA); PG8_STAGE(PG8_SB(1, 1), cB + hstep + kstep, voffB);
        PG8_WAIT_V(6); PG8_BAR;
    }
    for (;;) {
        const bool has_next = S.next(ui + 1, nxt);
        const char* nA = has_next ? (const char*)g.A + (size_t)nxt.pm * tstep : cA; const char* nB = has_next ? (const char*)g.Bt + (size_t)nxt.pn * tstep : cB;
        for (int t = 0; t < nt; t += 2) {
            const bool last = (t == nt - 2);
            const char* a1 = cA + (size_t)(t + 1) * kstep;
            const char* a2 = last ? nA : cA + (size_t)(t + 2) * kstep; const char* b2 = last ? nB : cB + (size_t)(t + 2) * kstep;
            const char* a3 = a2 + kstep; const char* b3 = b2 + kstep;
            if (last && has_next) S.a_ready(nxt);
            if constexpr (SP2) {
            PG8_LDB(B0, 0, 0); PG8_LDB(B1, 0, 1); PG8_SCHED; PG8_LDA(At, 0, 0); PG8_STAGE(PG8_SA(1, 1), a1 + hstep, voffA);
            PG8_WAIT_V(8); PG8_WAIT_L(0); PG8_BAR; PG8_MMA(0, 0, At, B0); PG8_MMA(0, 1, At, B1); PG8_BAR; PG8_SCHED;
            PG8_LDA(At, 0, 1); PG8_STAGE(PG8_SB(0, 0), b2, voffB); PG8_STAGE(PG8_SB(0, 1), b2 + hstep, voffB); PG8_STAGE(PG8_SA(0, 0), a2, voffA);
            PG8_WAIT_V(8); PG8_WAIT_L(0); PG8_BAR; PG8_MMA(1, 0, At, B0); PG8_MMA(1, 1, At, B1); PG8_BAR; PG8_SCHED;
            PG8_LDB(B0, 1, 0); PG8_LDB(B1, 1, 1); PG8_SCHED; PG8_LDA(At, 1, 0); PG8_STAGE(PG8_SA(0, 1), a2 + hstep, voffA);
            PG8_WAIT_V(8); PG8_WAIT_L(0); PG8_BAR; PG8_MMA(0, 0, At, B0); PG8_MMA(0, 1, At, B1); PG8_BAR; PG8_SCHED;
            PG8_LDA(At, 1, 1); PG8_STAGE(PG8_SB(1, 0), b3, voffB); PG8_STAGE(PG8_SB(1, 1), b3 + hstep, voffB); PG8_STAGE(PG8_SA(1, 0), a3, voffA);
            PG8_WAIT_V(8); PG8_WAIT_L(0); PG8_BAR; PG8_MMA(1, 0, At, B0); PG8_MMA(1, 1, At, B1); PG8_BAR; PG8_SCHED;
            } else {
            PG8_LDB(B0, 0, 0); PG8_SCHED; PG8_LDA(At, 0, 0); PG8_STAGE(PG8_SA(1, 1), a1 + hstep, voffA);
            PG8_WAIT_L(8); PG8_BAR; PG8_WAIT_L(0); PG8_MMA(0, 0, At, B0); PG8_BAR; PG8_SCHED;
            PG8_LDB(B1, 0, 1); PG8_STAGE(PG8_SB(0, 0), b2, voffB);
            PG8_BAR; PG8_WAIT_L(0); PG8_MMA(0, 1, At, B1); PG8_BAR;
            PG8_LDA(At, 0, 1); PG8_STAGE(PG8_SA(0, 0), a2, voffA);
            PG8_BAR; PG8_WAIT_L(0); PG8_MMA(1, 0, At, B0); PG8_BAR; PG8_SCHED;
            PG8_STAGE(PG8_SB(0, 1), b2 + hstep, voffB);
            PG8_WAIT_V(6); PG8_BAR; PG8_MMA(1, 1, At, B1); PG8_BAR;
            PG8_LDB(B0, 1, 0); PG8_SCHED; PG8_LDA(At, 1, 0); PG8_STAGE(PG8_SA(0, 1), a2 + hstep, voffA);
            PG8_WAIT_L(8); PG8_BAR; PG8_WAIT_L(0); PG8_MMA(0, 0, At, B0); PG8_BAR; PG8_SCHED;
            PG8_LDB(B1, 1, 1); PG8_STAGE(PG8_SB(1, 0), b3, voffB);
            PG8_BAR; PG8_WAIT_L(0); PG8_MMA(0, 1, At, B1); PG8_BAR;
            PG8_LDA(At, 1, 1); PG8_STAGE(PG8_SA(1, 0), a3, voffA);
            PG8_BAR; PG8_WAIT_L(0); PG8_MMA(1, 0, At, B0); PG8_BAR; PG8_SCHED;
            PG8_STAGE(PG8_SB(1, 1), b3 + hstep, voffB);
            PG8_WAIT_V(6); PG8_BAR; PG8_MMA(1, 1, At, B1); PG8_BAR;
            }
        }
        if constexpr (ALIGN_EPI) { if (wr == 0) PG8_BAR; }
        if constexpr (!Epi::AFTER_DRAIN) { E(acc, cur, wr, wc, fr, fq); S.done(cur); }
        if (!has_next) break;
#pragma unroll
        for (int a = 0; a < 2; ++a)
#pragma unroll
            for (int b = 0; b < 2; ++b)
#pragma unroll
                for (int m = 0; m < 4; ++m)
#pragma unroll
                    for (int n = 0; n < 2; ++n) acc[a][b][m][n] = (f32x4){0.f, 0.f, 0.f, 0.f};
        cur = nxt; cA = nA; cB = nB; ++ui;
        if constexpr (ALIGN_EPI) { if (wr == 1) PG8_BAR; }
    }
    PG8_WAIT_V(0);
    if constexpr (!ALIGN_EPI) { if (wr == 0) PG8_BAR; }
    PG8_BAR;
    if constexpr (Epi::AFTER_DRAIN) { E.fused(acc, cur, wr, wc, fr, fq, lds, wid, lane); S.done(cur); }
#undef PG8_SA
#undef PG8_SB
#undef PG8_STAGE
#undef PG8_LDA
#undef PG8_LDB
#undef PG8_MMA
#undef PG8_WAIT_V
#undef PG8_WAIT_L
#undef PG8_BAR
#undef PG8_SCHED
}
}

namespace mk {
using pg8::bf16_t; using pg8::bf16x8; using pg8::f32x4; using pg8::Unit;
typedef unsigned u32x4 __attribute__((ext_vector_type(4)));
typedef unsigned u32x2 __attribute__((ext_vector_type(2)));

constexpr int M = 16896, MP = 16384, D = 1024, FF = 2816;
constexpr int AB_N = 3840, GD_N = 4352, GD_NREAL = 4112;
constexpr float ALPHA = 1.6817928305074290f;
constexpr int LDS_BYTES = 163840;

constexpr size_t O_PSHIFT = 17301504, O_PRWKV = 17330176, O_PRET = 17854464, O_PCONV = 18903040, O_PGDN = 19050496;
constexpr size_t O_SSHIFT = 21147648, O_SRWKV = 21606400, O_SRET = 29995008, O_SCONV = 46772224, O_SGDN = 49131520;

constexpr size_t WS_WGU = 0;
constexpr size_t WS_WD = WS_WGU + 2ull * 5632 * 1024 * 2;
constexpr size_t WS_WIN = WS_WD + 2ull * 1024 * 2816 * 2;
constexpr size_t WS_WOUT = WS_WIN + 4352ull * 1024 * 2;
constexpr size_t WS_W2T = WS_WOUT + 1024ull * 1024 * 2;
constexpr size_t WS_A2T = WS_W2T + 65536;
constexpr size_t WS_G2T = WS_A2T + 65536;
constexpr size_t WS_X = WS_G2T + 131072;
constexpr size_t WS_HB = WS_X + (size_t)M * 1024 * 4;
constexpr size_t WS_S = WS_HB + (size_t)M * 1024 * 2;
constexpr size_t WS_HID = WS_S;
constexpr size_t WS_OMIX = WS_S;
constexpr size_t WS_ZB = WS_OMIX + (size_t)M * 1024 * 2;
constexpr size_t WS_OPS = WS_ZB + (size_t)M * AB_N * 2;
constexpr size_t WS_GATE = WS_OPS + (size_t)M * 3072 * 4;
constexpr size_t WS_ORAW = WS_GATE + (size_t)M * 512 * 4;
constexpr size_t WS_BONUS = WS_ORAW + (size_t)M * 512 * 4;
constexpr size_t WS_RQ = WS_BONUS + (size_t)M * 8 * 4;
constexpr size_t WS_RK = WS_RQ + (size_t)M * 512 * 2;
constexpr size_t WS_AB_END = WS_RK + (size_t)M * 512 * 2;
constexpr size_t WS_CH = WS_ZB + (size_t)M * GD_N * 2;
constexpr size_t CH_U = 0, CH_W = 32768, CH_QG = 49152, CH_QK = 65536, CH_KDT = 73728, CH_BYTES = 90112;
constexpr int N_CH = 2048 + 1024;
constexpr size_t WS_GL = WS_CH + (size_t)N_CH * CH_BYTES;
constexpr size_t WS_GD_END = WS_GL + N_CH * 4;
constexpr size_t WS_BAR = ((WS_AB_END > WS_GD_END ? WS_AB_END : WS_GD_END) + 255) / 256 * 256;
constexpr size_t WS_FLAGS = WS_BAR + 16384;
constexpr int CTL_WORDS = (16384 + 8192) / 4;
constexpr size_t WS_NEED = WS_FLAGS + 8192;
constexpr int GDN_LATE = 28;

struct Params { const float* in[33]; float* out; unsigned char* ws; };

__device__ __forceinline__ float bf2f(bf16_t h) { return __uint_as_float(((unsigned)h) << 16); }
__device__ __forceinline__ unsigned pk2(float lo, float hi) { unsigned r; asm volatile("v_cvt_pk_bf16_f32 %0, %1, %2" : "=v"(r) : "v"(lo), "v"(hi)); return r; }
__device__ __forceinline__ bf16_t f2bf(float x) { return (bf16_t)(pk2(x, 0.f) & 0xffffu); }
__device__ __forceinline__ float sigm(float x) { return __builtin_amdgcn_rcpf(1.f + __expf(-x)); }
__device__ __forceinline__ float silu(float x) { return x * __builtin_amdgcn_rcpf(1.f + __expf(-x)); }
__device__ __forceinline__ float dppf(float v, const int ctrl_sel) {
    int x = __builtin_bit_cast(int, v), y;
    if (ctrl_sel == 0) y = __builtin_amdgcn_update_dpp(0, x, 0xB1, 0xF, 0xF, true);
    else if (ctrl_sel == 1) y = __builtin_amdgcn_update_dpp(0, x, 0x4E, 0xF, 0xF, true);
    else if (ctrl_sel == 2) y = __builtin_amdgcn_update_dpp(0, x, 0x141, 0xF, 0xF, true);
    else y = __builtin_amdgcn_update_dpp(0, x, 0x140, 0xF, 0xF, true);
    return __builtin_bit_cast(float, y);
}
__device__ __forceinline__ float row16_sum(float v) { v += dppf(v, 0); v += dppf(v, 1); v += dppf(v, 2); v += dppf(v, 3); return v; }
__device__ __forceinline__ float wave_sum(float v) {
#pragma unroll
    for (int o = 1; o < 64; o <<= 1) v += __shfl_xor(v, o);
    return v;
}
#define XB_XCNT(j)  (256  + 64 * (j))
#define XB_XSUB(j)  (1280 + 64 * (j))
#define XB_XGEN(j)  (2304 + 64 * (j))
#define XB_TOP      3328
#define XB_TOPGEN   3392
#define XCD_BAR_WORDS 3456
__device__ __forceinline__ unsigned xb_ld(unsigned* p)              { return __hip_atomic_load(p, __ATOMIC_RELAXED, __HIP_MEMORY_SCOPE_AGENT); }
__device__ __forceinline__ unsigned xb_add(unsigned* p, unsigned v) { return __hip_atomic_fetch_add(p, v, __ATOMIC_RELAXED, __HIP_MEMORY_SCOPE_AGENT); }
__device__ __forceinline__ unsigned xb_xcc_id() { return (unsigned)__builtin_amdgcn_s_getreg((3 << 11) | 20) & 0xFu; }
__device__ __forceinline__ void gbar(unsigned* bar, volatile unsigned* st) {
    asm volatile("s_waitcnt vmcnt(0)" ::: "memory");
    __syncthreads();
    if (mk_ltid() == 0) {
        __builtin_amdgcn_s_waitcnt(0);
        const unsigned x = xb_xcc_id();
        unsigned nloc = st[0], nx = st[1];
        if (nloc == 0u) {
            const unsigned G = gridDim.x;
            unsigned sum, cnt, mine;
            for (;;) {
                sum = 0u; cnt = 0u; mine = 0u;
#pragma unroll
                for (unsigned j = 0; j < 16; ++j) { const unsigned c = xb_ld(&bar[XB_XCNT(j)]); sum += c; cnt += (c > 0u) ? 1u : 0u; mine = (j == x) ? c : mine; }
                if (sum == G) break;
                __builtin_amdgcn_s_sleep(1);
            }
            nloc = mine > 0u ? mine : 1u; nx = cnt > 0u ? cnt : 1u; st[0] = nloc; st[1] = nx;
        }
        const unsigned old = xb_add(&bar[XB_XSUB(x)], 1u);
        const unsigned gen = old / nloc;
        if (old + 1u == (gen + 1u) * nloc) {
            __builtin_amdgcn_fence(__ATOMIC_RELEASE, "agent");
            asm volatile("s_waitcnt vmcnt(0)" ::: "memory");
            const unsigned og = xb_add(&bar[XB_TOP], 1u);
            const unsigned tg = og / nx;
            if (og + 1u == (tg + 1u) * nx) xb_add(&bar[XB_TOPGEN], 1u);
            else while (xb_ld(&bar[XB_TOPGEN]) == tg) __builtin_amdgcn_s_sleep(1);
            __builtin_amdgcn_fence(__ATOMIC_ACQUIRE, "agent");
            xb_add(&bar[XB_XGEN(x)], 1u);
            asm volatile("s_waitcnt vmcnt(0)" ::: "memory");
        } else {
            while (xb_ld(&bar[XB_XGEN(x)]) == gen) __builtin_amdgcn_s_sleep(1);
            __builtin_amdgcn_fence(__ATOMIC_ACQUIRE, "agent");
            asm volatile("s_waitcnt vmcnt(0)" ::: "memory");
        }
    }
    __syncthreads();
}
__device__ __forceinline__ void seq_info(int s, int& row0, int& L) { if (s < 8) { row0 = s * 2048; L = 2048; } else { row0 = MP + (s - 8) * 4; L = 4; } }

struct EpiSwiglu { static constexpr bool PERM = true, AFTER_DRAIN = false; bf16_t* O;
    __device__ __forceinline__ void operator()(const f32x4 (&acc)[2][2][4][2], const Unit& u, int wr, int wc, int fr, int fq) const {
        const int row0 = u.pm * 256 + wr * 64 + fr, col0 = u.pn * 128 + wc * 32 + 8 * fq;
#pragma unroll
        for (int ai = 0; ai < 2; ++ai)
#pragma unroll
            for (int m = 0; m < 4; ++m) {
                bf16_t* rp = O + (size_t)(row0 + ai * 128 + m * 16) * FF + col0;
                const f32x4 g0 = acc[ai][0][m][0], g1 = acc[ai][0][m][1], u0 = acc[ai][1][m][0], u1 = acc[ai][1][m][1];
                u32x4 w;
                w.x = pk2(silu(g0[0]) * u0[0], silu(g0[1]) * u0[1]); w.y = pk2(silu(g0[2]) * u0[2], silu(g0[3]) * u0[3]);
                w.z = pk2(silu(g1[0]) * u1[0], silu(g1[1]) * u1[1]); w.w = pk2(silu(g1[2]) * u1[2], silu(g1[3]) * u1[3]);
                *(u32x4*)rp = w;
            }
    }
};
struct EpiResid { static constexpr bool PERM = true, AFTER_DRAIN = false; bf16_t* X; const bf16_t* H; float scale;
    __device__ __forceinline__ void operator()(const f32x4 (&acc)[2][2][4][2], const Unit& u, int wr, int wc, int fr, int fq) const {
        const int row0 = u.pm * 256 + wr * 64 + fr, col0 = u.pn * 256 + wc * 32 + 8 * fq;
#pragma unroll
        for (int ai = 0; ai < 2; ++ai)
#pragma unroll
            for (int m = 0; m < 4; ++m)
#pragma unroll
                for (int bj = 0; bj < 2; ++bj)
#pragma unroll
                    for (int n = 0; n < 2; ++n) {
                        const size_t off = (size_t)(row0 + ai * 128 + m * 16) * D + col0 + bj * 128 + 4 * n;
                        const u32x2 hu = *(const u32x2*)(H + off);
                        f32x4 x; x[0] = __uint_as_float(hu.x << 16); x[1] = __uint_as_float(hu.x & 0xffff0000u); x[2] = __uint_as_float(hu.y << 16); x[3] = __uint_as_float(hu.y & 0xffff0000u);
                        x = x * ALPHA + acc[ai][bj][m][n] * scale; u32x2 xo; xo.x = pk2(x[0], x[1]); xo.y = pk2(x[2], x[3]); *(u32x2*)(X + off) = xo;
                    }
    }
};
struct EpiZ { static constexpr bool PERM = true, AFTER_DRAIN = false; bf16_t* Z; int ld;
    __device__ __forceinline__ void operator()(const f32x4 (&acc)[2][2][4][2], const Unit& u, int wr, int wc, int fr, int fq) const {
        const int row0 = u.pm * 256 + wr * 64 + fr, col0 = u.pn * 256 + wc * 32 + 8 * fq;
#pragma unroll
        for (int ai = 0; ai < 2; ++ai)
#pragma unroll
            for (int m = 0; m < 4; ++m)
#pragma unroll
                for (int bj = 0; bj < 2; ++bj) {
                    const f32x4 a = acc[ai][bj][m][0], b = acc[ai][bj][m][1];
                    u32x4 w; w.x = pk2(a[0], a[1]); w.y = pk2(a[2], a[3]); w.z = pk2(b[0], b[1]); w.w = pk2(b[2], b[3]);
                    *(u32x4*)(Z + (size_t)(row0 + ai * 128 + m * 16) * ld + col0 + bj * 128) = w;
                }
    }
};

__device__ __forceinline__ void tr_item(const float* __restrict__ W, int K, int N, bf16_t* WT, int dst_row0, int k0, int n0, float* scr, int lane) {
#pragma unroll
    for (int i = 0; i < 32; ++i) { const int kk = 2 * i + (lane >> 5); const int col = n0 + (lane & 31);
        scr[kk * 33 + (lane & 31)] = (col < N) ? W[(size_t)(k0 + kk) * N + col] : 0.f; }
    asm volatile("s_waitcnt lgkmcnt(0)" ::: "memory");
    const int c = lane & 7;
#pragma unroll
    for (int j = 0; j < 4; ++j) { const int n = (lane >> 3) + 8 * j; const float* s = scr + (8 * c) * 33 + n;
        u32x4 o; o.x = pk2(s[0], s[33]); o.y = pk2(s[2 * 33], s[3 * 33]); o.z = pk2(s[4 * 33], s[5 * 33]); o.w = pk2(s[6 * 33], s[7 * 33]);
        *(u32x4*)(WT + (size_t)(dst_row0 + n) * K + k0 + 8 * c) = o; }
    asm volatile("s_waitcnt lgkmcnt(0)" ::: "memory");
}

__device__ __forceinline__ void convert_items(const Params& p, int l, int parts, int gw, int NGW, unsigned char* smem) {
    const int lane = mk_ltid() & 63, wave = mk_ltid() >> 6;
    float* scr = (float*)smem + wave * (64 * 33);
    unsigned char* ws = p.ws;
    const int i = l >> 1; const bool ab = (l & 1) == 0;
    constexpr int I_G = 16 * 88, I_O = 16 * 32;
    const int I_IN = ab ? 16 * 120 : 16 * 136;
    const int I_LORA = ab ? (16 + 16 + 32) : 0;
    const int n0 = (parts & 1) ? 3 * I_G : 0, n1 = (parts & 2) ? 3 * I_G : 0, n2 = (parts & 4) ? (I_IN + I_O + I_LORA) : 0;
    const int total = n0 + n1 + n2;
    for (int it = gw; it < total; it += NGW) {
        int r = it;
        if (r < n0 + n1) {
            const int j = (r < n0) ? 0 : 1; r -= (j ? n0 : 0);
            const int kind = r / I_G; r -= kind * I_G;
            const size_t lw = (size_t)(l * 2 + j);
            if (kind < 2) { const float* W = p.in[kind == 0 ? 9 : 10] + lw * (size_t)D * FF;
                const int kb = r / 88, nb = r % 88, nn0 = nb * 32;
                tr_item(W, D, FF, (bf16_t*)(ws + WS_WGU) + (size_t)j * 5632 * 1024, (nn0 >> 7) * 256 + (nn0 & 127) + kind * 128, kb * 64, nn0, scr, lane);
            } else { const float* W = p.in[11] + lw * (size_t)FF * D;
                const int kb = r / 32, nb = r % 32;
                tr_item(W, FF, D, (bf16_t*)(ws + WS_WD) + (size_t)j * 1024 * 2816, nb * 32, kb * 64, nb * 32, scr, lane);
            }
            continue;
        }
        r -= n0 + n1;
        if (r < I_IN) {
            if (ab) { const int kb = r / 120, nb = r % 120; tr_item(p.in[12] + (size_t)i * D * AB_N, D, AB_N, (bf16_t*)(ws + WS_WIN), nb * 32, kb * 64, nb * 32, scr, lane); }
            else { const int kb = r / 136, nb = r % 136; tr_item(p.in[27] + (size_t)i * D * GD_NREAL, D, GD_NREAL, (bf16_t*)(ws + WS_WIN), nb * 32, kb * 64, nb * 32, scr, lane); }
            continue;
        }
        r -= I_IN;
        if (r < I_O) { const int kb = r / 32, nb = r % 32;
            tr_item(p.in[ab ? 13 : 32] + (size_t)i * D * D, D, D, (bf16_t*)(ws + WS_WOUT), nb * 32, kb * 64, nb * 32, scr, lane); continue; }
        r -= I_O;
        if (r < 16) { tr_item(p.in[16] + (size_t)i * 64 * 512, 64, 512, (bf16_t*)(ws + WS_W2T), r * 32, 0, r * 32, scr, lane); continue; }
        r -= 16;
        if (r < 16) { tr_item(p.in[18] + (size_t)i * 64 * 512, 64, 512, (bf16_t*)(ws + WS_A2T), r * 32, 0, r * 32, scr, lane); continue; }
        r -= 16;
        { const int kb = r / 16, nb = r % 16; tr_item(p.in[19] + (size_t)i * 128 * 512, 128, 512, (bf16_t*)(ws + WS_G2T), nb * 32, kb * 64, nb * 32, scr, lane); }
    }
}
__device__ __forceinline__ void convert_ffn_ahead(const Params& p, int l, int gw, int NGW, unsigned char* smem) {
    __syncthreads();
    convert_items(p, l, 2, gw, NGW, smem);
    if (l < 3) convert_items(p, l + 1, 1, gw, NGW, smem);
    __syncthreads();
}

__device__ __forceinline__ void phase_start(const Params& p, unsigned char* smem) {
    const int tid = mk_ltid(), lane = tid & 63, wave = tid >> 6;
    const int gw = mk_lbid() * 8 + wave, NGW = gridDim.x * 8;
    convert_items(p, 0, 5, gw, NGW, smem);
    bf16_t* HB = (bf16_t*)(p.ws + WS_HB);
    for (int m = gw; m < M; m += NGW) {
        const float* src = (m < MP) ? p.in[0] + (size_t)m * D : p.in[1] + (size_t)(m - MP) * D;
#pragma unroll
        for (int j = 0; j < 4; ++j) { const int c = (lane + 64 * j) * 4; const f32x4 v = *(const f32x4*)(src + c);
            u32x2 o; o.x = pk2(v[0], v[1]); o.y = pk2(v[2], v[3]); *(u32x2*)(HB + (size_t)m * D + c) = o; }
    }
}

__device__ __forceinline__ void phase_ln(const Params& p, int l, int k, bool final_out) {
    const int tid = mk_ltid(), lane = tid & 63, wave = tid >> 6;
    const int gw = mk_lbid() * 8 + wave, NGW = gridDim.x * 8;
    const bf16_t* X = (const bf16_t*)(p.ws + WS_X); bf16_t* HB = (bf16_t*)(p.ws + WS_HB);
    const float* g = p.in[7] + (size_t)(l * 3 + k) * D; const float* b = p.in[8] + (size_t)(l * 3 + k) * D;
    float* dst = p.out;
    for (int mq = gw; mq < M / 4; mq += NGW) {
        f32x4 v[4][4]; float s[4];
#pragma unroll
        for (int rr = 0; rr < 4; ++rr) { s[rr] = 0.f;
#pragma unroll
            for (int j = 0; j < 4; ++j) { const u32x2 xu = *(const u32x2*)(X + (size_t)(mq * 4 + rr) * D + (lane + 64 * j) * 4);
                v[rr][j][0] = __uint_as_float(xu.x << 16); v[rr][j][1] = __uint_as_float(xu.x & 0xffff0000u); v[rr][j][2] = __uint_as_float(xu.y << 16); v[rr][j][3] = __uint_as_float(xu.y & 0xffff0000u); s[rr] += (v[rr][j][0] + v[rr][j][1]) + (v[rr][j][2] + v[rr][j][3]); } }
#pragma unroll
        for (int o = 1; o < 64; o <<= 1) {
#pragma unroll
            for (int rr = 0; rr < 4; ++rr) s[rr] += __shfl_xor(s[rr], o); }
        float s2[4];
#pragma unroll
        for (int rr = 0; rr < 4; ++rr) { const float mean = s[rr] * (1.f / D); s2[rr] = 0.f;
#pragma unroll
            for (int j = 0; j < 4; ++j) { v[rr][j] = v[rr][j] - mean; s2[rr] += (v[rr][j][0] * v[rr][j][0] + v[rr][j][1] * v[rr][j][1]) + (v[rr][j][2] * v[rr][j][2] + v[rr][j][3] * v[rr][j][3]); } }
#pragma unroll
        for (int o = 1; o < 64; o <<= 1) {
#pragma unroll
            for (int rr = 0; rr < 4; ++rr) s2[rr] += __shfl_xor(s2[rr], o); }
#pragma unroll
        for (int j = 0; j < 4; ++j) { const int c = (lane + 64 * j) * 4; const f32x4 gg = *(const f32x4*)(g + c), bb = *(const f32x4*)(b + c);
#pragma unroll
            for (int rr = 0; rr < 4; ++rr) { const int m = mq * 4 + rr; const float rstd = rsqrtf(s2[rr] * (1.f / D) + 1e-5f);
                const f32x4 y = v[rr][j] * rstd * gg + bb;
                if (final_out) *(f32x4*)(dst + (size_t)m * D + c) = y;
                else { u32x2 o; o.x = pk2(y[0], y[1]); o.y = pk2(y[2], y[3]); *(u32x2*)(HB + (size_t)m * D + c) = o; } } }
    }
}

__device__ __forceinline__ void small_resid_gemm(const bf16_t* __restrict__ A, const bf16_t* __restrict__ Bt, int K, bf16_t* X, const bf16_t* H, float scale, unsigned char* smem) {
    const int tid = mk_ltid(), lane = tid & 63, w = __builtin_amdgcn_readfirstlane(tid >> 6);
    const int r = lane & 15, q = lane >> 4;
    float* part = (float*)smem;
    for (int t = mk_lbid(); t < 256; t += gridDim.x) {
        const int R0 = MP + (t >> 4) * 32, C0 = (t & 15) * 64;
        f32x4 acc[2][4];
#pragma unroll
        for (int a = 0; a < 2; ++a)
#pragma unroll
            for (int b = 0; b < 4; ++b) acc[a][b] = (f32x4){0.f, 0.f, 0.f, 0.f};
        const int nks = K / 32;
#pragma unroll 2
        for (int ks = w; ks < nks; ks += 8) {
            bf16x8 fa[2], fb[4];
#pragma unroll
            for (int a = 0; a < 2; ++a) fa[a] = *(const bf16x8*)(A + (size_t)(R0 + a * 16 + r) * K + ks * 32 + q * 8);
#pragma unroll
            for (int b = 0; b < 4; ++b) fb[b] = *(const bf16x8*)(Bt + (size_t)(C0 + b * 16 + r) * K + ks * 32 + q * 8);
#pragma unroll
            for (int a = 0; a < 2; ++a)
#pragma unroll
                for (int b = 0; b < 4; ++b) acc[a][b] = __builtin_amdgcn_mfma_f32_16x16x32_bf16(fa[a], fb[b], acc[a][b], 0, 0, 0);
        }
        __syncthreads();
#pragma unroll
        for (int a = 0; a < 2; ++a)
#pragma unroll
            for (int b = 0; b < 4; ++b) *(f32x4*)(part + ((w * 8 + a * 4 + b) * 64 + lane) * 4) = acc[a][b];
        __syncthreads();
        {
            const int tile = tid >> 6, a = tile >> 2, b = tile & 3;
            f32x4 sum = (f32x4){0.f, 0.f, 0.f, 0.f};
#pragma unroll
            for (int ww = 0; ww < 8; ++ww) sum += *(const f32x4*)(part + ((ww * 8 + tile) * 64 + lane) * 4);
            const int col = C0 + b * 16 + r;
#pragma unroll
            for (int j = 0; j < 4; ++j) { const size_t off = (size_t)(R0 + a * 16 + q * 4 + j) * D + col;
                X[off] = f2bf(bf2f(H[off]) * ALPHA + sum[j] * scale); }
        }
    }
}

__device__ __forceinline__ void phase_ab_prep(const Params& p, int i, unsigned char* smem) {
    const int tid = mk_ltid(), lane = tid & 63, wave = __builtin_amdgcn_readfirstlane(tid >> 6);
    const int r = lane & 15, q = lane >> 4;
    unsigned char* ws = p.ws;
    const bf16_t* ZB = (const bf16_t*)(ws + WS_ZB);
    float* OPS = (float*)(ws + WS_OPS); float* GATE = (float*)(ws + WS_GATE); float* BONUS = (float*)(ws + WS_BONUS);
    bf16_t* RQ = (bf16_t*)(ws + WS_RQ); bf16_t* RK = (bf16_t*)(ws + WS_RK);
    const bf16_t* W2T = (const bf16_t*)(ws + WS_W2T); const bf16_t* A2T = (const bf16_t*)(ws + WS_A2T); const bf16_t* G2T = (const bf16_t*)(ws + WS_G2T);
    const float* mu = p.in[14] + (size_t)i * 1792; const float* w0 = p.in[15] + i * 512; const float* a0 = p.in[17] + i * 512;
    const float* k_k = p.in[20] + i * 512; const float* k_a = p.in[21] + i * 512; const float* r_k = p.in[22] + i * 512;
    const float* shift_in = p.in[2] + (size_t)i * 128 * 1792;
    constexpr int ZS_LD = 1796, ACT_LD = 264;
    float* zs = (float*)smem;
    bf16_t* act = (bf16_t*)(smem + 16 * ZS_LD * 4);
    for (int tile = mk_lbid(); tile < M / 16; tile += gridDim.x) {
        const int R0 = tile * 16;
        unsigned pfa = 0u, pfb = 0u;
        { const int ntile = tile + gridDim.x;
          if (ntile < M / 16) { const bf16_t* nz = ZB + (size_t)ntile * 16 * AB_N;
              pfa = *(const unsigned*)(nz + (size_t)tid * 64); pfb = *(const unsigned*)(((size_t)(tid + 512) * 64 < (size_t)16 * AB_N) ? nz + (size_t)(tid + 512) * 64 : nz); } }
#ifndef REP_A_ST
#define REP_A_ST 1
#endif
#ifndef REP_A_RO
#define REP_A_RO 1
#endif
#ifndef REP_A_EP
#define REP_A_EP 1
#endif
        __syncthreads();
#pragma unroll
        for (int idx = tid; idx < 16 * 224; idx += 512) {
            const int tok = idx / 224, c8 = (idx % 224) * 8; const int row = R0 + tok;
            const int t = (row < MP) ? (row & 2047) : ((row - MP) & 3);
            const int Lm1 = (row < MP) ? 2047 : 3;
            const u32x4 cu = *(const u32x4*)(ZB + (size_t)row * AB_N + c8);
            f32x4 c0, c1;
            c0[0] = __uint_as_float(cu.x << 16); c0[1] = __uint_as_float(cu.x & 0xffff0000u); c0[2] = __uint_as_float(cu.y << 16); c0[3] = __uint_as_float(cu.y & 0xffff0000u);
            c1[0] = __uint_as_float(cu.z << 16); c1[1] = __uint_as_float(cu.z & 0xffff0000u); c1[2] = __uint_as_float(cu.w << 16); c1[3] = __uint_as_float(cu.w & 0xffff0000u);
            f32x4 p0, p1;
            if (t == 0) { if (row < MP) { p0 = (f32x4){0.f, 0.f, 0.f, 0.f}; p1 = p0; }
                          else { const float* sp = shift_in + (size_t)((row - MP) >> 2) * 1792 + c8; p0 = *(const f32x4*)sp; p1 = *(const f32x4*)(sp + 4); } }
            else { const u32x4 pu = *(const u32x4*)(ZB + (size_t)(row - 1) * AB_N + c8);
                p0[0] = __uint_as_float(pu.x << 16); p0[1] = __uint_as_float(pu.x & 0xffff0000u); p0[2] = __uint_as_float(pu.y << 16); p0[3] = __uint_as_float(pu.y & 0xffff0000u);
                p1[0] = __uint_as_float(pu.z << 16); p1[1] = __uint_as_float(pu.z & 0xffff0000u); p1[2] = __uint_as_float(pu.w << 16); p1[3] = __uint_as_float(pu.w & 0xffff0000u); }
            if (t == Lm1) {
                float* o = (row < MP) ? p.out + O_PSHIFT + (size_t)(i * 8 + (row >> 11)) * 1792 : p.out + O_SSHIFT + (size_t)(i * 128 + ((row - MP) >> 2)) * 1792;
                *(f32x4*)(o + c8) = c0; *(f32x4*)(o + c8 + 4) = c1;
            }
            const f32x4 z0 = c0 + (p0 - c0) * *(const f32x4*)(mu + c8), z1 = c1 + (p1 - c1) * *(const f32x4*)(mu + c8 + 4);
            *(f32x4*)(zs + tok * ZS_LD + c8) = z0; *(f32x4*)(zs + tok * ZS_LD + c8 + 4) = z1;
            if (c8 >= 1536) {
                f32x4 a0, a1;
                if (c8 < 1600) { a0[0] = tanhf(z0[0]); a0[1] = tanhf(z0[1]); a0[2] = tanhf(z0[2]); a0[3] = tanhf(z0[3]); a1[0] = tanhf(z1[0]); a1[1] = tanhf(z1[1]); a1[2] = tanhf(z1[2]); a1[3] = tanhf(z1[3]); }
                else if (c8 < 1664) { a0 = z0; a1 = z1; }
                else { a0[0] = sigm(z0[0]); a0[1] = sigm(z0[1]); a0[2] = sigm(z0[2]); a0[3] = sigm(z0[3]); a1[0] = sigm(z1[0]); a1[1] = sigm(z1[1]); a1[2] = sigm(z1[2]); a1[3] = sigm(z1[3]); }
                u32x4 o; o.x = pk2(a0[0], a0[1]); o.y = pk2(a0[2], a0[3]); o.z = pk2(a1[0], a1[1]); o.w = pk2(a1[2], a1[3]);
                *(u32x4*)(act + tok * ACT_LD + (c8 - 1536)) = o;
            }
        }
        {
            const int tok = tid >> 5, hh = (tid >> 3) & 3, c8 = (tid & 7) * 8; const int row = R0 + tok;
            const float pos = (row < MP) ? (float)(row & 2047) : (float)(16384 + ((row - MP) & 3));
            const bf16_t* zq = ZB + (size_t)row * AB_N + 1792 + hh * 128 + c8;
            const u32x4 q1v = *(const u32x4*)zq, q2v = *(const u32x4*)(zq + 64), k1v = *(const u32x4*)(zq + 512), k2v = *(const u32x4*)(zq + 576);
            const unsigned q1w[4] = {q1v.x, q1v.y, q1v.z, q1v.w}, q2w[4] = {q2v.x, q2v.y, q2v.z, q2v.w}, k1w[4] = {k1v.x, k1v.y, k1v.z, k1v.w}, k2w[4] = {k2v.x, k2v.y, k2v.z, k2v.w};
            float oq1[8], oq2[8], ok1[8], ok2[8];
            const float ksc = 0.08838834764831845f;
#pragma unroll
            for (int e = 0; e < 8; ++e) {
                const int ii = c8 + e;
                const float inv_freq = exp2f(-(float)ii * (13.287712379549449f / 63.0f));
                const float ang = pos * inv_freq;
                const float n = rintf(ang * 0.15915494309189535f);
                float rr = fmaf(-n, 6.2831854820251465f, ang); rr = fmaf(-n, -1.7484555e-7f, rr);
                const float rev = rr * 0.15915494309189535f;
                const float sn = __builtin_amdgcn_sinf(rev), cs = __builtin_amdgcn_cosf(rev);
                const float q1 = (e & 1) ? __uint_as_float(q1w[e >> 1] & 0xffff0000u) : __uint_as_float(q1w[e >> 1] << 16);
                const float q2 = (e & 1) ? __uint_as_float(q2w[e >> 1] & 0xffff0000u) : __uint_as_float(q2w[e >> 1] << 16);
                const float k1 = (e & 1) ? __uint_as_float(k1w[e >> 1] & 0xffff0000u) : __uint_as_float(k1w[e >> 1] << 16);
                const float k2 = (e & 1) ? __uint_as_float(k2w[e >> 1] & 0xffff0000u) : __uint_as_float(k2w[e >> 1] << 16);
                oq1[e] = q1 * cs - q2 * sn; oq2[e] = q2 * cs + q1 * sn;
                ok1[e] = (k1 * cs - k2 * sn) * ksc; ok2[e] = (k2 * cs + k1 * sn) * ksc;
            }
            const size_t o = (size_t)row * 512 + hh * 128 + c8;
            u32x4 w;
            w.x = pk2(oq1[0], oq1[1]); w.y = pk2(oq1[2], oq1[3]); w.z = pk2(oq1[4], oq1[5]); w.w = pk2(oq1[6], oq1[7]); *(u32x4*)(RQ + o) = w;
            w.x = pk2(oq2[0], oq2[1]); w.y = pk2(oq2[2], oq2[3]); w.z = pk2(oq2[4], oq2[5]); w.w = pk2(oq2[6], oq2[7]); *(u32x4*)(RQ + o + 64) = w;
            w.x = pk2(ok1[0], ok1[1]); w.y = pk2(ok1[2], ok1[3]); w.z = pk2(ok1[4], ok1[5]); w.w = pk2(ok1[6], ok1[7]); *(u32x4*)(RK + o) = w;
            w.x = pk2(ok2[0], ok2[1]); w.y = pk2(ok2[2], ok2[3]); w.z = pk2(ok2[4], ok2[5]); w.w = pk2(ok2[6], ok2[7]); *(u32x4*)(RK + o + 64) = w;
        }
        __syncthreads();
        const int cb = wave * 64;
#pragma unroll 1
        for (int rp_ = 0; rp_ < REP_A_EP; ++rp_) {
        f32x4 aw[4], aa[4], ag[4];
#pragma unroll
        for (int nt = 0; nt < 4; ++nt) { aw[nt] = (f32x4){0.f, 0.f, 0.f, 0.f}; aa[nt] = aw[nt]; ag[nt] = aw[nt]; }
#pragma unroll
        for (int ks = 0; ks < 2; ++ks) {
            const bf16x8 bw = *(const bf16x8*)(act + r * ACT_LD + ks * 32 + q * 8);
            const bf16x8 ba = *(const bf16x8*)(act + r * ACT_LD + 64 + ks * 32 + q * 8);
#pragma unroll
            for (int nt = 0; nt < 4; ++nt) {
                const bf16x8 fw = *(const bf16x8*)(W2T + (size_t)(cb + nt * 16 + r) * 64 + ks * 32 + q * 8);
                const bf16x8 fa = *(const bf16x8*)(A2T + (size_t)(cb + nt * 16 + r) * 64 + ks * 32 + q * 8);
                aw[nt] = __builtin_amdgcn_mfma_f32_16x16x32_bf16(fw, bw, aw[nt], 0, 0, 0);
                aa[nt] = __builtin_amdgcn_mfma_f32_16x16x32_bf16(fa, ba, aa[nt], 0, 0, 0);
            }
        }
#pragma unroll
        for (int ks = 0; ks < 4; ++ks) {
            const bf16x8 bg = *(const bf16x8*)(act + r * ACT_LD + 128 + ks * 32 + q * 8);
#pragma unroll
            for (int nt = 0; nt < 4; ++nt) {
                const bf16x8 fg = *(const bf16x8*)(G2T + (size_t)(cb + nt * 16 + r) * 128 + ks * 32 + q * 8);
                ag[nt] = __builtin_amdgcn_mfma_f32_16x16x32_bf16(fg, bg, ag[nt], 0, 0, 0);
            }
        }
        const int row = R0 + r;
        float ssq = 0.f, bon = 0.f;
        f32x4 kkraw[4], av[4];
#pragma unroll
        for (int nt = 0; nt < 4; ++nt) {
            const int c = cb + nt * 16 + q * 4;
            const f32x4 rr = *(const f32x4*)(zs + r * ZS_LD + c), kx = *(const f32x4*)(zs + r * ZS_LD + 512 + c), vv = *(const f32x4*)(zs + r * ZS_LD + 1024 + c);
            const f32x4 w04 = *(const f32x4*)(w0 + c), a04 = *(const f32x4*)(a0 + c), kk4 = *(const f32x4*)(k_k + c), ka4 = *(const f32x4*)(k_a + c), rk4 = *(const f32x4*)(r_k + c);
            f32x4 dec, a, kp;
#pragma unroll
            for (int j = 0; j < 4; ++j) {
                const float wl = w04[j] + aw[nt][j];
                const float sp = fmaxf(-wl, 0.f) + __logf(1.f + __expf(-fabsf(wl)));
                const float wlog = -sp - 0.5f;
                dec[j] = __expf(-__expf(wlog));
                a[j] = sigm(a04[j] + aa[nt][j]);
                kkraw[nt][j] = kx[j] * kk4[j];
                kp[j] = kx[j] * (1.f + (a[j] - 1.f) * ka4[j]);
                ssq += kkraw[nt][j] * kkraw[nt][j];
                bon += rr[j] * kp[j] * rk4[j];
            }
            av[nt] = a;
            float* ob = OPS + ((size_t)row * 8 + wave) * 384 + nt * 16 + q * 4;
            *(f32x4*)(ob) = rr; *(f32x4*)(ob + 64) = dec; *(f32x4*)(ob + 128) = kp; *(f32x4*)(ob + 192) = vv;
            *(f32x4*)(GATE + (size_t)row * 512 + c) = ag[nt];
        }
        ssq += __shfl_xor(ssq, 16); ssq += __shfl_xor(ssq, 32);
        bon += __shfl_xor(bon, 16); bon += __shfl_xor(bon, 32);
        const float rn = rsqrtf(fmaxf(ssq, 1e-12f));
#pragma unroll
        for (int nt = 0; nt < 4; ++nt) {
            float* ob = OPS + ((size_t)row * 8 + wave) * 384 + nt * 16 + q * 4;
            const f32x4 kk = kkraw[nt] * rn;
            *(f32x4*)(ob + 256) = kk; *(f32x4*)(ob + 320) = kk * av[nt];
        }
        if (q == 0) BONUS[(size_t)row * 8 + wave] = bon;
        }
        if (pfa == 0x7fc17fc1u && pfb == 0x7fc27fc2u) zs[0] = 1.f;
    }
}

__device__ __forceinline__ void rwkv_item(const Params& p, int i, int s, int h, int rg, unsigned char* smem) {
    const int tid = mk_ltid(), lane = tid & 63, wave = __builtin_amdgcn_readfirstlane(tid >> 6);
    int row0, L; seq_info(s, row0, L);
    const float* OPS = (const float*)(p.ws + WS_OPS); float* ORAW = (float*)(p.ws + WS_ORAW);
    float* buf = (float*)smem;
    const int rih = rg * 16 + (wave & 3) * 4 + (lane >> 4);
    const int c4 = (lane & 15) * 4;
    f32x4 S = (f32x4){0.f, 0.f, 0.f, 0.f};
    if (s >= 8 && wave < 4) S = *(const f32x4*)(p.in[3] + ((((size_t)i * 128 + (s - 8)) * 8 + h) * 64 + rih) * 64 + c4);
    f32x4 pre[6];
    const int nch = (L + 31) / 32;
#pragma unroll
    for (int k = 0; k < 6; ++k) { const int idx4 = tid + k * 512; const int tt = idx4 / 96, off = idx4 % 96;
        pre[k] = (tt < L) ? *(const f32x4*)(OPS + ((size_t)(row0 + tt) * 8 + h) * 384 + off * 4) : (f32x4){0.f, 0.f, 0.f, 0.f}; }
    for (int ch = 0; ch < nch; ++ch) {
        const int t0 = ch * 32;
        __syncthreads();
#pragma unroll
        for (int k = 0; k < 6; ++k) { const int idx4 = tid + k * 512; *(f32x4*)(buf + idx4 * 4) = pre[k]; }
        __syncthreads();
        if (ch + 1 < nch) {
#pragma unroll
            for (int k = 0; k < 6; ++k) { const int idx4 = tid + k * 512; const int tt = t0 + 32 + idx4 / 96, off = idx4 % 96;
                pre[k] = (tt < L) ? *(const f32x4*)(OPS + ((size_t)(row0 + tt) * 8 + h) * 384 + off * 4) : (f32x4){0.f, 0.f, 0.f, 0.f}; }
        }
        if (wave < 4) {
            const int ns = (L - t0) < 32 ? (L - t0) : 32;
            f32x4 r4 = *(const f32x4*)(buf + c4), w4 = *(const f32x4*)(buf + 64 + c4), k4 = *(const f32x4*)(buf + 128 + c4);
            f32x4 kk4 = *(const f32x4*)(buf + 256 + c4), ka4 = *(const f32x4*)(buf + 320 + c4);
            float vv = buf[192 + rih];
            float* op = ORAW + (size_t)(row0 + t0) * 512 + h * 64 + rih;
            f32x4 rprev = r4;
#pragma unroll 2
            for (int tt = 0; tt < ns; ++tt) {
                const float* nb = buf + ((tt + 1 < 32) ? (tt + 1) : 31) * 384;
                const f32x4 r4n = *(const f32x4*)(nb + c4), w4n = *(const f32x4*)(nb + 64 + c4), k4n = *(const f32x4*)(nb + 128 + c4);
                const f32x4 kk4n = *(const f32x4*)(nb + 256 + c4), ka4n = *(const f32x4*)(nb + 320 + c4);
                const float vvn = nb[192 + rih];
                float o = (S[0] * rprev[0] + S[1] * rprev[1]) + (S[2] * rprev[2] + S[3] * rprev[3]);
                const f32x4 kv = k4 * vv;
                float sk = (S[0] * kk4[0] + S[1] * kk4[1]) + (S[2] * kk4[2] + S[3] * kk4[3]);
                sk = row16_sum(sk);
                o = row16_sum(o);
                const f32x4 t1 = kv - ka4 * sk;
                S = S * w4 + t1;
                if ((lane & 15) == 0 && tt > 0) op[(size_t)(tt - 1) * 512] = o;
                rprev = r4;
                r4 = r4n; w4 = w4n; k4 = k4n; kk4 = kk4n; ka4 = ka4n; vv = vvn;
            }
            {
                float o = (S[0] * rprev[0] + S[1] * rprev[1]) + (S[2] * rprev[2] + S[3] * rprev[3]);
                o = row16_sum(o);
                if ((lane & 15) == 0) op[(size_t)(ns - 1) * 512] = o;
            }
        }
    }
    if (wave < 4) {
        float* so = (s < 8) ? p.out + O_PRWKV + ((((size_t)i * 8 + s) * 8 + h) * 64 + rih) * 64 + c4
                            : p.out + O_SRWKV + ((((size_t)i * 128 + (s - 8)) * 8 + h) * 64 + rih) * 64 + c4;
        *(f32x4*)so = S;
    }
}

__device__ __forceinline__ void rwkv_item2(const Params& p, int i, int s, int h, int rg, unsigned char* smem) {
    const int tid = mk_ltid(), lane = tid & 63, wave = __builtin_amdgcn_readfirstlane(tid >> 6);
    int row0, L; seq_info(s, row0, L);
    const float* OPS = (const float*)(p.ws + WS_OPS); float* ORAW = (float*)(p.ws + WS_ORAW);
    float* buf = (float*)smem;
    const int ra = rg * 32 + (wave & 3) * 4 + (lane >> 4), rb = ra + 16;
    const int c4 = (lane & 15) * 4;
    f32x4 Sa = (f32x4){0.f, 0.f, 0.f, 0.f}, Sb = Sa;
    if (s >= 8 && wave < 4) { const float* sp = p.in[3] + (((size_t)i * 128 + (s - 8)) * 8 + h) * 4096;
        Sa = *(const f32x4*)(sp + ra * 64 + c4); Sb = *(const f32x4*)(sp + rb * 64 + c4); }
    f32x4 pre[12];
    const int nch = (L + 63) / 64;
#pragma unroll
    for (int k = 0; k < 12; ++k) { const int idx4 = tid + k * 512; const int tt = idx4 / 96, off = idx4 % 96;
        pre[k] = (tt < L) ? *(const f32x4*)(OPS + ((size_t)(row0 + tt) * 8 + h) * 384 + off * 4) : (f32x4){0.f, 0.f, 0.f, 0.f}; }
    for (int ch = 0; ch < nch; ++ch) {
        const int t0 = ch * 64;
        __syncthreads();
#pragma unroll
        for (int k = 0; k < 12; ++k) { const int idx4 = tid + k * 512; *(f32x4*)(buf + idx4 * 4) = pre[k]; }
        __syncthreads();
        if (ch + 1 < nch) {
#pragma unroll
            for (int k = 0; k < 12; ++k) { const int idx4 = tid + k * 512; const int tt = t0 + 64 + idx4 / 96, off = idx4 % 96;
                pre[k] = (tt < L) ? *(const f32x4*)(OPS + ((size_t)(row0 + tt) * 8 + h) * 384 + off * 4) : (f32x4){0.f, 0.f, 0.f, 0.f}; }
        }
        if (wave < 4) {
            const int ns = (L - t0) < 64 ? (L - t0) : 64;
            f32x4 rA = *(const f32x4*)(buf + c4), wA = *(const f32x4*)(buf + 64 + c4), kA = *(const f32x4*)(buf + 128 + c4);
            f32x4 kkA = *(const f32x4*)(buf + 256 + c4), kaA = *(const f32x4*)(buf + 320 + c4);
            float vaA = buf[192 + ra], vbA = buf[192 + rb];
            f32x4 rB, wB, kB, kkB, kaB; float vaB, vbB;
            float* op = ORAW + (size_t)(row0 + t0) * 512 + h * 64 + ra;
            f32x4 rprev = rA;
#define RW_LOAD(R, W, K, KK, KA, VA, VB, nb_) do { const float* nb = (nb_); R = *(const f32x4*)(nb + c4); W = *(const f32x4*)(nb + 64 + c4); K = *(const f32x4*)(nb + 128 + c4); \
                KK = *(const f32x4*)(nb + 256 + c4); KA = *(const f32x4*)(nb + 320 + c4); VA = nb[192 + ra]; VB = nb[192 + rb]; } while (0)
#define RW_STEP(R, W, K, KK, KA, VA, VB, RP, tt_) do { \
                float oa = (Sa[0] * RP[0] + Sa[1] * RP[1]) + (Sa[2] * RP[2] + Sa[3] * RP[3]); \
                float ob = (Sb[0] * RP[0] + Sb[1] * RP[1]) + (Sb[2] * RP[2] + Sb[3] * RP[3]); \
                float ska = (Sa[0] * KK[0] + Sa[1] * KK[1]) + (Sa[2] * KK[2] + Sa[3] * KK[3]); \
                float skb = (Sb[0] * KK[0] + Sb[1] * KK[1]) + (Sb[2] * KK[2] + Sb[3] * KK[3]); \
                ska = row16_sum(ska); skb = row16_sum(skb); oa = row16_sum(oa); ob = row16_sum(ob); \
                Sa = Sa * W + (K * VA - KA * ska); Sb = Sb * W + (K * VB - KA * skb); \
                if ((lane & 15) == 0 && (tt_) > 0) { op[(size_t)((tt_) - 1) * 512] = oa; op[(size_t)((tt_) - 1) * 512 + 16] = ob; } } while (0)
            for (int tt = 0; tt < ns; tt += 2) {
                RW_LOAD(rB, wB, kB, kkB, kaB, vaB, vbB, buf + (tt + 1) * 384);
                RW_STEP(rA, wA, kA, kkA, kaA, vaA, vbA, rprev, tt);
                const f32x4 rEven = rA;
                RW_LOAD(rA, wA, kA, kkA, kaA, vaA, vbA, buf + ((tt + 2 < 64) ? (tt + 2) : 63) * 384);
                RW_STEP(rB, wB, kB, kkB, kaB, vaB, vbB, rEven, tt + 1);
                rprev = rB;
            }
            {
                float oa = (Sa[0] * rprev[0] + Sa[1] * rprev[1]) + (Sa[2] * rprev[2] + Sa[3] * rprev[3]);
                float ob = (Sb[0] * rprev[0] + Sb[1] * rprev[1]) + (Sb[2] * rprev[2] + Sb[3] * rprev[3]);
                oa = row16_sum(oa); ob = row16_sum(ob);
                if ((lane & 15) == 0) { op[(size_t)(ns - 1) * 512] = oa; op[(size_t)(ns - 1) * 512 + 16] = ob; }
            }
#undef RW_LOAD
#undef RW_STEP
        }
    }
    if (wave < 4) {
        float* so = (s < 8) ? p.out + O_PRWKV + (((size_t)i * 8 + s) * 8 + h) * 4096 : p.out + O_SRWKV + (((size_t)i * 128 + (s - 8)) * 8 + h) * 4096;
        *(f32x4*)(so + ra * 64 + c4) = Sa; *(f32x4*)(so + rb * 64 + c4) = Sb;
    }
}

__device__ __forceinline__ void ret_item(const Params& p, int i, int s, int hb, unsigned char* smem) {
    const int tid = mk_ltid(), lane = tid & 63, w = __builtin_amdgcn_readfirstlane(tid >> 6);
    const int r = lane & 15, q = lane >> 4;
    int row0, L; seq_info(s, row0, L);
    const int C = (s < 8) ? 128 : 4; const int nch = L / C;
    const float lg = log2f(1.0f - exp2f(-5.0f - (float)hb));
    const bf16_t* ZB = (const bf16_t*)(p.ws + WS_ZB); const bf16_t* RQ = (const bf16_t*)(p.ws + WS_RQ); const bf16_t* RK = (const bf16_t*)(p.ws + WS_RK);
    bf16_t* OMIX = (bf16_t*)(p.ws + WS_OMIX);
    const float* gn_g = p.in[25] + i * 512 + hb * 128; const float* gn_b = p.in[26] + i * 512 + hb * 128;
    constexpr int LD = 136;
    bf16_t* KC = (bf16_t*)smem; bf16_t* KZT = KC + 128 * LD; bf16_t* VT = KZT + 128 * LD; bf16_t* SB = VT + 128 * LD;
    f32x4 ST[8];
#pragma unroll
    for (int nt = 0; nt < 8; ++nt) ST[nt] = (f32x4){0.f, 0.f, 0.f, 0.f};
    if (s >= 8) {
        const float* S0 = p.in[4] + (((size_t)i * 128 + (s - 8)) * 4 + hb) * 16384;
#pragma unroll
        for (int nt = 0; nt < 8; ++nt) ST[nt] = *(const f32x4*)(S0 + (size_t)(nt * 16 + r) * 128 + 16 * w + q * 4);
    }
    const float gch = exp2f((float)C * lg);
    for (int ch = 0; ch < nch; ++ch) {
        const int rb = row0 + ch * C;
        __syncthreads();
        for (int idx = tid; idx < 128 * 16; idx += 512) {
            const int tok = idx & 127, c8 = (idx >> 7) * 8;
            u32x4 kv = (u32x4){0u, 0u, 0u, 0u}, vv = kv;
            if (tok < C) { kv = *(const u32x4*)(RK + (size_t)(rb + tok) * 512 + hb * 128 + c8);
                           vv = *(const u32x4*)(ZB + (size_t)(rb + tok) * AB_N + 1792 + 1024 + hb * 128 + c8); }
            *(u32x4*)(KC + tok * LD + c8) = kv;
            const float zeta = __builtin_amdgcn_exp2f((float)(C - 1 - tok) * lg);
            const unsigned kw[4] = {kv.x, kv.y, kv.z, kv.w}; const unsigned vw[4] = {vv.x, vv.y, vv.z, vv.w};
#pragma unroll
            for (int e = 0; e < 4; ++e) {
                const float k0 = __uint_as_float(kw[e] << 16) * zeta, k1 = __uint_as_float(kw[e] & 0xffff0000u) * zeta;
                KZT[(c8 + 2 * e) * LD + tok] = f2bf(k0); KZT[(c8 + 2 * e + 1) * LD + tok] = f2bf(k1);
                VT[(c8 + 2 * e) * LD + tok] = (bf16_t)(vw[e] & 0xffffu); VT[(c8 + 2 * e + 1) * LD + tok] = (bf16_t)(vw[e] >> 16);
            }
        }
#pragma unroll
        for (int nt = 0; nt < 8; ++nt)
#pragma unroll
            for (int j = 0; j < 4; ++j) SB[(16 * w + q * 4 + j) * LD + nt * 16 + r] = f2bf(ST[nt][j]);
        __syncthreads();
        bf16x8 aq[4];
#pragma unroll
        for (int ks = 0; ks < 4; ++ks) {
            if (16 * w + r < C) aq[ks] = *(const bf16x8*)(RQ + (size_t)(rb + 16 * w + r) * 512 + hb * 128 + ks * 32 + q * 8);
            else aq[ks] = (bf16x8){0, 0, 0, 0, 0, 0, 0, 0};
        }
        u32x2 P[8]; f32x4 O[8];
#pragma unroll
        for (int nt = 0; nt < 8; ++nt) {
            f32x4 acc = (f32x4){0.f, 0.f, 0.f, 0.f}, oc = acc;
#pragma unroll
            for (int ks = 0; ks < 4; ++ks) {
                const bf16x8 bk = *(const bf16x8*)(KC + (nt * 16 + r) * LD + ks * 32 + q * 8);
                const bf16x8 bs = *(const bf16x8*)(SB + (nt * 16 + r) * LD + ks * 32 + q * 8);
                acc = __builtin_amdgcn_mfma_f32_16x16x32_bf16(aq[ks], bk, acc, 0, 0, 0);
                oc = __builtin_amdgcn_mfma_f32_16x16x32_bf16(aq[ks], bs, oc, 0, 0, 0);
            }
#pragma unroll
            for (int j = 0; j < 4; ++j) {
                const int ii = 16 * w + q * 4 + j, jt = nt * 16 + r;
                acc[j] = (ii >= jt) ? acc[j] * __builtin_amdgcn_exp2f((float)(ii - jt) * lg) : 0.f;
                oc[j] *= __builtin_amdgcn_exp2f((float)(ii + 1) * lg);
            }
            P[nt].x = pk2(acc[0], acc[1]); P[nt].y = pk2(acc[2], acc[3]); O[nt] = oc;
        }
        __syncthreads();
#pragma unroll
        for (int nt = 0; nt < 8; ++nt)
#pragma unroll
            for (int j = 0; j < 4; ++j) KC[(16 * w + q * 4 + j) * LD + nt * 16 + r] = (bf16_t)(((j & 2) ? P[nt].y : P[nt].x) >> ((j & 1) * 16));
        __syncthreads();
#pragma unroll
        for (int nt = 0; nt < 8; ++nt) ST[nt] = ST[nt] * gch;
#pragma unroll
        for (int ks = 0; ks < 4; ++ks) {
            const bf16x8 ap = *(const bf16x8*)(KC + (16 * w + r) * LD + ks * 32 + q * 8);
            const bf16x8 av = *(const bf16x8*)(VT + (16 * w + r) * LD + ks * 32 + q * 8);
#pragma unroll
            for (int nt = 0; nt < 8; ++nt) {
                const bf16x8 bv = *(const bf16x8*)(VT + (nt * 16 + r) * LD + ks * 32 + q * 8);
                const bf16x8 bz = *(const bf16x8*)(KZT + (nt * 16 + r) * LD + ks * 32 + q * 8);
                O[nt] = __builtin_amdgcn_mfma_f32_16x16x32_bf16(ap, bv, O[nt], 0, 0, 0);
                ST[nt] = __builtin_amdgcn_mfma_f32_16x16x32_bf16(av, bz, ST[nt], 0, 0, 0);
            }
        }
#pragma unroll
        for (int j = 0; j < 4; ++j) {
            float s1 = 0.f;
#pragma unroll
            for (int nt = 0; nt < 8; ++nt) s1 += O[nt][j];
            s1 = row16_sum(s1); const float mean = s1 * (1.f / 128.f);
            float s2 = 0.f;
#pragma unroll
            for (int nt = 0; nt < 8; ++nt) { const float d = O[nt][j] - mean; s2 += d * d; }
            s2 = row16_sum(s2); const float rstd = rsqrtf(s2 * (1.f / 128.f) + 1e-5f);
            const int ii = 16 * w + q * 4 + j;
            if (ii < C) {
                const size_t row = (size_t)(rb + ii);
#pragma unroll
                for (int nt = 0; nt < 8; ++nt) { const int dv = nt * 16 + r;
                    const float val = (O[nt][j] - mean) * rstd * gn_g[dv] + gn_b[dv];
                    const float gr = bf2f(ZB[row * AB_N + 1792 + 1536 + hb * 128 + dv]);
                    OMIX[row * 1024 + 512 + hb * 128 + dv] = f2bf(val * silu(gr)); }
            }
        }
    }
    float* so = (s < 8) ? p.out + O_PRET + (((size_t)i * 8 + s) * 4 + hb) * 16384 : p.out + O_SRET + (((size_t)i * 128 + (s - 8)) * 4 + hb) * 16384;
#pragma unroll
    for (int nt = 0; nt < 8; ++nt) *(f32x4*)(so + (size_t)(nt * 16 + r) * 128 + 16 * w + q * 4) = ST[nt];
}

__device__ __forceinline__ void phase_ab_core(const Params& p, int i, int l, unsigned char* smem) {
    const int bid = mk_lbid(), G = gridDim.x; const int wv = mk_ltid() >> 6;
    if (G == 256) {
        if (bid < 128) rwkv_item2(p, i, bid >> 4, (bid >> 1) & 7, bid & 1, smem);
        else if (bid < 160) ret_item(p, i, (bid - 128) >> 2, (bid - 128) & 3, smem);
        else {
            for (int it = bid - 160; it < 128 * 16; it += 96) rwkv_item2(p, i, 8 + (it >> 4), (it >> 1) & 7, it & 1, smem);
            __syncthreads();
            for (int it = bid - 160; it < 128 * 4; it += 96) ret_item(p, i, 8 + (it >> 2), it & 3, smem);
        }
        if (bid >= 160) convert_ffn_ahead(p, l, (bid - 160) * 8 + wv, 96 * 8, smem);
    } else {
        for (int it = bid; it < 136 * 16; it += G) rwkv_item2(p, i, it >> 4, (it >> 1) & 7, it & 1, smem);
        __syncthreads();
        for (int it = bid; it < 136 * 4; it += G) ret_item(p, i, it >> 2, it & 3, smem);
        convert_ffn_ahead(p, l, bid * 8 + wv, G * 8, smem);
    }
}

__device__ __forceinline__ void phase_ab_post(const Params& p, int i) {
    const int tid = mk_ltid(), lane = tid & 63, wave = tid >> 6;
    const int gw = mk_lbid() * 8 + wave, NGW = gridDim.x * 8;
    const float* OPS = (const float*)(p.ws + WS_OPS); const float* ORAW = (const float*)(p.ws + WS_ORAW);
    const float* GATE = (const float*)(p.ws + WS_GATE); const float* BONUS = (const float*)(p.ws + WS_BONUS);
    bf16_t* OMIX = (bf16_t*)(p.ws + WS_OMIX);
    const float* gg = p.in[23] + i * 512; const float* gb = p.in[24] + i * 512;
    for (int m = gw; m < M; m += NGW) {
        const int c = lane * 8, h = lane >> 3, hc = c & 63;
        const f32x4 o0 = *(const f32x4*)(ORAW + (size_t)m * 512 + c), o1 = *(const f32x4*)(ORAW + (size_t)m * 512 + c + 4);
        float s1 = (o0[0] + o0[1]) + (o0[2] + o0[3]) + (o1[0] + o1[1]) + (o1[2] + o1[3]);
        s1 += __shfl_xor(s1, 1); s1 += __shfl_xor(s1, 2); s1 += __shfl_xor(s1, 4);
        const float mean = s1 * (1.f / 64.f);
        const f32x4 d0 = o0 - mean, d1 = o1 - mean;
        float s2 = (d0[0] * d0[0] + d0[1] * d0[1]) + (d0[2] * d0[2] + d0[3] * d0[3]) + (d1[0] * d1[0] + d1[1] * d1[1]) + (d1[2] * d1[2] + d1[3] * d1[3]);
        s2 += __shfl_xor(s2, 1); s2 += __shfl_xor(s2, 2); s2 += __shfl_xor(s2, 4);
        const float rstd = rsqrtf(s2 * (1.f / 64.f) + 64e-5f);
        const float bon = BONUS[(size_t)m * 8 + h];
        const float* vb = OPS + ((size_t)m * 8 + h) * 384 + 192 + hc;
        const f32x4 v0 = *(const f32x4*)vb, v1 = *(const f32x4*)(vb + 4);
        const f32x4 g0 = *(const f32x4*)(gg + c), g1 = *(const f32x4*)(gg + c + 4), b0 = *(const f32x4*)(gb + c), b1 = *(const f32x4*)(gb + c + 4);
        const f32x4 t0 = *(const f32x4*)(GATE + (size_t)m * 512 + c), t1 = *(const f32x4*)(GATE + (size_t)m * 512 + c + 4);
        const f32x4 y0 = (d0 * rstd * g0 + b0 + v0 * bon) * t0, y1 = (d1 * rstd * g1 + b1 + v1 * bon) * t1;
        u32x4 o; o.x = pk2(y0[0], y0[1]); o.y = pk2(y0[2], y0[3]); o.z = pk2(y1[0], y1[1]); o.w = pk2(y1[2], y1[3]);
        *(u32x4*)(OMIX + (size_t)m * 1024 + c) = o;
    }
}

__device__ __forceinline__ int gdn_item_index(int s, int h, int c) { return (s < 8) ? ((s * 8 + h) * 32 + c) : (2048 + (s - 8) * 8 + h); }

__device__ __forceinline__ void gdn_chunk_item(const Params& p, int i, int s, int h, int c, int pf_row, int pf_h, unsigned char* smem) {
    const int tid = mk_ltid(), lane = tid & 63, w = __builtin_amdgcn_readfirstlane(tid >> 6);
    const int r = lane & 15, q = lane >> 4;
    int row0, L; seq_info(s, row0, L);
    const int t0 = c * 64; const int nvalid = (L - t0) < 64 ? (L - t0) : 64;
    const bf16_t* ZB = (const bf16_t*)(p.ws + WS_ZB);
    unsigned char* rec = p.ws + WS_CH + (size_t)gdn_item_index(s, h, c) * CH_BYTES;
    float* U = (float*)(rec + CH_U); bf16_t* Wd = (bf16_t*)(rec + CH_W); bf16_t* QG = (bf16_t*)(rec + CH_QG); bf16_t* QK = (bf16_t*)(rec + CH_QK); bf16_t* KDT = (bf16_t*)(rec + CH_KDT);
    constexpr int LD = 132, ALD = 68;
    float* qs = (float*)smem; float* ks = qs + 64 * LD; float* vs = ks + 64 * LD; float* As = vs + 64 * LD;
    float* AT = As + 64 * ALD; float* gcs = AT + 64 * ALD; float* bes = gcs + 64;
    unsigned short pfv = 0;
    if (pf_row >= 0 && tid < 384) { const int rr_ = tid / 6, pp_ = (tid % 6) >> 1, hh_ = tid & 1;
        pfv = ((const bf16_t*)(p.ws + WS_ZB))[(size_t)(pf_row + rr_) * GD_N + pp_ * 1024 + pf_h * 128 + hh_ * 64]; }
#ifndef REP_G_CONV
#define REP_G_CONV 1
#endif
#ifndef REP_G_MFMA
#define REP_G_MFMA 1
#endif
#ifndef REP_G_QG
#define REP_G_QG 1
#endif
#ifndef REP_G_SUB
#define REP_G_SUB 1
#endif
#pragma unroll 1
    for (int rp_ = 0; rp_ < REP_G_CONV; ++rp_) {
    __syncthreads();
    if (tid < 384) {
        if (nvalid == 64) {
            const int cg = tid % 48, tr = tid / 48;
            const int part = cg >> 4, ch0 = (cg & 15) * 8; const int zc0 = part * 1024 + h * 128 + ch0;
            const float* cw = p.in[28] + (size_t)i * 4 * 3072 + zc0;
            f32x4 wv[4][2];
#pragma unroll
            for (int j = 0; j < 4; ++j) { wv[j][0] = *(const f32x4*)(cw + j * 3072); wv[j][1] = *(const f32x4*)(cw + j * 3072 + 4); }
            u32x4 xr[11];
#pragma unroll
            for (int jr = 0; jr < 11; ++jr) { const int tt = t0 + tr * 8 - 3 + jr;
                xr[jr] = (tt >= 0) ? *(const u32x4*)(ZB + (size_t)(row0 + (tt >= 0 ? tt : 0)) * GD_N + zc0) : (u32x4){0u, 0u, 0u, 0u}; }
            float* dstb = (part == 0 ? qs : part == 1 ? ks : vs) + ch0;
#pragma unroll
            for (int e = 0; e < 8; ++e) {
                f32x4 o0, o1;
#pragma unroll
                for (int cc = 0; cc < 8; ++cc) {
                    float y = 0.f;
#pragma unroll
                    for (int j = 0; j < 4; ++j) { const unsigned wd = (cc >> 1) == 0 ? xr[e + j].x : (cc >> 1) == 1 ? xr[e + j].y : (cc >> 1) == 2 ? xr[e + j].z : xr[e + j].w;
                        const float xv = (cc & 1) ? __uint_as_float(wd & 0xffff0000u) : __uint_as_float(wd << 16);
                        y += wv[j][cc >> 2][cc & 3] * xv; }
                    const float sv = silu(y);
                    if (cc < 4) o0[cc] = sv; else o1[cc - 4] = sv;
                }
                *(f32x4*)(dstb + (tr * 8 + e) * LD) = o0; *(f32x4*)(dstb + (tr * 8 + e) * LD + 4) = o1;
            }
        } else {
            const int part = tid >> 7, ch = tid & 127; const int zc = part * 1024 + h * 128 + ch;
            const float* cw = p.in[28] + (size_t)i * 4 * 3072 + zc;
            const float cw0 = cw[0], cw1 = cw[3072], cw2 = cw[2 * 3072], cw3 = cw[3 * 3072];
            float* dst = (part == 0 ? qs : part == 1 ? ks : vs) + ch;
            float x3, x2, x1;
            { const float* cs = p.in[5] + (((size_t)i * 128 + (s - 8)) * 3) * 3072 + zc; x3 = cs[0]; x2 = cs[3072]; x1 = cs[2 * 3072]; }
#pragma unroll
            for (int e = 0; e < 64; ++e) {
                float v = 0.f;
                if (e < 4) { const float xe = (e < nvalid) ? bf2f(ZB[(size_t)(row0 + e) * GD_N + zc]) : 0.f;
                    const float y = cw0 * x3 + cw1 * x2 + cw2 * x1 + cw3 * xe; v = (e < nvalid) ? silu(y) : 0.f; x3 = x2; x2 = x1; x1 = xe; }
                dst[e * LD] = v;
            }
        }
    } else if (tid < 448) {
        const int t = tid - 384;
        float be = 0.f, g = 0.f;
        if (t < nvalid) { const size_t zr = (size_t)(row0 + t0 + t) * GD_N;
            be = sigm(bf2f(ZB[zr + 3072 + h]));
            const float a = bf2f(ZB[zr + 3080 + h]) + p.in[30][i * 8 + h];
            const float sp = fmaxf(a, 0.f) + __logf(1.f + __expf(-fabsf(a)));
            g = -__expf(p.in[29][i * 8 + h]) * sp; }
#pragma unroll
        for (int o = 1; o < 64; o <<= 1) { const float y = __shfl_up(g, o); if (t >= o) g += y; }
        gcs[t] = g; bes[t] = be;
    }
    }
    __syncthreads();
    for (int pass = 0; pass < 4; ++pass) {
        const int rowi = w * 16 + pass * 4 + q;
        const int t = rowi & 63;
        if ((w * 16 + pass * 4) % 64 < nvalid) {
            float* base = ((rowi < 64) ? qs : ks) + t * LD + r * 8;
            f32x4 a = *(f32x4*)base, b = *(f32x4*)(base + 4);
            float ss = (a[0] * a[0] + a[1] * a[1]) + (a[2] * a[2] + a[3] * a[3]) + (b[0] * b[0] + b[1] * b[1]) + (b[2] * b[2] + b[3] * b[3]);
            ss = row16_sum(ss);
            const float rn = rsqrtf(fmaxf(ss, 1e-12f));
            *(f32x4*)base = a * rn; *(f32x4*)(base + 4) = b * rn;
        }
    }
    __syncthreads();
#pragma unroll 1
    for (int rp_ = 0; rp_ < REP_G_MFMA; ++rp_)
#pragma unroll
    for (int tl = 0; tl < 2; ++tl) {
        const int tile = 2 * w + tl, mi = tile >> 2, ni = tile & 3;
        f32x4 akk = (f32x4){0.f, 0.f, 0.f, 0.f}, aqk = akk;
        if (mi * 16 < nvalid) {
#pragma unroll 8
            for (int k0 = 0; k0 < 128; k0 += 4) {
                const float ka = ks[(mi * 16 + r) * LD + k0 + q], kb = ks[(ni * 16 + r) * LD + k0 + q], qa = qs[(mi * 16 + r) * LD + k0 + q];
                akk = __builtin_amdgcn_mfma_f32_16x16x4f32(ka, kb, akk, 0, 0, 0);
                aqk = __builtin_amdgcn_mfma_f32_16x16x4f32(qa, kb, aqk, 0, 0, 0);
            }
        }
#pragma unroll
        for (int j = 0; j < 4; ++j) { const int ii = mi * 16 + q * 4 + j, jj = ni * 16 + r;
            const float dm = (ii >= jj) ? __expf(gcs[ii] - gcs[jj]) : 0.f;
            const float aij = (ii > jj) ? bes[ii] * akk[j] * dm : 0.f;
            As[ii * ALD + jj] = aij; AT[jj * ALD + ii] = aij;
            if (mi * 16 < nvalid) QK[ii * 64 + jj] = f2bf(aqk[j] * 0.08838834764831845f * dm); }
    }
    __syncthreads();
#pragma unroll 1
    for (int rp_ = 0; rp_ < REP_G_QG; ++rp_)
    {
        const float gl = gcs[63];
        const int nrow = (nvalid == 64) ? 64 : 16;
        for (int idx = tid; idx < nrow * 16; idx += 512) { const int t = idx >> 4, d0 = (idx & 15) * 8; const float sc = 0.08838834764831845f * __expf(gcs[t]);
            const f32x4 a = *(const f32x4*)(qs + t * LD + d0) * sc, b = *(const f32x4*)(qs + t * LD + d0 + 4) * sc;
            u32x4 o; o.x = pk2(a[0], a[1]); o.y = pk2(a[2], a[3]); o.z = pk2(b[0], b[1]); o.w = pk2(b[2], b[3]);
            *(u32x4*)(QG + t * 128 + d0) = o; }
        for (int idx = tid; idx < 128 * (nrow >> 3); idx += 512) { const int d = idx & 127, tc = (idx >> 7) * 8;
            float v[8];
#pragma unroll
            for (int e = 0; e < 8; ++e) v[e] = ks[(tc + e) * LD + d] * __expf(gl - gcs[tc + e]);
            u32x4 o; o.x = pk2(v[0], v[1]); o.y = pk2(v[2], v[3]); o.z = pk2(v[4], v[5]); o.w = pk2(v[6], v[7]);
            *(u32x4*)(KDT + d * 64 + tc) = o; }
        if (tid == 0) ((float*)(p.ws + WS_GL))[gdn_item_index(s, h, c)] = __expf(gl);
    }
    __syncthreads();
    for (int idx = tid; idx < 64 * 128; idx += 512) { const int t = idx >> 7, d = idx & 127; const float be = bes[t];
        vs[t * LD + d] *= be; ks[t * LD + d] *= be * __expf(gcs[t]); }
    __syncthreads();
    const int nblk = (nvalid + 15) >> 4;
#pragma unroll 1
    for (int blk = 0; blk < 4; ++blk) {
        if (blk >= nblk) continue;
        if (blk > 0) {
#pragma unroll
            for (int tl = 0; tl < 2; ++tl) {
                const int nt = 2 * w + tl; float* bb = (nt < 8 ? vs : ks) + (nt & 7) * 16 + r;
                f32x4 acc = (f32x4){0.f, 0.f, 0.f, 0.f};
                const float* ap = As + (blk * 16 + r) * ALD + q;
                for (int k0 = 0; k0 < blk * 16; k0 += 4)
                    acc = __builtin_amdgcn_mfma_f32_16x16x4f32(ap[k0], bb[(k0 + q) * LD], acc, 0, 0, 0);
#pragma unroll
                for (int j = 0; j < 4; ++j) bb[(blk * 16 + q * 4 + j) * LD] -= acc[j];
            }
            __syncthreads();
        }
        if (tid < 256) {
            const int col = tid & 127; const bool isu = tid < 128;
            float* buf = (isu ? vs : ks) + col;
            float acc[16];
#pragma unroll
            for (int e = 0; e < 16; ++e) acc[e] = buf[(blk * 16 + e) * LD];
#pragma unroll
            for (int e = 1; e < 16; ++e) {
#pragma unroll
                for (int f = 0; f < e; ++f) acc[e] -= As[(blk * 16 + e) * ALD + blk * 16 + f] * acc[f];
            }
#pragma unroll
            for (int e = 0; e < 16; ++e) { const int ii = blk * 16 + e; buf[ii * LD] = acc[e];
                if (isu) U[ii * 128 + col] = acc[e]; else Wd[ii * 128 + col] = f2bf(acc[e]); }
        }
        __syncthreads();
    }
    if (pfv == 0x7fc3u) gcs[0] = 1.f;
    asm volatile("s_waitcnt vmcnt(0)" ::: "memory");
    __syncthreads();
}

__device__ __forceinline__ void phase_gdn_chunk(const Params& p, int i, unsigned char* smem) {
    if (gridDim.x == 256) {
        for (int it = mk_lbid(); it < 64 * GDN_LATE; it += 256) {
            const int s = it / (8 * GDN_LATE), rem = it % (8 * GDN_LATE), h = rem / GDN_LATE, c = rem % GDN_LATE;
            const int nit = it + 256; int pf_row = -1, pf_h = 0;
            if (nit < 64 * GDN_LATE) { const int rem2 = nit % (8 * GDN_LATE); pf_row = (nit / (8 * GDN_LATE)) * 2048 + (rem2 % GDN_LATE) * 64; pf_h = rem2 / GDN_LATE; }
            gdn_chunk_item(p, i, s, h, c, pf_row, pf_h, smem);
        }
    } else
    for (int it = mk_lbid(); it < N_CH; it += gridDim.x) {
        int s, h, c;
        if (it < 2048) { s = it >> 8; h = (it >> 5) & 7; c = it & 31; } else { const int k = it - 2048; s = 8 + (k >> 3); h = k & 7; c = 0; }
        const int nit = it + gridDim.x; int pf_row = -1, pf_h = 0;
        if (nit < 2048) { pf_row = (nit >> 8) * 2048 + (nit & 31) * 64; pf_h = (nit >> 5) & 7; }
        gdn_chunk_item(p, i, s, h, c, pf_row, pf_h, smem);
    }
    const bf16_t* ZB = (const bf16_t*)(p.ws + WS_ZB);
    const int gt = mk_lbid() * 512 + mk_ltid(), GT = gridDim.x * 512;
    for (int idx = gt; idx < 136 * 3 * 3072; idx += GT) {
        const int s = idx / (3 * 3072), rem = idx % (3 * 3072), j = rem / 3072, zc = rem % 3072;
        int row0, L; seq_info(s, row0, L);
        const float v = bf2f(ZB[(size_t)(row0 + L - 3 + j) * GD_N + zc]);
        if (s < 8) p.out[O_PCONV + (((size_t)i * 8 + s) * 3 + j) * 3072 + zc] = v;
        else p.out[O_SCONV + (((size_t)i * 128 + (s - 8)) * 3 + j) * 3072 + zc] = v;
    }
}

__device__ __forceinline__ void gdn_scan_item(const Params& p, int i, int s, int h, unsigned* flags, unsigned tag, unsigned char* smem) {
    const int tid = mk_ltid(), lane = tid & 63, w = __builtin_amdgcn_readfirstlane(tid >> 6);
    const int r = lane & 15, q = lane >> 4;
    int row0, L; seq_info(s, row0, L);
    const int nch = (s < 8) ? 32 : 1;
    const bf16_t* ZB = (const bf16_t*)(p.ws + WS_ZB); bf16_t* OMIX = (bf16_t*)(p.ws + WS_OMIX);
    const float* GL = (const float*)(p.ws + WS_GL);
    const float* ng = p.in[31] + i * 128;
    constexpr int LD = 136, VLD = 72, ULD = 132;
    bf16_t* SB = (bf16_t*)smem;
    bf16_t* VN = (bf16_t*)(smem + 34816);
    float* red = (float*)(smem + 53248);
    bf16_t* WL = (bf16_t*)(smem + 53760);
    bf16_t* QGL = (bf16_t*)(smem + 71168);
    bf16_t* QKL = (bf16_t*)(smem + 88576);
    bf16_t* KDL = (bf16_t*)(smem + 97792);
    float* UL = (float*)(smem + 116224);
    f32x4 ST[8];
#pragma unroll
    for (int nt = 0; nt < 8; ++nt) ST[nt] = (f32x4){0.f, 0.f, 0.f, 0.f};
    if (s >= 8) {
        const float* S0 = p.in[6] + (((size_t)i * 128 + (s - 8)) * 8 + h) * 16384;
#pragma unroll
        for (int nt = 0; nt < 8; ++nt)
#pragma unroll
            for (int j = 0; j < 4; ++j) ST[nt][j] = S0[(size_t)(nt * 16 + q * 4 + j) * 128 + 16 * w + r];
    }
    const int mt = w & 3, nh = w >> 2;
    u32x4 pw[2], pq[2], pk, pd[2]; f32x4 pu[4]; float pgl;
    const bool smp = (s >= 8);
#define GDN_PREFETCH(cc) do { const int item_ = gdn_item_index(s, h, (cc)); const unsigned char* rec_ = p.ws + WS_CH + (size_t)item_ * CH_BYTES; \
        const u32x4 z4_ = (u32x4){0u, 0u, 0u, 0u}; \
        _Pragma("unroll") for (int k_ = 0; k_ < 2; ++k_) { const int idx_ = tid + k_ * 512; \
            pw[k_] = (smp && (idx_ >> 4) >= 16) ? z4_ : *(const u32x4*)((const bf16_t*)(rec_ + CH_W) + (idx_ >> 4) * 128 + (idx_ & 15) * 8); \
            pq[k_] = (smp && (idx_ >> 4) >= 16) ? z4_ : *(const u32x4*)((const bf16_t*)(rec_ + CH_QG) + (idx_ >> 4) * 128 + (idx_ & 15) * 8); \
            pd[k_] = (smp && (idx_ & 7) >= 2) ? z4_ : *(const u32x4*)((const bf16_t*)(rec_ + CH_KDT) + (idx_ >> 3) * 64 + (idx_ & 7) * 8); } \
        pk = (smp && (tid >> 3) >= 16) ? z4_ : *(const u32x4*)((const bf16_t*)(rec_ + CH_QK) + (tid >> 3) * 64 + (tid & 7) * 8); \
        _Pragma("unroll") for (int k_ = 0; k_ < 4; ++k_) { const int idx_ = tid + k_ * 512; \
            pu[k_] = (smp && (idx_ >> 5) >= 16) ? (f32x4){0.f, 0.f, 0.f, 0.f} : *(const f32x4*)((const float*)(rec_ + CH_U) + (idx_ >> 5) * 128 + (idx_ & 31) * 4); } \
        pgl = GL[item_]; } while (0)
#define GDN_WAIT(cc) do { if (flags && (cc) >= GDN_LATE) { if (tid == 0) { unsigned* f_ = flags + (s * 8 + h) * 32 + (cc); \
        while (__hip_atomic_load(f_, __ATOMIC_RELAXED, __HIP_MEMORY_SCOPE_AGENT) != tag) __builtin_amdgcn_s_sleep(2); \
        __builtin_amdgcn_fence(__ATOMIC_ACQUIRE, "agent"); asm volatile("s_waitcnt vmcnt(0)" ::: "memory"); } \
        __syncthreads(); } } while (0)
    GDN_PREFETCH(0);
    for (int c = 0; c < nch; ++c) {
        const float glast = pgl;
        const int rb = row0 + c * 64; const int nvalid = (L - c * 64) < 64 ? (L - c * 64) : 64;
#pragma unroll
        for (int k = 0; k < 2; ++k) { const int idx = tid + k * 512;
            *(u32x4*)(WL + (idx >> 4) * LD + (idx & 15) * 8) = pw[k]; *(u32x4*)(QGL + (idx >> 4) * LD + (idx & 15) * 8) = pq[k];
            *(u32x4*)(KDL + (idx >> 3) * VLD + (idx & 7) * 8) = pd[k]; }
        *(u32x4*)(QKL + (tid >> 3) * VLD + (tid & 7) * 8) = pk;
#pragma unroll
        for (int k = 0; k < 4; ++k) { const int idx = tid + k * 512; *(f32x4*)(UL + (idx >> 5) * ULD + (idx & 31) * 4) = pu[k]; }
#pragma unroll
        for (int nt = 0; nt < 8; ++nt) { u32x2 sv; sv.x = pk2(ST[nt][0], ST[nt][1]); sv.y = pk2(ST[nt][2], ST[nt][3]);
            *(u32x2*)(SB + (16 * w + r) * LD + nt * 16 + q * 4) = sv; }
        __syncthreads();
        if (c + 1 < nch) { GDN_WAIT(c + 1); GDN_PREFETCH(c + 1); }
        u32x2 zgv[4];
        { const int tk_ = mt * 16 + r; const size_t row_ = (size_t)(rb + (tk_ < nvalid ? tk_ : 0));
#pragma unroll
          for (int n4 = 0; n4 < 4; ++n4) zgv[n4] = *(const u32x2*)(ZB + row_ * GD_N + 3088 + h * 128 + (nh * 4 + n4) * 16 + q * 4); }
        f32x4 aws[4], aqg[4];
#pragma unroll
        for (int n4 = 0; n4 < 4; ++n4) { aws[n4] = (f32x4){0.f, 0.f, 0.f, 0.f}; aqg[n4] = aws[n4]; }
#pragma unroll
        for (int ks = 0; ks < 4; ++ks) {
            const bf16x8 fw = *(const bf16x8*)(WL + (mt * 16 + r) * LD + ks * 32 + q * 8);
            const bf16x8 fq = *(const bf16x8*)(QGL + (mt * 16 + r) * LD + ks * 32 + q * 8);
#pragma unroll
            for (int n4 = 0; n4 < 4; ++n4) {
                const bf16x8 bs = *(const bf16x8*)(SB + ((nh * 4 + n4) * 16 + r) * LD + ks * 32 + q * 8);
                aws[n4] = __builtin_amdgcn_mfma_f32_16x16x32_bf16(fw, bs, aws[n4], 0, 0, 0);
                aqg[n4] = __builtin_amdgcn_mfma_f32_16x16x32_bf16(bs, fq, aqg[n4], 0, 0, 0);
            }
        }
#pragma unroll
        for (int n4 = 0; n4 < 4; ++n4) {
            const int dv = (nh * 4 + n4) * 16 + r;
            float vn[4];
#pragma unroll
            for (int j = 0; j < 4; ++j) vn[j] = UL[(mt * 16 + q * 4 + j) * ULD + dv] - aws[n4][j];
            u32x2 o; o.x = pk2(vn[0], vn[1]); o.y = pk2(vn[2], vn[3]);
            *(u32x2*)(VN + dv * VLD + mt * 16 + q * 4) = o;
        }
        __syncthreads();
#pragma unroll
        for (int ks = 0; ks < 2; ++ks) {
            const bf16x8 fk = *(const bf16x8*)(QKL + (mt * 16 + r) * VLD + ks * 32 + q * 8);
#pragma unroll
            for (int n4 = 0; n4 < 4; ++n4) {
                const bf16x8 bv = *(const bf16x8*)(VN + ((nh * 4 + n4) * 16 + r) * VLD + ks * 32 + q * 8);
                aqg[n4] = __builtin_amdgcn_mfma_f32_16x16x32_bf16(bv, fk, aqg[n4], 0, 0, 0);
            }
        }
        {
            float a = 0.f;
#pragma unroll
            for (int n4 = 0; n4 < 4; ++n4)
#pragma unroll
                for (int j = 0; j < 4; ++j) a += aqg[n4][j] * aqg[n4][j];
            a += __shfl_xor(a, 16); a += __shfl_xor(a, 32);
            if (q == 0) red[(mt * 16 + r) * 2 + nh] = a;
        }
#pragma unroll
        for (int nt = 0; nt < 8; ++nt) ST[nt] = ST[nt] * glast;
#pragma unroll
        for (int ks = 0; ks < 2; ++ks) {
            const bf16x8 av = *(const bf16x8*)(VN + (16 * w + r) * VLD + ks * 32 + q * 8);
#pragma unroll
            for (int nt = 0; nt < 8; ++nt) {
                const bf16x8 bk = *(const bf16x8*)(KDL + (nt * 16 + r) * VLD + ks * 32 + q * 8);
                ST[nt] = __builtin_amdgcn_mfma_f32_16x16x32_bf16(bk, av, ST[nt], 0, 0, 0);
            }
        }
        __syncthreads();
        {
            const int tk = mt * 16 + r;
            if (tk < nvalid) {
                const float rs = rsqrtf((red[tk * 2] + red[tk * 2 + 1]) * (1.f / 128.f) + 1e-6f);
                const size_t row = (size_t)(rb + tk);
#pragma unroll
                for (int n4 = 0; n4 < 4; ++n4) { const int dvb = (nh * 4 + n4) * 16 + q * 4;
                    const f32x4 g4 = *(const f32x4*)(ng + dvb);
                    const float z0 = __uint_as_float(zgv[n4].x << 16), z1 = __uint_as_float(zgv[n4].x & 0xffff0000u), z2 = __uint_as_float(zgv[n4].y << 16), z3 = __uint_as_float(zgv[n4].y & 0xffff0000u);
                    u32x2 o; o.x = pk2(aqg[n4][0] * rs * g4[0] * silu(z0), aqg[n4][1] * rs * g4[1] * silu(z1));
                    o.y = pk2(aqg[n4][2] * rs * g4[2] * silu(z2), aqg[n4][3] * rs * g4[3] * silu(z3));
                    *(u32x2*)(OMIX + row * 1024 + h * 128 + dvb) = o; }
            }
        }
    }
#undef GDN_PREFETCH
#undef GDN_WAIT
    float* so = (s < 8) ? p.out + O_PGDN + (((size_t)i * 8 + s) * 8 + h) * 16384 : p.out + O_SGDN + (((size_t)i * 128 + (s - 8)) * 8 + h) * 16384;
#pragma unroll
    for (int nt = 0; nt < 8; ++nt)
#pragma unroll
        for (int j = 0; j < 4; ++j) so[(size_t)(nt * 16 + q * 4 + j) * 128 + 16 * w + r] = ST[nt][j];
    __syncthreads();
}

__device__ __forceinline__ void phase_gdn_scan(const Params& p, int i, int l, unsigned char* smem) {
    const int bid = mk_lbid(), G = gridDim.x; const int wv = mk_ltid() >> 6;
    if (G == 256) {
        unsigned* flags = (unsigned*)(p.ws + WS_FLAGS); const unsigned tag = (unsigned)(i + 1);
        if (bid < 64) gdn_scan_item(p, i, bid >> 3, bid & 7, flags, tag, smem);
        else {
            for (int j = bid - 64; j < 64 * (32 - GDN_LATE); j += 192) {
                const int c = GDN_LATE + (j >> 6), sh = j & 63;
                gdn_chunk_item(p, i, sh >> 3, sh & 7, c, -1, 0, smem);
                if (mk_ltid() == 0) { __builtin_amdgcn_fence(__ATOMIC_RELEASE, "agent"); asm volatile("s_waitcnt vmcnt(0)" ::: "memory");
                    __hip_atomic_store(&flags[sh * 32 + c], tag, __ATOMIC_RELAXED, __HIP_MEMORY_SCOPE_AGENT); }
            }
            for (int it = bid - 64; it < 128 * 8; it += 192) { gdn_chunk_item(p, i, 8 + (it >> 3), it & 7, 0, -1, 0, smem); gdn_scan_item(p, i, 8 + (it >> 3), it & 7, nullptr, 0u, smem); }
            convert_ffn_ahead(p, l, (bid - 64) * 8 + wv, 192 * 8, smem);
        }
    } else {
        for (int it = bid; it < 136 * 8; it += G) { const int s = it >> 3, h = it & 7; gdn_scan_item(p, i, s, h, nullptr, 0u, smem); }
        convert_ffn_ahead(p, l, bid * 8 + wv, G * 8, smem);
    }
}

__global__ void __launch_bounds__(512, 2) mega(Params p) {
    extern __shared__ __attribute__((aligned(16))) unsigned char lds[];
    cg::grid_group grid = cg::this_grid();
    constexpr int NPH = 1 + 4 * 12;
    unsigned* bar = (unsigned*)(p.ws + WS_BAR);
    volatile unsigned* bst = (volatile unsigned*)(lds + LDS_BYTES - 16);
    if (mk_ltid() == 0) { bst[0] = 0u; bst[1] = 0u; }
    if (mk_lbid() == 0) for (int u = mk_ltid(); u < CTL_WORDS; u += 512) __hip_atomic_store(bar + u, 0u, __ATOMIC_RELAXED, __HIP_MEMORY_SCOPE_AGENT);
    __syncthreads();
#pragma unroll 1
    for (int ph = 0; ph < NPH; ++ph) {
        int l = (ph == 0) ? 0 : (ph - 1) / 12, k = (ph == 0) ? -1 : (ph - 1) % 12;
        asm volatile("" : "+s"(l), "+s"(k));
        const int i = l >> 1; const bool ab = (l & 1) == 0;
        if (k == 6 && !ab) continue;
        unsigned char* ws = p.ws; asm volatile("" : "+s"(ws));
        unsigned char* smem = (unsigned char*)lds;
        PG8_LAS unsigned char* ldsp = (PG8_LAS unsigned char*)lds;
        const int G = gridDim.x, cu = mk_lbid();
#ifndef REPMASK
#define REPMASK 0
#endif
#ifndef REPAB
#define REPAB 3
#endif
        const int nrep = (((REPMASK >> (k + 1)) & 1) && ((REPAB >> (l & 1)) & 1)) ? 2 : 1;
#pragma unroll 1
        for (int rep = 0; rep < nrep; ++rep) {
        if (rep) grid.sync();
        if (k == -1) phase_start(p, smem);
        else if (k == 0 || k == 9) {
            const int j = (k == 9);
            pg8::Gemm g{(const bf16_t*)(ws + WS_HB), (const bf16_t*)(ws + WS_WGU) + (size_t)j * 5632 * 1024, M, 5632, D};
            pg8::StaticOrder S; S.init(g.M, g.N, G, cu); EpiSwiglu E{(bf16_t*)(ws + WS_HID)};
            pg8::gemm_phase<EpiSwiglu, pg8::StaticOrder, true, true>(ldsp, g, S, E);
        } else if (k == 1 || k == 10 || k == 7) {
            const int j = (k == 10);
            pg8::Gemm g{(const bf16_t*)(ws + (k == 7 ? WS_OMIX : WS_HID)), k == 7 ? (const bf16_t*)(ws + WS_WOUT) : (const bf16_t*)(ws + WS_WD) + (size_t)j * 1024 * 2816, MP, D, k == 7 ? D : FF};
            pg8::StaticOrder S; S.init(g.M, g.N, G, cu); EpiResid E{(bf16_t*)(ws + WS_X), (const bf16_t*)(ws + WS_HB), k == 7 ? 1.0f : 0.5f};
            pg8::gemm_phase<EpiResid, pg8::StaticOrder, true, true>(ldsp, g, S, E);
            small_resid_gemm(g.A, g.Bt, g.K, E.X, E.H, E.scale, smem);
        } else if (k == 2 || k == 8 || k == 11) {
            phase_ln(p, l, k == 2 ? 0 : (k == 8 ? 1 : 2), (l == 3 && k == 11));
            if (k == 11 && l < 3) convert_items(p, l + 1, 4, mk_lbid() * 8 + (mk_ltid() >> 6), gridDim.x * 8, smem);
        } else if (k == 3) {
            pg8::Gemm g{(const bf16_t*)(ws + WS_HB), (const bf16_t*)(ws + WS_WIN), M, ab ? AB_N : GD_N, D};
            pg8::StaticOrder S; S.init(g.M, g.N, G, cu); EpiZ E{(bf16_t*)(ws + WS_ZB), g.N};
            pg8::gemm_phase<EpiZ, pg8::StaticOrder, true, true>(ldsp, g, S, E);
        } else if (k == 4) { if (ab) phase_ab_prep(p, i, smem); else phase_gdn_chunk(p, i, smem); }
        else if (k == 5) { if (ab) phase_ab_core(p, i, l, smem); else phase_gdn_scan(p, i, l, smem); }
        else if (k == 6) phase_ab_post(p, i);
        }
        if (ph + 1 < NPH) { if (ph == 0) { grid.sync(); if (mk_ltid() == 0) (void)xb_add(&bar[XB_XCNT(xb_xcc_id())], 1u); } else gbar(bar, bst); }
#ifdef REPSYNC
        if (ph > 0) { gbar(bar, bst); gbar(bar, bst); }
#endif
    }
}
}

extern "C" void kernel_launch(void* const* d_in, const int* in_sizes, int n_in, void* d_out, int out_size, void* d_ws, size_t ws_size, hipStream_t stream) {
    static int grid_blocks = 0;
    if (grid_blocks == 0) {
        if (n_in != 33 || ws_size < mk::WS_NEED) { fprintf(stderr, "kernel_launch: need 33 inputs and %zu bytes of workspace; got %d, %zu\n", (size_t)mk::WS_NEED, n_in, ws_size); grid_blocks = -1; return; }
        int dev = 0, cus = 0, per_cu = 0;
        hipGetDevice(&dev);
        hipDeviceGetAttribute(&cus, hipDeviceAttributeMultiprocessorCount, dev);
        if (hipFuncSetAttribute((const void*)mk::mega, hipFuncAttributeMaxDynamicSharedMemorySize, mk::LDS_BYTES) != hipSuccess) { fprintf(stderr, "kernel_launch: hipFuncSetAttribute failed\n"); grid_blocks = -1; return; }
        if (hipOccupancyMaxActiveBlocksPerMultiprocessor(&per_cu, (const void*)mk::mega, 512, mk::LDS_BYTES) != hipSuccess || per_cu < 1) { fprintf(stderr, "kernel_launch: occupancy query failed (%d)\n", per_cu); (void)hipGetLastError(); per_cu = 1; }
        grid_blocks = cus * 1;
        fprintf(stderr, "kernel_launch: grid %d (cus %d, per_cu %d)\n", grid_blocks, cus, per_cu);
    }
    if (grid_blocks < 0) return;
    mk::Params prm{};
    for (int k = 0; k < 33; ++k) prm.in[k] = (const float*)d_in[k];
    prm.out = (float*)d_out; prm.ws = (unsigned char*)d_ws;
    void* args[] = {&prm};
    hipError_t e = hipLaunchCooperativeKernel((const void*)mk::mega, dim3(grid_blocks), dim3(512), args, mk::LDS_BYTES, stream);
    if (e != hipSuccess) fprintf(stderr, "cooperative launch failed: %s (grid %d)\n", hipGetErrorString(e), grid_blocks);
}
```
